# Optimizing an MI355X kernel written in HIP

```python
import math
import jax, jax.numpy as jnp
from jax import lax
import numpy as np

D_MODEL = 1024
BATCH = 4
SEQ = 8192
DEPTH = 2

HEAD_DIM = 64
N_MIXERS = 4
GROUP_WIDTH = D_MODEL // N_MIXERS
N_GROUP_HEADS = GROUP_WIDTH // HEAD_DIM
DIFF_HALF = HEAD_DIM // 2
ROPE_THETA = 10000.0
MAX_POS_OFFSET = 4096
Q_BLOCK = 128
MOBA_BLOCK = 256
MOBA_TOPK = 3
MOBA_Q_BLOCK = 32
NSA_CMP_LEN = 32
NSA_CMP_STRIDE = 16
NSA_CMP_HIDDEN = 256
NSA_SEL_BLOCK = 64
NSA_SEL_TOPK = 16
NSA_WINDOW = 512
NSA_N_BRANCH = 3
D_FF = 3584
N_EXPERTS = 8
TOP_K = 2
MOE_ROW_BLOCK = 256
PLE_DIM = 256
LN_EPS = 1e-5
RMS_EPS = 1e-5
DEEPNORM_ALPHA = (2 * DEPTH) ** 0.25
DEEPNORM_BETA = (8 * DEPTH) ** -0.25
IN_SPLITS = (GROUP_WIDTH,) * 10 + (HEAD_DIM,) * 6 + (N_GROUP_HEADS * NSA_N_BRANCH,)
N_IN = sum(IN_SPLITS)

kernel_name = 'hymba_style_sb_diff_moba_nsa_deepnorm_moe'


def layer_norm(x, g, b):
    xf = x.astype(jnp.float32)
    mu = jnp.mean(xf, -1, keepdims=True)
    var = jnp.mean(jnp.square(xf - mu), -1, keepdims=True)
    return ((xf - mu) * lax.rsqrt(var + LN_EPS) * g + b).astype(x.dtype)


def rope(x, positions):
    half = x.shape[-1] // 2
    inv_freq = ROPE_THETA ** (-jnp.arange(half, dtype=jnp.float32) / half)
    ang = positions.astype(jnp.float32)[:, :, None, None] * inv_freq
    cos, sin = jnp.cos(ang), jnp.sin(ang)
    x1 = x[..., :half].astype(jnp.float32)
    x2 = x[..., half:].astype(jnp.float32)
    return jnp.concatenate([x1 * cos - x2 * sin, x2 * cos + x1 * sin], -1).astype(x.dtype)


def split_heads(t, n_heads):
    B, S, _ = t.shape
    return t.reshape(B, S, n_heads, -1).transpose(0, 2, 1, 3)


def merge_heads(t):
    B, H, S, d = t.shape
    return t.transpose(0, 2, 1, 3).reshape(B, S, H * d)


def to_qblocks(t, blk):
    S, d = t.shape[-2], t.shape[-1]
    t = t.reshape(t.shape[:-2] + (S // blk, blk, d))
    return jnp.moveaxis(t, -3, 0)


def from_qblocks(o):
    o = jnp.moveaxis(o, 0, -3)
    return o.reshape(o.shape[:-3] + (o.shape[-3] * o.shape[-2], o.shape[-1]))


def masked_softmax(s, mask):
    s = jnp.where(mask, s, -jnp.inf)
    m = jnp.max(s, axis=-1, keepdims=True)
    m = jnp.where(jnp.isfinite(m), m, 0.0)
    e = jnp.exp(s - m)
    den = jnp.sum(e, axis=-1, keepdims=True)
    return e / jnp.where(den > 0, den, 1.0)


def stick_breaking_attention(q, k, v):
    B, H, S, d = q.shape
    scale = d ** -0.5
    kpos = jnp.arange(S)

    def block(args):
        qb, i = args
        qpos = i * Q_BLOCK + jnp.arange(Q_BLOCK)
        z = jnp.einsum('bhqd,bhkd->bhqk', qb, k).astype(jnp.float32) * scale
        past = kpos[None, :] < qpos[:, None]
        log_1m = jnp.where(past, jax.nn.log_sigmoid(-z), 0.0)
        later = lax.cumsum(log_1m, axis=3, reverse=True) - log_1m
        w = jnp.where(past, jnp.exp(jax.nn.log_sigmoid(z) + later), 0.0)
        return jnp.einsum('bhqk,bhkd->bhqd', w.astype(v.dtype), v)

    return from_qblocks(lax.map(block, (to_qblocks(q, Q_BLOCK), jnp.arange(S // Q_BLOCK))))


def diff_attention(q, k, v, lam, gain, lam_init):
    S, dh = q.shape[-2], q.shape[-1]
    scale = dh ** -0.5
    kpos = jnp.arange(S)

    def block(args):
        qb, i = args
        qpos = i * Q_BLOCK + jnp.arange(Q_BLOCK)
        s = jnp.einsum('bhcqd,bhckd->bhcqk', qb, k).astype(jnp.float32) * scale
        p = jax.nn.softmax(jnp.where(kpos[None, :] <= qpos[:, None], s, -jnp.inf), axis=-1)
        a = p[:, :, 0] - lam * p[:, :, 1]
        return jnp.einsum('bhqk,bhkd->bhqd', a.astype(v.dtype), v)

    o = from_qblocks(lax.map(block, (to_qblocks(q, Q_BLOCK), jnp.arange(S // Q_BLOCK))))
    of = o.astype(jnp.float32)
    of = of * lax.rsqrt(jnp.mean(of * of, -1, keepdims=True) + RMS_EPS) * gain
    return (of * (1.0 - lam_init)).astype(v.dtype)


def moba_attention(q, k, v):
    B, H, S, d = q.shape
    scale = d ** -0.5
    nb = -(-S // MOBA_BLOCK)
    pad = nb * MOBA_BLOCK - S
    kp = jnp.pad(k, ((0, 0), (0, 0), (0, pad), (0, 0)))
    vp = jnp.pad(v, ((0, 0), (0, 0), (0, pad), (0, 0)))
    kb = kp.reshape(B, H, nb, MOBA_BLOCK, d)
    vb = vp.reshape(B, H, nb, MOBA_BLOCK, d)
    k_mean = jnp.mean(kb.astype(jnp.float32), axis=3).astype(k.dtype)
    n_top = min(MOBA_TOPK, nb)
    n_g = n_top * MOBA_BLOCK
    blk_ids = jnp.arange(nb)
    in_blk = jnp.arange(MOBA_BLOCK)
    bi = jnp.arange(B)[:, None, None, None]
    hi = jnp.arange(H)[None, :, None, None]

    def block(args):
        qb, i = args
        q0 = i * MOBA_Q_BLOCK
        qpos = q0 + jnp.arange(MOBA_Q_BLOCK)
        own = q0 // MOBA_BLOCK
        gate = jnp.einsum('bhqd,bhnd->bhqn', qb, k_mean).astype(jnp.float32)
        gate = jnp.where(blk_ids < own, gate, -jnp.inf)
        _, sel = lax.top_k(gate, n_top)
        k_g = kb[bi, hi, sel]
        v_g = vb[bi, hi, sel]
        s_g = jnp.einsum('bhqd,bhqnld->bhqnl', qb, k_g).astype(jnp.float32) * scale
        m_g = jnp.broadcast_to((sel < own)[..., None], s_g.shape)
        k_o = lax.dynamic_slice_in_dim(kp, own * MOBA_BLOCK, MOBA_BLOCK, axis=2)
        v_o = lax.dynamic_slice_in_dim(vp, own * MOBA_BLOCK, MOBA_BLOCK, axis=2)
        s_o = jnp.einsum('bhqd,bhld->bhql', qb, k_o).astype(jnp.float32) * scale
        m_o = jnp.broadcast_to((own * MOBA_BLOCK + in_blk)[None, :] <= qpos[:, None], s_o.shape)
        p = masked_softmax(jnp.concatenate([s_g.reshape(B, H, MOBA_Q_BLOCK, n_g), s_o], -1),
                           jnp.concatenate([m_g.reshape(B, H, MOBA_Q_BLOCK, n_g), m_o], -1)).astype(v.dtype)
        return (jnp.einsum('bhqnl,bhqnld->bhqd', p[..., :n_g].reshape(s_g.shape), v_g)
                + jnp.einsum('bhql,bhld->bhqd', p[..., n_g:], v_o))

    return from_qblocks(lax.map(block, (to_qblocks(q, MOBA_Q_BLOCK), jnp.arange(S // MOBA_Q_BLOCK))))


def compress_blocks(t, pos_enc, w1, w2):
    B, S, d = t.shape
    n_span = NSA_CMP_LEN // NSA_CMP_STRIDE
    c = t.reshape(B, S // NSA_CMP_STRIDE, NSA_CMP_STRIDE, d)
    n_chunks = c.shape[1]
    blocks = jnp.concatenate([c[:, j:n_chunks - n_span + 1 + j] for j in range(n_span)], axis=2)
    blocks = (blocks + pos_enc).reshape(B, n_chunks - n_span + 1, NSA_CMP_LEN * d)
    return jax.nn.silu(blocks @ w1) @ w2


def nsa_attention(q, qr, kc_tok, vc_tok, ks, vs, kw, vw, gates, cmp_pos, cmp_w1, cmp_w2):
    B, S, H, d = q.shape
    scale = d ** -0.5
    kc = compress_blocks(kc_tok, cmp_pos[0], cmp_w1[0], cmp_w2[0])
    vc = compress_blocks(vc_tok, cmp_pos[1], cmp_w1[1], cmp_w2[1])
    n_cmp = kc.shape[1]
    cmp_start = jnp.arange(n_cmp) * NSA_CMP_STRIDE
    cmp_end = cmp_start + NSA_CMP_LEN - 1
    n_sel = S // NSA_SEL_BLOCK
    k_top = min(NSA_SEL_TOPK, n_sel)
    sel_start = jnp.arange(n_sel) * NSA_SEL_BLOCK
    overlap = ((cmp_start[:, None] < sel_start[None, :] + NSA_SEL_BLOCK)
               & (cmp_start[:, None] + NSA_CMP_LEN > sel_start[None, :])).astype(jnp.float32)
    ksb = ks.reshape(B, n_sel, NSA_SEL_BLOCK, d)
    vsb = vs.reshape(B, n_sel, NSA_SEL_BLOCK, d)
    kw_pad = jnp.pad(kw, ((0, 0), (NSA_WINDOW, 0), (0, 0)))
    vw_pad = jnp.pad(vw, ((0, 0), (NSA_WINDOW, 0), (0, 0)))
    bi = jnp.arange(B)[:, None, None]
    sel_ids = jnp.arange(n_sel)
    in_blk = jnp.arange(NSA_SEL_BLOCK)
    win_off = jnp.arange(NSA_WINDOW + Q_BLOCK)

    def block(args):
        qb, qrb, gb, i = args
        q0 = i * Q_BLOCK
        qpos = q0 + jnp.arange(Q_BLOCK)
        s_c = jnp.einsum('bhqd,bnd->bhqn', qb, kc).astype(jnp.float32) * scale
        p_c = masked_softmax(s_c, cmp_end[None, :] <= qpos[:, None])
        o_c = jnp.einsum('bhqn,bnd->bhqd', p_c.astype(vc.dtype), vc)
        imp = jnp.einsum('bhqn,nm->bqm', p_c, overlap)
        qblk = qpos // NSA_SEL_BLOCK
        causal_blk = sel_ids[None, :] <= qblk[:, None]
        forced = (sel_ids[None, :] == 0) | (sel_ids[None, :] == qblk[:, None]) | (sel_ids[None, :] == qblk[:, None] - 1)
        imp = jnp.where(forced, jnp.inf, jnp.where(causal_blk, imp, -jnp.inf))
        _, sel = lax.top_k(imp, k_top)
        k_g = ksb[bi, sel]
        v_g = vsb[bi, sel]
        kpos = sel[..., None] * NSA_SEL_BLOCK + in_blk
        mask_s = (sel <= qblk[None, :, None])[..., None] & (kpos <= qpos[None, :, None, None])
        s_s = jnp.einsum('bhqd,bqnld->bhqnl', qrb, k_g).astype(jnp.float32) * scale
        p_s = masked_softmax(s_s.reshape(B, H, Q_BLOCK, -1), mask_s.reshape(B, 1, Q_BLOCK, -1))
        o_s = jnp.einsum('bhqnl,bqnld->bhqd', p_s.reshape(s_s.shape).astype(v_g.dtype), v_g)
        k_w = lax.dynamic_slice_in_dim(kw_pad, q0, NSA_WINDOW + Q_BLOCK, axis=1)
        v_w = lax.dynamic_slice_in_dim(vw_pad, q0, NSA_WINDOW + Q_BLOCK, axis=1)
        kpos_w = q0 - NSA_WINDOW + win_off
        mask_w = ((kpos_w[None, :] >= 0) & (kpos_w[None, :] <= qpos[:, None])
                  & (kpos_w[None, :] > qpos[:, None] - NSA_WINDOW))
        s_w = jnp.einsum('bhqd,bkd->bhqk', qrb, k_w).astype(jnp.float32) * scale
        p_w = masked_softmax(s_w, mask_w)
        o_w = jnp.einsum('bhqk,bkd->bhqd', p_w.astype(v_w.dtype), v_w)
        return gb[..., 0:1] * o_c + gb[..., 1:2] * o_s + gb[..., 2:3] * o_w

    qt = q.transpose(0, 2, 1, 3)
    qrt = qr.transpose(0, 2, 1, 3)
    gt = gates.transpose(0, 2, 1, 3)
    out = lax.map(block, (to_qblocks(qt, Q_BLOCK), to_qblocks(qrt, Q_BLOCK), to_qblocks(gt, Q_BLOCK),
                          jnp.arange(S // Q_BLOCK)))
    return from_qblocks(out)


def token_mixer(h, positions, w_in, w_out, diff_lambda, diff_gain, cmp_pos, cmp_w1, cmp_w2, layer_idx):
    B, S, _ = h.shape
    H = N_GROUP_HEADS
    proj = jnp.einsum('bsd,dn->bsn', h, w_in)
    points = [int(v) for v in np.cumsum(IN_SPLITS)[:-1]]
    (a_q, a_k, a_v, b_q, b_k, b_v, c_q, c_k, c_v, d_q,
     d_kc, d_vc, d_ks, d_vs, d_kw, d_vw, d_g) = jnp.split(proj, points, axis=-1)
    o_a = stick_breaking_attention(split_heads(a_q, H), split_heads(a_k, H), split_heads(a_v, H))
    bq = rope(b_q.reshape(B, S, 2 * H, DIFF_HALF), positions).reshape(B, S, H, 2, DIFF_HALF).transpose(0, 2, 3, 1, 4)
    bk = rope(b_k.reshape(B, S, 2 * H, DIFF_HALF), positions).reshape(B, S, H, 2, DIFF_HALF).transpose(0, 2, 3, 1, 4)
    lam_init = 0.8 - 0.6 * math.exp(-0.3 * layer_idx)
    lf = diff_lambda.astype(jnp.float32)
    lam = jnp.exp(jnp.sum(lf[0] * lf[1])) - jnp.exp(jnp.sum(lf[2] * lf[3])) + lam_init
    o_b = diff_attention(bq, bk, split_heads(b_v, H), lam, diff_gain, lam_init)
    cq = rope(c_q.reshape(B, S, H, HEAD_DIM), positions).transpose(0, 2, 1, 3)
    ck = rope(c_k.reshape(B, S, H, HEAD_DIM), positions).transpose(0, 2, 1, 3)
    o_c = moba_attention(cq, ck, split_heads(c_v, H))
    dq = d_q.reshape(B, S, H, HEAD_DIM)
    ks_r = rope(d_ks.reshape(B, S, 1, HEAD_DIM), positions).reshape(B, S, HEAD_DIM)
    kw_r = rope(d_kw.reshape(B, S, 1, HEAD_DIM), positions).reshape(B, S, HEAD_DIM)
    gates = jax.nn.sigmoid(d_g.astype(jnp.float32)).astype(h.dtype).reshape(B, S, H, NSA_N_BRANCH)
    o_d = nsa_attention(dq, rope(dq, positions), d_kc, d_vc, ks_r, d_vs, kw_r, d_vw, gates, cmp_pos, cmp_w1, cmp_w2)
    mixed = jnp.concatenate([merge_heads(o_a), merge_heads(o_b), merge_heads(o_c), merge_heads(o_d)], -1)
    return jnp.einsum('bsn,nd->bsd', mixed, w_out)


def swiglu(x, w1, w3, w2):
    return (jax.nn.silu(x @ w1) * (x @ w3)) @ w2


def moe_swiglu(x, w_router, w1, w3, w2):
    B, S, D = x.shape
    T = B * S
    xf = x.reshape(T, D)
    logits = (xf @ w_router).astype(jnp.float32)
    top_logits, top_e = lax.top_k(logits, TOP_K)
    gates = jax.nn.softmax(top_logits, axis=-1).astype(x.dtype)
    flat_e = top_e.reshape(-1)
    order = jnp.argsort(flat_e)
    e_sorted = flat_e[order]
    tok_sorted = order // TOP_K
    gate_sorted = gates.reshape(-1)[order]
    counts = jnp.bincount(flat_e, length=N_EXPERTS)
    padded = (counts + MOE_ROW_BLOCK - 1) // MOE_ROW_BLOCK * MOE_ROW_BLOCK
    start = jnp.cumsum(counts) - counts
    pad_end = jnp.cumsum(padded)
    pad_start = pad_end - padded
    dest = pad_start[e_sorted] + jnp.arange(T * TOP_K) - start[e_sorted]
    n_rows = T * TOP_K + N_EXPERTS * MOE_ROW_BLOCK
    n_blk = n_rows // MOE_ROW_BLOCK
    row_tok = jnp.zeros((n_rows,), jnp.int32).at[dest].set(tok_sorted)
    blk_e = jnp.minimum(jnp.searchsorted(pad_end, jnp.arange(n_blk) * MOE_ROW_BLOCK, side='right'), N_EXPERTS - 1)
    xb = xf[row_tok].reshape(n_blk, MOE_ROW_BLOCK, D)

    def expert_block(args):
        xblk, e = args
        return swiglu(xblk, w1[e], w3[e], w2[e])

    y = lax.map(expert_block, (xb, blk_e)).reshape(n_rows, D)
    out = jnp.zeros((T, D), x.dtype).at[tok_sorted].add(y[dest] * gate_sorted[:, None])
    return out.reshape(B, S, D)


def setup_inputs(seed: int = 0) -> dict:
    key = jax.random.key(seed)
    ks = jax.random.split(key, 24)
    f32 = jnp.float32
    n_dense = (DEPTH + 1) // 2
    n_moe = DEPTH // 2

    def nrm(k, shape, scale):
        return jax.random.normal(k, shape, f32) * scale

    offsets = jax.random.randint(ks[2], (BATCH, 1), 0, MAX_POS_OFFSET, dtype=jnp.int32)
    return {
        'x': nrm(ks[0], (BATCH, SEQ, D_MODEL), 1.0),
        'p': nrm(ks[1], (DEPTH, BATCH, SEQ, PLE_DIM), 1.0),
        'positions': offsets + jnp.arange(SEQ, dtype=jnp.int32)[None, :],
        'w_in': nrm(ks[3], (DEPTH, D_MODEL, N_IN), D_MODEL ** -0.5),
        'w_out': nrm(ks[4], (DEPTH, D_MODEL, D_MODEL), D_MODEL ** -0.5 * DEEPNORM_BETA),
        'ln_mix_g': 1.0 + nrm(ks[5], (DEPTH, D_MODEL), 0.02),
        'ln_mix_b': nrm(ks[6], (DEPTH, D_MODEL), 0.02),
        'diff_lambda': nrm(ks[7], (DEPTH, 4, DIFF_HALF), 0.1),
        'diff_gain': 1.0 + nrm(ks[8], (DEPTH, HEAD_DIM), 0.02),
        'nsa_cmp_pos': nrm(ks[9], (DEPTH, 2, NSA_CMP_LEN, HEAD_DIM), 0.1),
        'nsa_cmp_w1': nrm(ks[10], (DEPTH, 2, NSA_CMP_LEN * HEAD_DIM, NSA_CMP_HIDDEN), (NSA_CMP_LEN * HEAD_DIM) ** -0.5),
        'nsa_cmp_w2': nrm(ks[11], (DEPTH, 2, NSA_CMP_HIDDEN, HEAD_DIM), NSA_CMP_HIDDEN ** -0.5),
        'ffn_w1': nrm(ks[12], (n_dense, D_MODEL, D_FF), D_MODEL ** -0.5),
        'ffn_w3': nrm(ks[13], (n_dense, D_MODEL, D_FF), D_MODEL ** -0.5),
        'ffn_w2': nrm(ks[14], (n_dense, D_FF, D_MODEL), D_FF ** -0.5 * DEEPNORM_BETA),
        'moe_router': nrm(ks[15], (n_moe, D_MODEL, N_EXPERTS), D_MODEL ** -0.5),
        'moe_w1': nrm(ks[16], (n_moe, N_EXPERTS, D_MODEL, D_FF), D_MODEL ** -0.5),
        'moe_w3': nrm(ks[17], (n_moe, N_EXPERTS, D_MODEL, D_FF), D_MODEL ** -0.5),
        'moe_w2': nrm(ks[18], (n_moe, N_EXPERTS, D_FF, D_MODEL), D_FF ** -0.5 * DEEPNORM_BETA),
        'ln_ffn_g': 1.0 + nrm(ks[19], (DEPTH, D_MODEL), 0.02),
        'ln_ffn_b': nrm(ks[20], (DEPTH, D_MODEL), 0.02),
        'ple_proj': nrm(ks[21], (DEPTH, PLE_DIM, D_MODEL), PLE_DIM ** -0.5),
        'ple_gate': nrm(ks[22], (DEPTH, D_MODEL, D_MODEL), D_MODEL ** -0.5),
    }


def reference(x, p, positions, w_in, w_out, ln_mix_g, ln_mix_b, diff_lambda, diff_gain,
              nsa_cmp_pos, nsa_cmp_w1, nsa_cmp_w2, ffn_w1, ffn_w3, ffn_w2,
              moe_router, moe_w1, moe_w3, moe_w2, ln_ffn_g, ln_ffn_b, ple_proj, ple_gate):
    h = x
    for i in range(DEPTH):
        mix = token_mixer(h, positions, w_in[i], w_out[i], diff_lambda[i], diff_gain[i],
                          nsa_cmp_pos[i], nsa_cmp_w1[i], nsa_cmp_w2[i], i)
        h = layer_norm(DEEPNORM_ALPHA * h + mix, ln_mix_g[i], ln_mix_b[i])
        if i % 2 == 0:
            f = swiglu(h, ffn_w1[i // 2], ffn_w3[i // 2], ffn_w2[i // 2])
        else:
            f = moe_swiglu(h, moe_router[i // 2], moe_w1[i // 2], moe_w3[i // 2], moe_w2[i // 2])
        h = layer_norm(DEEPNORM_ALPHA * h + f, ln_ffn_g[i], ln_ffn_b[i])
        h = h + jax.nn.sigmoid(h @ ple_gate[i]) * (p[i] @ ple_proj[i])
    return h
```

```cpp
#include <hip/hip_runtime.h>
#include <cstdio>
#include <cstdint>

#ifndef PHMASK
#define PHMASK 0xFFFF
#endif
#ifndef ATTMASK
#define ATTMASK 0xF
#endif
#ifndef MK_MULTI
#define MK_MULTI 0
#endif

#define LAS __attribute__((address_space(3)))
#define GAS __attribute__((address_space(1)))
typedef unsigned short bf16_t;
typedef short bf16x8 __attribute__((ext_vector_type(8)));
typedef short s16x4 __attribute__((ext_vector_type(4)));
typedef float f32x2 __attribute__((ext_vector_type(2)));
typedef float f32x4 __attribute__((ext_vector_type(4)));
typedef float f32x16 __attribute__((ext_vector_type(16)));
typedef unsigned u32x2 __attribute__((ext_vector_type(2)));
typedef unsigned u32x4 __attribute__((ext_vector_type(4)));
typedef __bf16 bf16x2_t __attribute__((ext_vector_type(2)));

constexpr int NB = 4, SEQ = 8192, NT = NB * SEQ, DM = 1024, NIN = 2956, NINP = 3072, DFF = 3584, NEXP = 8, PLE = 256, DEPTH = 2;
constexpr int NCMP = 512;
constexpr float LOG2E = 1.4426950408889634f;
constexpr float ALPHA = 1.4142135623730951f;
constexpr float LN_EPS = 1e-5f, RMS_EPS = 1e-5f;
constexpr float QS64 = 0.125f * LOG2E;
constexpr float QS32 = 0.17677669529663687f * LOG2E;
constexpr int C_AQ = 0, C_AK = 256, C_AV = 512, C_BQ = 768, C_BK = 1024, C_BV = 1280, C_CQ = 1536, C_CK = 1792, C_CV = 2048, C_DQ = 2304;
constexpr int C_KC = 2560, C_VC = 2624, C_KS = 2688, C_VS = 2752, C_KW = 2816, C_VW = 2880, C_G = 2944;

constexpr size_t MiB = 1u << 20;
constexpr size_t WS_CTL = 0, CTL_ZERO_BYTES = 1 * MiB;
constexpr size_t WS_MISC = 1 * MiB;
constexpr size_t OFF_LAM = 0;
constexpr size_t OFF_C1 = 4096;
constexpr size_t OFF_KMEAN = 16384;
constexpr size_t OFF_KC = 128 * 1024;
constexpr size_t OFF_VC = 384 * 1024;
constexpr size_t OFF_GATES = 1 * MiB;
constexpr size_t OFF_MOEG = 3 * MiB;
constexpr size_t OFF_LIST = 4 * MiB;
constexpr size_t OFF_HID = 5 * MiB;
constexpr size_t WS_ROPE = 11 * MiB;
constexpr size_t WS_W = 23 * MiB;
constexpr size_t W_IN = 0;
constexpr size_t W_OUT = W_IN + (size_t)DEPTH * NINP * DM * 2;
constexpr size_t W_PG = W_OUT + (size_t)DEPTH * DM * DM * 2;
constexpr size_t W_PP = W_PG + (size_t)DEPTH * DM * DM * 2;
constexpr size_t W_C1 = W_PP + (size_t)DEPTH * DM * PLE * 2;
constexpr size_t W_F13 = W_C1 + (size_t)DEPTH * 2 * 256 * 2048 * 2;
constexpr size_t W_F2 = W_F13 + (size_t)9 * 2 * DFF * DM * 2;
constexpr size_t W_END = W_F2 + (size_t)9 * DM * DFF * 2;
constexpr size_t WS_HB = WS_W + ((W_END + MiB - 1) / MiB) * MiB;
constexpr size_t WS_PB = WS_HB + 64 * MiB;
constexpr size_t WS_R = WS_PB + 16 * MiB;
constexpr size_t R_PROJ = 0;
constexpr size_t R_QR = 193 * MiB;
constexpr size_t R_MIXED = 209 * MiB;
constexpr size_t R_HID = 0;
constexpr size_t R_H2 = 0;
constexpr size_t R_P = 128 * MiB;
constexpr size_t WS_END = WS_R + 274 * MiB;
constexpr int CW_BAR = 4096, CW_CNT = 8192;

__device__ __forceinline__ unsigned pk2(float lo, float hi) { f32x2 v = {lo, hi}; bf16x2_t b = __builtin_convertvector(v, bf16x2_t); return __builtin_bit_cast(unsigned, b); }
__device__ __forceinline__ float bflo(unsigned w) { return __uint_as_float(w << 16); }
__device__ __forceinline__ float bfhi(unsigned w) { return __uint_as_float(w & 0xffff0000u); }
__device__ __forceinline__ float wave_sum(float v) {
#pragma unroll
    for (int o = 1; o < 64; o <<= 1) v += __shfl_xor(v, o);
    return v;
}
__device__ __forceinline__ float wave_max(float v) {
#pragma unroll
    for (int o = 1; o < 64; o <<= 1) v = fmaxf(v, __shfl_xor(v, o));
    return v;
}
__device__ __forceinline__ unsigned wave_or(unsigned v) {
#pragma unroll
    for (int o = 1; o < 64; o <<= 1) v |= (unsigned)__shfl_xor((int)v, o);
    return v;
}
__device__ __forceinline__ float xhalf(float x) { const unsigned u = __float_as_uint(x); auto rr = __builtin_amdgcn_permlane32_swap(u, u, false, false); return __uint_as_float(rr[0] ^ rr[1] ^ u); }
__device__ __forceinline__ float ex2(float x) { return __builtin_amdgcn_exp2f(x); }
__device__ __forceinline__ float lg2(float x) { return __builtin_amdgcn_logf(x); }
__device__ __forceinline__ float sigmoidf_(float x) { return 1.0f / (1.0f + __expf(-x)); }
__device__ __forceinline__ float quad_sum(float x) {
    x += __builtin_bit_cast(float, __builtin_amdgcn_update_dpp(0, __builtin_bit_cast(int, x), 0xB1, 0xF, 0xF, true));
    x += __builtin_bit_cast(float, __builtin_amdgcn_update_dpp(0, __builtin_bit_cast(int, x), 0x4E, 0xF, 0xF, true));
    return x;
}

#define XB_TMO      128
#define XB_XCNT(j)  (256  + 64 * (j))
#define XB_XSUB(j)  (1280 + 64 * (j))
#define XB_XGEN(j)  (2304 + 64 * (j))
#define XB_TOP      3328
#define XB_TOPGEN   3392
#define XCD_BAR_WORDS 3456
#define XB_SPIN_CAP (1u << 18)
__device__ __forceinline__ unsigned xb_ld(unsigned* p)              { return __hip_atomic_load(p, __ATOMIC_RELAXED, __HIP_MEMORY_SCOPE_AGENT); }
__device__ __forceinline__ unsigned xb_add(unsigned* p, unsigned v) { return __hip_atomic_fetch_add(p, v, __ATOMIC_RELAXED, __HIP_MEMORY_SCOPE_AGENT); }
__device__ __forceinline__ unsigned xb_xcc_id() { return (unsigned)__builtin_amdgcn_s_getreg((3 << 11) | 20) & 0xFu; }
#define XB_SPIN(cond, bar) do { unsigned _sp = 0; while (cond) { __builtin_amdgcn_s_sleep(1); \
    if ((++_sp & 255u) == 0u) { if (xb_ld(&(bar)[XB_TMO])) break; if (_sp > XB_SPIN_CAP) { atomicAdd(&(bar)[XB_TMO], 1u); break; } } } } while (0)
struct XcdBarrier { unsigned* bar; unsigned x; volatile LAS unsigned* st; };
__device__ __forceinline__ XcdBarrier xcd_barrier_post(unsigned* bar, volatile LAS unsigned* st) {
    XcdBarrier b; b.bar = bar; b.x = xb_xcc_id(); b.st = st;
    if (threadIdx.x == 0) (void)xb_add(&bar[XB_XCNT(b.x)], 1u);
    return b;
}
__device__ __forceinline__ void xcd_barrier_complete(unsigned* bar, unsigned x, unsigned& nloc, unsigned& nx) {
    const unsigned G = gridDim.x * gridDim.y * gridDim.z;
    unsigned sum, cnt, mine, sp = 0u;
    for (;;) {
        sum = 0u; cnt = 0u; mine = 0u;
#pragma unroll
        for (unsigned j = 0; j < 16; ++j) { const unsigned c = xb_ld(&bar[XB_XCNT(j)]); sum += c; cnt += (c > 0u) ? 1u : 0u; mine = (j == x) ? c : mine; }
        if (sum == G) break;
        __builtin_amdgcn_s_sleep(1);
        if ((++sp & 255u) == 0u) { if (xb_ld(&bar[XB_TMO])) break; if (sp > XB_SPIN_CAP) { atomicAdd(&bar[XB_TMO], 1u); break; } }
    }
    nloc = mine > 0u ? mine : 1u; nx = cnt > 0u ? cnt : 1u;
}
__device__ __forceinline__ void xcd_barrier(const XcdBarrier& b) {
    asm volatile("s_waitcnt vmcnt(0)" ::: "memory");
    __syncthreads();
    if (threadIdx.x == 0) {
        unsigned* bar = b.bar;
        __builtin_amdgcn_s_waitcnt(0);
        unsigned nloc = b.st[0], nx = b.st[1];
        if (nloc == 0u) { xcd_barrier_complete(bar, b.x, nloc, nx); b.st[0] = nloc; b.st[1] = nx; }
        const unsigned old = xb_add(&bar[XB_XSUB(b.x)], 1u);
        const unsigned gen = old / nloc;
        if (old + 1u == (gen + 1u) * nloc) {
            __builtin_amdgcn_fence(__ATOMIC_RELEASE, "agent");
            asm volatile("s_waitcnt vmcnt(0)" ::: "memory");
            const unsigned og = xb_add(&bar[XB_TOP], 1u);
            const unsigned tg = og / nx;
            if (og + 1u == (tg + 1u) * nx) xb_add(&bar[XB_TOPGEN], 1u);
            else XB_SPIN(xb_ld(&bar[XB_TOPGEN]) == tg, bar);
            __builtin_amdgcn_fence(__ATOMIC_ACQUIRE, "agent");
            xb_add(&bar[XB_XGEN(b.x)], 1u);
            asm volatile("s_waitcnt vmcnt(0)" ::: "memory");
        } else {
            XB_SPIN(xb_ld(&bar[XB_XGEN(b.x)]) == gen, bar);
            __builtin_amdgcn_fence(__ATOMIC_ACQUIRE, "agent");
            asm volatile("s_waitcnt vmcnt(0)" ::: "memory");
        }
    }
    __syncthreads();
}

namespace pg8 {
constexpr int BM = 256, BK = 64, HALF = 128, HTB = HALF * BK * 2, STAGE_BYTES = 8 * HTB, NXCD = 8, WGM = 8;
__host__ __device__ __forceinline__ int lds_byte(int r, int c) { const int st = (r >> 4) * 2 + (c >> 5), rr = r & 15, cc = c & 31, ob = rr * 64 + cc * 2; return st * 1024 + (ob ^ (((ob >> 9) & 1) << 5)); }
__host__ __device__ __forceinline__ void stage_rc(int b, int& R, int& C) { const int st = b / 1024, sb = b % 1024, swz = sb ^ (((sb >> 9) & 1) << 5); R = (st >> 1) * 16 + swz / 64; C = (st & 1) * 32 + (swz % 64) / 2; }
__host__ __device__ __forceinline__ int perm32(int rho) { const int n = rho >> 4, i = rho & 15; return 8 * (i >> 2) + 4 * n + (i & 3); }
struct Unit { int pm, pn, pb; };
struct Gemm { const bf16_t* A; const bf16_t* Bt; int K; unsigned kstepA; };

struct StaticOrder {
    int nM, nN, nwg, G, c; unsigned ldaB;
    __device__ void init(int M, int N, int G_, int c_, int lda) { nM = M / BM; nN = N / BM; nwg = nM * nN; G = G_; c = c_; ldaB = (unsigned)lda * 2u; }
    __device__ bool next(int i, Unit& u) const {
        const long L = (long)i * G + c; if (L >= nwg) return false;
        int wgid = (int)L; { const int q = nwg / NXCD, r = nwg % NXCD, xcd = wgid % NXCD, off = wgid / NXCD; wgid = (xcd < r ? xcd * (q + 1) : r * (q + 1) + (xcd - r) * q) + off; }
        const int nig = WGM * nN, gid = wgid / nig, fm = gid * WGM, gsz = (nM - fm) < WGM ? (nM - fm) : WGM;
        u.pm = fm + ((wgid % nig) % gsz); u.pn = (wgid % nig) / gsz; u.pb = u.pn; return true;
    }
    __device__ __forceinline__ unsigned arow(const Unit& u, int r) const { return (unsigned)(u.pm * BM + r) * ldaB; }
};

template <class Epi, class Sched>
__device__ __forceinline__ void gemm_phase(LAS unsigned char* lds, const Gemm g, const Sched& S, const Epi& E, const int tid) {
    const int wid = __builtin_amdgcn_readfirstlane(tid >> 6), lane = tid & 63, wr = wid >> 2, wc = wid & 3, fr = lane & 15, fq = lane >> 4;
    const int K = g.K, nt = K / BK;
    int Rr[2], Cc[2]; unsigned voffB[2];
#pragma unroll
    for (int i = 0; i < 2; ++i) { stage_rc(tid * 16 + i * 8192, Rr[i], Cc[i]); const int Rb = Epi::PERM ? ((Rr[i] & ~31) + perm32(Rr[i] & 31)) : Rr[i]; voffB[i] = (unsigned)(Rb * K + Cc[i]) * 2u; }
    const size_t kstepB = (size_t)(BK * 2), kstepA = (size_t)g.kstepA;
    const size_t hstepB = (size_t)HALF * K * 2, tstepB = 2 * hstepB;
    const unsigned ldsw = (unsigned)wid * 1024u;
    const int aoff = lds_byte(wr * 64 + fr, fq * 8), boff = lds_byte(wc * 32 + fr, fq * 8);
#define PG8_SA(b, h) (((b) * 2 + (h)) * HTB)
#define PG8_SB(b, h) ((4 + (b) * 2 + (h)) * HTB)
#define PG8_STAGE(bufoff, gbase, voff) do { _Pragma("unroll") for (int _i = 0; _i < 2; ++_i) \
        __builtin_amdgcn_global_load_lds((const unsigned*)((const char*)(gbase) + (voff)[_i]), (LAS unsigned*)(lds + (bufoff) + ldsw + _i * 8192), 16, 0, 0); } while (0)
#define PG8_LDA(dst, b, h) do { _Pragma("unroll") for (int m = 0; m < 4; ++m) _Pragma("unroll") for (int k = 0; k < 2; ++k) dst[m][k] = *(const LAS bf16x8*)(lds + PG8_SA(b, h) + aoff + m * 2048 + k * 1024); } while (0)
#define PG8_LDB(dst, b, h) do { _Pragma("unroll") for (int n = 0; n < 2; ++n) _Pragma("unroll") for (int k = 0; k < 2; ++k) dst[n][k] = *(const LAS bf16x8*)(lds + PG8_SB(b, h) + boff + n * 2048 + k * 1024); } while (0)
#define PG8_MMA(ai, bj, At, Bt) do { __builtin_amdgcn_s_setprio(1); _Pragma("unroll") for (int m = 0; m < 4; ++m) _Pragma("unroll") for (int n = 0; n < 2; ++n) _Pragma("unroll") for (int k = 0; k < 2; ++k) \
        acc[ai][bj][m][n] = __builtin_amdgcn_mfma_f32_16x16x32_bf16(Bt[n][k], At[m][k], acc[ai][bj][m][n], 0, 0, 0); __builtin_amdgcn_s_setprio(0); } while (0)
#define PG8_WAIT_V(n) asm volatile("s_waitcnt vmcnt(" #n ")" ::: "memory")
#define PG8_WAIT_L(n) asm volatile("s_waitcnt lgkmcnt(" #n ")" ::: "memory")
#define PG8_BAR __builtin_amdgcn_s_barrier()
#define PG8_SCHED __builtin_amdgcn_sched_barrier(0)
    Unit cur, nxt; int ui = 0;
    if (!S.next(0, cur)) return;
    f32x4 acc[2][2][4][2];
#pragma unroll
    for (int a = 0; a < 2; ++a)
#pragma unroll
        for (int b = 0; b < 2; ++b)
#pragma unroll
            for (int m = 0; m < 4; ++m)
#pragma unroll
                for (int n = 0; n < 2; ++n) acc[a][b][m][n] = (f32x4){0.f, 0.f, 0.f, 0.f};
    bf16x8 At[4][2], B0[2][2], B1[2][2];
    unsigned vc0[2], vc1[2];
    LAS u32x4* const stash = (LAS u32x4*)(lds + 133120 + tid * 16);
#pragma unroll
    for (int i = 0; i < 2; ++i) { vc0[i] = S.arow(cur, Rr[i]) + (unsigned)Cc[i] * 2u; vc1[i] = S.arow(cur, HALF + Rr[i]) + (unsigned)Cc[i] * 2u; }
    const char* const Ab = (const char*)g.A;
    const char* cB = (const char*)g.Bt + (size_t)cur.pb * tstepB;
    PG8_STAGE(PG8_SB(0, 0), cB, voffB); PG8_STAGE(PG8_SB(0, 1), cB + hstepB, voffB); PG8_STAGE(PG8_SA(0, 0), Ab, vc0); PG8_STAGE(PG8_SA(0, 1), Ab, vc1);
    if (wr == 1) PG8_BAR;
    PG8_WAIT_V(2); PG8_BAR;
    PG8_STAGE(PG8_SB(1, 0), cB + kstepB, voffB); PG8_STAGE(PG8_SA(1, 0), Ab + kstepA, vc0); PG8_STAGE(PG8_SB(1, 1), cB + hstepB + kstepB, voffB);
    PG8_WAIT_V(6); PG8_BAR;
    for (;;) {
        const bool has_next = S.next(ui + 1, nxt);
        if (!has_next) nxt = cur;
        { u32x4 sv; sv.x = S.arow(nxt, Rr[0]) + (unsigned)Cc[0] * 2u; sv.y = S.arow(nxt, Rr[1]) + (unsigned)Cc[1] * 2u; sv.z = S.arow(nxt, HALF + Rr[0]) + (unsigned)Cc[0] * 2u; sv.w = S.arow(nxt, HALF + Rr[1]) + (unsigned)Cc[1] * 2u; *stash = sv; }
        const char* nB = (const char*)g.Bt + (size_t)nxt.pb * tstepB;
        for (int t = 0; t < nt; t += 2) {
            const bool last = (t == nt - 2);
            const char* a1 = Ab + (size_t)(t + 1) * kstepA;
            const char* a2 = last ? Ab : Ab + (size_t)(t + 2) * kstepA; const char* b2 = last ? nB : cB + (size_t)(t + 2) * kstepB;
            const char* a3 = a2 + kstepA; const char* b3 = b2 + kstepB;
            PG8_LDB(B0, 0, 0); PG8_LDB(B1, 0, 1); PG8_SCHED; PG8_LDA(At, 0, 0); PG8_STAGE(PG8_SA(1, 1), a1, vc1);
            if (last) { const u32x4 sv = *stash; vc0[0] = sv.x; vc0[1] = sv.y; vc1[0] = sv.z; vc1[1] = sv.w; }
            PG8_WAIT_V(8); PG8_WAIT_L(0); PG8_BAR; PG8_MMA(0, 0, At, B0); PG8_MMA(0, 1, At, B1); PG8_BAR; PG8_SCHED;
            PG8_LDA(At, 0, 1); PG8_STAGE(PG8_SB(0, 0), b2, voffB); PG8_STAGE(PG8_SB(0, 1), b2 + hstepB, voffB); PG8_STAGE(PG8_SA(0, 0), a2, vc0);
            PG8_WAIT_V(8); PG8_WAIT_L(0); PG8_BAR; PG8_MMA(1, 0, At, B0); PG8_MMA(1, 1, At, B1); PG8_BAR; PG8_SCHED;
            PG8_LDB(B0, 1, 0); PG8_LDB(B1, 1, 1); PG8_SCHED; PG8_LDA(At, 1, 0); PG8_STAGE(PG8_SA(0, 1), a2, vc1);
            PG8_WAIT_V(8); PG8_WAIT_L(0); PG8_BAR; PG8_MMA(0, 0, At, B0); PG8_MMA(0, 1, At, B1); PG8_BAR; PG8_SCHED;
            PG8_LDA(At, 1, 1); PG8_STAGE(PG8_SB(1, 0), b3, voffB); PG8_STAGE(PG8_SB(1, 1), b3 + hstepB, voffB); PG8_STAGE(PG8_SA(1, 0), a3, vc0);
            PG8_WAIT_V(8); PG8_WAIT_L(0); PG8_BAR; PG8_MMA(1, 0, At, B0); PG8_MMA(1, 1, At, B1); PG8_BAR; PG8_SCHED;
        }
        if (wr == 0) PG8_BAR;
        { int fr_e = fr, fq_e = fq; asm volatile("" : "+v"(fr_e), "+v"(fq_e)); E(acc, cur, wr, wc, fr_e, fq_e); }
        if (!has_next) break;
#pragma unroll
        for (int a = 0; a < 2; ++a)
#pragma unroll
            for (int b = 0; b < 2; ++b)
#pragma unroll
                for (int m = 0; m < 4; ++m)
#pragma unroll
                    for (int n = 0; n < 2; ++n) acc[a][b][m][n] = (f32x4){0.f, 0.f, 0.f, 0.f};
        cur = nxt; cB = nB; ++ui;
        if (wr == 1) PG8_BAR;
    }
    PG8_WAIT_V(0);
    PG8_BAR;
#undef PG8_SA
#undef PG8_SB
#undef PG8_STAGE
#undef PG8_LDA
#undef PG8_LDB
#undef PG8_MMA
#undef PG8_WAIT_V
#undef PG8_WAIT_L
#undef PG8_BAR
#undef PG8_SCHED
}
}

typedef f32x4 Acc[2][2][4][2];
__device__ __forceinline__ void st_bf4(bf16_t* p, f32x4 v) { u32x2 w; w.x = pk2(v[0], v[1]); w.y = pk2(v[2], v[3]); *(u32x2*)p = w; }

struct EpiInProj {
    static constexpr bool PERM = false;
    bf16_t* proj; bf16_t* qr; float* gates; const float* cos32; const float* sin32; const float* cos16; const float* sin16;
    __device__ __forceinline__ void operator()(const Acc& acc, const pg8::Unit& u, int wr, int wc, int fr, int fq) const {
        const int pn = u.pn;
#pragma unroll
        for (int ai = 0; ai < 2; ++ai)
#pragma unroll
            for (int m = 0; m < 4; ++m) {
                const int row = u.pm * 256 + ai * 128 + wr * 64 + m * 16 + fr;
                bf16_t* prow = proj + (size_t)row * NINP + pn * 256;
#pragma unroll
                for (int bj = 0; bj < 2; ++bj) {
                    const f32x4 v0 = acc[ai][bj][m][0], v1 = acc[ai][bj][m][1];
                    const int cb = 128 * bj + 32 * wc;
                    const int blk = cb >> 6, a = wc & 1;
                    int mode = 0; float sc = 1.f;
                    if (pn == 0) sc = QS64;
                    else if (pn == 3) { mode = 1; sc = QS32; }
                    else if (pn == 4) mode = 1;
                    else if (pn == 6) { mode = 2; sc = QS64; }
                    else if (pn == 7) mode = 2;
                    else if (pn == 9) { mode = 3; sc = QS64; }
                    else if (pn == 10) mode = (blk == 2) ? 2 : 0;
                    else if (pn == 11) mode = (blk == 0) ? 2 : (blk == 1) ? 0 : (blk == 2 && a == 0) ? 4 : 5;
                    if (mode == 0) { st_bf4(prow + cb + 4 * fq, v0 * sc); st_bf4(prow + cb + 16 + 4 * fq, v1 * sc); }
                    else if (mode == 1) {
                        const f32x4 c = *(const f32x4*)(cos16 + (size_t)row * 16 + 4 * fq), s = *(const f32x4*)(sin16 + (size_t)row * 16 + 4 * fq);
                        st_bf4(prow + cb + 4 * fq, (v0 * c - v1 * s) * sc); st_bf4(prow + cb + 16 + 4 * fq, (v1 * c + v0 * s) * sc);
                    } else if (mode == 2 || mode == 3) {
                        const f32x4 c = *(const f32x4*)(cos32 + (size_t)row * 32 + 16 * a + 4 * fq), s = *(const f32x4*)(sin32 + (size_t)row * 32 + 16 * a + 4 * fq);
                        const f32x4 o0 = (v0 * c - v1 * s) * sc, o1 = (v1 * c + v0 * s) * sc;
                        const int lc = 64 * blk + 16 * a + 4 * fq;
                        if (mode == 2) { st_bf4(prow + lc, o0); st_bf4(prow + lc + 32, o1); }
                        else { st_bf4(prow + lc, v0 * sc); st_bf4(prow + lc + 32, v1 * sc); bf16_t* q = qr + (size_t)row * 256 + lc; st_bf4(q, o0); st_bf4(q + 32, o1); }
                    } else if (mode == 4) {
                        if (fq < 3) { f32x4 g; g[0] = sigmoidf_(v0[0]); g[1] = sigmoidf_(v0[1]); g[2] = sigmoidf_(v0[2]); g[3] = sigmoidf_(v0[3]); *(f32x4*)(gates + (size_t)row * 12 + 4 * fq) = g; }
                    }
                }
            }
    }
};
struct EpiResid {
    static constexpr bool PERM = false;
    const float* base; float* out;
    __device__ __forceinline__ void operator()(const Acc& acc, const pg8::Unit& u, int wr, int wc, int fr, int fq) const {
#pragma unroll
        for (int ai = 0; ai < 2; ++ai)
#pragma unroll
            for (int m = 0; m < 4; ++m) {
                const size_t off = (size_t)(u.pm * 256 + ai * 128 + wr * 64 + m * 16 + fr) * DM + u.pn * 256 + wc * 32 + 4 * fq;
#pragma unroll
                for (int bj = 0; bj < 2; ++bj)
#pragma unroll
                    for (int n = 0; n < 2; ++n) { const size_t o = off + bj * 128 + n * 16; const f32x4 b = *(const f32x4*)(base + o); *(f32x4*)(out + o) = b * ALPHA + acc[ai][bj][m][n]; }
            }
    }
};
struct EpiBf16 {
    static constexpr bool PERM = true;
    bf16_t* O; int ldc;
    __device__ __forceinline__ void operator()(const Acc& acc, const pg8::Unit& u, int wr, int wc, int fr, int fq) const {
#pragma unroll
        for (int ai = 0; ai < 2; ++ai)
#pragma unroll
            for (int m = 0; m < 4; ++m) {
                bf16_t* rowp = O + (size_t)(u.pm * 256 + ai * 128 + wr * 64 + m * 16 + fr) * ldc + u.pn * 256 + wc * 32 + 8 * fq;
#pragma unroll
                for (int bj = 0; bj < 2; ++bj) { const f32x4 v0 = acc[ai][bj][m][0], v1 = acc[ai][bj][m][1]; u32x4 w; w.x = pk2(v0[0], v0[1]); w.y = pk2(v0[2], v0[3]); w.z = pk2(v1[0], v1[1]); w.w = pk2(v1[2], v1[3]); *(u32x4*)(rowp + bj * 128) = w; }
            }
    }
};
struct EpiCmp {
    static constexpr bool PERM = false;
    float* hid; const float* c1;
    __device__ __forceinline__ void operator()(const Acc& acc, const pg8::Unit& u, int wr, int wc, int fr, int fq) const {
        const int kv = u.pn;
#pragma unroll
        for (int ai = 0; ai < 2; ++ai)
#pragma unroll
            for (int m = 0; m < 4; ++m) {
                float* rowp = hid + ((size_t)kv * 2048 + (u.pm * 256 + ai * 128 + wr * 64 + m * 16 + fr)) * 256 + wc * 32 + 4 * fq;
#pragma unroll
                for (int bj = 0; bj < 2; ++bj)
#pragma unroll
                    for (int n = 0; n < 2; ++n) { const int c = bj * 128 + n * 16; const f32x4 b = *(const f32x4*)(c1 + kv * 256 + wc * 32 + 4 * fq + c); f32x4 v = acc[ai][bj][m][n] + b;
                        v[0] = v[0] * sigmoidf_(v[0]); v[1] = v[1] * sigmoidf_(v[1]); v[2] = v[2] * sigmoidf_(v[2]); v[3] = v[3] * sigmoidf_(v[3]); *(f32x4*)(rowp + c) = v; }
            }
    }
};
struct EpiSwiglu {
    static constexpr bool PERM = true;
    bf16_t* H; int row0;
    __device__ __forceinline__ void operator()(const Acc& acc, const pg8::Unit& u, int wr, int wc, int fr, int fq) const {
#pragma unroll
        for (int ai = 0; ai < 2; ++ai)
#pragma unroll
            for (int m = 0; m < 4; ++m) {
                bf16_t* rowp = H + (size_t)((u.pm - row0) * 256 + ai * 128 + wr * 64 + m * 16 + fr) * DFF + u.pn * 128 + wc * 16 + 4 * fq;
#pragma unroll
                for (int bj = 0; bj < 2; ++bj) { const f32x4 v0 = acc[ai][bj][m][0], v1 = acc[ai][bj][m][1];
                    f32x4 o; o[0] = v0[0] * sigmoidf_(v0[0]) * v0[1]; o[1] = v0[2] * sigmoidf_(v0[2]) * v0[3]; o[2] = v1[0] * sigmoidf_(v1[0]) * v1[1]; o[3] = v1[2] * sigmoidf_(v1[2]) * v1[3];
                    st_bf4(rowp + bj * 64, o); }
            }
    }
};

namespace att {
constexpr int SLOT = 8192, L_K = 0, L_V = 16384, L_X = 32768;
typedef short v4i16_t __attribute__((ext_vector_type(4)));
struct Stage { u32x4 k, v; };
struct KVp { const bf16_t* K; const bf16_t* V; int pk, pv; };
__device__ __forceinline__ void g_load(Stage& s, const KVp& p, int jt, int wid, int lane) {
    s.k = *(const u32x4*)(p.K + (size_t)(64 * jt + lane) * p.pk + wid * 8);
    s.v = *(const u32x4*)(p.V + (size_t)(64 * jt + 16 * (wid & 3) + (lane >> 2)) * p.pv + (wid >> 2) * 32 + (lane & 3) * 8);
}
__device__ __forceinline__ void s_store(LAS unsigned char* lds, int slot, const Stage& s, int tid) {
    *(LAS u32x4*)(lds + L_K + slot * SLOT + tid * 16) = s.k; *(LAS u32x4*)(lds + L_V + slot * SLOT + tid * 16) = s.v;
}
__device__ __forceinline__ f32x16 zero16() { f32x16 z;
#pragma unroll
    for (int r = 0; r < 16; ++r) z[r] = 0.f;
    return z; }
__device__ __forceinline__ f32x16 mfma32(bf16x8 a, bf16x8 b, f32x16 c) { return __builtin_amdgcn_mfma_f32_32x32x16_bf16(a, b, c, 0, 0, 0); }
__device__ __forceinline__ int crow(int r, int hi) { return (r & 3) + 8 * (r >> 2) + 4 * hi; }
template <int D0, int D1> __device__ __forceinline__ void qk(f32x16& p0, f32x16& p1, const LAS unsigned char* Ks, const bf16x8 (&qf)[4], int hi, int r32) {
    const LAS unsigned char* kb = Ks + hi * 1024 + r32 * 16;
    p0 = zero16(); p1 = zero16();
#pragma unroll
    for (int d0 = D0; d0 < D1; ++d0) {
        const bf16x8 b0 = *(const LAS bf16x8*)(kb + d0 * 2048), b1 = *(const LAS bf16x8*)(kb + d0 * 2048 + 512);
        p0 = mfma32(b0, qf[d0], p0); p1 = mfma32(b1, qf[d0], p1);
    }
}
__device__ __forceinline__ s16x4 vtr(const LAS unsigned char* p) { return __builtin_bit_cast(s16x4, __builtin_amdgcn_ds_read_tr16_b64_v4i16((LAS v4i16_t*)p)); }
__device__ __forceinline__ void pv(f32x16 (&o)[2], const LAS unsigned char* Vs, const bf16x8 (&pw)[4], int lane, int hi) {
    const LAS unsigned char* vp = Vs + ((lane >> 4) & 1) * 32 + (lane & 3) * 8 + (4 * hi + ((lane & 15) >> 2)) * 64;
#pragma unroll
    for (int d0 = 0; d0 < 2; ++d0)
#pragma unroll
        for (int ks = 0; ks < 4; ++ks) {
            const s16x4 lo = vtr(vp + d0 * 4096 + ks * 1024), hh = vtr(vp + d0 * 4096 + ks * 1024 + 512);
            const bf16x8 vf = {lo[0], lo[1], lo[2], lo[3], hh[0], hh[1], hh[2], hh[3]};
            o[d0] = mfma32(vf, pw[ks], o[d0]);
        }
}
__device__ __forceinline__ void pack_p(bf16x8 (&pw)[4], const f32x16& p0, const f32x16& p1) {
    u32x4 a, b, c, d;
    a.x = pk2(p0[0], p0[1]); a.y = pk2(p0[2], p0[3]); a.z = pk2(p0[4], p0[5]); a.w = pk2(p0[6], p0[7]);
    b.x = pk2(p0[8], p0[9]); b.y = pk2(p0[10], p0[11]); b.z = pk2(p0[12], p0[13]); b.w = pk2(p0[14], p0[15]);
    c.x = pk2(p1[0], p1[1]); c.y = pk2(p1[2], p1[3]); c.z = pk2(p1[4], p1[5]); c.w = pk2(p1[6], p1[7]);
    d.x = pk2(p1[8], p1[9]); d.y = pk2(p1[10], p1[11]); d.z = pk2(p1[12], p1[13]); d.w = pk2(p1[14], p1[15]);
    pw[0] = __builtin_bit_cast(bf16x8, a); pw[1] = __builtin_bit_cast(bf16x8, b); pw[2] = __builtin_bit_cast(bf16x8, c); pw[3] = __builtin_bit_cast(bf16x8, d);
}
__device__ __forceinline__ void osm(f32x16& p0, f32x16& p1, float& m, float& l, f32x16 (&o)[2], bf16x8 (&pw)[4]) {
    float mx = fmaxf(p0[0], p1[0]);
#pragma unroll
    for (int r = 1; r < 16; ++r) mx = fmaxf(mx, fmaxf(p0[r], p1[r]));
    mx = fmaxf(mx, xhalf(mx));
    const float mn = fmaxf(m, mx), al = ex2(m - mn); m = mn;
    if (!__all(al == 1.0f)) { l *= al; o[0] *= al; o[1] *= al; }
    float s = 0.f;
#pragma unroll
    for (int r = 0; r < 16; ++r) { p0[r] = ex2(p0[r] - mn); p1[r] = ex2(p1[r] - mn); s += p0[r] + p1[r]; }
    l += s;
    pack_p(pw, p0, p1);
}
__device__ __forceinline__ void mask_le(f32x16& p0, f32x16& p1, int lim, int hi) {
#pragma unroll
    for (int r = 0; r < 16; ++r) { const int kk = crow(r, hi); if (kk > lim) p0[r] = -INFINITY; if (kk + 32 > lim) p1[r] = -INFINITY; }
}
__device__ __forceinline__ void mask_gt(f32x16& p0, f32x16& p1, int lim, int hi) {
#pragma unroll
    for (int r = 0; r < 16; ++r) { const int kk = crow(r, hi); if (kk <= lim) p0[r] = -INFINITY; if (kk + 32 <= lim) p1[r] = -INFINITY; }
}
__device__ __forceinline__ void mask_all(f32x16& p0, f32x16& p1, bool keep) {
#pragma unroll
    for (int r = 0; r < 16; ++r) { p0[r] = keep ? p0[r] : -INFINITY; p1[r] = keep ? p1[r] : -INFINITY; }
}
__device__ __forceinline__ void store_o(bf16_t* dst, const f32x16 (&o)[2], int hi) {
#pragma unroll
    for (int d0 = 0; d0 < 2; ++d0)
#pragma unroll
        for (int g = 0; g < 4; ++g) { f32x4 v = {o[d0][4 * g], o[d0][4 * g + 1], o[d0][4 * g + 2], o[d0][4 * g + 3]}; st_bf4(dst + 32 * d0 + 8 * g + 4 * hi, v); }
}
__device__ __forceinline__ void load_q(bf16x8 (&qf)[4], const bf16_t* qp, int hi) {
#pragma unroll
    for (int d0 = 0; d0 < 4; ++d0) qf[d0] = *(const bf16x8*)(qp + 16 * d0 + 8 * hi);
}

__device__ __forceinline__ void unit_A(LAS unsigned char* lds, const bf16_t* proj, bf16_t* mixed, int b, int h, int qb, int tid, int wid, int lane) {
    const int r32 = lane & 31, hi = lane >> 5;
    const int t = 256 * qb + 32 * wid + r32;
    const size_t rowb = (size_t)b * SEQ;
    bf16x8 qf[4]; load_q(qf, proj + (rowb + t) * NINP + C_AQ + h * 64, hi);
    const KVp kv{proj + rowb * NINP + C_AK + h * 64, proj + rowb * NINP + C_AV + h * 64, NINP, NINP};
    f32x16 o[2]; o[0] = zero16(); o[1] = zero16();
    float C = 0.f;
    const int jmax = 4 * qb + 3, tmaxw = 256 * qb + 32 * wid + 31, tminw = tmaxw - 31;
    LAS float* wm = (LAS float*)(lds + L_X);
    Stage st; g_load(st, kv, jmax, wid, lane);
    for (int it = 0; it <= jmax; ++it) {
        const int jt = jmax - it;
        s_store(lds, it & 1, st, tid);
        __syncthreads();
        if (it > 0) { float mx = wm[((it - 1) & 1) * 8];
#pragma unroll
            for (int w = 1; w < 8; ++w) mx = fmaxf(mx, wm[((it - 1) & 1) * 8 + w]);
            if (mx < -100.f) break; }
        if (jt > 0) g_load(st, kv, jt - 1, wid, lane);
        if (64 * jt < tmaxw) {
            f32x16 p0, p1; qk<0, 4>(p0, p1, lds + L_K + (it & 1) * SLOT, qf, hi, r32);
            if (64 * jt + 63 >= tminw) mask_le(p0, p1, t - 1 - 64 * jt, hi);
            float L0[16], L1[16];
#pragma unroll
            for (int r = 0; r < 16; ++r) { const float z0 = p0[r], z1 = p1[r];
                L0[r] = -(fmaxf(z0, 0.f) + lg2(1.f + ex2(-fabsf(z0)))); L1[r] = -(fmaxf(z1, 0.f) + lg2(1.f + ex2(-fabsf(z1)))); }
            float gs[8], og[8];
#pragma unroll
            for (int k = 0; k < 4; ++k) { gs[k] = (L0[4 * k] + L0[4 * k + 1]) + (L0[4 * k + 2] + L0[4 * k + 3]); gs[4 + k] = (L1[4 * k] + L1[4 * k + 1]) + (L1[4 * k + 2] + L1[4 * k + 3]); }
#pragma unroll
            for (int k = 0; k < 8; ++k) og[k] = xhalf(gs[k]);
            float aown = 0.f, aoth = 0.f;
#pragma unroll
            for (int k = 7; k >= 0; --k) {
                const float base = C + (aown + aoth + (hi == 0 ? og[k] : 0.f));
                if (k >= 4) { const int q = 4 * (k - 4);
                    const float i3 = base + L1[q + 3], i2 = i3 + L1[q + 2], i1 = i2 + L1[q + 1], i0 = i1 + L1[q];
                    p1[q + 3] = ex2(p1[q + 3] + i3); p1[q + 2] = ex2(p1[q + 2] + i2); p1[q + 1] = ex2(p1[q + 1] + i1); p1[q] = ex2(p1[q] + i0);
                } else { const int q = 4 * k;
                    const float i3 = base + L0[q + 3], i2 = i3 + L0[q + 2], i1 = i2 + L0[q + 1], i0 = i1 + L0[q];
                    p0[q + 3] = ex2(p0[q + 3] + i3); p0[q + 2] = ex2(p0[q + 2] + i2); p0[q + 1] = ex2(p0[q + 1] + i1); p0[q] = ex2(p0[q] + i0);
                }
                aown += gs[k]; aoth += og[k];
            }
            C += (hi ? aoth : aown) + (hi ? aown : aoth);
            bf16x8 pw[4]; pack_p(pw, p0, p1);
            pv(o, lds + L_V + (it & 1) * SLOT, pw, lane, hi);
        }
        const float cm = wave_max(C);
        if (lane == 0) wm[(it & 1) * 8 + wid] = cm;
    }
    __syncthreads();
    store_o(mixed + (rowb + t) * DM + 0 + h * 64, o, hi);
}

__device__ __forceinline__ void unit_B(LAS unsigned char* lds, const bf16_t* proj, bf16_t* mixed, const float* gain, float lam, float lam_init, int b, int h, int qb, int tid, int wid, int lane) {
    const int r32 = lane & 31, hi = lane >> 5;
    const int t = 256 * qb + 32 * wid + r32;
    const size_t rowb = (size_t)b * SEQ;
    bf16x8 qf[4]; load_q(qf, proj + (rowb + t) * NINP + C_BQ + h * 64, hi);
    const KVp kv{proj + rowb * NINP + C_BK + h * 64, proj + rowb * NINP + C_BV + h * 64, NINP, NINP};
    f32x16 oa[2], ob[2]; oa[0] = zero16(); oa[1] = zero16(); ob[0] = zero16(); ob[1] = zero16();
    float m0 = -1e30f, l0 = 0.f, m1 = -1e30f, l1 = 0.f;
    const int jd = 4 * qb + 3, tmaxw = 256 * qb + 32 * wid + 31, tminw = tmaxw - 31;
    Stage st; g_load(st, kv, 0, wid, lane);
    for (int jt = 0; jt <= jd; ++jt) {
        s_store(lds, jt & 1, st, tid);
        __syncthreads();
        if (jt < jd) g_load(st, kv, jt + 1, wid, lane);
        if (64 * jt <= tmaxw) {
            const bool nm = (64 * jt + 63 > tminw);
            f32x16 p0, p1; bf16x8 pw[4];
            qk<0, 2>(p0, p1, lds + L_K + (jt & 1) * SLOT, qf, hi, r32);
            if (nm) mask_le(p0, p1, t - 64 * jt, hi);
            osm(p0, p1, m0, l0, oa, pw);
            pv(oa, lds + L_V + (jt & 1) * SLOT, pw, lane, hi);
            qk<2, 4>(p0, p1, lds + L_K + (jt & 1) * SLOT, qf, hi, r32);
            if (nm) mask_le(p0, p1, t - 64 * jt, hi);
            osm(p0, p1, m1, l1, ob, pw);
            pv(ob, lds + L_V + (jt & 1) * SLOT, pw, lane, hi);
        }
    }
    __syncthreads();
    l0 += xhalf(l0); l1 += xhalf(l1);
    const float i0 = 1.f / l0, i1 = lam / l1;
    float ss = 0.f;
#pragma unroll
    for (int d0 = 0; d0 < 2; ++d0)
#pragma unroll
        for (int r = 0; r < 16; ++r) { const float v = oa[d0][r] * i0 - ob[d0][r] * i1; oa[d0][r] = v; ss += v * v; }
    ss += xhalf(ss);
    const float rs = rsqrtf(ss * (1.f / 64.f) + RMS_EPS) * (1.f - lam_init);
#pragma unroll
    for (int d0 = 0; d0 < 2; ++d0)
#pragma unroll
        for (int g = 0; g < 4; ++g) { const f32x4 gv = *(const f32x4*)(gain + 32 * d0 + 8 * g + 4 * hi);
#pragma unroll
            for (int e = 0; e < 4; ++e) oa[d0][4 * g + e] *= rs * gv[e]; }
    store_o(mixed + (rowb + t) * DM + 256 + h * 64, oa, hi);
}

__device__ __forceinline__ void unit_C(LAS unsigned char* lds, const bf16_t* proj, const bf16_t* kmean, bf16_t* mixed, int b, int h, int qb, int tid, int wid, int lane) {
    const int r32 = lane & 31, hi = lane >> 5, own = qb;
    const int t = 256 * qb + 32 * wid + r32;
    const size_t rowb = (size_t)b * SEQ;
    bf16x8 qf[4]; load_q(qf, proj + (rowb + t) * NINP + C_CQ + h * 64, hi);
    const KVp kv{proj + rowb * NINP + C_CK + h * 64, proj + rowb * NINP + C_CV + h * 64, NINP, NINP};
    LAS unsigned* un_w = (LAS unsigned*)(lds + L_X);
    unsigned sel = 0u;
    if (tid == 0) un_w[0] = 0u;
    if (own > 0) {
        if (tid < 256) { const int chunk = tid >> 5, key = tid & 31; *(LAS u32x4*)(lds + L_K + chunk * 1024 + key * 16) = *(const u32x4*)(kmean + ((size_t)((b * 4 + h) * 32 + key)) * 64 + chunk * 8); }
        __syncthreads();
        f32x16 g = zero16();
        { const LAS unsigned char* kb = lds + L_K + hi * 1024 + r32 * 16;
#pragma unroll
          for (int d0 = 0; d0 < 4; ++d0) g = mfma32(*(const LAS bf16x8*)(kb + d0 * 2048), qf[d0], g); }
        float og[16];
#pragma unroll
        for (int r = 0; r < 16; ++r) og[r] = xhalf(g[r]);
#pragma unroll
        for (int round = 0; round < 3; ++round) {
            float best = -INFINITY; int bi = -1;
#pragma unroll
            for (int j = 0; j < 32; ++j) { const int hj = (j >> 2) & 1, r = (j & 3) + 4 * (j >> 3);
                const float v = (hj == hi) ? g[r] : og[r];
                const bool ok = (j < own) && !((sel >> j) & 1u) && (v > best);
                best = ok ? v : best; bi = ok ? j : bi; }
            if (bi >= 0) sel |= 1u << bi;
        }
        const unsigned wo = wave_or(sel);
        if (lane == 0) atomicOr((unsigned*)un_w, wo);
    }
    __syncthreads();
    const unsigned un = (un_w[0] | (1u << own)) & (own == 31 ? 0xffffffffu : ((2u << own) - 1u));
    f32x16 o[2]; o[0] = zero16(); o[1] = zero16();
    float m = -1e30f, l = 0.f;
    const int tmaxw = 256 * qb + 32 * wid + 31, tminw = tmaxw - 31;
    int jt = 4 * (__builtin_ctz(un));
    const int jlast = 4 * own + 3;
    Stage st; g_load(st, kv, jt, wid, lane);
    for (int it = 0;; ++it) {
        s_store(lds, it & 1, st, tid);
        __syncthreads();
        int jn = jt + 1;
        if ((jt & 3) == 3) { int j = (jt >> 2) + 1; if (j <= own) { const unsigned rest = un >> j; j += __builtin_ctz(rest | 0x80000000u); } jn = 4 * j; }
        const bool more = (jt < jlast);
        if (more) g_load(st, kv, jn, wid, lane);
        const int blk = jt >> 2;
        bool act; bool rowsel = true;
        if (blk == own) act = (64 * jt <= tmaxw); else { rowsel = (sel >> blk) & 1u; act = __any(rowsel); }
        if (act) {
            f32x16 p0, p1; bf16x8 pw[4];
            qk<0, 4>(p0, p1, lds + L_K + (it & 1) * SLOT, qf, hi, r32);
            if (blk == own) { if (64 * jt + 63 > tminw) mask_le(p0, p1, t - 64 * jt, hi); } else mask_all(p0, p1, rowsel);
            osm(p0, p1, m, l, o, pw);
            pv(o, lds + L_V + (it & 1) * SLOT, pw, lane, hi);
        }
        if (!more) break;
        jt = jn;
    }
    __syncthreads();
    l += xhalf(l);
    const float inv = 1.f / l;
    o[0] *= inv; o[1] *= inv;
    store_o(mixed + (rowb + t) * DM + 512 + h * 64, o, hi);
}

constexpr int LD_IA = L_X, LD_IB = L_X + 32768, LD_SM = L_X + 65536, LD_WO = LD_SM + 1024, LD_END = LD_WO + 128;
__device__ __forceinline__ void unit_D(LAS unsigned char* lds, const bf16_t* proj, const bf16_t* qr, const bf16_t* kc, const bf16_t* vc, const float* gates, bf16_t* mixed,
                                       int b, int i, int tid, int wid, int lane) {
    const int r32 = lane & 31, hi = lane >> 5, hd = r32 & 3, tl = 8 * wid + (r32 >> 2);
    const int t = 64 * i + tl, tt = tl;
    const size_t rowb = (size_t)b * SEQ, row = rowb + t;
    LAS float* impA = (LAS float*)(lds + LD_IA); LAS float* impB = (LAS float*)(lds + LD_IB);
    LAS unsigned* smk = (LAS unsigned*)(lds + LD_SM); LAS unsigned* wor = (LAS unsigned*)(lds + LD_WO);
    bf16x8 qf[4]; load_q(qf, proj + row * NINP + C_DQ + hd * 64, hi);
    const float g_c = gates[row * 12 + hd * 3 + 0], g_s = gates[row * 12 + hd * 3 + 1], g_w = gates[row * 12 + hd * 3 + 2];
    f32x16 acc[2]; acc[0] = zero16(); acc[1] = zero16();
    const KVp kvc{kc + (size_t)b * NCMP * 64, vc + (size_t)b * NCMP * 64, 64, 64};
    const int J = (4 * i + 2) >> 6, nlim = (t - 31) >> 4;
    float m = -1e30f, l = 0.f;
    Stage st; int ln = lane; asm volatile("" : "+v"(ln)); g_load(st, kvc, 0, wid, ln);
    for (int jt = 0; jt <= J; ++jt) {
        s_store(lds, jt & 1, st, tid);
        __syncthreads();
        if (jt < J) g_load(st, kvc, jt + 1, wid, ln);
        f32x16 p0, p1; qk<0, 4>(p0, p1, lds + L_K + (jt & 1) * SLOT, qf, hi, r32);
        mask_le(p0, p1, nlim - 64 * jt, hi);
        float mx = fmaxf(p0[0], p1[0]);
#pragma unroll
        for (int r = 1; r < 16; ++r) mx = fmaxf(mx, fmaxf(p0[r], p1[r]));
        const float mn = fmaxf(m, mx); float s = 0.f;
#pragma unroll
        for (int r = 0; r < 16; ++r) s += ex2(p0[r] - mn) + ex2(p1[r] - mn);
        l = l * ex2(m - mn) + s; m = mn;
    }
    __syncthreads();
    { const float mo = xhalf(m), lo = xhalf(l), M = fmaxf(m, mo); l = l * ex2(m - M) + lo * ex2(mo - M); m = M; }
    const float invl = l > 0.f ? 1.f / l : 0.f;
    ln = lane; asm volatile("" : "+v"(ln)); g_load(st, kvc, 0, wid, ln);
    for (int jt = 0; jt <= J; ++jt) {
        s_store(lds, jt & 1, st, tid);
        __syncthreads();
        if (jt < J) g_load(st, kvc, jt + 1, wid, ln);
        f32x16 p0, p1; qk<0, 4>(p0, p1, lds + L_K + (jt & 1) * SLOT, qf, hi, r32);
        mask_le(p0, p1, nlim - 64 * jt, hi);
#pragma unroll
        for (int r = 0; r < 16; ++r) { p0[r] = ex2(p0[r] - m) * invl; p1[r] = ex2(p1[r] - m) * invl; }
#pragma unroll
        for (int k = 0; k < 8; ++k) {
            float gsum, last;
            if (k < 4) { gsum = (p0[4 * k] + p0[4 * k + 1]) + (p0[4 * k + 2] + p0[4 * k + 3]); last = p0[4 * k + 3]; }
            else { gsum = (p1[4 * k - 16] + p1[4 * k - 15]) + (p1[4 * k - 14] + p1[4 * k - 13]); last = p1[4 * k - 13]; }
            gsum = quad_sum(gsum); last = quad_sum(last);
            const int G = 16 * jt + 2 * k + hi;
            if (hd == 0) { impA[tl * 128 + G] = gsum; if (G + 1 < 128) impB[tl * 128 + G + 1] = last; }
        }
        bf16x8 pw[4]; pack_p(pw, p0, p1);
        pv(acc, lds + L_V + (jt & 1) * SLOT, pw, lane, hi);
    }
    acc[0] *= g_c; acc[1] *= g_c;
    unsigned wo0 = 0u, wo1 = 0u, wo2 = 0u, wo3 = 0u;
#pragma unroll 1
    for (int k8 = 0; k8 < 8; ++k8) {
        const int tk = 8 * wid + k8;
        unsigned long long b0, b1;
        if (i < 16) { b0 = (2ull << i) - 1ull; b1 = 0ull; }
        else {
            const int m0 = lane, m1 = lane + 64;
            const bool c0 = (m0 <= i) && (m0 != 0) && (m0 != i) && (m0 != i - 1), c1 = (m1 <= i) && (m1 != i) && (m1 != i - 1);
            const bool f0 = (m0 == 0) || (m0 == i) || (m0 == i - 1), f1 = (m1 == i) || (m1 == i - 1);
            const float v0 = impA[tk * 128 + m0] + (m0 > 0 ? impB[tk * 128 + m0] : 0.f), v1 = impA[tk * 128 + m1] + impB[tk * 128 + m1];
            const unsigned k0 = c0 ? __float_as_uint(v0) + 1u : 0u, k1 = c1 ? __float_as_uint(v1) + 1u : 0u;
            unsigned thr = 0u;
            for (int bit = 30; bit >= 0; --bit) { const unsigned cand = thr | (1u << bit);
                const int c = __popcll(__ballot(k0 >= cand)) + __popcll(__ballot(k1 >= cand)); if (c >= 13) thr = cand; }
            const bool gt0 = k0 > thr, gt1 = k1 > thr, eq0 = (k0 == thr) && c0, eq1 = (k1 == thr) && c1;
            const int need = 13 - (__popcll(__ballot(gt0)) + __popcll(__ballot(gt1)));
            const unsigned long long be0 = __ballot(eq0), be1 = __ballot(eq1), lt = (1ull << lane) - 1ull;
            const int rk0 = __popcll(be0 & lt), rk1 = __popcll(be0) + __popcll(be1 & lt);
            b0 = __ballot(f0 || gt0 || (eq0 && rk0 < need)); b1 = __ballot(f1 || gt1 || (eq1 && rk1 < need));
        }
        const unsigned w0 = (unsigned)b0, w1 = (unsigned)(b0 >> 32), w2 = (unsigned)b1, w3 = (unsigned)(b1 >> 32);
        if (lane == 0) { smk[tk * 4 + 0] = w0; smk[tk * 4 + 1] = w1; smk[tk * 4 + 2] = w2; smk[tk * 4 + 3] = w3; }
        wo0 |= w0; wo1 |= w1; wo2 |= w2; wo3 |= w3;
    }
    if (lane == 0) { wor[wid * 4 + 0] = wo0; wor[wid * 4 + 1] = wo1; wor[wid * 4 + 2] = wo2; wor[wid * 4 + 3] = wo3; }
    __syncthreads();
    unsigned un0 = 0u, un1 = 0u, un2 = 0u, un3 = 0u;
#pragma unroll
    for (int w = 0; w < 8; ++w) { un0 |= wor[w * 4 + 0]; un1 |= wor[w * 4 + 1]; un2 |= wor[w * 4 + 2]; un3 |= wor[w * 4 + 3]; }
    const unsigned sm0 = smk[tl * 4 + 0], sm1 = smk[tl * 4 + 1], sm2 = smk[tl * 4 + 2], sm3 = smk[tl * 4 + 3];
    { int r2 = (int)(row & 0x7fffffff); asm volatile("" : "+v"(r2)); load_q(qf, qr + (size_t)r2 * 256 + hd * 64, hi); }
    {
        const KVp kvs{proj + rowb * NINP + C_KS, proj + rowb * NINP + C_VS, NINP, NINP};
        f32x16 o[2]; o[0] = zero16(); o[1] = zero16(); m = -1e30f; l = 0.f;
        int jt = 0;
        ln = lane; asm volatile("" : "+v"(ln)); g_load(st, kvs, 0, wid, ln);
        for (int it = 0;; ++it) {
            s_store(lds, it & 1, st, tid);
            __syncthreads();
            int jn = jt + 1;
            for (; jn <= i; ++jn) { const unsigned w = jn < 32 ? un0 : jn < 64 ? un1 : jn < 96 ? un2 : un3; if ((w >> (jn & 31)) & 1u) break; }
            const bool more = (jn <= i);
            if (more) g_load(st, kvs, jn, wid, ln);
            const unsigned w = jt < 32 ? sm0 : jt < 64 ? sm1 : jt < 96 ? sm2 : sm3;
            const bool rowsel = (w >> (jt & 31)) & 1u;
            if (__any(rowsel)) {
                f32x16 p0, p1; bf16x8 pw[4];
                qk<0, 4>(p0, p1, lds + L_K + (it & 1) * SLOT, qf, hi, r32);
                if (jt == i) mask_le(p0, p1, tt, hi);
                mask_all(p0, p1, rowsel);
                osm(p0, p1, m, l, o, pw);
                pv(o, lds + L_V + (it & 1) * SLOT, pw, lane, hi);
            }
            if (!more) break;
            jt = jn;
        }
        __syncthreads();
        l += xhalf(l);
        const float f = g_s / l;
        acc[0] += o[0] * f; acc[1] += o[1] * f;
    }
    {
        const KVp kvw{proj + rowb * NINP + C_KW, proj + rowb * NINP + C_VW, NINP, NINP};
        f32x16 o[2]; o[0] = zero16(); o[1] = zero16(); m = -1e30f; l = 0.f;
        const int j0 = i >= 8 ? i - 8 : 0;
        ln = lane; asm volatile("" : "+v"(ln)); g_load(st, kvw, j0, wid, ln);
        for (int jt = j0; jt <= i; ++jt) {
            s_store(lds, (jt - j0) & 1, st, tid);
            __syncthreads();
            if (jt < i) g_load(st, kvw, jt + 1, wid, ln);
            f32x16 p0, p1; bf16x8 pw[4];
            qk<0, 4>(p0, p1, lds + L_K + ((jt - j0) & 1) * SLOT, qf, hi, r32);
            if (jt == i) mask_le(p0, p1, tt, hi);
            if (jt == i - 8) mask_gt(p0, p1, tt, hi);
            osm(p0, p1, m, l, o, pw);
            pv(o, lds + L_V + ((jt - j0) & 1) * SLOT, pw, lane, hi);
        }
        __syncthreads();
        l += xhalf(l);
        const float f = g_w / l;
        acc[0] += o[0] * f; acc[1] += o[1] * f;
    }
    { int r2 = (int)(row & 0x7fffffff); asm volatile("" : "+v"(r2)); store_o(mixed + (size_t)r2 * DM + 768 + hd * 64, acc, hi); }
}
}

constexpr int LDS_CTL = 131072, LDS_BYTES = 147456;
constexpr int LW_BAR = 0, LW_CNT = 8, LW_TS = 16, LW_CNTL = 32, LW_BASEL = 40, LW_PE = 64;
struct SchedGU {
    const LAS int* cw; const int* list; int t0, t1, G, c; bool dense;
    __device__ bool next(int i, pg8::Unit& u) const {
        const long L = (long)i * G + c; if (L >= (long)(t1 - t0) * 28) return false;
        u.pm = t0 + (int)(L / 28); u.pn = (int)(L % 28); int e = 0;
        if (!dense) { for (; e < 7; ++e) if (u.pm < cw[LW_TS + e + 1]) break; }
        u.pb = (dense ? 0 : 1 + e) * 28 + u.pn; return true;
    }
    __device__ __forceinline__ unsigned arow(const pg8::Unit& u, int r) const {
        if (dense) return (unsigned)(u.pm * 256 + r) * 2048u;
        const int e = u.pb / 28 - 1, slot = (u.pm - cw[LW_TS + e]) * 256 + r;
        const int pid = slot < cw[LW_CNT + e] ? list[e * 32768 + slot] : 0;
        return (unsigned)(pid >> 1) * 2048u;
    }
};
struct SchedDN {
    const LAS int* cw; int t0, t1, G, c; bool dense;
    __device__ bool next(int i, pg8::Unit& u) const {
        const long L = (long)i * G + c; if (L >= (long)(t1 - t0) * 4) return false;
        u.pm = t0 + (int)(L / 4); u.pn = (int)(L % 4); int e = 0;
        if (!dense) { for (; e < 7; ++e) if (u.pm < cw[LW_TS + e + 1]) break; }
        u.pb = (dense ? 0 : 1 + e) * 4 + u.pn; return true;
    }
    __device__ __forceinline__ unsigned arow(const pg8::Unit& u, int r) const { return (unsigned)((u.pm - t0) * 256 + r) * (unsigned)(DFF * 2); }
};
struct EpiDown {
    static constexpr bool PERM = false;
    bool dense; float* out; bf16_t* Y; const LAS int* cw; const int* list; const float* moeg;
    __device__ __forceinline__ void operator()(const Acc& acc, const pg8::Unit& u, int wr, int wc, int fr, int fq) const {
        const int col = u.pn * 256 + wc * 32 + 4 * fq;
        if (dense) {
#pragma unroll
            for (int ai = 0; ai < 2; ++ai)
#pragma unroll
                for (int m = 0; m < 4; ++m) { const size_t off = (size_t)(u.pm * 256 + ai * 128 + wr * 64 + m * 16 + fr) * DM + col;
#pragma unroll
                    for (int bj = 0; bj < 2; ++bj)
#pragma unroll
                        for (int n = 0; n < 2; ++n) { const size_t o = off + bj * 128 + n * 16; const f32x4 b = *(const f32x4*)(out + o); *(f32x4*)(out + o) = b * ALPHA + acc[ai][bj][m][n]; } }
        } else {
            const int e = u.pb / 4 - 1, s0 = (u.pm - cw[LW_TS + e]) * 256, ce = cw[LW_CNT + e];
#pragma unroll
            for (int ai = 0; ai < 2; ++ai)
#pragma unroll
                for (int m = 0; m < 4; ++m) { const int slot = s0 + ai * 128 + wr * 64 + m * 16 + fr;
                    if (slot < ce) { const int pid = list[e * 32768 + slot]; const float g = moeg[pid]; bf16_t* yp = Y + (size_t)pid * DM + col;
#pragma unroll
                        for (int bj = 0; bj < 2; ++bj)
#pragma unroll
                            for (int n = 0; n < 2; ++n) st_bf4(yp + bj * 128 + n * 16, acc[ai][bj][m][n] * g); } }
        }
    }
};
struct EpiPle {
    static constexpr bool PERM = false;
    const float* H2; const bf16_t* P; float* out; bf16_t* hb;
    __device__ __forceinline__ void operator()(const Acc& acc, const pg8::Unit& u, int wr, int wc, int fr, int fq) const {
#pragma unroll
        for (int ai = 0; ai < 2; ++ai)
#pragma unroll
            for (int m = 0; m < 4; ++m) { const size_t off = (size_t)(u.pm * 256 + ai * 128 + wr * 64 + m * 16 + fr) * DM + u.pn * 256 + wc * 32 + 4 * fq;
#pragma unroll
                for (int bj = 0; bj < 2; ++bj)
#pragma unroll
                    for (int n = 0; n < 2; ++n) { const size_t o = off + bj * 128 + n * 16; const f32x4 h = *(const f32x4*)(H2 + o); const u32x2 pw = *(const u32x2*)(P + o); const f32x4 a = acc[ai][bj][m][n];
                        f32x4 r; r[0] = h[0] + sigmoidf_(a[0]) * bflo(pw.x); r[1] = h[1] + sigmoidf_(a[1]) * bfhi(pw.x); r[2] = h[2] + sigmoidf_(a[2]) * bflo(pw.y); r[3] = h[3] + sigmoidf_(a[3]) * bfhi(pw.y);
                        *(f32x4*)(out + o) = r; if (hb) st_bf4(hb + o, r); } }
    }
};
struct SchedCmp {
    int c;
    __device__ bool next(int i, pg8::Unit& u) const { if (i > 0 || c >= 16) return false; u.pm = c & 7; u.pn = c >> 3; u.pb = c >> 3; return true; }
    __device__ __forceinline__ unsigned arow(const pg8::Unit& u, int r) const { const int rr = u.pm * 256 + r; return (unsigned)(((rr >> 9) * SEQ + 16 * (rr & 511)) * NINP + (u.pn ? C_VC : C_KC)) * 2u; }
};

template <class RM> __device__ __forceinline__ void transpose_item(const float* W, int K, int N, bf16_t* WT, const RM& rm, LAS float* scr, int item, int lane) {
    const int nblk = (N + 31) / 32, kb = item / nblk, nb = item % nblk, k0 = 64 * kb, n0 = 32 * nb;
    const int nl = n0 + (lane & 31);
#pragma unroll 8
    for (int i = 0; i < 32; ++i) { const int kk = 2 * i + (lane >> 5); scr[kk * 33 + (lane & 31)] = nl < N ? W[(size_t)(k0 + kk) * N + nl] : 0.f; }
    asm volatile("s_waitcnt lgkmcnt(0)" ::: "memory");
    const int c = lane & 7;
#pragma unroll
    for (int j = 0; j < 4; ++j) { const int n = (lane >> 3) + 8 * j; const LAS float* s = scr + (8 * c) * 33 + n;
        u32x4 o; o.x = pk2(s[0 * 33], s[1 * 33]); o.y = pk2(s[2 * 33], s[3 * 33]); o.z = pk2(s[4 * 33], s[5 * 33]); o.w = pk2(s[6 * 33], s[7 * 33]);
        if (n0 + n < N) *(u32x4*)(WT + (size_t)rm(n0 + n) * K + k0 + 8 * c) = o; }
    asm volatile("s_waitcnt lgkmcnt(0)" ::: "memory");
}
struct RmId { int off; __device__ __forceinline__ int operator()(int n) const { return off + n; } };
struct RmIl { int s; __device__ __forceinline__ int operator()(int n) const { return 2 * n + s; } };
struct RmIn { __device__ __forceinline__ int operator()(int n) const {
    const bool rp = (n >= C_CQ && n < C_CV) || (n >= C_DQ && n < C_KC) || (n >= C_KS && n < C_VS) || (n >= C_KW && n < C_VW);
    return rp ? ((n & ~48) | ((n & 16) << 1) | ((n & 32) >> 1)) : n; } };

struct Args { const void* in[23]; float* out; unsigned char* ws; int ph_lo, ph_hi; };
constexpr int NWAVES = 8, NTHREADS = 512;
constexpr int NPHASES = 1 + 11 + 13;

__global__ void __launch_bounds__(NTHREADS, 2) mk_fwd(Args args) {
    extern __shared__ __attribute__((aligned(16))) unsigned char lds_raw[];
    LAS unsigned char* lds = (LAS unsigned char*)lds_raw;
    LAS int* cw = (LAS int*)(lds + LDS_CTL);
    const int tid0 = threadIdx.x, wave0 = __builtin_amdgcn_readfirstlane(tid0 >> 6);
    const int G = gridDim.x, bx = blockIdx.x, vcu = (G % 8 == 0) ? (bx % 8) * (G / 8) + bx / 8 : bx;
    const int NGW = G * NWAVES;
    unsigned* ctl = (unsigned*)(args.ws + WS_CTL);
    const int lo = args.ph_lo, hi = args.ph_hi;
    for (int u = tid0; u < (LDS_BYTES - LDS_CTL) / 4; u += NTHREADS) cw[u] = 0;
    __syncthreads();
    XcdBarrier bar; bar.bar = ctl + CW_BAR; bar.x = 0; bar.st = nullptr;
    if (hi - lo > 1) bar = xcd_barrier_post(ctl + CW_BAR, (volatile LAS unsigned*)(cw + LW_BAR));
    float* const dout = args.out;
#define CAS __attribute__((address_space(4)))
#define KIN(i) (*(const void* CAS const*)(ka + 8 * (i)))
#define PHASE_NAMES \
    unsigned zz_ = 0u; asm volatile("" : "+v"(zz_)); int tid = wave0 * 64 + (int)__builtin_amdgcn_mbcnt_hi(~0u, __builtin_amdgcn_mbcnt_lo(~0u, zz_)); asm volatile("" : "+v"(tid)); const int lane = tid & 63, wave = __builtin_amdgcn_readfirstlane(tid >> 6), gw = vcu * NWAVES + wave; \
    CAS const unsigned char* ka = (CAS const unsigned char*)__builtin_amdgcn_kernarg_segment_ptr(); asm volatile("" : "+s"(ka)); \
    unsigned char* ws = *(unsigned char* CAS const*)(ka + 24 * 8); \
    const float* x = (const float*)KIN(0); const float* pin = (const float*)KIN(1); const int* pos = (const int*)KIN(2); \
    const float* w_in = (const float*)KIN(3); const float* w_out = (const float*)KIN(4); \
    const float* ln_mix_g = (const float*)KIN(5); const float* ln_mix_b = (const float*)KIN(6); \
    const float* diff_lambda = (const float*)KIN(7); const float* diff_gain = (const float*)KIN(8); \
    const float* cmp_pos = (const float*)KIN(9); const float* cmp_w1 = (const float*)KIN(10); const float* cmp_w2 = (const float*)KIN(11); \
    const float* ffn_w1 = (const float*)KIN(12); const float* ffn_w3 = (const float*)KIN(13); const float* ffn_w2 = (const float*)KIN(14); \
    const float* moe_router = (const float*)KIN(15); const float* moe_w1 = (const float*)KIN(16); const float* moe_w3 = (const float*)KIN(17); const float* moe_w2 = (const float*)KIN(18); \
    const float* ln_ffn_g = (const float*)KIN(19); const float* ln_ffn_b = (const float*)KIN(20); \
    const float* ple_proj = (const float*)KIN(21); const float* ple_gate = (const float*)KIN(22); \
    unsigned char* misc = ws + WS_MISC; \
    float* lamv = (float*)(misc + OFF_LAM); float* c1 = (float*)(misc + OFF_C1); \
    bf16_t* kmean = (bf16_t*)(misc + OFF_KMEAN); bf16_t* KC = (bf16_t*)(misc + OFF_KC); bf16_t* VC = (bf16_t*)(misc + OFF_VC); \
    float* gates = (float*)(misc + OFF_GATES); float* moeg = (float*)(misc + OFF_MOEG); int* list = (int*)(misc + OFF_LIST); float* hid = (float*)(misc + OFF_HID); \
    float* cos32 = (float*)(ws + WS_ROPE); float* sin32 = cos32 + (size_t)NT * 32; float* cos16 = sin32 + (size_t)NT * 32; float* sin16 = cos16 + (size_t)NT * 16; \
    unsigned char* wb = ws + WS_W; \
    bf16_t* hb = (bf16_t*)(ws + WS_HB); bf16_t* pb = (bf16_t*)(ws + WS_PB); \
    unsigned char* R = ws + WS_R; \
    bf16_t* proj = (bf16_t*)(R + R_PROJ); bf16_t* qr = (bf16_t*)(R + R_QR); bf16_t* mixed = (bf16_t*)(R + R_MIXED); \
    bf16_t* hidb = (bf16_t*)(R + R_HID); float* H2 = (float*)(R + R_H2); bf16_t* Pp = (bf16_t*)(R + R_P); \
    (void)lane; (void)gw; (void)x; (void)pin; (void)pos; (void)w_in; (void)w_out; (void)ln_mix_g; (void)ln_mix_b; (void)diff_lambda; (void)diff_gain; (void)cmp_pos; (void)cmp_w1; (void)cmp_w2; \
    (void)ffn_w1; (void)ffn_w3; (void)ffn_w2; (void)moe_router; (void)moe_w1; (void)moe_w3; (void)moe_w2; (void)ln_ffn_g; (void)ln_ffn_b; (void)ple_proj; (void)ple_gate; (void)lamv; (void)c1; \
    (void)kmean; (void)KC; (void)VC; (void)gates; (void)moeg; (void)list; (void)hid; (void)sin16; (void)wb; (void)hb; (void)pb; (void)proj; (void)qr; (void)mixed; (void)hidb; (void)H2; (void)Pp;

    int ph = 0;
#define PHASE_BEGIN(k) if (ph >= lo && ph < hi) { if ((PHMASK >> (k)) & 1) { PHASE_NAMES
#define PHASE_END   } if (ph + 1 < hi) xcd_barrier(bar); } ++ph;

    PHASE_BEGIN(0)
    {
        LAS float* scr = (LAS float*)(lds + wave * 16384);
        for (int f = gw; f < 27 * 1792; f += NGW) {
            const int idx = f / 1792, item = f % 1792, e = idx / 3, which = idx % 3;
            const float* W = e == 0 ? (which == 0 ? ffn_w1 : which == 1 ? ffn_w3 : ffn_w2) : ((which == 0 ? moe_w1 : which == 1 ? moe_w3 : moe_w2) + (size_t)(e - 1) * DM * DFF);
            if (which < 2) transpose_item(W, DM, DFF, (bf16_t*)(wb + W_F13) + (size_t)e * 2 * DFF * DM, RmIl{which}, scr, item, lane);
            else transpose_item(W, DFF, DM, (bf16_t*)(wb + W_F2) + (size_t)e * DM * DFF, RmId{0}, scr, item, lane);
        }
        for (int f = gw; f < DEPTH * 16 * 93; f += NGW) { const int L = f / (16 * 93), item = f % (16 * 93);
            transpose_item(w_in + (size_t)L * DM * NIN, DM, NIN, (bf16_t*)(wb + W_IN) + (size_t)L * NINP * DM, RmIn{}, scr, item, lane); }
        for (int f = gw; f < DEPTH * 512; f += NGW) { const int L = f / 512, item = f % 512;
            transpose_item(w_out + (size_t)L * DM * DM, DM, DM, (bf16_t*)(wb + W_OUT) + (size_t)L * DM * DM, RmId{0}, scr, item, lane); }
        for (int f = gw; f < DEPTH * 512; f += NGW) { const int L = f / 512, item = f % 512;
            transpose_item(ple_gate + (size_t)L * DM * DM, DM, DM, (bf16_t*)(wb + W_PG) + (size_t)L * DM * DM, RmId{0}, scr, item, lane); }
        for (int f = gw; f < DEPTH * 128; f += NGW) { const int L = f / 128, item = f % 128;
            transpose_item(ple_proj + (size_t)L * PLE * DM, PLE, DM, (bf16_t*)(wb + W_PP) + (size_t)L * DM * PLE, RmId{0}, scr, item, lane); }
        for (int f = gw; f < DEPTH * 2 * 256; f += NGW) { const int lk = f / 256, item = f % 256;
            transpose_item(cmp_w1 + (size_t)lk * 2048 * 256, 2048, 256, (bf16_t*)(wb + W_C1) + (size_t)lk * 256 * 2048, RmId{0}, scr, item, lane); }
        for (int f = gw * 64 + lane; f < DEPTH * (NINP - NIN) * (DM / 8); f += NGW * 64) { const int L = f / ((NINP - NIN) * (DM / 8)), r = f % ((NINP - NIN) * (DM / 8));
            *(u32x4*)((bf16_t*)(wb + W_IN) + ((size_t)L * NINP + NIN) * DM + (size_t)r * 8) = (u32x4){0u, 0u, 0u, 0u}; }
        for (int r = gw; r < NT; r += NGW) { const f32x4* xr = (const f32x4*)(x + (size_t)r * DM) + lane; u32x2* o8 = (u32x2*)(hb + (size_t)r * DM) + lane;
#pragma unroll
            for (int j = 0; j < 4; ++j) { const f32x4 v = xr[64 * j]; u32x2 w; w.x = pk2(v[0], v[1]); w.y = pk2(v[2], v[3]); o8[64 * j] = w; } }
        for (int f = gw * 64 + lane; f < NT * 32; f += NGW * 64) { const int tok = f >> 5, fi = f & 31; const float p = (float)pos[tok];
            const float a32 = p * powf(10000.f, -(float)fi / 32.f); float s, c; sincosf(a32, &s, &c); cos32[f] = c; sin32[f] = s;
            if (fi < 16) { const float a16 = p * powf(10000.f, -(float)fi / 16.f); sincosf(a16, &s, &c); cos16[tok * 16 + fi] = c; sin16[tok * 16 + fi] = s; } }
        if (vcu < DEPTH * 2) {
            const float* pe = cmp_pos + (size_t)vcu * 2048; const float* w1 = cmp_w1 + (size_t)vcu * 2048 * 256;
            const int n = tid & 255, half = tid >> 8; float s = 0.f;
            for (int kk = half * 1024; kk < half * 1024 + 1024; ++kk) s += pe[kk] * w1[(size_t)kk * 256 + n];
            LAS float* red = (LAS float*)lds;
            __syncthreads(); if (half == 1) red[n] = s; __syncthreads(); if (half == 0) c1[vcu * 256 + n] = s + red[n];
        }
        if (vcu == DEPTH * 2 && tid < DEPTH) { const float* lf = diff_lambda + tid * 128; float a = 0.f, b = 0.f;
            for (int k = 0; k < 32; ++k) { a += lf[k] * lf[32 + k]; b += lf[64 + k] * lf[96 + k]; }
            lamv[tid] = expf(a) - expf(b) + (0.8f - 0.6f * expf(-0.3f * (float)tid)); }
    }
    PHASE_END

    for (int L = 0; L < DEPTH; ++L) {
        const float lam_init = 0.8f - 0.6f * expf(-0.3f * (float)L);
        const bool moe = (L & 1);
        PHASE_BEGIN(1)
        {
            pg8::Gemm g{L == 0 ? hb : mixed, (const bf16_t*)(wb + W_IN) + (size_t)L * NINP * DM, DM, 128u};
            pg8::StaticOrder S; S.init(NT, NINP, G, bx, DM);
            EpiInProj E{proj, qr, gates, cos32, sin32, cos16, sin16};
            pg8::gemm_phase(lds, g, S, E, tid);
        }
        PHASE_END
        PHASE_BEGIN(2)
        {
            if (vcu < 16) {
                pg8::Gemm g{proj, (const bf16_t*)(wb + W_C1) + (size_t)L * 2 * 256 * 2048, 2048, (unsigned)(NINP * 2)};
                SchedCmp S{vcu}; EpiCmp E{hid, c1 + L * 512};
                pg8::gemm_phase(lds, g, S, E, tid);
            } else {
                LAS float* part = (LAS float*)lds;
                for (int it = vcu - 16; it < 512; it += G - 16) {
                    const int bh = it >> 5, j = it & 31, b = bh >> 2, h = bh & 3, kg = tid >> 3, c = tid & 7;
                    const bf16_t* kp = proj + ((size_t)b * SEQ + 256 * j + 4 * kg) * NINP + C_CK + h * 64 + c * 8;
                    float s[8] = {0.f, 0.f, 0.f, 0.f, 0.f, 0.f, 0.f, 0.f};
#pragma unroll
                    for (int k = 0; k < 4; ++k) { const u32x4 v = *(const u32x4*)(kp + (size_t)k * NINP);
                        s[0] += bflo(v.x); s[1] += bfhi(v.x); s[2] += bflo(v.y); s[3] += bfhi(v.y); s[4] += bflo(v.z); s[5] += bfhi(v.z); s[6] += bflo(v.w); s[7] += bfhi(v.w); }
                    __syncthreads();
#pragma unroll
                    for (int q = 0; q < 8; ++q) part[kg * 64 + c * 8 + q] = s[q];
                    __syncthreads();
                    if (tid < 64) { float a = 0.f; for (int k = 0; k < 64; ++k) a += part[k * 64 + tid]; kmean[(size_t)it * 64 + tid] = (bf16_t)(pk2(a * (1.f / 256.f), 0.f) & 0xffffu); }
                }
            }
        }
        PHASE_END
        PHASE_BEGIN(3)
        {
            for (int f = (vcu * NTHREADS + tid); f < 2 * 2048 * 64; f += G * NTHREADS) {
                const int d = f & 63, r = (f >> 6) & 2047, kv = f >> 17;
                const float* hr = hid + ((size_t)kv * 2048 + r) * 256; const float* w2 = cmp_w2 + ((size_t)(L * 2 + kv) * 256) * 64 + d;
                float a = 0.f;
                if ((r & 511) != 511) { for (int n = 0; n < 256; ++n) a += hr[n] * w2[(size_t)n * 64]; }
                (kv ? VC : KC)[(size_t)r * 64 + d] = (bf16_t)(pk2(a, 0.f) & 0xffffu);
            }
        }
        PHASE_END
        PHASE_BEGIN(4)
        {
            const float lam = lamv[L];
            { const int bh = vcu >> 4, s = vcu & 15;
              if (ATTMASK & 2) for (int k = 0; k < 2; ++k) att::unit_B(lds, proj, mixed, diff_gain + L * 64, lam, lam_init, bh >> 2, bh & 3, k ? 31 - s : s, tid, wave, lane);
              if (ATTMASK & 4) for (int k = 0; k < 2; ++k) att::unit_C(lds, proj, kmean, mixed, bh >> 2, bh & 3, k ? 31 - s : s, tid, wave, lane);
              if (ATTMASK & 1) for (int k = 0; k < 2; ++k) att::unit_A(lds, proj, mixed, bh >> 2, bh & 3, k ? 31 - s : s, tid, wave, lane); }
            { const int b = vcu >> 6, s = vcu & 63;
              if (ATTMASK & 8) for (int k = 0; k < 2; ++k) att::unit_D(lds, proj, qr, KC, VC, gates, mixed, b, k ? 127 - s : s, tid, wave, lane); }
        }
        PHASE_END
        PHASE_BEGIN(5)
        {
            pg8::Gemm g{mixed, (const bf16_t*)(wb + W_OUT) + (size_t)L * DM * DM, DM, 128u};
            pg8::StaticOrder S; S.init(NT, DM, G, bx, DM);
            EpiResid E{L == 0 ? x : dout, dout};
            pg8::gemm_phase(lds, g, S, E, tid);
        }
        PHASE_END
        PHASE_BEGIN(6)
        {
            const float* gv = ln_mix_g + L * DM; const float* bv = ln_mix_b + L * DM;
            f32x4 gg[4], bb[4];
#pragma unroll
            for (int j = 0; j < 4; ++j) { gg[j] = *((const f32x4*)gv + lane + 64 * j); bb[j] = *((const f32x4*)bv + lane + 64 * j); }
            if (tid < 8) cw[LW_CNTL + tid] = 0;
            __syncthreads();
            int k = 0;
            for (int r = gw; r < NT; r += NGW, ++k) {
                f32x4* xr = (f32x4*)(dout + (size_t)r * DM) + lane;
                f32x4 v[4]; float s = 0.f;
#pragma unroll
                for (int j = 0; j < 4; ++j) { v[j] = xr[64 * j]; s += (v[j][0] + v[j][1]) + (v[j][2] + v[j][3]); }
                const float mean = wave_sum(s) * (1.f / DM); float s2 = 0.f;
#pragma unroll
                for (int j = 0; j < 4; ++j) { v[j] = v[j] - mean; s2 += (v[j][0] * v[j][0] + v[j][1] * v[j][1]) + (v[j][2] * v[j][2] + v[j][3] * v[j][3]); }
                const float rstd = rsqrtf(wave_sum(s2) * (1.f / DM) + LN_EPS);
                u32x2* o8 = (u32x2*)(hb + (size_t)r * DM) + lane;
#pragma unroll
                for (int j = 0; j < 4; ++j) { v[j] = v[j] * rstd * gg[j] + bb[j]; u32x2 w; w.x = pk2(v[j][0], v[j][1]); w.y = pk2(v[j][2], v[j][3]); o8[64 * j] = w; if (!moe) xr[64 * j] = v[j]; }
                if (moe) {
                    float lg[8];
#pragma unroll
                    for (int e = 0; e < 8; ++e) lg[e] = 0.f;
#pragma unroll
                    for (int j = 0; j < 4; ++j)
#pragma unroll
                        for (int q = 0; q < 4; ++q) { const f32x4* wr = (const f32x4*)(moe_router + (size_t)(4 * lane + 256 * j + q) * 8); const f32x4 w0 = wr[0], w1 = wr[1]; const float hv = v[j][q];
                            lg[0] += hv * w0[0]; lg[1] += hv * w0[1]; lg[2] += hv * w0[2]; lg[3] += hv * w0[3]; lg[4] += hv * w1[0]; lg[5] += hv * w1[1]; lg[6] += hv * w1[2]; lg[7] += hv * w1[3]; }
#pragma unroll
                    for (int e = 0; e < 8; ++e) lg[e] = wave_sum(lg[e]);
                    int e0 = 0; float b0 = lg[0];
#pragma unroll
                    for (int e = 1; e < 8; ++e) if (lg[e] > b0) { b0 = lg[e]; e0 = e; }
                    int e1 = -1; float b1 = -INFINITY;
#pragma unroll
                    for (int e = 0; e < 8; ++e) if (e != e0 && lg[e] > b1) { b1 = lg[e]; e1 = e; }
                    const float g1 = 1.f / (1.f + expf(b0 - b1)), g0 = 1.f - g1;
                    if (lane == 0) {
                        const int s0 = __hip_atomic_fetch_add(cw + LW_CNTL + e0, 1, __ATOMIC_RELAXED, __HIP_MEMORY_SCOPE_WORKGROUP), s1 = __hip_atomic_fetch_add(cw + LW_CNTL + e1, 1, __ATOMIC_RELAXED, __HIP_MEMORY_SCOPE_WORKGROUP);
                        const int ix = (wave * 16 + k) * 2; cw[LW_PE + ix] = e0 | (s0 << 8); cw[LW_PE + ix + 1] = e1 | (s1 << 8);
                        moeg[2 * r] = g0; moeg[2 * r + 1] = g1;
                    }
                }
                { const f32x4 pv4 = *((const f32x4*)(pin + ((size_t)L * NT + r) * PLE) + lane); u32x2 w; w.x = pk2(pv4[0], pv4[1]); w.y = pk2(pv4[2], pv4[3]); *((u32x2*)(pb + (size_t)r * PLE) + lane) = w; }
            }
            if (moe) {
                __syncthreads();
                if (tid < 8) cw[LW_BASEL + tid] = (int)__hip_atomic_fetch_add(ctl + CW_CNT + 64 * tid, (unsigned)cw[LW_CNTL + tid], __ATOMIC_RELAXED, __HIP_MEMORY_SCOPE_AGENT);
                __syncthreads();
                if (tid < 256) { const int wv = tid >> 5, kk = (tid >> 1) & 15, r = vcu * NWAVES + wv + kk * NGW;
                    if (r < NT) { const int pe = cw[LW_PE + tid], e = pe & 255, sl = pe >> 8; list[e * 32768 + cw[LW_BASEL + e] + sl] = 2 * r + (tid & 1); } }
            }
        }
        PHASE_END
        for (int chunk = 0; chunk < (moe ? 2 : 1); ++chunk) {
            PHASE_BEGIN(7)
            {
                __syncthreads();
                if (tid == 0) { int ts = 0;
                    for (int e = 0; e < 8; ++e) { const int c = moe ? (int)__hip_atomic_load(ctl + CW_CNT + 64 * e, __ATOMIC_RELAXED, __HIP_MEMORY_SCOPE_AGENT) : (e == 0 ? NT : 0); cw[LW_CNT + e] = c; cw[LW_TS + e] = ts; ts += (c + 255) >> 8; }
                    cw[LW_TS + 8] = ts; }
                __syncthreads();
                const int ntile = cw[LW_TS + 8], t0 = chunk * 128, t1 = chunk == 0 ? (ntile < 128 ? ntile : 128) : ntile;
                if (t1 > t0) {
                    pg8::Gemm g{hb, (const bf16_t*)(wb + W_F13), DM, 128u};
                    SchedGU S{cw, list, t0, t1, G, bx, !moe}; EpiSwiglu E{hidb, t0};
                    pg8::gemm_phase(lds, g, S, E, tid);
                }
            }
            PHASE_END
            PHASE_BEGIN(8)
            {
                __syncthreads();
                if (tid == 0) { int ts = 0;
                    for (int e = 0; e < 8; ++e) { const int c = moe ? (int)__hip_atomic_load(ctl + CW_CNT + 64 * e, __ATOMIC_RELAXED, __HIP_MEMORY_SCOPE_AGENT) : (e == 0 ? NT : 0); cw[LW_CNT + e] = c; cw[LW_TS + e] = ts; ts += (c + 255) >> 8; }
                    cw[LW_TS + 8] = ts; }
                __syncthreads();
                const int ntile = cw[LW_TS + 8], t0 = chunk * 128, t1 = chunk == 0 ? (ntile < 128 ? ntile : 128) : ntile;
                if (t1 > t0) {
                    pg8::Gemm g{hidb, (const bf16_t*)(wb + W_F2), DFF, 128u};
                    SchedDN S{cw, t0, t1, G, bx, !moe}; EpiDown E{!moe, dout, (bf16_t*)dout, cw, list, moeg};
                    pg8::gemm_phase(lds, g, S, E, tid);
                }
            }
            PHASE_END
        }
        PHASE_BEGIN(9)
        {
            const float* gv = ln_ffn_g + L * DM; const float* bv = ln_ffn_b + L * DM;
            f32x4 gg[4], bb[4];
#pragma unroll
            for (int j = 0; j < 4; ++j) { gg[j] = *((const f32x4*)gv + lane + 64 * j); bb[j] = *((const f32x4*)bv + lane + 64 * j); }
            float* hout = moe ? H2 : dout;
            for (int r = gw; r < NT; r += NGW) {
                f32x4 v[4]; float s = 0.f;
                u32x2* h8 = (u32x2*)(hb + (size_t)r * DM) + lane;
                if (!moe) {
                    const f32x4* xr = (const f32x4*)(dout + (size_t)r * DM) + lane;
#pragma unroll
                    for (int j = 0; j < 4; ++j) v[j] = xr[64 * j];
                } else {
                    const u32x2* y0 = (const u32x2*)((const bf16_t*)dout + (size_t)(2 * r) * DM) + lane; const u32x2* y1 = (const u32x2*)((const bf16_t*)dout + (size_t)(2 * r + 1) * DM) + lane;
#pragma unroll
                    for (int j = 0; j < 4; ++j) { const u32x2 a = h8[64 * j], c = y0[64 * j], d = y1[64 * j];
                        v[j][0] = ALPHA * bflo(a.x) + (bflo(c.x) + bflo(d.x)); v[j][1] = ALPHA * bfhi(a.x) + (bfhi(c.x) + bfhi(d.x));
                        v[j][2] = ALPHA * bflo(a.y) + (bflo(c.y) + bflo(d.y)); v[j][3] = ALPHA * bfhi(a.y) + (bfhi(c.y) + bfhi(d.y)); }
                }
#pragma unroll
                for (int j = 0; j < 4; ++j) s += (v[j][0] + v[j][1]) + (v[j][2] + v[j][3]);
                const float mean = wave_sum(s) * (1.f / DM); float s2 = 0.f;
#pragma unroll
                for (int j = 0; j < 4; ++j) { v[j] = v[j] - mean; s2 += (v[j][0] * v[j][0] + v[j][1] * v[j][1]) + (v[j][2] * v[j][2] + v[j][3] * v[j][3]); }
                const float rstd = rsqrtf(wave_sum(s2) * (1.f / DM) + LN_EPS);
                f32x4* orow = (f32x4*)(hout + (size_t)r * DM) + lane;
#pragma unroll
                for (int j = 0; j < 4; ++j) { v[j] = v[j] * rstd * gg[j] + bb[j]; orow[64 * j] = v[j]; u32x2 w; w.x = pk2(v[j][0], v[j][1]); w.y = pk2(v[j][2], v[j][3]); h8[64 * j] = w; }
            }
        }
        PHASE_END
        PHASE_BEGIN(10)
        {
            pg8::Gemm g{pb, (const bf16_t*)(wb + W_PP) + (size_t)L * DM * PLE, PLE, 128u};
            pg8::StaticOrder S; S.init(NT, DM, G, bx, PLE);
            EpiBf16 E{Pp, DM};
            pg8::gemm_phase(lds, g, S, E, tid);
        }
        PHASE_END
        PHASE_BEGIN(11)
        {
            pg8::Gemm g{hb, (const bf16_t*)(wb + W_PG) + (size_t)L * DM * DM, DM, 128u};
            pg8::StaticOrder S; S.init(NT, DM, G, bx, DM);
            EpiPle E{moe ? H2 : dout, Pp, dout, (L + 1 < DEPTH) ? mixed : nullptr};
            pg8::gemm_phase(lds, g, S, E, tid);
        }
        PHASE_END
    }
#undef PHASE_BEGIN
#undef PHASE_END
}

extern "C" void kernel_launch(void* const* d_in, const int* in_sizes, int n_in, void* d_out, int out_size, void* d_ws, size_t ws_size, hipStream_t stream) {
    static int grid = 0;
    if (grid == 0) {
        if (n_in != 23 || out_size != NT * DM || ws_size < WS_END) { fprintf(stderr, "kernel_launch: unexpected problem (n_in %d out %d ws %zu need %zu)\n", n_in, out_size, ws_size, (size_t)WS_END); grid = -1; return; }
        int dev = 0, cus = 0;
        if (hipGetDevice(&dev) != hipSuccess || hipDeviceGetAttribute(&cus, hipDeviceAttributeMultiprocessorCount, dev) != hipSuccess) { grid = -1; return; }
        if (hipFuncSetAttribute((const void*)mk_fwd, hipFuncAttributeMaxDynamicSharedMemorySize, LDS_BYTES) != hipSuccess) { fprintf(stderr, "kernel_launch: hipFuncSetAttribute failed\n"); grid = -1; return; }
        int per_cu = 0;
        if (hipOccupancyMaxActiveBlocksPerMultiprocessor(&per_cu, (const void*)mk_fwd, NTHREADS, LDS_BYTES) != hipSuccess || per_cu < 1) { fprintf(stderr, "kernel_launch: occupancy query says %d blocks per CU\n", per_cu); }
        (void)hipGetLastError();
        grid = cus;
        if (grid != 256) { fprintf(stderr, "kernel_launch: built for 256 CUs, device has %d\n", cus); grid = -1; return; }
    }
    if (grid < 0) return;
    (void)hipMemsetAsync((char*)d_ws + WS_CTL, 0, CTL_ZERO_BYTES, stream);
    Args a{};
    for (int i = 0; i < 23; ++i) a.in[i] = d_in[i];
    a.out = (float*)d_out; a.ws = (unsigned char*)d_ws;
#if MK_MULTI
    for (int p = 0; p < NPHASES; ++p) { a.ph_lo = p; a.ph_hi = p + 1; hipLaunchKernelGGL(mk_fwd, dim3(grid), dim3(NTHREADS), LDS_BYTES, stream, a); }
#else
    a.ph_lo = 0; a.ph_hi = NPHASES;
    hipLaunchKernelGGL(mk_fwd, dim3(grid), dim3(NTHREADS), LDS_BYTES, stream, a);
#endif
}
```

```cpp
#include <hip/hip_runtime.h>
#include <cstdio>
#include <cstdint>

#ifndef PHMASK
#define PHMASK 0xFFFF
#endif
#ifndef DUPMASK
#define DUPMASK 0
#endif
#ifndef DUPATT
#define DUPATT 0
#endif
#ifndef ATTMASK
#define ATTMASK 0xF
#endif
#ifndef MK_MULTI
#define MK_MULTI 0
#endif

#define LAS __attribute__((address_space(3)))
#define GAS __attribute__((address_space(1)))
typedef unsigned short bf16_t;
typedef short bf16x8 __attribute__((ext_vector_type(8)));
typedef short s16x4 __attribute__((ext_vector_type(4)));
typedef float f32x2 __attribute__((ext_vector_type(2)));
typedef float f32x4 __attribute__((ext_vector_type(4)));
typedef float f32x16 __attribute__((ext_vector_type(16)));
typedef unsigned u32x2 __attribute__((ext_vector_type(2)));
typedef unsigned u32x4 __attribute__((ext_vector_type(4)));
typedef __bf16 bf16x2_t __attribute__((ext_vector_type(2)));

constexpr int NB = 4, SEQ = 8192, NT = NB * SEQ, DM = 1024, NIN = 2956, NINP = 3072, DFF = 3584, NEXP = 8, PLE = 256, DEPTH = 2;
constexpr int NCMP = 512;
constexpr float LOG2E = 1.4426950408889634f;
constexpr float ALPHA = 1.4142135623730951f;
constexpr float LN_EPS = 1e-5f, RMS_EPS = 1e-5f;
constexpr float QS64 = 0.125f * LOG2E;
constexpr float QS32 = 0.17677669529663687f * LOG2E;
constexpr int C_AQ = 0, C_AK = 256, C_AV = 512, C_BQ = 768, C_BK = 1024, C_BV = 1280, C_CQ = 1536, C_CK = 1792, C_CV = 2048, C_DQ = 2304;
constexpr int C_KC = 2560, C_VC = 2624, C_KS = 2688, C_VS = 2752, C_KW = 2816, C_VW = 2880, C_G = 2944;

constexpr size_t MiB = 1u << 20;
constexpr size_t WS_CTL = 0, CTL_ZERO_BYTES = 1 * MiB;
constexpr size_t WS_MISC = 1 * MiB;
constexpr size_t OFF_LAM = 0;
constexpr size_t OFF_C1 = 4096;
constexpr size_t OFF_KMEAN = 16384;
constexpr size_t OFF_KC = 128 * 1024;
constexpr size_t OFF_VC = 384 * 1024;
constexpr size_t OFF_GATES = 1 * MiB;
constexpr size_t OFF_MOEG = 3 * MiB;
constexpr size_t OFF_LIST = 4 * MiB;
constexpr size_t OFF_HID = 5 * MiB;
constexpr size_t WS_ROPE = 11 * MiB;
constexpr size_t WS_W = 23 * MiB;
constexpr size_t W_IN = 0;
constexpr size_t W_OUT = W_IN + (size_t)DEPTH * NINP * DM * 2;
constexpr size_t W_PG = W_OUT + (size_t)DEPTH * DM * DM * 2;
constexpr size_t W_PP = W_PG + (size_t)DEPTH * DM * DM * 2;
constexpr size_t W_C1 = W_PP + (size_t)DEPTH * DM * PLE * 2;
constexpr size_t W_F13 = W_C1 + (size_t)DEPTH * 2 * 256 * 2048 * 2;
constexpr size_t W_F2 = W_F13 + (size_t)9 * 2 * DFF * DM * 2;
constexpr size_t W_END = W_F2 + (size_t)9 * DM * DFF * 2;
constexpr size_t WS_HB = WS_W + ((W_END + MiB - 1) / MiB) * MiB;
constexpr size_t WS_PB = WS_HB + 64 * MiB;
constexpr size_t WS_R = WS_PB + 16 * MiB;
constexpr size_t R_PROJ = 0;
constexpr size_t R_QR = 193 * MiB;
constexpr size_t R_MIXED = 209 * MiB;
constexpr size_t R_HID = 0;
constexpr size_t R_H2 = 0;
constexpr size_t R_P = 128 * MiB;
constexpr size_t WS_END = WS_R + 274 * MiB;
constexpr int CW_BAR = 4096, CW_CNT = 8192;

__device__ __forceinline__ unsigned pk2(float lo, float hi) { f32x2 v = {lo, hi}; bf16x2_t b = __builtin_convertvector(v, bf16x2_t); return __builtin_bit_cast(unsigned, b); }
__device__ __forceinline__ float bflo(unsigned w) { return __uint_as_float(w << 16); }
__device__ __forceinline__ float bfhi(unsigned w) { return __uint_as_float(w & 0xffff0000u); }
__device__ __forceinline__ float wave_sum(float v) {
#pragma unroll
    for (int o = 1; o < 64; o <<= 1) v += __shfl_xor(v, o);
    return v;
}
__device__ __forceinline__ float wave_max(float v) {
#pragma unroll
    for (int o = 1; o < 64; o <<= 1) v = fmaxf(v, __shfl_xor(v, o));
    return v;
}
__device__ __forceinline__ unsigned wave_or(unsigned v) {
#pragma unroll
    for (int o = 1; o < 64; o <<= 1) v |= (unsigned)__shfl_xor((int)v, o);
    return v;
}
__device__ __forceinline__ float xhalf(float x) { const unsigned u = __float_as_uint(x); auto rr = __builtin_amdgcn_permlane32_swap(u, u, false, false); return __uint_as_float(rr[0] ^ rr[1] ^ u); }
__device__ __forceinline__ float ex2(float x) { return __builtin_amdgcn_exp2f(x); }
__device__ __forceinline__ float lg2(float x) { return __builtin_amdgcn_logf(x); }
__device__ __forceinline__ float sigmoidf_(float x) { return 1.0f / (1.0f + __expf(-x)); }
__device__ __forceinline__ float quad_sum(float x) {
    x += __builtin_bit_cast(float, __builtin_amdgcn_update_dpp(0, __builtin_bit_cast(int, x), 0xB1, 0xF, 0xF, true));
    x += __builtin_bit_cast(float, __builtin_amdgcn_update_dpp(0, __builtin_bit_cast(int, x), 0x4E, 0xF, 0xF, true));
    return x;
}

#define XB_TMO      128
#define XB_XCNT(j)  (256  + 64 * (j))
#define XB_XSUB(j)  (1280 + 64 * (j))
#define XB_XGEN(j)  (2304 + 64 * (j))
#define XB_TOP      3328
#define XB_TOPGEN   3392
#define XCD_BAR_WORDS 3456
#define XB_SPIN_CAP (1u << 18)
__device__ __forceinline__ unsigned xb_ld(unsigned* p)              { return __hip_atomic_load(p, __ATOMIC_RELAXED, __HIP_MEMORY_SCOPE_AGENT); }
__device__ __forceinline__ unsigned xb_add(unsigned* p, unsigned v) { return __hip_atomic_fetch_add(p, v, __ATOMIC_RELAXED, __HIP_MEMORY_SCOPE_AGENT); }
__device__ __forceinline__ unsigned xb_xcc_id() { return (unsigned)__builtin_amdgcn_s_getreg((3 << 11) | 20) & 0xFu; }
#define XB_SPIN(cond, bar) do { unsigned _sp = 0; while (cond) { __builtin_amdgcn_s_sleep(1); \
    if ((++_sp & 255u) == 0u) { if (xb_ld(&(bar)[XB_TMO])) break; if (_sp > XB_SPIN_CAP) { atomicAdd(&(bar)[XB_TMO], 1u); break; } } } } while (0)
struct XcdBarrier { unsigned* bar; unsigned x; volatile LAS unsigned* st; };
__device__ __forceinline__ XcdBarrier xcd_barrier_post(unsigned* bar, volatile LAS unsigned* st) {
    XcdBarrier b; b.bar = bar; b.x = xb_xcc_id(); b.st = st;
    if (threadIdx.x == 0) (void)xb_add(&bar[XB_XCNT(b.x)], 1u);
    return b;
}
__device__ __forceinline__ void xcd_barrier_complete(unsigned* bar, unsigned x, unsigned& nloc, unsigned& nx) {
    const unsigned G = gridDim.x * gridDim.y * gridDim.z;
    unsigned sum, cnt, mine, sp = 0u;
    for (;;) {
        sum = 0u; cnt = 0u; mine = 0u;
#pragma unroll
        for (unsigned j = 0; j < 16; ++j) { const unsigned c = xb_ld(&bar[XB_XCNT(j)]); sum += c; cnt += (c > 0u) ? 1u : 0u; mine = (j == x) ? c : mine; }
        if (sum == G) break;
        __builtin_amdgcn_s_sleep(1);
        if ((++sp & 255u) == 0u) { if (xb_ld(&bar[XB_TMO])) break; if (sp > XB_SPIN_CAP) { atomicAdd(&bar[XB_TMO], 1u); break; } }
    }
    nloc = mine > 0u ? mine : 1u; nx = cnt > 0u ? cnt : 1u;
}
__device__ __forceinline__ void xcd_barrier(const XcdBarrier& b) {
    asm volatile("s_waitcnt vmcnt(0)" ::: "memory");
    __syncthreads();
    if (threadIdx.x == 0) {
        unsigned* bar = b.bar;
        __builtin_amdgcn_s_waitcnt(0);
        unsigned nloc = b.st[0], nx = b.st[1];
        if (nloc == 0u) { xcd_barrier_complete(bar, b.x, nloc, nx); b.st[0] = nloc; b.st[1] = nx; }
        const unsigned old = xb_add(&bar[XB_XSUB(b.x)], 1u);
        const unsigned gen = old / nloc;
        if (old + 1u == (gen + 1u) * nloc) {
            __builtin_amdgcn_fence(__ATOMIC_RELEASE, "agent");
            asm volatile("s_waitcnt vmcnt(0)" ::: "memory");
            const unsigned og = xb_add(&bar[XB_TOP], 1u);
            const unsigned tg = og / nx;
            if (og + 1u == (tg + 1u) * nx) xb_add(&bar[XB_TOPGEN], 1u);
            else XB_SPIN(xb_ld(&bar[XB_TOPGEN]) == tg, bar);
            __builtin_amdgcn_fence(__ATOMIC_ACQUIRE, "agent");
            xb_add(&bar[XB_XGEN(b.x)], 1u);
            asm volatile("s_waitcnt vmcnt(0)" ::: "memory");
        } else {
            XB_SPIN(xb_ld(&bar[XB_XGEN(b.x)]) == gen, bar);
            __builtin_amdgcn_fence(__ATOMIC_ACQUIRE, "agent");
            asm volatile("s_waitcnt vmcnt(0)" ::: "memory");
        }
    }
    __syncthreads();
}

namespace pg8 {
constexpr int BM = 256, BK = 64, HALF = 128, HTB = HALF * BK * 2, STAGE_BYTES = 8 * HTB, NXCD = 8, WGM = 8;
__host__ __device__ __forceinline__ int lds_byte(int r, int c) { const int st = (r >> 4) * 2 + (c >> 5), rr = r & 15, cc = c & 31, ob = rr * 64 + cc * 2; return st * 1024 + (ob ^ (((ob >> 9) & 1) << 5)); }
__host__ __device__ __forceinline__ void stage_rc(int b, int& R, int& C) { const int st = b / 1024, sb = b % 1024, swz = sb ^ (((sb >> 9) & 1) << 5); R = (st >> 1) * 16 + swz / 64; C = (st & 1) * 32 + (swz % 64) / 2; }
__host__ __device__ __forceinline__ int perm32(int rho) { const int n = rho >> 4, i = rho & 15; return 8 * (i >> 2) + 4 * n + (i & 3); }
struct Unit { int pm, pn, pb; };
struct Gemm { const bf16_t* A; const bf16_t* Bt; int K; unsigned kstepA; };

struct StaticOrder {
    int nM, nN, nwg, G, c; unsigned ldaB;
    __device__ void init(int M, int N, int G_, int c_, int lda) { nM = M / BM; nN = N / BM; nwg = nM * nN; G = G_; c = c_; ldaB = (unsigned)lda * 2u; }
    __device__ bool next(int i, Unit& u) const {
        const long L = (long)i * G + c; if (L >= nwg) return false;
        int wgid = (int)L; { const int q = nwg / NXCD, r = nwg % NXCD, xcd = wgid % NXCD, off = wgid / NXCD; wgid = (xcd < r ? xcd * (q + 1) : r * (q + 1) + (xcd - r) * q) + off; }
        const int nig = WGM * nN, gid = wgid / nig, fm = gid * WGM, gsz = (nM - fm) < WGM ? (nM - fm) : WGM;
        u.pm = fm + ((wgid % nig) % gsz); u.pn = (wgid % nig) / gsz; u.pb = u.pn; return true;
    }
    __device__ __forceinline__ unsigned arow(const Unit& u, int r) const { return (unsigned)(u.pm * BM + r) * ldaB; }
};

template <class Epi, class Sched>
__device__ __forceinline__ void gemm_phase(LAS unsigned char* lds, const Gemm g, const Sched& S, const Epi& E, const int tid) {
    const int wid = __builtin_amdgcn_readfirstlane(tid >> 6), lane = tid & 63, wr = wid >> 2, wc = wid & 3, fr = lane & 15, fq = lane >> 4;
    const int K = g.K, nt = K / BK;
    int Rr[2], Cc[2]; unsigned voffB[2];
#pragma unroll
    for (int i = 0; i < 2; ++i) { stage_rc(tid * 16 + i * 8192, Rr[i], Cc[i]); const int Rb = Epi::PERM ? ((Rr[i] & ~31) + perm32(Rr[i] & 31)) : Rr[i]; voffB[i] = (unsigned)(Rb * K + Cc[i]) * 2u; }
    const size_t kstepB = (size_t)(BK * 2), kstepA = (size_t)g.kstepA;
    const size_t hstepB = (size_t)HALF * K * 2, tstepB = 2 * hstepB;
    const unsigned ldsw = (unsigned)wid * 1024u;
    const int aoff = lds_byte(wr * 64 + fr, fq * 8), boff = lds_byte(wc * 32 + fr, fq * 8);
#define PG8_SA(b, h) (((b) * 2 + (h)) * HTB)
#define PG8_SB(b, h) ((4 + (b) * 2 + (h)) * HTB)
#define PG8_STAGE(bufoff, gbase, voff) do { _Pragma("unroll") for (int _i = 0; _i < 2; ++_i) \
        __builtin_amdgcn_global_load_lds((const unsigned*)((const char*)(gbase) + (voff)[_i]), (LAS unsigned*)(lds + (bufoff) + ldsw + _i * 8192), 16, 0, 0); } while (0)
#define PG8_LDA(dst, b, h) do { _Pragma("unroll") for (int m = 0; m < 4; ++m) _Pragma("unroll") for (int k = 0; k < 2; ++k) dst[m][k] = *(const LAS bf16x8*)(lds + PG8_SA(b, h) + aoff + m * 2048 + k * 1024); } while (0)
#define PG8_LDB(dst, b, h) do { _Pragma("unroll") for (int n = 0; n < 2; ++n) _Pragma("unroll") for (int k = 0; k < 2; ++k) dst[n][k] = *(const LAS bf16x8*)(lds + PG8_SB(b, h) + boff + n * 2048 + k * 1024); } while (0)
#define PG8_MMA(ai, bj, At, Bt) do { __builtin_amdgcn_s_setprio(1); _Pragma("unroll") for (int m = 0; m < 4; ++m) _Pragma("unroll") for (int n = 0; n < 2; ++n) _Pragma("unroll") for (int k = 0; k < 2; ++k) \
        acc[ai][bj][m][n] = __builtin_amdgcn_mfma_f32_16x16x32_bf16(Bt[n][k], At[m][k], acc[ai][bj][m][n], 0, 0, 0); __builtin_amdgcn_s_setprio(0); } while (0)
#define PG8_WAIT_V(n) asm volatile("s_waitcnt vmcnt(" #n ")" ::: "memory")
#define PG8_WAIT_L(n) asm volatile("s_waitcnt lgkmcnt(" #n ")" ::: "memory")
#define PG8_BAR __builtin_amdgcn_s_barrier()
#define PG8_SCHED __builtin_amdgcn_sched_barrier(0)
    Unit cur, nxt; int ui = 0;
    if (!S.next(0, cur)) return;
    f32x4 acc[2][2][4][2];
#pragma unroll
    for (int a = 0; a < 2; ++a)
#pragma unroll
        for (int b = 0; b < 2; ++b)
#pragma unroll
            for (int m = 0; m < 4; ++m)
#pragma unroll
                for (int n = 0; n < 2; ++n) acc[a][b][m][n] = (f32x4){0.f, 0.f, 0.f, 0.f};
    bf16x8 At[4][2], B0[2][2], B1[2][2];
    unsigned vc0[2], vc1[2];
    LAS u32x4* const stash = (LAS u32x4*)(lds + 133120 + tid * 16);
#pragma unroll
    for (int i = 0; i < 2; ++i) { vc0[i] = S.arow(cur, Rr[i]) + (unsigned)Cc[i] * 2u; vc1[i] = S.arow(cur, HALF + Rr[i]) + (unsigned)Cc[i] * 2u; }
    const char* const Ab = (const char*)g.A;
    const char* cB = (const char*)g.Bt + (size_t)cur.pb * tstepB;
    PG8_STAGE(PG8_SB(0, 0), cB, voffB); PG8_STAGE(PG8_SB(0, 1), cB + hstepB, voffB); PG8_STAGE(PG8_SA(0, 0), Ab, vc0); PG8_STAGE(PG8_SA(0, 1), Ab, vc1);
    if (wr == 1) PG8_BAR;
    PG8_WAIT_V(2); PG8_BAR;
    PG8_STAGE(PG8_SB(1, 0), cB + kstepB, voffB); PG8_STAGE(PG8_SA(1, 0), Ab + kstepA, vc0); PG8_STAGE(PG8_SB(1, 1), cB + hstepB + kstepB, voffB);
    PG8_WAIT_V(6); PG8_BAR;
    for (;;) {
        const bool has_next = S.next(ui + 1, nxt);
        if (!has_next) nxt = cur;
        { u32x4 sv; sv.x = S.arow(nxt, Rr[0]) + (unsigned)Cc[0] * 2u; sv.y = S.arow(nxt, Rr[1]) + (unsigned)Cc[1] * 2u; sv.z = S.arow(nxt, HALF + Rr[0]) + (unsigned)Cc[0] * 2u; sv.w = S.arow(nxt, HALF + Rr[1]) + (unsigned)Cc[1] * 2u; *stash = sv; }
        const char* nB = (const char*)g.Bt + (size_t)nxt.pb * tstepB;
        for (int t = 0; t < nt; t += 2) {
            const bool last = (t == nt - 2);
            const char* a1 = Ab + (size_t)(t + 1) * kstepA;
            const char* a2 = last ? Ab : Ab + (size_t)(t + 2) * kstepA; const char* b2 = last ? nB : cB + (size_t)(t + 2) * kstepB;
            const char* a3 = a2 + kstepA; const char* b3 = b2 + kstepB;
            PG8_LDB(B0, 0, 0); PG8_LDB(B1, 0, 1); PG8_SCHED; PG8_LDA(At, 0, 0); PG8_STAGE(PG8_SA(1, 1), a1, vc1);
            if (last) { const u32x4 sv = *stash; vc0[0] = sv.x; vc0[1] = sv.y; vc1[0] = sv.z; vc1[1] = sv.w; }
            PG8_WAIT_V(8); PG8_WAIT_L(0); PG8_BAR; PG8_MMA(0, 0, At, B0); PG8_MMA(0, 1, At, B1); PG8_BAR; PG8_SCHED;
            PG8_LDA(At, 0, 1); PG8_STAGE(PG8_SB(0, 0), b2, voffB); PG8_STAGE(PG8_SB(0, 1), b2 + hstepB, voffB); PG8_STAGE(PG8_SA(0, 0), a2, vc0);
            PG8_WAIT_V(8); PG8_WAIT_L(0); PG8_BAR; PG8_MMA(1, 0, At, B0); PG8_MMA(1, 1, At, B1); PG8_BAR; PG8_SCHED;
            PG8_LDB(B0, 1, 0); PG8_LDB(B1, 1, 1); PG8_SCHED; PG8_LDA(At, 1, 0); PG8_STAGE(PG8_SA(0, 1), a2, vc1);
            PG8_WAIT_V(8); PG8_WAIT_L(0); PG8_BAR; PG8_MMA(0, 0, At, B0); PG8_MMA(0, 1, At, B1); PG8_BAR; PG8_SCHED;
            PG8_LDA(At, 1, 1); PG8_STAGE(PG8_SB(1, 0), b3, voffB); PG8_STAGE(PG8_SB(1, 1), b3 + hstepB, voffB); PG8_STAGE(PG8_SA(1, 0), a3, vc0);
            PG8_WAIT_V(8); PG8_WAIT_L(0); PG8_BAR; PG8_MMA(1, 0, At, B0); PG8_MMA(1, 1, At, B1); PG8_BAR; PG8_SCHED;
        }
        if (wr == 0) PG8_BAR;
        { int fr_e = fr, fq_e = fq; asm volatile("" : "+v"(fr_e), "+v"(fq_e)); E(acc, cur, wr, wc, fr_e, fq_e); }
        if (!has_next) break;
#pragma unroll
        for (int a = 0; a < 2; ++a)
#pragma unroll
            for (int b = 0; b < 2; ++b)
#pragma unroll
                for (int m = 0; m < 4; ++m)
#pragma unroll
                    for (int n = 0; n < 2; ++n) acc[a][b][m][n] = (f32x4){0.f, 0.f, 0.f, 0.f};
        cur = nxt; cB = nB; ++ui;
        if (wr == 1) PG8_BAR;
    }
    PG8_WAIT_V(0);
    PG8_BAR;
#undef PG8_SA
#undef PG8_SB
#undef PG8_STAGE
#undef PG8_LDA
#undef PG8_LDB
#undef PG8_MMA
#undef PG8_WAIT_V
#undef PG8_WAIT_L
#undef PG8_BAR
#undef PG8_SCHED
}
}

typedef f32x4 Acc[2][2][4][2];
__device__ __forceinline__ void st_bf4(bf16_t* p, f32x4 v) { u32x2 w; w.x = pk2(v[0], v[1]); w.y = pk2(v[2], v[3]); *(u32x2*)p = w; }

struct EpiInProj {
    static constexpr bool PERM = false;
    bf16_t* proj; bf16_t* qr; float* gates; const float* cos32; const float* sin32; const float* cos16; const float* sin16;
    __device__ __forceinline__ void operator()(const Acc& acc, const pg8::Unit& u, int wr, int wc, int fr, int fq) const {
        const int pn = u.pn;
#pragma unroll
        for (int ai = 0; ai < 2; ++ai)
#pragma unroll
            for (int m = 0; m < 4; ++m) {
                const int row = u.pm * 256 + ai * 128 + wr * 64 + m * 16 + fr;
                bf16_t* prow = proj + (size_t)row * NINP + pn * 256;
#pragma unroll
                for (int bj = 0; bj < 2; ++bj) {
                    const f32x4 v0 = acc[ai][bj][m][0], v1 = acc[ai][bj][m][1];
                    const int cb = 128 * bj + 32 * wc;
                    const int blk = cb >> 6, a = wc & 1;
                    int mode = 0; float sc = 1.f;
                    if (pn == 0) sc = QS64;
                    else if (pn == 3) { mode = 1; sc = QS32; }
                    else if (pn == 4) mode = 1;
                    else if (pn == 6) { mode = 2; sc = QS64; }
                    else if (pn == 7) mode = 2;
                    else if (pn == 9) { mode = 3; sc = QS64; }
                    else if (pn == 10) mode = (blk == 2) ? 2 : 0;
                    else if (pn == 11) mode = (blk == 0) ? 2 : (blk == 1) ? 0 : (blk == 2 && a == 0) ? 4 : 5;
                    if (mode == 0) { st_bf4(prow + cb + 4 * fq, v0 * sc); st_bf4(prow + cb + 16 + 4 * fq, v1 * sc); }
                    else if (mode == 1) {
                        const f32x4 c = *(const f32x4*)(cos16 + (size_t)row * 16 + 4 * fq), s = *(const f32x4*)(sin16 + (size_t)row * 16 + 4 * fq);
                        st_bf4(prow + cb + 4 * fq, (v0 * c - v1 * s) * sc); st_bf4(prow + cb + 16 + 4 * fq, (v1 * c + v0 * s) * sc);
                    } else if (mode == 2 || mode == 3) {
                        const f32x4 c = *(const f32x4*)(cos32 + (size_t)row * 32 + 16 * a + 4 * fq), s = *(const f32x4*)(sin32 + (size_t)row * 32 + 16 * a + 4 * fq);
                        const f32x4 o0 = (v0 * c - v1 * s) * sc, o1 = (v1 * c + v0 * s) * sc;
                        const int lc = 64 * blk + 16 * a + 4 * fq;
                        if (mode == 2) { st_bf4(prow + lc, o0); st_bf4(prow + lc + 32, o1); }
                        else { st_bf4(prow + lc, v0 * sc); st_bf4(prow + lc + 32, v1 * sc); bf16_t* q = qr + (size_t)row * 256 + lc; st_bf4(q, o0); st_bf4(q + 32, o1); }
                    } else if (mode == 4) {
                        if (fq < 3) { f32x4 g; g[0] = sigmoidf_(v0[0]); g[1] = sigmoidf_(v0[1]); g[2] = sigmoidf_(v0[2]); g[3] = sigmoidf_(v0[3]); *(f32x4*)(gates + (size_t)row * 12 + 4 * fq) = g; }
                    }
                }
            }
    }
};
struct EpiResid {
    static constexpr bool PERM = false;
    const float* base; float* out;
    __device__ __forceinline__ void operator()(const Acc& acc, const pg8::Unit& u, int wr, int wc, int fr, int fq) const {
#pragma unroll
        for (int ai = 0; ai < 2; ++ai)
#pragma unroll
            for (int m = 0; m < 4; ++m) {
                const size_t off = (size_t)(u.pm * 256 + ai * 128 + wr * 64 + m * 16 + fr) * DM + u.pn * 256 + wc * 32 + 4 * fq;
#pragma unroll
                for (int bj = 0; bj < 2; ++bj)
#pragma unroll
                    for (int n = 0; n < 2; ++n) { const size_t o = off + bj * 128 + n * 16; const f32x4 b = *(const f32x4*)(base + o); *(f32x4*)(out + o) = b * ALPHA + acc[ai][bj][m][n]; }
            }
    }
};
struct EpiBf16 {
    static constexpr bool PERM = true;
    bf16_t* O; int ldc;
    __device__ __forceinline__ void operator()(const Acc& acc, const pg8::Unit& u, int wr, int wc, int fr, int fq) const {
#pragma unroll
        for (int ai = 0; ai < 2; ++ai)
#pragma unroll
            for (int m = 0; m < 4; ++m) {
                bf16_t* rowp = O + (size_t)(u.pm * 256 + ai * 128 + wr * 64 + m * 16 + fr) * ldc + u.pn * 256 + wc * 32 + 8 * fq;
#pragma unroll
                for (int bj = 0; bj < 2; ++bj) { const f32x4 v0 = acc[ai][bj][m][0], v1 = acc[ai][bj][m][1]; u32x4 w; w.x = pk2(v0[0], v0[1]); w.y = pk2(v0[2], v0[3]); w.z = pk2(v1[0], v1[1]); w.w = pk2(v1[2], v1[3]); *(u32x4*)(rowp + bj * 128) = w; }
            }
    }
};
struct EpiCmp {
    static constexpr bool PERM = false;
    float* hid; const float* c1;
    __device__ __forceinline__ void operator()(const Acc& acc, const pg8::Unit& u, int wr, int wc, int fr, int fq) const {
        const int kv = u.pn;
#pragma unroll
        for (int ai = 0; ai < 2; ++ai)
#pragma unroll
            for (int m = 0; m < 4; ++m) {
                float* rowp = hid + ((size_t)kv * 2048 + (u.pm * 256 + ai * 128 + wr * 64 + m * 16 + fr)) * 256 + wc * 32 + 4 * fq;
#pragma unroll
                for (int bj = 0; bj < 2; ++bj)
#pragma unroll
                    for (int n = 0; n < 2; ++n) { const int c = bj * 128 + n * 16; const f32x4 b = *(const f32x4*)(c1 + kv * 256 + wc * 32 + 4 * fq + c); f32x4 v = acc[ai][bj][m][n] + b;
                        v[0] = v[0] * sigmoidf_(v[0]); v[1] = v[1] * sigmoidf_(v[1]); v[2] = v[2] * sigmoidf_(v[2]); v[3] = v[3] * sigmoidf_(v[3]); *(f32x4*)(rowp + c) = v; }
            }
    }
};
struct EpiSwiglu {
    static constexpr bool PERM = true;
    bf16_t* H; int row0;
    __device__ __forceinline__ void operator()(const Acc& acc, const pg8::Unit& u, int wr, int wc, int fr, int fq) const {
#pragma unroll
        for (int ai = 0; ai < 2; ++ai)
#pragma unroll
            for (int m = 0; m < 4; ++m) {
                bf16_t* rowp = H + (size_t)((u.pm - row0) * 256 + ai * 128 + wr * 64 + m * 16 + fr) * DFF + u.pn * 128 + wc * 16 + 4 * fq;
#pragma unroll
                for (int bj = 0; bj < 2; ++bj) { const f32x4 v0 = acc[ai][bj][m][0], v1 = acc[ai][bj][m][1];
                    f32x4 o; o[0] = v0[0] * sigmoidf_(v0[0]) * v0[1]; o[1] = v0[2] * sigmoidf_(v0[2]) * v0[3]; o[2] = v1[0] * sigmoidf_(v1[0]) * v1[1]; o[3] = v1[2] * sigmoidf_(v1[2]) * v1[3];
                    st_bf4(rowp + bj * 64, o); }
            }
    }
};

namespace att {
constexpr int NS = 4, SLOT = 8192, L_K = 0, L_V = NS * SLOT, L_X = 2 * NS * SLOT;
typedef short v4i16_t __attribute__((ext_vector_type(4)));
struct KVp { const bf16_t* K; const bf16_t* V; int pk, pv; };
__device__ __forceinline__ void glds16(const void* gsrc, unsigned lds_dst) { unsigned keep;
    asm volatile("s_mov_b32 %0, m0\n\ts_mov_b32 m0, %2\n\ts_nop 0\n\tglobal_load_lds_dwordx4 %1, off\n\ts_mov_b32 m0, %0" : "=&s"(keep) : "v"(gsrc), "s"(lds_dst) : "memory"); }
#define ATT_WAIT_BAR(N) asm volatile("s_waitcnt vmcnt(" #N ") lgkmcnt(0)\n\ts_barrier" ::: "memory")
struct Ring { const bf16_t* ks; const bf16_t* vs; unsigned kd, vd; int pk, pv; };
__device__ __forceinline__ Ring ring_init(LAS unsigned char* lds, const KVp& p, int wid, int lane) {
    Ring r; r.ks = p.K + (size_t)lane * p.pk + wid * 8; r.vs = p.V + (size_t)(16 * (wid & 3) + (lane >> 2)) * p.pv + (wid >> 2) * 32 + (lane & 3) * 8;
    const unsigned l0 = (unsigned)(size_t)lds; r.kd = l0 + L_K + wid * 1024; r.vd = l0 + L_V + wid * 1024; r.pk = p.pk; r.pv = p.pv; return r;
}
__device__ __forceinline__ void ring_issue(const Ring& r, int jt, int slot) {
    glds16(r.ks + (size_t)jt * 64 * r.pk, (unsigned)__builtin_amdgcn_readfirstlane((int)(r.kd + slot * SLOT)));
    glds16(r.vs + (size_t)jt * 64 * r.pv, (unsigned)__builtin_amdgcn_readfirstlane((int)(r.vd + slot * SLOT)));
}
__device__ __forceinline__ void ring_drain() { asm volatile("s_waitcnt vmcnt(0) lgkmcnt(0)\n\ts_barrier" ::: "memory"); }
__device__ __forceinline__ f32x16 zero16() { f32x16 z;
#pragma unroll
    for (int r = 0; r < 16; ++r) z[r] = 0.f;
    return z; }
__device__ __forceinline__ f32x16 mfma32(bf16x8 a, bf16x8 b, f32x16 c) { return __builtin_amdgcn_mfma_f32_32x32x16_bf16(a, b, c, 0, 0, 0); }
__device__ __forceinline__ int crow(int r, int hi) { return (r & 3) + 8 * (r >> 2) + 4 * hi; }
template <int D0, int D1> __device__ __forceinline__ void qk(f32x16& p0, f32x16& p1, const LAS unsigned char* Ks, const bf16x8 (&qf)[4], int hi, int r32) {
    const LAS unsigned char* kb = Ks + hi * 1024 + r32 * 16;
    p0 = zero16(); p1 = zero16();
#pragma unroll
    for (int d0 = D0; d0 < D1; ++d0) {
        const bf16x8 b0 = *(const LAS bf16x8*)(kb + d0 * 2048), b1 = *(const LAS bf16x8*)(kb + d0 * 2048 + 512);
        p0 = mfma32(b0, qf[d0], p0); p1 = mfma32(b1, qf[d0], p1);
    }
}
__device__ __forceinline__ s16x4 vtr(const LAS unsigned char* p) { return __builtin_bit_cast(s16x4, __builtin_amdgcn_ds_read_tr16_b64_v4i16((LAS v4i16_t*)p)); }
__device__ __forceinline__ void pv(f32x16 (&o)[2], const LAS unsigned char* Vs, const bf16x8 (&pw)[4], int lane, int hi) {
    const LAS unsigned char* vp = Vs + ((lane >> 4) & 1) * 32 + (lane & 3) * 8 + (4 * hi + ((lane & 15) >> 2)) * 64;
#pragma unroll
    for (int d0 = 0; d0 < 2; ++d0)
#pragma unroll
        for (int ks = 0; ks < 4; ++ks) {
            const s16x4 lo = vtr(vp + d0 * 4096 + ks * 1024), hh = vtr(vp + d0 * 4096 + ks * 1024 + 512);
            const bf16x8 vf = {lo[0], lo[1], lo[2], lo[3], hh[0], hh[1], hh[2], hh[3]};
            o[d0] = mfma32(vf, pw[ks], o[d0]);
        }
}
__device__ __forceinline__ void pack_p(bf16x8 (&pw)[4], const f32x16& p0, const f32x16& p1) {
    u32x4 a, b, c, d;
    a.x = pk2(p0[0], p0[1]); a.y = pk2(p0[2], p0[3]); a.z = pk2(p0[4], p0[5]); a.w = pk2(p0[6], p0[7]);
    b.x = pk2(p0[8], p0[9]); b.y = pk2(p0[10], p0[11]); b.z = pk2(p0[12], p0[13]); b.w = pk2(p0[14], p0[15]);
    c.x = pk2(p1[0], p1[1]); c.y = pk2(p1[2], p1[3]); c.z = pk2(p1[4], p1[5]); c.w = pk2(p1[6], p1[7]);
    d.x = pk2(p1[8], p1[9]); d.y = pk2(p1[10], p1[11]); d.z = pk2(p1[12], p1[13]); d.w = pk2(p1[14], p1[15]);
    pw[0] = __builtin_bit_cast(bf16x8, a); pw[1] = __builtin_bit_cast(bf16x8, b); pw[2] = __builtin_bit_cast(bf16x8, c); pw[3] = __builtin_bit_cast(bf16x8, d);
}
__device__ __forceinline__ float max3f(float a, float b, float c) { return fmaxf(fmaxf(a, b), c); }
__device__ __forceinline__ void osm(f32x16& p0, f32x16& p1, float& m, float& l, f32x16 (&o)[2], bf16x8 (&pw)[4]) {
    float mx = max3f(p0[0], p1[0], p0[1]);
#pragma unroll
    for (int r = 1; r < 15; r += 2) mx = max3f(mx, p1[r], p0[r + 1]), mx = fmaxf(mx, p1[r + 1]);
    mx = fmaxf(mx, p1[15]);
    mx = fmaxf(mx, xhalf(mx));
    if (__any(mx > m + 8.f)) { const float mn = fmaxf(m, mx), al = ex2(m - mn); m = mn; l *= al; o[0] *= al; o[1] *= al; }
    float s = 0.f;
#pragma unroll
    for (int r = 0; r < 16; ++r) { p0[r] = ex2(p0[r] - m); p1[r] = ex2(p1[r] - m); s += p0[r] + p1[r]; }
    l += s;
    pack_p(pw, p0, p1);
}
__device__ __forceinline__ void mask_le(f32x16& p0, f32x16& p1, int lim, int hi) {
#pragma unroll
    for (int r = 0; r < 16; ++r) { const int kk = crow(r, hi); if (kk > lim) p0[r] = -INFINITY; if (kk + 32 > lim) p1[r] = -INFINITY; }
}
__device__ __forceinline__ void mask_gt(f32x16& p0, f32x16& p1, int lim, int hi) {
#pragma unroll
    for (int r = 0; r < 16; ++r) { const int kk = crow(r, hi); if (kk <= lim) p0[r] = -INFINITY; if (kk + 32 <= lim) p1[r] = -INFINITY; }
}
__device__ __forceinline__ void mask_all(f32x16& p0, f32x16& p1, bool keep) {
#pragma unroll
    for (int r = 0; r < 16; ++r) { p0[r] = keep ? p0[r] : -INFINITY; p1[r] = keep ? p1[r] : -INFINITY; }
}
__device__ __forceinline__ void store_o(bf16_t* dst, const f32x16 (&o)[2], int hi) {
#pragma unroll
    for (int d0 = 0; d0 < 2; ++d0)
#pragma unroll
        for (int g = 0; g < 4; ++g) { f32x4 v = {o[d0][4 * g], o[d0][4 * g + 1], o[d0][4 * g + 2], o[d0][4 * g + 3]}; st_bf4(dst + 32 * d0 + 8 * g + 4 * hi, v); }
}
__device__ __forceinline__ void load_q(bf16x8 (&qf)[4], const bf16_t* qp, int hi) {
#pragma unroll
    for (int d0 = 0; d0 < 4; ++d0) qf[d0] = *(const bf16x8*)(qp + 16 * d0 + 8 * hi);
}

__device__ __forceinline__ void unit_A(LAS unsigned char* lds, const bf16_t* proj, bf16_t* mixed, int b, int h, int qb, int tid, int wid, int lane) {
    const int r32 = lane & 31, hi = lane >> 5;
    const int t = 256 * qb + 32 * wid + r32;
    const size_t rowb = (size_t)b * SEQ;
    bf16x8 qf[4]; load_q(qf, proj + (rowb + t) * NINP + C_AQ + h * 64, hi);
    const KVp kv{proj + rowb * NINP + C_AK + h * 64, proj + rowb * NINP + C_AV + h * 64, NINP, NINP};
    const Ring rg = ring_init(lds, kv, wid, lane);
    f32x16 o[2]; o[0] = zero16(); o[1] = zero16();
    float C = 0.f;
    const int jmax = 4 * qb + 3, tmaxw = 256 * qb + 32 * wid + 31, tminw = tmaxw - 31;
    LAS float* wm = (LAS float*)(lds + L_X);
#pragma unroll
    for (int k = 0; k < NS - 1; ++k) ring_issue(rg, jmax - k > 0 ? jmax - k : 0, k);
    ATT_WAIT_BAR(4);
    for (int it = 0; it <= jmax; ++it) {
        const int jt = jmax - it;
        if (it > 0) { float mx = wm[((it - 1) & 1) * 8];
#pragma unroll
            for (int w = 1; w < 8; ++w) mx = fmaxf(mx, wm[((it - 1) & 1) * 8 + w]);
            if (mx < -100.f) break; }
        { const int jn = jt - (NS - 1); ring_issue(rg, jn > 0 ? jn : 0, (it + NS - 1) % NS); }
        if (64 * jt < tmaxw) {
            f32x16 p0, p1; qk<0, 4>(p0, p1, lds + L_K + (it % NS) * SLOT, qf, hi, r32);
            if (64 * jt + 63 >= tminw) mask_le(p0, p1, t - 1 - 64 * jt, hi);
            float L0[16], L1[16];
#pragma unroll
            for (int r = 0; r < 16; ++r) { const float z0 = p0[r], z1 = p1[r];
                L0[r] = -(fmaxf(z0, 0.f) + lg2(1.f + ex2(-fabsf(z0)))); L1[r] = -(fmaxf(z1, 0.f) + lg2(1.f + ex2(-fabsf(z1)))); }
            float gs[8], og[8];
#pragma unroll
            for (int k = 0; k < 4; ++k) { gs[k] = (L0[4 * k] + L0[4 * k + 1]) + (L0[4 * k + 2] + L0[4 * k + 3]); gs[4 + k] = (L1[4 * k] + L1[4 * k + 1]) + (L1[4 * k + 2] + L1[4 * k + 3]); }
#pragma unroll
            for (int k = 0; k < 8; ++k) og[k] = xhalf(gs[k]);
            float aown = 0.f, aoth = 0.f;
#pragma unroll
            for (int k = 7; k >= 0; --k) {
                const float base = C + (aown + aoth + (hi == 0 ? og[k] : 0.f));
                if (k >= 4) { const int q = 4 * (k - 4);
                    const float i3 = base + L1[q + 3], i2 = i3 + L1[q + 2], i1 = i2 + L1[q + 1], i0 = i1 + L1[q];
                    p1[q + 3] = ex2(p1[q + 3] + i3); p1[q + 2] = ex2(p1[q + 2] + i2); p1[q + 1] = ex2(p1[q + 1] + i1); p1[q] = ex2(p1[q] + i0);
                } else { const int q = 4 * k;
                    const float i3 = base + L0[q + 3], i2 = i3 + L0[q + 2], i1 = i2 + L0[q + 1], i0 = i1 + L0[q];
                    p0[q + 3] = ex2(p0[q + 3] + i3); p0[q + 2] = ex2(p0[q + 2] + i2); p0[q + 1] = ex2(p0[q + 1] + i1); p0[q] = ex2(p0[q] + i0);
                }
                aown += gs[k]; aoth += og[k];
            }
            C += (hi ? aoth : aown) + (hi ? aown : aoth);
            bf16x8 pw[4]; pack_p(pw, p0, p1);
            pv(o, lds + L_V + (it % NS) * SLOT, pw, lane, hi);
        }
        const float cm = wave_max(C);
        if (lane == 0) wm[(it & 1) * 8 + wid] = cm;
        ATT_WAIT_BAR(4);
    }
    ring_drain();
    store_o(mixed + (rowb + t) * DM + 0 + h * 64, o, hi);
}

__device__ __forceinline__ void unit_B(LAS unsigned char* lds, const bf16_t* proj, bf16_t* mixed, const float* gain, float lam, float lam_init, int b, int h, int qb, int tid, int wid, int lane) {
    const int r32 = lane & 31, hi = lane >> 5;
    const int t = 256 * qb + 32 * wid + r32;
    const size_t rowb = (size_t)b * SEQ;
    bf16x8 qf[4]; load_q(qf, proj + (rowb + t) * NINP + C_BQ + h * 64, hi);
    const KVp kv{proj + rowb * NINP + C_BK + h * 64, proj + rowb * NINP + C_BV + h * 64, NINP, NINP};
    const Ring rg = ring_init(lds, kv, wid, lane);
    f32x16 oa[2], ob[2]; oa[0] = zero16(); oa[1] = zero16(); ob[0] = zero16(); ob[1] = zero16();
    float m0 = -1e30f, l0 = 0.f, m1 = -1e30f, l1 = 0.f;
    const int jd = 4 * qb + 3, tmaxw = 256 * qb + 32 * wid + 31, tminw = tmaxw - 31;
#pragma unroll
    for (int k = 0; k < NS - 1; ++k) ring_issue(rg, k < jd ? k : jd, k);
    ATT_WAIT_BAR(4);
    for (int jt = 0; jt <= jd; ++jt) {
        { const int jn = jt + NS - 1; ring_issue(rg, jn < jd ? jn : jd, jn % NS); }
        if (64 * jt <= tmaxw) {
            const bool nm = (64 * jt + 63 > tminw);
            f32x16 p0, p1; bf16x8 pw[4];
            qk<0, 2>(p0, p1, lds + L_K + (jt % NS) * SLOT, qf, hi, r32);
            if (nm) mask_le(p0, p1, t - 64 * jt, hi);
            osm(p0, p1, m0, l0, oa, pw);
            pv(oa, lds + L_V + (jt % NS) * SLOT, pw, lane, hi);
            qk<2, 4>(p0, p1, lds + L_K + (jt % NS) * SLOT, qf, hi, r32);
            if (nm) mask_le(p0, p1, t - 64 * jt, hi);
            osm(p0, p1, m1, l1, ob, pw);
            pv(ob, lds + L_V + (jt % NS) * SLOT, pw, lane, hi);
        }
        ATT_WAIT_BAR(4);
    }
    ring_drain();
    l0 += xhalf(l0); l1 += xhalf(l1);
    const float i0 = 1.f / l0, i1 = lam / l1;
    float ss = 0.f;
#pragma unroll
    for (int d0 = 0; d0 < 2; ++d0)
#pragma unroll
        for (int r = 0; r < 16; ++r) { const float v = oa[d0][r] * i0 - ob[d0][r] * i1; oa[d0][r] = v; ss += v * v; }
    ss += xhalf(ss);
    const float rs = rsqrtf(ss * (1.f / 64.f) + RMS_EPS) * (1.f - lam_init);
#pragma unroll
    for (int d0 = 0; d0 < 2; ++d0)
#pragma unroll
        for (int g = 0; g < 4; ++g) { const f32x4 gv = *(const f32x4*)(gain + 32 * d0 + 8 * g + 4 * hi);
#pragma unroll
            for (int e = 0; e < 4; ++e) oa[d0][4 * g + e] *= rs * gv[e]; }
    store_o(mixed + (rowb + t) * DM + 256 + h * 64, oa, hi);
}

__device__ __forceinline__ int c_next(int jt, unsigned un, int own) {
    if ((jt & 3) != 3) return jt + 1;
    int j = (jt >> 2) + 1; if (j > own) return jt;
    j += __builtin_ctz((un >> j) | 0x80000000u); return 4 * j;
}
__device__ __forceinline__ void unit_C(LAS unsigned char* lds, const bf16_t* proj, const bf16_t* kmean, bf16_t* mixed, int b, int h, int qb, int tid, int wid, int lane) {
    const int r32 = lane & 31, hi = lane >> 5, own = qb;
    const int t = 256 * qb + 32 * wid + r32;
    const size_t rowb = (size_t)b * SEQ;
    bf16x8 qf[4]; load_q(qf, proj + (rowb + t) * NINP + C_CQ + h * 64, hi);
    const KVp kv{proj + rowb * NINP + C_CK + h * 64, proj + rowb * NINP + C_CV + h * 64, NINP, NINP};
    const Ring rg = ring_init(lds, kv, wid, lane);
    LAS unsigned* un_w = (LAS unsigned*)(lds + L_X);
    unsigned sel = 0u;
    if (tid == 0) un_w[0] = 0u;
    if (own > 0) {
        if (tid < 256) { const int chunk = tid >> 5, key = tid & 31; *(LAS u32x4*)(lds + L_K + chunk * 1024 + key * 16) = *(const u32x4*)(kmean + ((size_t)((b * 4 + h) * 32 + key)) * 64 + chunk * 8); }
        __syncthreads();
        f32x16 g = zero16();
        { const LAS unsigned char* kb = lds + L_K + hi * 1024 + r32 * 16;
#pragma unroll
          for (int d0 = 0; d0 < 4; ++d0) g = mfma32(*(const LAS bf16x8*)(kb + d0 * 2048), qf[d0], g); }
        float og[16];
#pragma unroll
        for (int r = 0; r < 16; ++r) og[r] = xhalf(g[r]);
#pragma unroll
        for (int round = 0; round < 3; ++round) {
            float best = -INFINITY; int bi = -1;
#pragma unroll
            for (int j = 0; j < 32; ++j) { const int hj = (j >> 2) & 1, r = (j & 3) + 4 * (j >> 3);
                const float v = (hj == hi) ? g[r] : og[r];
                const bool ok = (j < own) && !((sel >> j) & 1u) && (v > best);
                best = ok ? v : best; bi = ok ? j : bi; }
            if (bi >= 0) sel |= 1u << bi;
        }
        const unsigned wo = wave_or(sel);
        if (lane == 0) __hip_atomic_fetch_or(un_w, wo, __ATOMIC_RELAXED, __HIP_MEMORY_SCOPE_WORKGROUP);
    }
    __syncthreads();
    const unsigned un = (un_w[0] | (1u << own)) & (own == 31 ? 0xffffffffu : ((2u << own) - 1u));
    f32x16 o[2]; o[0] = zero16(); o[1] = zero16();
    float m = -1e30f, l = 0.f;
    const int tmaxw = 256 * qb + 32 * wid + 31, tminw = tmaxw - 31;
    const int ntile = 4 * __builtin_popcount(un);
    int jt = 4 * (__builtin_ctz(un)), ji = jt;
#pragma unroll
    for (int k = 0; k < NS - 1; ++k) { ring_issue(rg, ji, k); ji = c_next(ji, un, own); }
    ATT_WAIT_BAR(4);
    for (int it = 0; it < ntile; ++it) {
        ring_issue(rg, ji, (it + NS - 1) % NS); ji = c_next(ji, un, own);
        const int blk = jt >> 2;
        bool act; bool rowsel = true;
        if (blk == own) act = (64 * jt <= tmaxw); else { rowsel = (sel >> blk) & 1u; act = __any(rowsel); }
        if (act) {
            f32x16 p0, p1; bf16x8 pw[4];
            qk<0, 4>(p0, p1, lds + L_K + (it % NS) * SLOT, qf, hi, r32);
            if (blk == own) { if (64 * jt + 63 > tminw) mask_le(p0, p1, t - 64 * jt, hi); } else mask_all(p0, p1, rowsel);
            osm(p0, p1, m, l, o, pw);
            pv(o, lds + L_V + (it % NS) * SLOT, pw, lane, hi);
        }
        jt = c_next(jt, un, own);
        ATT_WAIT_BAR(4);
    }
    ring_drain();
    l += xhalf(l);
    const float inv = 1.f / l;
    o[0] *= inv; o[1] *= inv;
    store_o(mixed + (rowb + t) * DM + 512 + h * 64, o, hi);
}

constexpr int LD_IA = L_X, LD_SM = L_X + 32768, LD_WO = LD_SM + 1024, LD_END = LD_WO + 128;
__device__ __forceinline__ int d_next(int jt, unsigned u0, unsigned u1, unsigned u2, unsigned u3, int i) {
    for (int jn = jt + 1; jn <= i; ++jn) { const unsigned w = jn < 32 ? u0 : jn < 64 ? u1 : jn < 96 ? u2 : u3; if ((w >> (jn & 31)) & 1u) return jn; }
    return jt;
}
__device__ __forceinline__ void unit_D(LAS unsigned char* lds, const bf16_t* proj, const bf16_t* qr, const bf16_t* kc, const bf16_t* vc, const float* gates, bf16_t* mixed,
                                       int b, int i, int tid, int wid, int lane) {
    const int r32 = lane & 31, hi = lane >> 5, hd = r32 & 3, tl = 8 * wid + (r32 >> 2);
    const int t = 64 * i + tl, tt = tl;
    const size_t rowb = (size_t)b * SEQ, row = rowb + t;
    LAS float* imp = (LAS float*)(lds + LD_IA);
    LAS unsigned* smk = (LAS unsigned*)(lds + LD_SM); LAS unsigned* wor = (LAS unsigned*)(lds + LD_WO);
    bf16x8 qf[4]; load_q(qf, proj + row * NINP + C_DQ + hd * 64, hi);
    const float g_c = gates[row * 12 + hd * 3 + 0], g_s = gates[row * 12 + hd * 3 + 1], g_w = gates[row * 12 + hd * 3 + 2];
    f32x16 acc[2]; acc[0] = zero16(); acc[1] = zero16();
    const KVp kvc{kc + (size_t)b * NCMP * 64, vc + (size_t)b * NCMP * 64, 64, 64};
    const int J = (4 * i + 2) >> 6, nlim = (t - 31) >> 4;
    float m = -1e30f, l = 0.f;
    {
        int ln = lane; asm volatile("" : "+v"(ln)); const Ring rg = ring_init(lds, kvc, wid, ln);
#pragma unroll
        for (int k = 0; k < NS - 1; ++k) ring_issue(rg, k < J ? k : J, k);
        ATT_WAIT_BAR(4);
        for (int jt = 0; jt <= J; ++jt) {
            { const int jn = jt + NS - 1; ring_issue(rg, jn < J ? jn : J, jn % NS); }
            f32x16 p0, p1; qk<0, 4>(p0, p1, lds + L_K + (jt % NS) * SLOT, qf, hi, r32);
            mask_le(p0, p1, nlim - 64 * jt, hi);
            float mx = fmaxf(p0[0], p1[0]);
#pragma unroll
            for (int r = 1; r < 16; ++r) mx = fmaxf(mx, fmaxf(p0[r], p1[r]));
            const float mn = fmaxf(m, mx); float s = 0.f;
#pragma unroll
            for (int r = 0; r < 16; ++r) s += ex2(p0[r] - mn) + ex2(p1[r] - mn);
            l = l * ex2(m - mn) + s; m = mn;
            ATT_WAIT_BAR(4);
        }
        { const float mo = xhalf(m), lo = xhalf(l), M = fmaxf(m, mo); l = l * ex2(m - M) + lo * ex2(mo - M); m = M; }
        const float invl = l > 0.f ? 1.f / l : 0.f;
        ring_drain();
#pragma unroll
        for (int k = 0; k < NS - 1; ++k) ring_issue(rg, k < J ? k : J, k);
        ATT_WAIT_BAR(4);
        float carry = 0.f;
        for (int jt = 0; jt <= J; ++jt) {
            { const int jn = jt + NS - 1; ring_issue(rg, jn < J ? jn : J, jn % NS); }
            f32x16 p0, p1; qk<0, 4>(p0, p1, lds + L_K + (jt % NS) * SLOT, qf, hi, r32);
            mask_le(p0, p1, nlim - 64 * jt, hi);
#pragma unroll
            for (int r = 0; r < 16; ++r) { p0[r] = ex2(p0[r] - m) * invl; p1[r] = ex2(p1[r] - m) * invl; }
            float ol[8];
#pragma unroll
            for (int k = 0; k < 8; ++k) ol[k] = xhalf(k < 4 ? p0[4 * k + 3] : p1[4 * k - 13]);
#pragma unroll
            for (int k = 0; k < 8; ++k) {
                float gsum = (k < 4) ? (p0[4 * k] + p0[4 * k + 1]) + (p0[4 * k + 2] + p0[4 * k + 3]) : (p1[4 * k - 16] + p1[4 * k - 15]) + (p1[4 * k - 14] + p1[4 * k - 13]);
                const float prev = hi ? ol[k] : (k > 0 ? ol[k - 1] : carry);
                const float v = quad_sum(gsum + prev);
                if (hd == 0) imp[tl * 128 + 16 * jt + 2 * k + hi] = v;
            }
            carry = ol[7];
            bf16x8 pw[4]; pack_p(pw, p0, p1);
            pv(acc, lds + L_V + (jt % NS) * SLOT, pw, lane, hi);
            ATT_WAIT_BAR(4);
        }
        ring_drain();
    }
    acc[0] *= g_c; acc[1] *= g_c;
    unsigned wo0 = 0u, wo1 = 0u, wo2 = 0u, wo3 = 0u;
#pragma unroll 1
    for (int k8 = 0; k8 < 8; ++k8) {
        const int tk = 8 * wid + k8;
        unsigned long long b0, b1;
        if (i < 16) { b0 = (2ull << i) - 1ull; b1 = 0ull; }
        else {
            const int m0 = lane, m1 = lane + 64;
            const bool c0 = (m0 <= i) && (m0 != 0) && (m0 != i) && (m0 != i - 1), c1 = (m1 <= i) && (m1 != i) && (m1 != i - 1);
            const bool f0 = (m0 == 0) || (m0 == i) || (m0 == i - 1), f1 = (m1 == i) || (m1 == i - 1);
            const float v0 = imp[tk * 128 + m0], v1 = imp[tk * 128 + m1];
            const unsigned k0 = c0 ? __float_as_uint(v0) + 1u : 0u, k1 = c1 ? __float_as_uint(v1) + 1u : 0u;
            unsigned thr = 0u;
            for (int bit = 30; bit >= 0; --bit) { const unsigned cand = thr | (1u << bit);
                const int c = __popcll(__ballot(k0 >= cand)) + __popcll(__ballot(k1 >= cand)); if (c >= 13) thr = cand; }
            const bool gt0 = k0 > thr, gt1 = k1 > thr, eq0 = (k0 == thr) && c0, eq1 = (k1 == thr) && c1;
            const int need = 13 - (__popcll(__ballot(gt0)) + __popcll(__ballot(gt1)));
            const unsigned long long be0 = __ballot(eq0), be1 = __ballot(eq1), lt = (1ull << lane) - 1ull;
            const int rk0 = __popcll(be0 & lt), rk1 = __popcll(be0) + __popcll(be1 & lt);
            b0 = __ballot(f0 || gt0 || (eq0 && rk0 < need)); b1 = __ballot(f1 || gt1 || (eq1 && rk1 < need));
        }
        const unsigned w0 = (unsigned)b0, w1 = (unsigned)(b0 >> 32), w2 = (unsigned)b1, w3 = (unsigned)(b1 >> 32);
        if (lane == 0) { smk[tk * 4 + 0] = w0; smk[tk * 4 + 1] = w1; smk[tk * 4 + 2] = w2; smk[tk * 4 + 3] = w3; }
        wo0 |= w0; wo1 |= w1; wo2 |= w2; wo3 |= w3;
    }
    if (lane == 0) { wor[wid * 4 + 0] = wo0; wor[wid * 4 + 1] = wo1; wor[wid * 4 + 2] = wo2; wor[wid * 4 + 3] = wo3; }
    __syncthreads();
    unsigned un0 = 0u, un1 = 0u, un2 = 0u, un3 = 0u;
#pragma unroll
    for (int w = 0; w < 8; ++w) { un0 |= wor[w * 4 + 0]; un1 |= wor[w * 4 + 1]; un2 |= wor[w * 4 + 2]; un3 |= wor[w * 4 + 3]; }
    const unsigned sm0 = smk[tl * 4 + 0], sm1 = smk[tl * 4 + 1], sm2 = smk[tl * 4 + 2], sm3 = smk[tl * 4 + 3];
    { int r2 = (int)(row & 0x7fffffff); asm volatile("" : "+v"(r2)); load_q(qf, qr + (size_t)r2 * 256 + hd * 64, hi); }
    {
        const KVp kvs{proj + rowb * NINP + C_KS, proj + rowb * NINP + C_VS, NINP, NINP};
        int ln = lane; asm volatile("" : "+v"(ln)); const Ring rg = ring_init(lds, kvs, wid, ln);
        f32x16 o[2]; o[0] = zero16(); o[1] = zero16(); m = -1e30f; l = 0.f;
        const int ntile = __builtin_popcount(un0) + __builtin_popcount(un1) + __builtin_popcount(un2) + __builtin_popcount(un3);
        int jt = 0, ji = 0;
#pragma unroll
        for (int k = 0; k < NS - 1; ++k) { ring_issue(rg, ji, k); ji = d_next(ji, un0, un1, un2, un3, i); }
        ATT_WAIT_BAR(4);
        for (int it = 0; it < ntile; ++it) {
            ring_issue(rg, ji, (it + NS - 1) % NS); ji = d_next(ji, un0, un1, un2, un3, i);
            const unsigned w = jt < 32 ? sm0 : jt < 64 ? sm1 : jt < 96 ? sm2 : sm3;
            const bool rowsel = (w >> (jt & 31)) & 1u;
            if (__any(rowsel)) {
                f32x16 p0, p1; bf16x8 pw[4];
                qk<0, 4>(p0, p1, lds + L_K + (it % NS) * SLOT, qf, hi, r32);
                if (jt == i) mask_le(p0, p1, tt, hi);
                mask_all(p0, p1, rowsel);
                osm(p0, p1, m, l, o, pw);
                pv(o, lds + L_V + (it % NS) * SLOT, pw, lane, hi);
            }
            jt = d_next(jt, un0, un1, un2, un3, i);
            ATT_WAIT_BAR(4);
        }
        ring_drain();
        l += xhalf(l);
        const float f = g_s / l;
        acc[0] += o[0] * f; acc[1] += o[1] * f;
    }
    {
        const KVp kvw{proj + rowb * NINP + C_KW, proj + rowb * NINP + C_VW, NINP, NINP};
        int ln = lane; asm volatile("" : "+v"(ln)); const Ring rg = ring_init(lds, kvw, wid, ln);
        f32x16 o[2]; o[0] = zero16(); o[1] = zero16(); m = -1e30f; l = 0.f;
        const int j0 = i >= 8 ? i - 8 : 0;
#pragma unroll
        for (int k = 0; k < NS - 1; ++k) ring_issue(rg, j0 + k < i ? j0 + k : i, k);
        ATT_WAIT_BAR(4);
        for (int jt = j0; jt <= i; ++jt) {
            { const int jn = jt + NS - 1; ring_issue(rg, jn < i ? jn : i, (jn - j0) % NS); }
            f32x16 p0, p1; bf16x8 pw[4];
            qk<0, 4>(p0, p1, lds + L_K + ((jt - j0) % NS) * SLOT, qf, hi, r32);
            if (jt == i) mask_le(p0, p1, tt, hi);
            if (jt == i - 8) mask_gt(p0, p1, tt, hi);
            osm(p0, p1, m, l, o, pw);
            pv(o, lds + L_V + ((jt - j0) % NS) * SLOT, pw, lane, hi);
            ATT_WAIT_BAR(4);
        }
        ring_drain();
        l += xhalf(l);
        const float f = g_w / l;
        acc[0] += o[0] * f; acc[1] += o[1] * f;
    }
    { int r2 = (int)(row & 0x7fffffff); asm volatile("" : "+v"(r2)); store_o(mixed + (size_t)r2 * DM + 768 + hd * 64, acc, hi); }
}
#undef ATT_WAIT_BAR
}

constexpr int LDS_CTL = 131072, LDS_BYTES = 147456;
constexpr int LW_BAR = 0, LW_CNT = 8, LW_TS = 16, LW_CNTL = 32, LW_BASEL = 40, LW_PE = 64;
struct SchedGU {
    const LAS int* cw; const int* list; int t0, t1, G, c; bool dense;
    __device__ bool next(int i, pg8::Unit& u) const {
        const long L = (long)i * G + c; if (L >= (long)(t1 - t0) * 28) return false;
        u.pm = t0 + (int)(L / 28); u.pn = (int)(L % 28); int e = 0;
        if (!dense) { for (; e < 7; ++e) if (u.pm < cw[LW_TS + e + 1]) break; }
        u.pb = (dense ? 0 : 1 + e) * 28 + u.pn; return true;
    }
    __device__ __forceinline__ unsigned arow(const pg8::Unit& u, int r) const {
        if (dense) return (unsigned)(u.pm * 256 + r) * 2048u;
        const int e = u.pb / 28 - 1, slot = (u.pm - cw[LW_TS + e]) * 256 + r;
        const int pid = slot < cw[LW_CNT + e] ? list[e * 32768 + slot] : 0;
        return (unsigned)(pid >> 1) * 2048u;
    }
};
struct SchedDN {
    const LAS int* cw; int t0, t1, G, c; bool dense;
    __device__ bool next(int i, pg8::Unit& u) const {
        const long L = (long)i * G + c; if (L >= (long)(t1 - t0) * 4) return false;
        u.pm = t0 + (int)(L / 4); u.pn = (int)(L % 4); int e = 0;
        if (!dense) { for (; e < 7; ++e) if (u.pm < cw[LW_TS + e + 1]) break; }
        u.pb = (dense ? 0 : 1 + e) * 4 + u.pn; return true;
    }
    __device__ __forceinline__ unsigned arow(const pg8::Unit& u, int r) const { return (unsigned)((u.pm - t0) * 256 + r) * (unsigned)(DFF * 2); }
};
struct EpiDown {
    static constexpr bool PERM = false;
    bool dense; float* out; bf16_t* Y; const LAS int* cw; const int* list; const float* moeg;
    __device__ __forceinline__ void operator()(const Acc& acc, const pg8::Unit& u, int wr, int wc, int fr, int fq) const {
        const int col = u.pn * 256 + wc * 32 + 4 * fq;
        if (dense) {
#pragma unroll
            for (int ai = 0; ai < 2; ++ai)
#pragma unroll
                for (int m = 0; m < 4; ++m) { const size_t off = (size_t)(u.pm * 256 + ai * 128 + wr * 64 + m * 16 + fr) * DM + col;
#pragma unroll
                    for (int bj = 0; bj < 2; ++bj)
#pragma unroll
                        for (int n = 0; n < 2; ++n) { const size_t o = off + bj * 128 + n * 16; const f32x4 b = *(const f32x4*)(out + o); *(f32x4*)(out + o) = b * ALPHA + acc[ai][bj][m][n]; } }
        } else {
            const int e = u.pb / 4 - 1, s0 = (u.pm - cw[LW_TS + e]) * 256, ce = cw[LW_CNT + e];
#pragma unroll
            for (int ai = 0; ai < 2; ++ai)
#pragma unroll
                for (int m = 0; m < 4; ++m) { const int slot = s0 + ai * 128 + wr * 64 + m * 16 + fr;
                    if (slot < ce) { const int pid = list[e * 32768 + slot]; const float g = moeg[pid]; bf16_t* yp = Y + (size_t)pid * DM + col;
#pragma unroll
                        for (int bj = 0; bj < 2; ++bj)
#pragma unroll
                            for (int n = 0; n < 2; ++n) st_bf4(yp + bj * 128 + n * 16, acc[ai][bj][m][n] * g); } }
        }
    }
};
struct EpiPle {
    static constexpr bool PERM = false;
    const float* H2; const bf16_t* P; float* out; bf16_t* hb;
    __device__ __forceinline__ void operator()(const Acc& acc, const pg8::Unit& u, int wr, int wc, int fr, int fq) const {
#pragma unroll
        for (int ai = 0; ai < 2; ++ai)
#pragma unroll
            for (int m = 0; m < 4; ++m) { const size_t off = (size_t)(u.pm * 256 + ai * 128 + wr * 64 + m * 16 + fr) * DM + u.pn * 256 + wc * 32 + 4 * fq;
#pragma unroll
                for (int bj = 0; bj < 2; ++bj)
#pragma unroll
                    for (int n = 0; n < 2; ++n) { const size_t o = off + bj * 128 + n * 16; const f32x4 h = *(const f32x4*)(H2 + o); const u32x2 pw = *(const u32x2*)(P + o); const f32x4 a = acc[ai][bj][m][n];
                        f32x4 r; r[0] = h[0] + sigmoidf_(a[0]) * bflo(pw.x); r[1] = h[1] + sigmoidf_(a[1]) * bfhi(pw.x); r[2] = h[2] + sigmoidf_(a[2]) * bflo(pw.y); r[3] = h[3] + sigmoidf_(a[3]) * bfhi(pw.y);
                        *(f32x4*)(out + o) = r; if (hb) st_bf4(hb + o, r); } }
    }
};
struct SchedCmp {
    int c;
    __device__ bool next(int i, pg8::Unit& u) const { if (i > 0 || c >= 16) return false; u.pm = c & 7; u.pn = c >> 3; u.pb = c >> 3; return true; }
    __device__ __forceinline__ unsigned arow(const pg8::Unit& u, int r) const { const int rr = u.pm * 256 + r; return (unsigned)(((rr >> 9) * SEQ + 16 * (rr & 511)) * NINP + (u.pn ? C_VC : C_KC)) * 2u; }
};

template <class RM> __device__ __forceinline__ void transpose_item(const float* W, int K, int N, bf16_t* WT, const RM& rm, LAS float* scr, int item, int lane) {
    const int nblk = (N + 31) / 32, kb = item / nblk, nb = item % nblk, k0 = 64 * kb, n0 = 32 * nb;
    const int nl = n0 + (lane & 31);
#pragma unroll 8
    for (int i = 0; i < 32; ++i) { const int kk = 2 * i + (lane >> 5); scr[kk * 33 + (lane & 31)] = nl < N ? W[(size_t)(k0 + kk) * N + nl] : 0.f; }
    asm volatile("s_waitcnt lgkmcnt(0)" ::: "memory");
    const int c = lane & 7;
#pragma unroll
    for (int j = 0; j < 4; ++j) { const int n = (lane >> 3) + 8 * j; const LAS float* s = scr + (8 * c) * 33 + n;
        u32x4 o; o.x = pk2(s[0 * 33], s[1 * 33]); o.y = pk2(s[2 * 33], s[3 * 33]); o.z = pk2(s[4 * 33], s[5 * 33]); o.w = pk2(s[6 * 33], s[7 * 33]);
        if (n0 + n < N) *(u32x4*)(WT + (size_t)rm(n0 + n) * K + k0 + 8 * c) = o; }
    asm volatile("s_waitcnt lgkmcnt(0)" ::: "memory");
}
struct RmId { int off; __device__ __forceinline__ int operator()(int n) const { return off + n; } };
struct RmIl { int s; __device__ __forceinline__ int operator()(int n) const { return 2 * n + s; } };
struct RmIn { __device__ __forceinline__ int operator()(int n) const {
    const bool rp = (n >= C_CQ && n < C_CV) || (n >= C_DQ && n < C_KC) || (n >= C_KS && n < C_VS) || (n >= C_KW && n < C_VW);
    return rp ? ((n & ~48) | ((n & 16) << 1) | ((n & 32) >> 1)) : n; } };

struct Args { const void* in[23]; float* out; unsigned char* ws; int ph_lo, ph_hi; };
constexpr int NWAVES = 8, NTHREADS = 512;
constexpr int NPHASES = 1 + 11 + 13;

__global__ void __launch_bounds__(NTHREADS, 2) mk_fwd(Args args) {
    extern __shared__ __attribute__((aligned(16))) unsigned char lds_raw[];
    LAS unsigned char* lds = (LAS unsigned char*)lds_raw;
    LAS int* cw = (LAS int*)(lds + LDS_CTL);
    const int tid0 = threadIdx.x, wave0 = __builtin_amdgcn_readfirstlane(tid0 >> 6);
    const int G = gridDim.x, bx = blockIdx.x, vcu = (G % 8 == 0) ? (bx % 8) * (G / 8) + bx / 8 : bx;
    const int NGW = G * NWAVES;
    unsigned* ctl = (unsigned*)(args.ws + WS_CTL);
    const int lo = args.ph_lo, hi = args.ph_hi;
    for (int u = tid0; u < (LDS_BYTES - LDS_CTL) / 4; u += NTHREADS) cw[u] = 0;
    __syncthreads();
    XcdBarrier bar; bar.bar = ctl + CW_BAR; bar.x = 0; bar.st = nullptr;
    if (hi - lo > 1) bar = xcd_barrier_post(ctl + CW_BAR, (volatile LAS unsigned*)(cw + LW_BAR));
    float* const dout = args.out;
#define CAS __attribute__((address_space(4)))
#define KIN(i) (*(const void* CAS const*)(ka + 8 * (i)))
#define PHASE_NAMES \
    unsigned zz_ = 0u; asm volatile("" : "+v"(zz_)); int tid = wave0 * 64 + (int)__builtin_amdgcn_mbcnt_hi(~0u, __builtin_amdgcn_mbcnt_lo(~0u, zz_)); asm volatile("" : "+v"(tid)); const int lane = tid & 63, wave = __builtin_amdgcn_readfirstlane(tid >> 6), gw = vcu * NWAVES + wave; \
    CAS const unsigned char* ka = (CAS const unsigned char*)__builtin_amdgcn_kernarg_segment_ptr(); asm volatile("" : "+s"(ka)); \
    unsigned char* ws = *(unsigned char* CAS const*)(ka + 24 * 8); \
    const float* x = (const float*)KIN(0); const float* pin = (const float*)KIN(1); const int* pos = (const int*)KIN(2); \
    const float* w_in = (const float*)KIN(3); const float* w_out = (const float*)KIN(4); \
    const float* ln_mix_g = (const float*)KIN(5); const float* ln_mix_b = (const float*)KIN(6); \
    const float* diff_lambda = (const float*)KIN(7); const float* diff_gain = (const float*)KIN(8); \
    const float* cmp_pos = (const float*)KIN(9); const float* cmp_w1 = (const float*)KIN(10); const float* cmp_w2 = (const float*)KIN(11); \
    const float* ffn_w1 = (const float*)KIN(12); const float* ffn_w3 = (const float*)KIN(13); const float* ffn_w2 = (const float*)KIN(14); \
    const float* moe_router = (const float*)KIN(15); const float* moe_w1 = (const float*)KIN(16); const float* moe_w3 = (const float*)KIN(17); const float* moe_w2 = (const float*)KIN(18); \
    const float* ln_ffn_g = (const float*)KIN(19); const float* ln_ffn_b = (const float*)KIN(20); \
    const float* ple_proj = (const float*)KIN(21); const float* ple_gate = (const float*)KIN(22); \
    unsigned char* misc = ws + WS_MISC; \
    float* lamv = (float*)(misc + OFF_LAM); float* c1 = (float*)(misc + OFF_C1); \
    bf16_t* kmean = (bf16_t*)(misc + OFF_KMEAN); bf16_t* KC = (bf16_t*)(misc + OFF_KC); bf16_t* VC = (bf16_t*)(misc + OFF_VC); \
    float* gates = (float*)(misc + OFF_GATES); float* moeg = (float*)(misc + OFF_MOEG); int* list = (int*)(misc + OFF_LIST); float* hid = (float*)(misc + OFF_HID); \
    float* cos32 = (float*)(ws + WS_ROPE); float* sin32 = cos32 + (size_t)NT * 32; float* cos16 = sin32 + (size_t)NT * 32; float* sin16 = cos16 + (size_t)NT * 16; \
    unsigned char* wb = ws + WS_W; \
    bf16_t* hb = (bf16_t*)(ws + WS_HB); bf16_t* pb = (bf16_t*)(ws + WS_PB); \
    unsigned char* R = ws + WS_R; \
    bf16_t* proj = (bf16_t*)(R + R_PROJ); bf16_t* qr = (bf16_t*)(R + R_QR); bf16_t* mixed = (bf16_t*)(R + R_MIXED); \
    bf16_t* hidb = (bf16_t*)(R + R_HID); float* H2 = (float*)(R + R_H2); bf16_t* Pp = (bf16_t*)(R + R_P); \
    (void)lane; (void)gw; (void)x; (void)pin; (void)pos; (void)w_in; (void)w_out; (void)ln_mix_g; (void)ln_mix_b; (void)diff_lambda; (void)diff_gain; (void)cmp_pos; (void)cmp_w1; (void)cmp_w2; \
    (void)ffn_w1; (void)ffn_w3; (void)ffn_w2; (void)moe_router; (void)moe_w1; (void)moe_w3; (void)moe_w2; (void)ln_ffn_g; (void)ln_ffn_b; (void)ple_proj; (void)ple_gate; (void)lamv; (void)c1; \
    (void)kmean; (void)KC; (void)VC; (void)gates; (void)moeg; (void)list; (void)hid; (void)sin16; (void)wb; (void)hb; (void)pb; (void)proj; (void)qr; (void)mixed; (void)hidb; (void)H2; (void)Pp;

    int ph = 0;
#define PHASE_BEGIN(k) if (ph >= lo && ph < hi) { for (int rep_ = 0; rep_ < 1 + ((DUPMASK >> (k)) & 1); ++rep_) { if (rep_) xcd_barrier(bar); PHASE_NAMES
#define PHASE_END   } if (ph + 1 < hi) xcd_barrier(bar); } ++ph;

    PHASE_BEGIN(0)
    {
        LAS float* scr = (LAS float*)(lds + wave * 16384);
        for (int f = gw; f < 27 * 1792; f += NGW) {
            const int idx = f / 1792, item = f % 1792, e = idx / 3, which = idx % 3;
            const float* W = e == 0 ? (which == 0 ? ffn_w1 : which == 1 ? ffn_w3 : ffn_w2) : ((which == 0 ? moe_w1 : which == 1 ? moe_w3 : moe_w2) + (size_t)(e - 1) * DM * DFF);
            if (which < 2) transpose_item(W, DM, DFF, (bf16_t*)(wb + W_F13) + (size_t)e * 2 * DFF * DM, RmIl{which}, scr, item, lane);
            else transpose_item(W, DFF, DM, (bf16_t*)(wb + W_F2) + (size_t)e * DM * DFF, RmId{0}, scr, item, lane);
        }
        for (int f = gw; f < DEPTH * 16 * 93; f += NGW) { const int L = f / (16 * 93), item = f % (16 * 93);
            transpose_item(w_in + (size_t)L * DM * NIN, DM, NIN, (bf16_t*)(wb + W_IN) + (size_t)L * NINP * DM, RmIn{}, scr, item, lane); }
        for (int f = gw; f < DEPTH * 512; f += NGW) { const int L = f / 512, item = f % 512;
            transpose_item(w_out + (size_t)L * DM * DM, DM, DM, (bf16_t*)(wb + W_OUT) + (size_t)L * DM * DM, RmId{0}, scr, item, lane); }
        for (int f = gw; f < DEPTH * 512; f += NGW) { const int L = f / 512, item = f % 512;
            transpose_item(ple_gate + (size_t)L * DM * DM, DM, DM, (bf16_t*)(wb + W_PG) + (size_t)L * DM * DM, RmId{0}, scr, item, lane); }
        for (int f = gw; f < DEPTH * 128; f += NGW) { const int L = f / 128, item = f % 128;
            transpose_item(ple_proj + (size_t)L * PLE * DM, PLE, DM, (bf16_t*)(wb + W_PP) + (size_t)L * DM * PLE, RmId{0}, scr, item, lane); }
        for (int f = gw; f < DEPTH * 2 * 256; f += NGW) { const int lk = f / 256, item = f % 256;
            transpose_item(cmp_w1 + (size_t)lk * 2048 * 256, 2048, 256, (bf16_t*)(wb + W_C1) + (size_t)lk * 256 * 2048, RmId{0}, scr, item, lane); }
        for (int f = gw * 64 + lane; f < DEPTH * (NINP - NIN) * (DM / 8); f += NGW * 64) { const int L = f / ((NINP - NIN) * (DM / 8)), r = f % ((NINP - NIN) * (DM / 8));
            *(u32x4*)((bf16_t*)(wb + W_IN) + ((size_t)L * NINP + NIN) * DM + (size_t)r * 8) = (u32x4){0u, 0u, 0u, 0u}; }
        for (int r = gw; r < NT; r += NGW) { const f32x4* xr = (const f32x4*)(x + (size_t)r * DM) + lane; u32x2* o8 = (u32x2*)(hb + (size_t)r * DM) + lane;
#pragma unroll
            for (int j = 0; j < 4; ++j) { const f32x4 v = xr[64 * j]; u32x2 w; w.x = pk2(v[0], v[1]); w.y = pk2(v[2], v[3]); o8[64 * j] = w; } }
        for (int f = gw * 64 + lane; f < NT * 32; f += NGW * 64) { const int tok = f >> 5, fi = f & 31; const float p = (float)pos[tok];
            const float a32 = p * powf(10000.f, -(float)fi / 32.f); float s, c; sincosf(a32, &s, &c); cos32[f] = c; sin32[f] = s;
            if (fi < 16) { const float a16 = p * powf(10000.f, -(float)fi / 16.f); sincosf(a16, &s, &c); cos16[tok * 16 + fi] = c; sin16[tok * 16 + fi] = s; } }
        if (vcu < DEPTH * 2) {
            const float* pe = cmp_pos + (size_t)vcu * 2048; const float* w1 = cmp_w1 + (size_t)vcu * 2048 * 256;
            const int n = tid & 255, half = tid >> 8; float s = 0.f;
            for (int kk = half * 1024; kk < half * 1024 + 1024; ++kk) s += pe[kk] * w1[(size_t)kk * 256 + n];
            LAS float* red = (LAS float*)lds;
            __syncthreads(); if (half == 1) red[n] = s; __syncthreads(); if (half == 0) c1[vcu * 256 + n] = s + red[n];
        }
        if (vcu == DEPTH * 2 && tid < DEPTH) { const float* lf = diff_lambda + tid * 128; float a = 0.f, b = 0.f;
            for (int k = 0; k < 32; ++k) { a += lf[k] * lf[32 + k]; b += lf[64 + k] * lf[96 + k]; }
            lamv[tid] = expf(a) - expf(b) + (0.8f - 0.6f * expf(-0.3f * (float)tid)); }
    }
    PHASE_END

    for (int L = 0; L < DEPTH; ++L) {
        const float lam_init = 0.8f - 0.6f * expf(-0.3f * (float)L);
        const bool moe = (L & 1);
        PHASE_BEGIN(1)
        {
            pg8::Gemm g{L == 0 ? hb : mixed, (const bf16_t*)(wb + W_IN) + (size_t)L * NINP * DM, DM, 128u};
            pg8::StaticOrder S; S.init(NT, NINP, G, bx, DM);
            EpiInProj E{proj, qr, gates, cos32, sin32, cos16, sin16};
            pg8::gemm_phase(lds, g, S, E, tid);
        }
        PHASE_END
        PHASE_BEGIN(2)
        {
            if (vcu < 16) {
                pg8::Gemm g{proj, (const bf16_t*)(wb + W_C1) + (size_t)L * 2 * 256 * 2048, 2048, (unsigned)(NINP * 2)};
                SchedCmp S{vcu}; EpiCmp E{hid, c1 + L * 512};
                pg8::gemm_phase(lds, g, S, E, tid);
            } else {
                LAS float* part = (LAS float*)lds;
                for (int it = vcu - 16; it < 512; it += G - 16) {
                    const int bh = it >> 5, j = it & 31, b = bh >> 2, h = bh & 3, kg = tid >> 3, c = tid & 7;
                    const bf16_t* kp = proj + ((size_t)b * SEQ + 256 * j + 4 * kg) * NINP + C_CK + h * 64 + c * 8;
                    float s[8] = {0.f, 0.f, 0.f, 0.f, 0.f, 0.f, 0.f, 0.f};
#pragma unroll
                    for (int k = 0; k < 4; ++k) { const u32x4 v = *(const u32x4*)(kp + (size_t)k * NINP);
                        s[0] += bflo(v.x); s[1] += bfhi(v.x); s[2] += bflo(v.y); s[3] += bfhi(v.y); s[4] += bflo(v.z); s[5] += bfhi(v.z); s[6] += bflo(v.w); s[7] += bfhi(v.w); }
                    __syncthreads();
#pragma unroll
                    for (int q = 0; q < 8; ++q) part[kg * 64 + c * 8 + q] = s[q];
                    __syncthreads();
                    if (tid < 64) { float a = 0.f; for (int k = 0; k < 64; ++k) a += part[k * 64 + tid]; kmean[(size_t)it * 64 + tid] = (bf16_t)(pk2(a * (1.f / 256.f), 0.f) & 0xffffu); }
                }
            }
        }
        PHASE_END
        PHASE_BEGIN(3)
        {
            for (int f = (vcu * NTHREADS + tid); f < 2 * 2048 * 64; f += G * NTHREADS) {
                const int d = f & 63, r = (f >> 6) & 2047, kv = f >> 17;
                const float* hr = hid + ((size_t)kv * 2048 + r) * 256; const float* w2 = cmp_w2 + ((size_t)(L * 2 + kv) * 256) * 64 + d;
                float a = 0.f;
                if ((r & 511) != 511) { for (int n = 0; n < 256; ++n) a += hr[n] * w2[(size_t)n * 64]; }
                (kv ? VC : KC)[(size_t)r * 64 + d] = (bf16_t)(pk2(a, 0.f) & 0xffffu);
            }
        }
        PHASE_END
        PHASE_BEGIN(4)
        {
            const float lam = lamv[L];
            { const int bh = vcu >> 4, s = vcu & 15;
              if (ATTMASK & 2) for (int k = 0; k < ((DUPATT & 2) ? 4 : 2); ++k) att::unit_B(lds, proj, mixed, diff_gain + L * 64, lam, lam_init, bh >> 2, bh & 3, (k & 1) ? 31 - s : s, tid, wave, lane);
              if (ATTMASK & 4) for (int k = 0; k < ((DUPATT & 4) ? 4 : 2); ++k) att::unit_C(lds, proj, kmean, mixed, bh >> 2, bh & 3, (k & 1) ? 31 - s : s, tid, wave, lane);
              if (ATTMASK & 1) for (int k = 0; k < ((DUPATT & 1) ? 4 : 2); ++k) att::unit_A(lds, proj, mixed, bh >> 2, bh & 3, (k & 1) ? 31 - s : s, tid, wave, lane); }
            { const int b = vcu >> 6, s = vcu & 63;
              if (ATTMASK & 8) for (int k = 0; k < ((DUPATT & 8) ? 4 : 2); ++k) att::unit_D(lds, proj, qr, KC, VC, gates, mixed, b, (k & 1) ? 127 - s : s, tid, wave, lane); }
        }
        PHASE_END
        PHASE_BEGIN(5)
        {
            pg8::Gemm g{mixed, (const bf16_t*)(wb + W_OUT) + (size_t)L * DM * DM, DM, 128u};
            pg8::StaticOrder S; S.init(NT, DM, G, bx, DM);
            EpiResid E{L == 0 ? x : dout, dout};
            pg8::gemm_phase(lds, g, S, E, tid);
        }
        PHASE_END
        PHASE_BEGIN(6)
        {
            const float* gv = ln_mix_g + L * DM; const float* bv = ln_mix_b + L * DM;
            f32x4 gg[4], bb[4];
#pragma unroll
            for (int j = 0; j < 4; ++j) { gg[j] = *((const f32x4*)gv + lane + 64 * j); bb[j] = *((const f32x4*)bv + lane + 64 * j); }
            if (tid < 8) cw[LW_CNTL + tid] = 0;
            __syncthreads();
            int k = 0;
            for (int r = gw; r < NT; r += NGW, ++k) {
                f32x4* xr = (f32x4*)(dout + (size_t)r * DM) + lane;
                f32x4 v[4]; float s = 0.f;
#pragma unroll
                for (int j = 0; j < 4; ++j) { v[j] = xr[64 * j]; s += (v[j][0] + v[j][1]) + (v[j][2] + v[j][3]); }
                const float mean = wave_sum(s) * (1.f / DM); float s2 = 0.f;
#pragma unroll
                for (int j = 0; j < 4; ++j) { v[j] = v[j] - mean; s2 += (v[j][0] * v[j][0] + v[j][1] * v[j][1]) + (v[j][2] * v[j][2] + v[j][3] * v[j][3]); }
                const float rstd = rsqrtf(wave_sum(s2) * (1.f / DM) + LN_EPS);
                u32x2* o8 = (u32x2*)(hb + (size_t)r * DM) + lane;
#pragma unroll
                for (int j = 0; j < 4; ++j) { v[j] = v[j] * rstd * gg[j] + bb[j]; u32x2 w; w.x = pk2(v[j][0], v[j][1]); w.y = pk2(v[j][2], v[j][3]); o8[64 * j] = w; if (!moe) xr[64 * j] = v[j]; }
                if (moe) {
                    float lg[8];
#pragma unroll
                    for (int e = 0; e < 8; ++e) lg[e] = 0.f;
#pragma unroll
                    for (int j = 0; j < 4; ++j)
#pragma unroll
                        for (int q = 0; q < 4; ++q) { const f32x4* wr = (const f32x4*)(moe_router + (size_t)(4 * lane + 256 * j + q) * 8); const f32x4 w0 = wr[0], w1 = wr[1]; const float hv = v[j][q];
                            lg[0] += hv * w0[0]; lg[1] += hv * w0[1]; lg[2] += hv * w0[2]; lg[3] += hv * w0[3]; lg[4] += hv * w1[0]; lg[5] += hv * w1[1]; lg[6] += hv * w1[2]; lg[7] += hv * w1[3]; }
#pragma unroll
                    for (int e = 0; e < 8; ++e) lg[e] = wave_sum(lg[e]);
                    int e0 = 0; float b0 = lg[0];
#pragma unroll
                    for (int e = 1; e < 8; ++e) if (lg[e] > b0) { b0 = lg[e]; e0 = e; }
                    int e1 = -1; float b1 = -INFINITY;
#pragma unroll
                    for (int e = 0; e < 8; ++e) if (e != e0 && lg[e] > b1) { b1 = lg[e]; e1 = e; }
                    const float g1 = 1.f / (1.f + expf(b0 - b1)), g0 = 1.f - g1;
                    if (lane == 0) {
                        const int s0 = __hip_atomic_fetch_add(cw + LW_CNTL + e0, 1, __ATOMIC_RELAXED, __HIP_MEMORY_SCOPE_WORKGROUP), s1 = __hip_atomic_fetch_add(cw + LW_CNTL + e1, 1, __ATOMIC_RELAXED, __HIP_MEMORY_SCOPE_WORKGROUP);
                        const int ix = (wave * 16 + k) * 2; cw[LW_PE + ix] = e0 | (s0 << 8); cw[LW_PE + ix + 1] = e1 | (s1 << 8);
                        moeg[2 * r] = g0; moeg[2 * r + 1] = g1;
                    }
                }
                { const f32x4 pv4 = *((const f32x4*)(pin + ((size_t)L * NT + r) * PLE) + lane); u32x2 w; w.x = pk2(pv4[0], pv4[1]); w.y = pk2(pv4[2], pv4[3]); *((u32x2*)(pb + (size_t)r * PLE) + lane) = w; }
            }
            if (moe) {
                __syncthreads();
                if (tid < 8) cw[LW_BASEL + tid] = (int)__hip_atomic_fetch_add(ctl + CW_CNT + 64 * tid, (unsigned)cw[LW_CNTL + tid], __ATOMIC_RELAXED, __HIP_MEMORY_SCOPE_AGENT);
                __syncthreads();
                if (tid < 256) { const int wv = tid >> 5, kk = (tid >> 1) & 15, r = vcu * NWAVES + wv + kk * NGW;
                    if (r < NT) { const int pe = cw[LW_PE + tid], e = pe & 255, sl = pe >> 8; list[e * 32768 + cw[LW_BASEL + e] + sl] = 2 * r + (tid & 1); } }
            }
        }
        PHASE_END
        for (int chunk = 0; chunk < (moe ? 2 : 1); ++chunk) {
            PHASE_BEGIN(7)
            {
                __syncthreads();
                if (tid == 0) { int ts = 0;
                    for (int e = 0; e < 8; ++e) { const int c = moe ? (int)__hip_atomic_load(ctl + CW_CNT + 64 * e, __ATOMIC_RELAXED, __HIP_MEMORY_SCOPE_AGENT) : (e == 0 ? NT : 0); cw[LW_CNT + e] = c; cw[LW_TS + e] = ts; ts += (c + 255) >> 8; }
                    cw[LW_TS + 8] = ts; }
                __syncthreads();
                const int ntile = cw[LW_TS + 8], t0 = chunk * 128, t1 = chunk == 0 ? (ntile < 128 ? ntile : 128) : ntile;
                if (t1 > t0) {
                    pg8::Gemm g{hb, (const bf16_t*)(wb + W_F13), DM, 128u};
                    SchedGU S{cw, list, t0, t1, G, bx, !moe}; EpiSwiglu E{hidb, t0};
                    pg8::gemm_phase(lds, g, S, E, tid);
                }
            }
            PHASE_END
            PHASE_BEGIN(8)
            {
                __syncthreads();
                if (tid == 0) { int ts = 0;
                    for (int e = 0; e < 8; ++e) { const int c = moe ? (int)__hip_atomic_load(ctl + CW_CNT + 64 * e, __ATOMIC_RELAXED, __HIP_MEMORY_SCOPE_AGENT) : (e == 0 ? NT : 0); cw[LW_CNT + e] = c; cw[LW_TS + e] = ts; ts += (c + 255) >> 8; }
                    cw[LW_TS + 8] = ts; }
                __syncthreads();
                const int ntile = cw[LW_TS + 8], t0 = chunk * 128, t1 = chunk == 0 ? (ntile < 128 ? ntile : 128) : ntile;
                if (t1 > t0) {
                    pg8::Gemm g{hidb, (const bf16_t*)(wb + W_F2), DFF, 128u};
                    SchedDN S{cw, t0, t1, G, bx, !moe}; EpiDown E{!moe, dout, (bf16_t*)dout, cw, list, moeg};
                    pg8::gemm_phase(lds, g, S, E, tid);
                }
            }
            PHASE_END
        }
        PHASE_BEGIN(9)
        {
            const float* gv = ln_ffn_g + L * DM; const float* bv = ln_ffn_b + L * DM;
            f32x4 gg[4], bb[4];
#pragma unroll
            for (int j = 0; j < 4; ++j) { gg[j] = *((const f32x4*)gv + lane + 64 * j); bb[j] = *((const f32x4*)bv + lane + 64 * j); }
            float* hout = moe ? H2 : dout;
            for (int r = gw; r < NT; r += NGW) {
                f32x4 v[4]; float s = 0.f;
                u32x2* h8 = (u32x2*)(hb + (size_t)r * DM) + lane;
                if (!moe) {
                    const f32x4* xr = (const f32x4*)(dout + (size_t)r * DM) + lane;
#pragma unroll
                    for (int j = 0; j < 4; ++j) v[j] = xr[64 * j];
                } else {
                    const u32x2* y0 = (const u32x2*)((const bf16_t*)dout + (size_t)(2 * r) * DM) + lane; const u32x2* y1 = (const u32x2*)((const bf16_t*)dout + (size_t)(2 * r + 1) * DM) + lane;
#pragma unroll
                    for (int j = 0; j < 4; ++j) { const u32x2 a = h8[64 * j], c = y0[64 * j], d = y1[64 * j];
                        v[j][0] = ALPHA * bflo(a.x) + (bflo(c.x) + bflo(d.x)); v[j][1] = ALPHA * bfhi(a.x) + (bfhi(c.x) + bfhi(d.x));
                        v[j][2] = ALPHA * bflo(a.y) + (bflo(c.y) + bflo(d.y)); v[j][3] = ALPHA * bfhi(a.y) + (bfhi(c.y) + bfhi(d.y)); }
                }
#pragma unroll
                for (int j = 0; j < 4; ++j) s += (v[j][0] + v[j][1]) + (v[j][2] + v[j][3]);
                const float mean = wave_sum(s) * (1.f / DM); float s2 = 0.f;
#pragma unroll
                for (int j = 0; j < 4; ++j) { v[j] = v[j] - mean; s2 += (v[j][0] * v[j][0] + v[j][1] * v[j][1]) + (v[j][2] * v[j][2] + v[j][3] * v[j][3]); }
                const float rstd = rsqrtf(wave_sum(s2) * (1.f / DM) + LN_EPS);
                f32x4* orow = (f32x4*)(hout + (size_t)r * DM) + lane;
#pragma unroll
                for (int j = 0; j < 4; ++j) { v[j] = v[j] * rstd * gg[j] + bb[j]; orow[64 * j] = v[j]; u32x2 w; w.x = pk2(v[j][0], v[j][1]); w.y = pk2(v[j][2], v[j][3]); h8[64 * j] = w; }
            }
        }
        PHASE_END
        PHASE_BEGIN(10)
        {
            pg8::Gemm g{pb, (const bf16_t*)(wb + W_PP) + (size_t)L * DM * PLE, PLE, 128u};
            pg8::StaticOrder S; S.init(NT, DM, G, bx, PLE);
            EpiBf16 E{Pp, DM};
            pg8::gemm_phase(lds, g, S, E, tid);
        }
        PHASE_END
        PHASE_BEGIN(11)
        {
            pg8::Gemm g{hb, (const bf16_t*)(wb + W_PG) + (size_t)L * DM * DM, DM, 128u};
            pg8::StaticOrder S; S.init(NT, DM, G, bx, DM);
            EpiPle E{moe ? H2 : dout, Pp, dout, (L + 1 < DEPTH) ? mixed : nullptr};
            pg8::gemm_phase(lds, g, S, E, tid);
        }
        PHASE_END
    }
#undef PHASE_BEGIN
#undef PHASE_END
}

extern "C" void kernel_launch(void* const* d_in, const int* in_sizes, int n_in, void* d_out, int out_size, void* d_ws, size_t ws_size, hipStream_t stream) {
    static int grid = 0;
    if (grid == 0) {
        if (n_in != 23 || out_size != NT * DM || ws_size < WS_END) { fprintf(stderr, "kernel_launch: unexpected problem (n_in %d out %d ws %zu need %zu)\n", n_in, out_size, ws_size, (size_t)WS_END); grid = -1; return; }
        int dev = 0, cus = 0;
        if (hipGetDevice(&dev) != hipSuccess || hipDeviceGetAttribute(&cus, hipDeviceAttributeMultiprocessorCount, dev) != hipSuccess) { grid = -1; return; }
        if (hipFuncSetAttribute((const void*)mk_fwd, hipFuncAttributeMaxDynamicSharedMemorySize, LDS_BYTES) != hipSuccess) { fprintf(stderr, "kernel_launch: hipFuncSetAttribute failed\n"); grid = -1; return; }
        int per_cu = 0;
        if (hipOccupancyMaxActiveBlocksPerMultiprocessor(&per_cu, (const void*)mk_fwd, NTHREADS, LDS_BYTES) != hipSuccess || per_cu < 1) { fprintf(stderr, "kernel_launch: occupancy query says %d blocks per CU\n", per_cu); }
        (void)hipGetLastError();
        grid = cus;
        if (grid != 256) { fprintf(stderr, "kernel_launch: built for 256 CUs, device has %d\n", cus); grid = -1; return; }
    }
    if (grid < 0) return;
    (void)hipMemsetAsync((char*)d_ws + WS_CTL, 0, CTL_ZERO_BYTES, stream);
    Args a{};
    for (int i = 0; i < 23; ++i) a.in[i] = d_in[i];
    a.out = (float*)d_out; a.ws = (unsigned char*)d_ws;
#if MK_MULTI
    for (int p = 0; p < NPHASES; ++p) { a.ph_lo = p; a.ph_hi = p + 1; hipLaunchKernelGGL(mk_fwd, dim3(grid), dim3(NTHREADS), LDS_BYTES, stream, a); }
#else
    a.ph_lo = 0; a.ph_hi = NPHASES;
    hipLaunchKernelGGL(mk_fwd, dim3(grid), dim3(NTHREADS), LDS_BYTES, stream, a);
#endif
}
```

```cpp
#include <hip/hip_runtime.h>
#include <cstdio>
#include <cstdint>

#ifndef PHMASK
#define PHMASK 0xFFFF
#endif
#ifndef DUPMASK
#define DUPMASK 0
#endif
#ifndef DUPATT
#define DUPATT 0
#endif
#ifndef ATTMASK
#define ATTMASK 0xF
#endif
#ifndef MK_MULTI
#define MK_MULTI 0
#endif

#define LAS __attribute__((address_space(3)))
#define GAS __attribute__((address_space(1)))
typedef unsigned short bf16_t;
typedef short bf16x8 __attribute__((ext_vector_type(8)));
typedef short s16x4 __attribute__((ext_vector_type(4)));
typedef float f32x2 __attribute__((ext_vector_type(2)));
typedef float f32x4 __attribute__((ext_vector_type(4)));
typedef float f32x16 __attribute__((ext_vector_type(16)));
typedef unsigned u32x2 __attribute__((ext_vector_type(2)));
typedef unsigned u32x4 __attribute__((ext_vector_type(4)));
typedef __bf16 bf16x2_t __attribute__((ext_vector_type(2)));

constexpr int NB = 4, SEQ = 8192, NT = NB * SEQ, DM = 1024, NIN = 2956, NINP = 3072, DFF = 3584, NEXP = 8, PLE = 256, DEPTH = 2;
constexpr int NCMP = 512;
constexpr float LOG2E = 1.4426950408889634f;
constexpr float ALPHA = 1.4142135623730951f;
constexpr float LN_EPS = 1e-5f, RMS_EPS = 1e-5f;
constexpr float QS64 = 0.125f * LOG2E;
constexpr float QS32 = 0.17677669529663687f * LOG2E;
constexpr int C_AQ = 0, C_AK = 256, C_AV = 512, C_BQ = 768, C_BK = 1024, C_BV = 1280, C_CQ = 1536, C_CK = 1792, C_CV = 2048, C_DQ = 2304;
constexpr int C_KC = 2560, C_VC = 2624, C_KS = 2688, C_VS = 2752, C_KW = 2816, C_VW = 2880, C_G = 2944;

constexpr size_t MiB = 1u << 20;
constexpr size_t WS_CTL = 0, CTL_ZERO_BYTES = 1 * MiB;
constexpr size_t WS_MISC = 1 * MiB;
constexpr size_t OFF_LAM = 0;
constexpr size_t OFF_C1 = 4096;
constexpr size_t OFF_KMEAN = 16384;
constexpr size_t OFF_KC = 128 * 1024;
constexpr size_t OFF_VC = 384 * 1024;
constexpr size_t OFF_GATES = 1 * MiB;
constexpr size_t OFF_MOEG = 3 * MiB;
constexpr size_t OFF_LIST = 4 * MiB;
constexpr size_t OFF_HID = 5 * MiB;
constexpr size_t WS_ROPE = 11 * MiB;
constexpr size_t WS_W = 23 * MiB;
constexpr size_t W_IN = 0;
constexpr size_t W_OUT = W_IN + (size_t)DEPTH * NINP * DM * 2;
constexpr size_t W_PG = W_OUT + (size_t)DEPTH * DM * DM * 2;
constexpr size_t W_PP = W_PG + (size_t)DEPTH * DM * DM * 2;
constexpr size_t W_C1 = W_PP + (size_t)DEPTH * DM * PLE * 2;
constexpr size_t W_F13 = W_C1 + (size_t)DEPTH * 2 * 256 * 2048 * 2;
constexpr size_t W_F2 = W_F13 + (size_t)9 * 2 * DFF * DM * 2;
constexpr size_t W_END = W_F2 + (size_t)9 * DM * DFF * 2;
constexpr size_t WS_HB = WS_W + ((W_END + MiB - 1) / MiB) * MiB;
constexpr size_t WS_PB = WS_HB + 64 * MiB;
constexpr size_t WS_R = WS_PB + 16 * MiB;
constexpr size_t R_PROJ = 0;
constexpr size_t R_QR = 193 * MiB;
constexpr size_t R_MIXED = 209 * MiB;
constexpr size_t R_HID = 0;
constexpr size_t R_H2 = 0;
constexpr size_t R_P = 128 * MiB;
constexpr size_t WS_END = WS_R + 274 * MiB;
constexpr int CW_BAR = 4096, CW_CNT = 8192;

__device__ __forceinline__ unsigned pk2(float lo, float hi) { f32x2 v = {lo, hi}; bf16x2_t b = __builtin_convertvector(v, bf16x2_t); return __builtin_bit_cast(unsigned, b); }
__device__ __forceinline__ float bflo(unsigned w) { return __uint_as_float(w << 16); }
__device__ __forceinline__ float bfhi(unsigned w) { return __uint_as_float(w & 0xffff0000u); }
__device__ __forceinline__ float wave_sum(float v) {
#pragma unroll
    for (int o = 1; o < 64; o <<= 1) v += __shfl_xor(v, o);
    return v;
}
__device__ __forceinline__ float wave_max(float v) {
#pragma unroll
    for (int o = 1; o < 64; o <<= 1) v = fmaxf(v, __shfl_xor(v, o));
    return v;
}
__device__ __forceinline__ unsigned wave_or(unsigned v) {
#pragma unroll
    for (int o = 1; o < 64; o <<= 1) v |= (unsigned)__shfl_xor((int)v, o);
    return v;
}
__device__ __forceinline__ float xhalf(float x) { const unsigned u = __float_as_uint(x); auto rr = __builtin_amdgcn_permlane32_swap(u, u, false, false); return __uint_as_float(rr[0] ^ rr[1] ^ u); }
__device__ __forceinline__ float ex2(float x) { return __builtin_amdgcn_exp2f(x); }
__device__ __forceinline__ float lg2(float x) { return __builtin_amdgcn_logf(x); }
__device__ __forceinline__ float sigmoidf_(float x) { return 1.0f / (1.0f + __expf(-x)); }
__device__ __forceinline__ float quad_sum(float x) {
    x += __builtin_bit_cast(float, __builtin_amdgcn_update_dpp(0, __builtin_bit_cast(int, x), 0xB1, 0xF, 0xF, true));
    x += __builtin_bit_cast(float, __builtin_amdgcn_update_dpp(0, __builtin_bit_cast(int, x), 0x4E, 0xF, 0xF, true));
    return x;
}

#define XB_TMO      128
#define XB_XCNT(j)  (256  + 64 * (j))
#define XB_XSUB(j)  (1280 + 64 * (j))
#define XB_XGEN(j)  (2304 + 64 * (j))
#define XB_TOP      3328
#define XB_TOPGEN   3392
#define XCD_BAR_WORDS 3456
#define XB_SPIN_CAP (1u << 18)
__device__ __forceinline__ unsigned xb_ld(unsigned* p)              { return __hip_atomic_load(p, __ATOMIC_RELAXED, __HIP_MEMORY_SCOPE_AGENT); }
__device__ __forceinline__ unsigned xb_add(unsigned* p, unsigned v) { return __hip_atomic_fetch_add(p, v, __ATOMIC_RELAXED, __HIP_MEMORY_SCOPE_AGENT); }
__device__ __forceinline__ unsigned xb_xcc_id() { return (unsigned)__builtin_amdgcn_s_getreg((3 << 11) | 20) & 0xFu; }
#define XB_SPIN(cond, bar) do { unsigned _sp = 0; while (cond) { __builtin_amdgcn_s_sleep(1); \
    if ((++_sp & 255u) == 0u) { if (xb_ld(&(bar)[XB_TMO])) break; if (_sp > XB_SPIN_CAP) { atomicAdd(&(bar)[XB_TMO], 1u); break; } } } } while (0)
struct XcdBarrier { unsigned* bar; unsigned x; volatile LAS unsigned* st; };
__device__ __forceinline__ XcdBarrier xcd_barrier_post(unsigned* bar, volatile LAS unsigned* st) {
    XcdBarrier b; b.bar = bar; b.x = xb_xcc_id(); b.st = st;
    if (threadIdx.x == 0) (void)xb_add(&bar[XB_XCNT(b.x)], 1u);
    return b;
}
__device__ __forceinline__ void xcd_barrier_complete(unsigned* bar, unsigned x, unsigned& nloc, unsigned& nx) {
    const unsigned G = gridDim.x * gridDim.y * gridDim.z;
    unsigned sum, cnt, mine, sp = 0u;
    for (;;) {
        sum = 0u; cnt = 0u; mine = 0u;
#pragma unroll 1
        for (unsigned j = 0; j < 16; ++j) { const unsigned c = xb_ld(&bar[XB_XCNT(j)]); sum += c; cnt += (c > 0u) ? 1u : 0u; mine = (j == x) ? c : mine; }
        if (sum == G) break;
        __builtin_amdgcn_s_sleep(1);
        if ((++sp & 255u) == 0u) { if (xb_ld(&bar[XB_TMO])) break; if (sp > XB_SPIN_CAP) { atomicAdd(&bar[XB_TMO], 1u); break; } }
    }
    nloc = mine > 0u ? mine : 1u; nx = cnt > 0u ? cnt : 1u;
}
__device__ __forceinline__ void xcd_barrier(const XcdBarrier& b) {
    asm volatile("s_waitcnt vmcnt(0)" ::: "memory");
    __syncthreads();
    if (threadIdx.x == 0) {
        unsigned* bar = b.bar;
        __builtin_amdgcn_s_waitcnt(0);
        unsigned nloc = b.st[0], nx = b.st[1];
        if (nloc == 0u) { xcd_barrier_complete(bar, b.x, nloc, nx); b.st[0] = nloc; b.st[1] = nx; }
        const unsigned old = xb_add(&bar[XB_XSUB(b.x)], 1u);
        const unsigned gen = old / nloc;
        if (old + 1u == (gen + 1u) * nloc) {
            __builtin_amdgcn_fence(__ATOMIC_RELEASE, "agent");
            asm volatile("s_waitcnt vmcnt(0)" ::: "memory");
            const unsigned og = xb_add(&bar[XB_TOP], 1u);
            const unsigned tg = og / nx;
            if (og + 1u == (tg + 1u) * nx) xb_add(&bar[XB_TOPGEN], 1u);
            else XB_SPIN(xb_ld(&bar[XB_TOPGEN]) == tg, bar);
            __builtin_amdgcn_fence(__ATOMIC_ACQUIRE, "agent");
            xb_add(&bar[XB_XGEN(b.x)], 1u);
            asm volatile("s_waitcnt vmcnt(0)" ::: "memory");
        } else {
            XB_SPIN(xb_ld(&bar[XB_XGEN(b.x)]) == gen, bar);
            __builtin_amdgcn_fence(__ATOMIC_ACQUIRE, "agent");
            asm volatile("s_waitcnt vmcnt(0)" ::: "memory");
        }
    }
    __syncthreads();
}

namespace pg8 {
constexpr int BM = 256, BK = 64, HALF = 128, HTB = HALF * BK * 2, STAGE_BYTES = 8 * HTB, NXCD = 8, WGM = 8;
__host__ __device__ __forceinline__ int lds_byte(int r, int c) { const int st = (r >> 4) * 2 + (c >> 5), rr = r & 15, cc = c & 31, ob = rr * 64 + cc * 2; return st * 1024 + (ob ^ (((ob >> 9) & 1) << 5)); }
__host__ __device__ __forceinline__ void stage_rc(int b, int& R, int& C) { const int st = b / 1024, sb = b % 1024, swz = sb ^ (((sb >> 9) & 1) << 5); R = (st >> 1) * 16 + swz / 64; C = (st & 1) * 32 + (swz % 64) / 2; }
__host__ __device__ __forceinline__ int perm32(int rho) { const int n = rho >> 4, i = rho & 15; return 8 * (i >> 2) + 4 * n + (i & 3); }
struct Unit { int pm, pn, pb; };
struct Gemm { const bf16_t* A; const bf16_t* Bt; int K; unsigned kstepA; };

struct StaticOrder {
    int nM, nN, nwg, G, c; unsigned ldaB;
    __device__ void init(int M, int N, int G_, int c_, int lda) { nM = M / BM; nN = N / BM; nwg = nM * nN; G = G_; c = c_; ldaB = (unsigned)lda * 2u; }
    __device__ bool next(int i, Unit& u) const {
        const long L = (long)i * G + c; if (L >= nwg) return false;
        int wgid = (int)L; { const int q = nwg / NXCD, r = nwg % NXCD, xcd = wgid % NXCD, off = wgid / NXCD; wgid = (xcd < r ? xcd * (q + 1) : r * (q + 1) + (xcd - r) * q) + off; }
        const int nig = WGM * nN, gid = wgid / nig, fm = gid * WGM, gsz = (nM - fm) < WGM ? (nM - fm) : WGM;
        u.pm = fm + ((wgid % nig) % gsz); u.pn = (wgid % nig) / gsz; u.pb = u.pn; return true;
    }
    __device__ __forceinline__ unsigned arow(const Unit& u, int r) const { return (unsigned)(u.pm * BM + r) * ldaB; }
};

template <class Epi, class Sched>
__device__ __forceinline__ void gemm_phase(LAS unsigned char* lds, const Gemm g, const Sched& S, const Epi& E, const int tid) {
    const int wid = __builtin_amdgcn_readfirstlane(tid >> 6), lane = tid & 63, wr = wid >> 2, wc = wid & 3, fr = lane & 15, fq = lane >> 4;
    const int K = g.K, nt = K / BK;
    int Rr[2], Cc[2]; unsigned voffB[2];
#pragma unroll
    for (int i = 0; i < 2; ++i) { stage_rc(tid * 16 + i * 8192, Rr[i], Cc[i]); const int Rb = Epi::PERM ? ((Rr[i] & ~31) + perm32(Rr[i] & 31)) : Rr[i]; voffB[i] = (unsigned)(Rb * K + Cc[i]) * 2u; }
    const size_t kstepB = (size_t)(BK * 2), kstepA = (size_t)g.kstepA;
    const size_t hstepB = (size_t)HALF * K * 2, tstepB = 2 * hstepB;
    const unsigned ldsw = (unsigned)wid * 1024u;
    const int aoff = lds_byte(wr * 64 + fr, fq * 8), boff = lds_byte(wc * 32 + fr, fq * 8);
#define PG8_SA(b, h) (((b) * 2 + (h)) * HTB)
#define PG8_SB(b, h) ((4 + (b) * 2 + (h)) * HTB)
#define PG8_STAGE(bufoff, gbase, voff) do { _Pragma("unroll") for (int _i = 0; _i < 2; ++_i) \
        __builtin_amdgcn_global_load_lds((const unsigned*)((const char*)(gbase) + (voff)[_i]), (LAS unsigned*)(lds + (bufoff) + ldsw + _i * 8192), 16, 0, 0); } while (0)
#define PG8_LDA(dst, b, h) do { _Pragma("unroll") for (int m = 0; m < 4; ++m) _Pragma("unroll") for (int k = 0; k < 2; ++k) dst[m][k] = *(const LAS bf16x8*)(lds + PG8_SA(b, h) + aoff + m * 2048 + k * 1024); } while (0)
#define PG8_LDB(dst, b, h) do { _Pragma("unroll") for (int n = 0; n < 2; ++n) _Pragma("unroll") for (int k = 0; k < 2; ++k) dst[n][k] = *(const LAS bf16x8*)(lds + PG8_SB(b, h) + boff + n * 2048 + k * 1024); } while (0)
#define PG8_MMA(ai, bj, At, Bt) do { __builtin_amdgcn_s_setprio(1); _Pragma("unroll") for (int m = 0; m < 4; ++m) _Pragma("unroll") for (int n = 0; n < 2; ++n) _Pragma("unroll") for (int k = 0; k < 2; ++k) \
        acc[ai][bj][m][n] = __builtin_amdgcn_mfma_f32_16x16x32_bf16(Bt[n][k], At[m][k], acc[ai][bj][m][n], 0, 0, 0); __builtin_amdgcn_s_setprio(0); } while (0)
#define PG8_WAIT_V(n) asm volatile("s_waitcnt vmcnt(" #n ")" ::: "memory")
#define PG8_WAIT_L(n) asm volatile("s_waitcnt lgkmcnt(" #n ")" ::: "memory")
#define PG8_BAR __builtin_amdgcn_s_barrier()
#define PG8_SCHED __builtin_amdgcn_sched_barrier(0)
    Unit cur, nxt; int ui = 0;
    if (!S.next(0, cur)) return;
    f32x4 acc[2][2][4][2];
#pragma unroll
    for (int a = 0; a < 2; ++a)
#pragma unroll
        for (int b = 0; b < 2; ++b)
#pragma unroll
            for (int m = 0; m < 4; ++m)
#pragma unroll
                for (int n = 0; n < 2; ++n) acc[a][b][m][n] = (f32x4){0.f, 0.f, 0.f, 0.f};
    bf16x8 At[4][2], B0[2][2], B1[2][2];
    unsigned vc0[2], vc1[2];
    LAS u32x4* const stash = (LAS u32x4*)(lds + 133120 + tid * 16);
#pragma unroll
    for (int i = 0; i < 2; ++i) { vc0[i] = S.arow(cur, Rr[i]) + (unsigned)Cc[i] * 2u; vc1[i] = S.arow(cur, HALF + Rr[i]) + (unsigned)Cc[i] * 2u; }
    const char* const Ab = (const char*)g.A;
    const char* cB = (const char*)g.Bt + (size_t)cur.pb * tstepB;
    PG8_STAGE(PG8_SB(0, 0), cB, voffB); PG8_STAGE(PG8_SB(0, 1), cB + hstepB, voffB); PG8_STAGE(PG8_SA(0, 0), Ab, vc0); PG8_STAGE(PG8_SA(0, 1), Ab, vc1);
    if (wr == 1) PG8_BAR;
    PG8_WAIT_V(2); PG8_BAR;
    PG8_STAGE(PG8_SB(1, 0), cB + kstepB, voffB); PG8_STAGE(PG8_SA(1, 0), Ab + kstepA, vc0); PG8_STAGE(PG8_SB(1, 1), cB + hstepB + kstepB, voffB);
    PG8_WAIT_V(6); PG8_BAR;
    for (;;) {
        const bool has_next = S.next(ui + 1, nxt);
        if (!has_next) nxt = cur;
        { u32x4 sv; sv.x = S.arow(nxt, Rr[0]) + (unsigned)Cc[0] * 2u; sv.y = S.arow(nxt, Rr[1]) + (unsigned)Cc[1] * 2u; sv.z = S.arow(nxt, HALF + Rr[0]) + (unsigned)Cc[0] * 2u; sv.w = S.arow(nxt, HALF + Rr[1]) + (unsigned)Cc[1] * 2u; *stash = sv; }
        const char* nB = (const char*)g.Bt + (size_t)nxt.pb * tstepB;
        for (int t = 0; t < nt; t += 2) {
            const bool last = (t == nt - 2);
            const char* a1 = Ab + (size_t)(t + 1) * kstepA;
            const char* a2 = last ? Ab : Ab + (size_t)(t + 2) * kstepA; const char* b2 = last ? nB : cB + (size_t)(t + 2) * kstepB;
            const char* a3 = a2 + kstepA; const char* b3 = b2 + kstepB;
            PG8_LDB(B0, 0, 0); PG8_LDB(B1, 0, 1); PG8_SCHED; PG8_LDA(At, 0, 0); PG8_STAGE(PG8_SA(1, 1), a1, vc1);
            if (last) { const u32x4 sv = *stash; vc0[0] = sv.x; vc0[1] = sv.y; vc1[0] = sv.z; vc1[1] = sv.w; }
            PG8_WAIT_V(8); PG8_WAIT_L(0); PG8_BAR; PG8_MMA(0, 0, At, B0); PG8_MMA(0, 1, At, B1); PG8_BAR; PG8_SCHED;
            PG8_LDA(At, 0, 1); PG8_STAGE(PG8_SB(0, 0), b2, voffB); PG8_STAGE(PG8_SB(0, 1), b2 + hstepB, voffB); PG8_STAGE(PG8_SA(0, 0), a2, vc0);
            PG8_WAIT_V(8); PG8_WAIT_L(0); PG8_BAR; PG8_MMA(1, 0, At, B0); PG8_MMA(1, 1, At, B1); PG8_BAR; PG8_SCHED;
            PG8_LDB(B0, 1, 0); PG8_LDB(B1, 1, 1); PG8_SCHED; PG8_LDA(At, 1, 0); PG8_STAGE(PG8_SA(0, 1), a2, vc1);
            PG8_WAIT_V(8); PG8_WAIT_L(0); PG8_BAR; PG8_MMA(0, 0, At, B0); PG8_MMA(0, 1, At, B1); PG8_BAR; PG8_SCHED;
            PG8_LDA(At, 1, 1); PG8_STAGE(PG8_SB(1, 0), b3, voffB); PG8_STAGE(PG8_SB(1, 1), b3 + hstepB, voffB); PG8_STAGE(PG8_SA(1, 0), a3, vc0);
            PG8_WAIT_V(8); PG8_WAIT_L(0); PG8_BAR; PG8_MMA(1, 0, At, B0); PG8_MMA(1, 1, At, B1); PG8_BAR; PG8_SCHED;
        }
        if (wr == 0) PG8_BAR;
        { int fr_e = fr, fq_e = fq; asm volatile("" : "+v"(fr_e), "+v"(fq_e)); E(acc, cur, wr, wc, fr_e, fq_e); }
        if (!has_next) break;
#pragma unroll
        for (int a = 0; a < 2; ++a)
#pragma unroll
            for (int b = 0; b < 2; ++b)
#pragma unroll
                for (int m = 0; m < 4; ++m)
#pragma unroll
                    for (int n = 0; n < 2; ++n) acc[a][b][m][n] = (f32x4){0.f, 0.f, 0.f, 0.f};
        cur = nxt; cB = nB; ++ui;
        if (wr == 1) PG8_BAR;
    }
    PG8_WAIT_V(0);
    PG8_BAR;
#undef PG8_SA
#undef PG8_SB
#undef PG8_STAGE
#undef PG8_LDA
#undef PG8_LDB
#undef PG8_MMA
#undef PG8_WAIT_V
#undef PG8_WAIT_L
#undef PG8_BAR
#undef PG8_SCHED
}
}

typedef f32x4 Acc[2][2][4][2];
__device__ __forceinline__ void st_bf4(bf16_t* p, f32x4 v) { u32x2 w; w.x = pk2(v[0], v[1]); w.y = pk2(v[2], v[3]); *(u32x2*)p = w; }

struct EpiInProj {
    static constexpr bool PERM = false;
    bf16_t* proj; bf16_t* qr; float* gates; const float* cos32; const float* sin32; const float* cos16; const float* sin16;
    __device__ __forceinline__ void operator()(const Acc& acc, const pg8::Unit& u, int wr, int wc, int fr, int fq) const {
        const int pn = u.pn;
#pragma unroll
        for (int ai = 0; ai < 2; ++ai)
#pragma unroll
            for (int m = 0; m < 4; ++m) {
                const int row = u.pm * 256 + ai * 128 + wr * 64 + m * 16 + fr;
                bf16_t* prow = proj + (size_t)row * NINP + pn * 256;
#pragma unroll
                for (int bj = 0; bj < 2; ++bj) {
                    const f32x4 v0 = acc[ai][bj][m][0], v1 = acc[ai][bj][m][1];
                    const int cb = 128 * bj + 32 * wc;
                    const int blk = cb >> 6, a = wc & 1;
                    int mode = 0; float sc = 1.f;
                    if (pn == 0) sc = QS64;
                    else if (pn == 3) { mode = 1; sc = QS32; }
                    else if (pn == 4) mode = 1;
                    else if (pn == 6) { mode = 2; sc = QS64; }
                    else if (pn == 7) mode = 2;
                    else if (pn == 9) { mode = 3; sc = QS64; }
                    else if (pn == 10) mode = (blk == 2) ? 2 : 0;
                    else if (pn == 11) mode = (blk == 0) ? 2 : (blk == 1) ? 0 : (blk == 2 && a == 0) ? 4 : 5;
                    if (mode == 0) { st_bf4(prow + cb + 4 * fq, v0 * sc); st_bf4(prow + cb + 16 + 4 * fq, v1 * sc); }
                    else if (mode == 1) {
                        const f32x4 c = *(const f32x4*)(cos16 + (size_t)row * 16 + 4 * fq), s = *(const f32x4*)(sin16 + (size_t)row * 16 + 4 * fq);
                        st_bf4(prow + cb + 4 * fq, (v0 * c - v1 * s) * sc); st_bf4(prow + cb + 16 + 4 * fq, (v1 * c + v0 * s) * sc);
                    } else if (mode == 2 || mode == 3) {
                        const f32x4 c = *(const f32x4*)(cos32 + (size_t)row * 32 + 16 * a + 4 * fq), s = *(const f32x4*)(sin32 + (size_t)row * 32 + 16 * a + 4 * fq);
                        const f32x4 o0 = (v0 * c - v1 * s) * sc, o1 = (v1 * c + v0 * s) * sc;
                        const int lc = 64 * blk + 16 * a + 4 * fq;
                        if (mode == 2) { st_bf4(prow + lc, o0); st_bf4(prow + lc + 32, o1); }
                        else { st_bf4(prow + lc, v0 * sc); st_bf4(prow + lc + 32, v1 * sc); bf16_t* q = qr + (size_t)row * 256 + lc; st_bf4(q, o0); st_bf4(q + 32, o1); }
                    } else if (mode == 4) {
                        if (fq < 3) { f32x4 g; g[0] = sigmoidf_(v0[0]); g[1] = sigmoidf_(v0[1]); g[2] = sigmoidf_(v0[2]); g[3] = sigmoidf_(v0[3]); *(f32x4*)(gates + (size_t)row * 12 + 4 * fq) = g; }
                    }
                }
            }
    }
};
struct EpiResid {
    static constexpr bool PERM = false;
    const float* base; float* out;
    __device__ __forceinline__ void operator()(const Acc& acc, const pg8::Unit& u, int wr, int wc, int fr, int fq) const {
#pragma unroll
        for (int ai = 0; ai < 2; ++ai)
#pragma unroll
            for (int m = 0; m < 4; ++m) {
                const size_t off = (size_t)(u.pm * 256 + ai * 128 + wr * 64 + m * 16 + fr) * DM + u.pn * 256 + wc * 32 + 4 * fq;
#pragma unroll
                for (int bj = 0; bj < 2; ++bj)
#pragma unroll
                    for (int n = 0; n < 2; ++n) { const size_t o = off + bj * 128 + n * 16; const f32x4 b = *(const f32x4*)(base + o); *(f32x4*)(out + o) = b * ALPHA + acc[ai][bj][m][n]; }
            }
    }
};
struct EpiBf16 {
    static constexpr bool PERM = true;
    bf16_t* O; int ldc;
    __device__ __forceinline__ void operator()(const Acc& acc, const pg8::Unit& u, int wr, int wc, int fr, int fq) const {
#pragma unroll
        for (int ai = 0; ai < 2; ++ai)
#pragma unroll
            for (int m = 0; m < 4; ++m) {
                bf16_t* rowp = O + (size_t)(u.pm * 256 + ai * 128 + wr * 64 + m * 16 + fr) * ldc + u.pn * 256 + wc * 32 + 8 * fq;
#pragma unroll
                for (int bj = 0; bj < 2; ++bj) { const f32x4 v0 = acc[ai][bj][m][0], v1 = acc[ai][bj][m][1]; u32x4 w; w.x = pk2(v0[0], v0[1]); w.y = pk2(v0[2], v0[3]); w.z = pk2(v1[0], v1[1]); w.w = pk2(v1[2], v1[3]); *(u32x4*)(rowp + bj * 128) = w; }
            }
    }
};
struct EpiCmp {
    static constexpr bool PERM = false;
    float* hid; const float* c1;
    __device__ __forceinline__ void operator()(const Acc& acc, const pg8::Unit& u, int wr, int wc, int fr, int fq) const {
        const int kv = u.pn;
#pragma unroll
        for (int ai = 0; ai < 2; ++ai)
#pragma unroll
            for (int m = 0; m < 4; ++m) {
                float* rowp = hid + ((size_t)kv * 2048 + (u.pm * 256 + ai * 128 + wr * 64 + m * 16 + fr)) * 256 + wc * 32 + 4 * fq;
#pragma unroll
                for (int bj = 0; bj < 2; ++bj)
#pragma unroll
                    for (int n = 0; n < 2; ++n) { const int c = bj * 128 + n * 16; const f32x4 b = *(const f32x4*)(c1 + kv * 256 + wc * 32 + 4 * fq + c); f32x4 v = acc[ai][bj][m][n] + b;
                        v[0] = v[0] * sigmoidf_(v[0]); v[1] = v[1] * sigmoidf_(v[1]); v[2] = v[2] * sigmoidf_(v[2]); v[3] = v[3] * sigmoidf_(v[3]); *(f32x4*)(rowp + c) = v; }
            }
    }
};
struct EpiSwiglu {
    static constexpr bool PERM = true;
    bf16_t* H; int row0;
    __device__ __forceinline__ void operator()(const Acc& acc, const pg8::Unit& u, int wr, int wc, int fr, int fq) const {
#pragma unroll
        for (int ai = 0; ai < 2; ++ai)
#pragma unroll
            for (int m = 0; m < 4; ++m) {
                bf16_t* rowp = H + (size_t)((u.pm - row0) * 256 + ai * 128 + wr * 64 + m * 16 + fr) * DFF + u.pn * 128 + wc * 16 + 4 * fq;
#pragma unroll
                for (int bj = 0; bj < 2; ++bj) { const f32x4 v0 = acc[ai][bj][m][0], v1 = acc[ai][bj][m][1];
                    f32x4 o; o[0] = v0[0] * sigmoidf_(v0[0]) * v0[1]; o[1] = v0[2] * sigmoidf_(v0[2]) * v0[3]; o[2] = v1[0] * sigmoidf_(v1[0]) * v1[1]; o[3] = v1[2] * sigmoidf_(v1[2]) * v1[3];
                    st_bf4(rowp + bj * 64, o); }
            }
    }
};

namespace att {
constexpr int NS = 4, SLOT = 8192, L_K = 0, L_V = NS * SLOT, L_X = 2 * NS * SLOT;
constexpr int L_IMP = L_X, L_QS = L_X + 32768, L_S = 133120;
typedef short v4i16_t __attribute__((ext_vector_type(4)));
struct KVp { const bf16_t* K; const bf16_t* V; int pk, pv; };
__device__ __forceinline__ void glds16(const void* sbase, unsigned voff, unsigned lds_dst) { unsigned keep;
    asm volatile("s_mov_b32 %0, m0\n\ts_mov_b32 m0, %3\n\ts_nop 0\n\tglobal_load_lds_dwordx4 %1, %2\n\ts_mov_b32 m0, %0" : "=&s"(keep) : "v"(voff), "s"(sbase), "s"(lds_dst) : "memory"); }
#define ATT_WAIT_BAR(N) asm volatile("s_waitcnt vmcnt(" #N ") lgkmcnt(0)\n\ts_barrier" ::: "memory")
struct Ring { const char* kb; const char* vb; unsigned ko, vo, kd, vd; int pk, pv; };
__device__ __forceinline__ Ring ring_init(LAS unsigned char* lds, const KVp& p, int wid, int lane) {
    Ring r; r.kb = (const char*)p.K; r.vb = (const char*)p.V;
    r.ko = (unsigned)(lane * p.pk + wid * 8) * 2u; r.vo = (unsigned)((16 * (wid & 3) + (lane >> 2)) * p.pv + (wid >> 2) * 32 + (lane & 3) * 8) * 2u;
    const unsigned l0 = (unsigned)(size_t)lds; r.kd = l0 + L_K + wid * 1024; r.vd = l0 + L_V + wid * 1024; r.pk = p.pk; r.pv = p.pv; return r;
}
__device__ __forceinline__ void ring_issue(const Ring& r, int jt, int slot) {
    jt = __builtin_amdgcn_readfirstlane(jt);
    glds16(r.kb + (size_t)jt * 128 * r.pk, r.ko, (unsigned)__builtin_amdgcn_readfirstlane((int)(r.kd + slot * SLOT)));
    glds16(r.vb + (size_t)jt * 128 * r.pv, r.vo, (unsigned)__builtin_amdgcn_readfirstlane((int)(r.vd + slot * SLOT)));
}
__device__ __forceinline__ void ring_drain() { asm volatile("s_waitcnt vmcnt(0) lgkmcnt(0)\n\ts_barrier" ::: "memory"); }
__device__ __forceinline__ f32x16 zero16() { f32x16 z;
#pragma unroll
    for (int r = 0; r < 16; ++r) z[r] = 0.f;
    return z; }
__device__ __forceinline__ f32x16 mfma32(bf16x8 a, bf16x8 b, f32x16 c) { return __builtin_amdgcn_mfma_f32_32x32x16_bf16(a, b, c, 0, 0, 0); }
__device__ __forceinline__ int crow(int r, int hi) { return (r & 3) + 8 * (r >> 2) + 4 * hi; }
template <int D0, int D1> __device__ __forceinline__ void qk(f32x16& p0, f32x16& p1, const LAS unsigned char* Ks, const bf16x8 (&qf)[4], int hi, int r32) {
    const LAS unsigned char* kb = Ks + hi * 1024 + r32 * 16;
    p0 = zero16(); p1 = zero16();
#pragma unroll
    for (int d0 = D0; d0 < D1; ++d0) {
        const bf16x8 b0 = *(const LAS bf16x8*)(kb + d0 * 2048), b1 = *(const LAS bf16x8*)(kb + d0 * 2048 + 512);
        p0 = mfma32(b0, qf[d0], p0); p1 = mfma32(b1, qf[d0], p1);
    }
}
__device__ __forceinline__ s16x4 vtr(const LAS unsigned char* p) { return __builtin_bit_cast(s16x4, __builtin_amdgcn_ds_read_tr16_b64_v4i16((LAS v4i16_t*)p)); }
__device__ __forceinline__ void pv(f32x16 (&o)[2], const LAS unsigned char* Vs, const bf16x8 (&pw)[4], int lane, int hi) {
    const LAS unsigned char* vp = Vs + ((lane >> 4) & 1) * 32 + (lane & 3) * 8 + (4 * hi + ((lane & 15) >> 2)) * 64;
#pragma unroll
    for (int d0 = 0; d0 < 2; ++d0)
#pragma unroll
        for (int ks = 0; ks < 4; ++ks) {
            const s16x4 lo = vtr(vp + d0 * 4096 + ks * 1024), hh = vtr(vp + d0 * 4096 + ks * 1024 + 512);
            const bf16x8 vf = {lo[0], lo[1], lo[2], lo[3], hh[0], hh[1], hh[2], hh[3]};
            o[d0] = mfma32(vf, pw[ks], o[d0]);
            if (ks == 3 && d0 == 0) __builtin_amdgcn_sched_barrier(0);
        }
}
__device__ __forceinline__ void pack_p(bf16x8 (&pw)[4], const f32x16& p0, const f32x16& p1) {
    u32x4 a, b, c, d;
    a.x = pk2(p0[0], p0[1]); a.y = pk2(p0[2], p0[3]); a.z = pk2(p0[4], p0[5]); a.w = pk2(p0[6], p0[7]);
    b.x = pk2(p0[8], p0[9]); b.y = pk2(p0[10], p0[11]); b.z = pk2(p0[12], p0[13]); b.w = pk2(p0[14], p0[15]);
    c.x = pk2(p1[0], p1[1]); c.y = pk2(p1[2], p1[3]); c.z = pk2(p1[4], p1[5]); c.w = pk2(p1[6], p1[7]);
    d.x = pk2(p1[8], p1[9]); d.y = pk2(p1[10], p1[11]); d.z = pk2(p1[12], p1[13]); d.w = pk2(p1[14], p1[15]);
    pw[0] = __builtin_bit_cast(bf16x8, a); pw[1] = __builtin_bit_cast(bf16x8, b); pw[2] = __builtin_bit_cast(bf16x8, c); pw[3] = __builtin_bit_cast(bf16x8, d);
}
__device__ __forceinline__ float max3f(float a, float b, float c) { return fmaxf(fmaxf(a, b), c); }
__device__ __forceinline__ void osm(f32x16& p0, f32x16& p1, float& m, float& l, f32x16 (&o)[2], bf16x8 (&pw)[4]) {
    float mx = max3f(p0[0], p1[0], p0[1]);
#pragma unroll
    for (int r = 1; r < 15; r += 2) mx = max3f(mx, p1[r], p0[r + 1]), mx = fmaxf(mx, p1[r + 1]);
    mx = fmaxf(mx, p1[15]);
    mx = fmaxf(mx, xhalf(mx));
    if (__any(mx > m + 8.f)) { const float mn = fmaxf(m, mx), al = ex2(m - mn); m = mn; l *= al; o[0] *= al; o[1] *= al; }
    float s = 0.f;
#pragma unroll
    for (int r = 0; r < 16; ++r) { p0[r] = ex2(p0[r] - m); p1[r] = ex2(p1[r] - m); s += p0[r] + p1[r]; }
    l += s;
    pack_p(pw, p0, p1);
}
__device__ __forceinline__ void mask_le(f32x16& p0, f32x16& p1, int lim, int hi) {
    int l2 = lim - 4 * hi; asm volatile("" : "+v"(l2));
#pragma unroll
    for (int r = 0; r < 16; ++r) { const int c = (r & 3) + 8 * (r >> 2); if (c > l2) p0[r] = -INFINITY; if (c + 32 > l2) p1[r] = -INFINITY; }
}
__device__ __forceinline__ void mask_gt(f32x16& p0, f32x16& p1, int lim, int hi) {
    int l2 = lim - 4 * hi; asm volatile("" : "+v"(l2));
#pragma unroll
    for (int r = 0; r < 16; ++r) { const int c = (r & 3) + 8 * (r >> 2); if (c <= l2) p0[r] = -INFINITY; if (c + 32 <= l2) p1[r] = -INFINITY; }
}
__device__ __forceinline__ void mask_all(f32x16& p0, f32x16& p1, bool keep) {
#pragma unroll
    for (int r = 0; r < 16; ++r) { p0[r] = keep ? p0[r] : -INFINITY; p1[r] = keep ? p1[r] : -INFINITY; }
}
__device__ __forceinline__ void store_o(bf16_t* dst, const f32x16 (&o)[2], int hi) {
#pragma unroll
    for (int d0 = 0; d0 < 2; ++d0)
#pragma unroll
        for (int g = 0; g < 4; ++g) { f32x4 v = {o[d0][4 * g], o[d0][4 * g + 1], o[d0][4 * g + 2], o[d0][4 * g + 3]}; st_bf4(dst + 32 * d0 + 8 * g + 4 * hi, v); }
}
__device__ __forceinline__ void load_q(bf16x8 (&qf)[4], const bf16_t* qp, int hi) {
#pragma unroll
    for (int d0 = 0; d0 < 4; ++d0) qf[d0] = *(const bf16x8*)(qp + 16 * d0 + 8 * hi);
}


template <int D0, int D1> __device__ __forceinline__ void qk_b(f32x16& p0, f32x16& p1, const LAS unsigned char* Ks, const LAS unsigned char* qs, float c0, int hi, int r32) {
    const LAS unsigned char* kb = Ks + hi * 1024 + r32 * 16;
    f32x16 nb;
#pragma unroll
    for (int r = 0; r < 16; ++r) nb[r] = c0;
#pragma unroll
    for (int d0 = D0; d0 < D1; ++d0) {
        const bf16x8 q = *(const LAS bf16x8*)(qs + d0 * 1024);
        const bf16x8 b0 = *(const LAS bf16x8*)(kb + d0 * 2048), b1 = *(const LAS bf16x8*)(kb + d0 * 2048 + 512);
        p0 = mfma32(b0, q, d0 == D0 ? nb : p0); p1 = mfma32(b1, q, d0 == D0 ? nb : p1);
    }
}
__device__ __forceinline__ const LAS unsigned char* stash_q(LAS unsigned char* lds, const bf16_t* qp, int wid, int lane, int hi) {
    LAS unsigned char* qs = lds + L_QS + wid * 4096 + lane * 16;
#pragma unroll
    for (int d0 = 0; d0 < 4; ++d0) *(LAS bf16x8*)(qs + d0 * 1024) = *(const bf16x8*)(qp + 16 * d0 + 8 * hi);
    return qs;
}
__device__ __forceinline__ void osm2(f32x16& p0, f32x16& p1, float& m, bool& seen, float& l, f32x16 (&o)[2], bf16x8 (&pw)[4]) {
    float mx = max3f(p0[0], p1[0], p0[1]);
#pragma unroll
    for (int r = 1; r < 15; r += 2) { mx = max3f(mx, p1[r], p0[r + 1]); mx = fmaxf(mx, p1[r + 1]); }
    mx = fmaxf(mx, p1[15]);
    mx = fmaxf(mx, xhalf(mx));
    const bool fin = mx > -INFINITY;
    const bool need = fin && ((mx > 8.f) || (!seen && mx < -8.f));
    if (__any(need)) {
        const float d = need ? mx : 0.f, sc = (seen && need) ? ex2(-d) : 1.f;
        m += d; l *= sc; o[0] *= sc; o[1] *= sc;
#pragma unroll
        for (int r = 0; r < 16; ++r) { p0[r] -= d; p1[r] -= d; }
    }
    seen = seen || fin;
    f32x2 s2 = {0.f, 0.f};
#pragma unroll
    for (int r = 0; r < 16; ++r) { p0[r] = ex2(p0[r]); p1[r] = ex2(p1[r]); s2 += (f32x2){p0[r], p1[r]}; }
    l += s2[0] + s2[1];
    pack_p(pw, p0, p1);
}
#define PP_BAR() asm volatile("s_waitcnt lgkmcnt(0)\n\ts_barrier" ::: "memory")
#define PP_WAIT_BAR() asm volatile("s_waitcnt vmcnt(2) lgkmcnt(0)\n\ts_barrier" ::: "memory")
#define PP_SCHED() __builtin_amdgcn_sched_barrier(0)
template <class Pol>
__device__ __forceinline__ void flash_pp(LAS unsigned char* lds, const Ring& rg, const LAS unsigned char* qs, const Pol& pol, const int n, f32x16 (&o)[2], float& l_out, const int wid, const int lane) {
    const int r32 = lane & 31, hi = lane >> 5, grp = wid >> 2;
    float m = 0.f, l = 0.f; bool seen = false;
    f32x16 p0, p1; bf16x8 pw[4];
    int ji = pol.first();
    ring_issue(rg, ji, 0); ji = pol.next(ji); ring_issue(rg, ji, 1); ji = pol.next(ji);
    PP_WAIT_BAR();
    if (grp == 1) { ring_issue(rg, ji, 2); ji = pol.next(ji); PP_BAR(); }
    PP_SCHED();
    int jt = pol.first(); bool act = false, actp = false;
    for (int t = 0; t <= n; ++t) {
        if (grp == 0) { ring_issue(rg, ji, (t + 2) & 3); ji = pol.next(ji); }
        __builtin_amdgcn_s_setprio(1);
        if (t >= 1 && actp) pv(o, lds + L_V + ((t - 1) & 3) * SLOT, pw, lane, hi);
        if (t < n) { act = pol.active(jt); if (act) qk_b<0, 4>(p0, p1, lds + L_K + (t & 3) * SLOT, qs, pol.rowsel(jt) ? -m : -INFINITY, hi, r32); }
        __builtin_amdgcn_s_setprio(0);
        if (grp == 1) PP_WAIT_BAR(); else PP_BAR();
        PP_SCHED();
        if (t == n) break;
        if (grp == 1) { ring_issue(rg, ji, (t + 3) & 3); ji = pol.next(ji); }
        if (act) { pol.mask(p0, p1, jt); osm2(p0, p1, m, seen, l, o, pw); }
        actp = act; jt = pol.next(jt);
        if (grp == 0) PP_WAIT_BAR(); else PP_BAR();
        PP_SCHED();
    }
    if (grp == 0) PP_BAR();
    ring_drain();
    l_out = l + xhalf(l);
}

__device__ __forceinline__ void unit_A(LAS unsigned char* lds, const bf16_t* proj, bf16_t* mixed, int b, int h, int qb, int tid, int wid, int lane) {
    const int r32 = lane & 31, hi = lane >> 5;
    const int t = 256 * qb + 32 * wid + r32;
    const size_t rowb = (size_t)b * SEQ;
    bf16x8 qf[4]; load_q(qf, proj + (rowb + t) * NINP + C_AQ + h * 64, hi);
    const KVp kv{proj + rowb * NINP + C_AK + h * 64, proj + rowb * NINP + C_AV + h * 64, NINP, NINP};
    const Ring rg = ring_init(lds, kv, wid, lane);
    f32x16 o[2]; o[0] = zero16(); o[1] = zero16();
    float C = 0.f;
    const int jmax = 4 * qb + 3, tmaxw = 256 * qb + 32 * wid + 31, tminw = tmaxw - 31;
    LAS float* wm = (LAS float*)(lds + L_S);
#pragma unroll
    for (int k = 0; k < NS - 1; ++k) ring_issue(rg, jmax - k > 0 ? jmax - k : 0, k);
    ATT_WAIT_BAR(4);
    for (int it = 0; it <= jmax; ++it) {
        const int jt = jmax - it;
        if (it > 0) { float mx = wm[((it - 1) & 1) * 8];
#pragma unroll
            for (int w = 1; w < 8; ++w) mx = fmaxf(mx, wm[((it - 1) & 1) * 8 + w]);
            if (mx < -100.f) break; }
        { const int jn = jt - (NS - 1); ring_issue(rg, jn > 0 ? jn : 0, (it + NS - 1) % NS); }
        if (64 * jt < tmaxw) {
            f32x16 p0, p1; qk<0, 4>(p0, p1, lds + L_K + (it % NS) * SLOT, qf, hi, r32);
            if (64 * jt + 63 >= tminw) mask_le(p0, p1, t - 1 - 64 * jt, hi);
            float L0[16], L1[16];
#pragma unroll
            for (int r = 0; r < 16; ++r) { const float z0 = p0[r], z1 = p1[r];
                L0[r] = -(fmaxf(z0, 0.f) + lg2(1.f + ex2(-fabsf(z0)))); L1[r] = -(fmaxf(z1, 0.f) + lg2(1.f + ex2(-fabsf(z1)))); }
            float gs[8], og[8];
#pragma unroll
            for (int k = 0; k < 4; ++k) { gs[k] = (L0[4 * k] + L0[4 * k + 1]) + (L0[4 * k + 2] + L0[4 * k + 3]); gs[4 + k] = (L1[4 * k] + L1[4 * k + 1]) + (L1[4 * k + 2] + L1[4 * k + 3]); }
#pragma unroll
            for (int k = 0; k < 8; ++k) og[k] = xhalf(gs[k]);
            float aown = 0.f, aoth = 0.f;
#pragma unroll
            for (int k = 7; k >= 0; --k) {
                const float base = C + (aown + aoth + (hi == 0 ? og[k] : 0.f));
                if (k >= 4) { const int q = 4 * (k - 4);
                    const float i3 = base + L1[q + 3], i2 = i3 + L1[q + 2], i1 = i2 + L1[q + 1], i0 = i1 + L1[q];
                    p1[q + 3] = ex2(p1[q + 3] + i3); p1[q + 2] = ex2(p1[q + 2] + i2); p1[q + 1] = ex2(p1[q + 1] + i1); p1[q] = ex2(p1[q] + i0);
                } else { const int q = 4 * k;
                    const float i3 = base + L0[q + 3], i2 = i3 + L0[q + 2], i1 = i2 + L0[q + 1], i0 = i1 + L0[q];
                    p0[q + 3] = ex2(p0[q + 3] + i3); p0[q + 2] = ex2(p0[q + 2] + i2); p0[q + 1] = ex2(p0[q + 1] + i1); p0[q] = ex2(p0[q] + i0);
                }
                aown += gs[k]; aoth += og[k];
            }
            C += (hi ? aoth : aown) + (hi ? aown : aoth);
            bf16x8 pw[4]; pack_p(pw, p0, p1);
            pv(o, lds + L_V + (it % NS) * SLOT, pw, lane, hi);
        }
        const float cm = wave_max(C);
        if (lane == 0) wm[(it & 1) * 8 + wid] = cm;
        ATT_WAIT_BAR(4);
    }
    ring_drain();
    store_o(mixed + (rowb + t) * DM + 0 + h * 64, o, hi);
}

__device__ __forceinline__ void unit_B(LAS unsigned char* lds, const bf16_t* proj, bf16_t* mixed, const float* gain, float lam, float lam_init, int b, int h, int qb, int tid, int wid, int lane) {
    const int r32 = lane & 31, hi = lane >> 5, grp = wid >> 2;
    const int t = 256 * qb + 32 * wid + r32;
    const size_t rowb = (size_t)b * SEQ;
    const LAS unsigned char* qs = stash_q(lds, proj + (rowb + t) * NINP + C_BQ + h * 64, wid, lane, hi);
    const KVp kv{proj + rowb * NINP + C_BK + h * 64, proj + rowb * NINP + C_BV + h * 64, NINP, NINP};
    const Ring rg = ring_init(lds, kv, wid, lane);
    f32x16 oa[2], ob[2]; oa[0] = zero16(); oa[1] = zero16(); ob[0] = zero16(); ob[1] = zero16();
    float ma = 0.f, la = 0.f, mb = 0.f, lb = 0.f; bool sa = false, sb = false;
    const int jd = 4 * qb + 3, n = jd + 1, tmaxw = 256 * qb + 32 * wid + 31, tminw = tmaxw - 31;
    f32x16 p0, p1; bf16x8 pw[4];
    ring_issue(rg, 0, 0); ring_issue(rg, 1 < jd ? 1 : jd, 1);
    PP_WAIT_BAR();
    if (grp == 1) { ring_issue(rg, 2 < jd ? 2 : jd, 2); PP_BAR(); }
    PP_SCHED();
    bool act = false, actp = false;
    for (int jt = 0; jt <= n; ++jt) {
        const bool nm = (64 * jt + 63 > tminw);
        if (grp == 0) { const int jn = jt + 2; ring_issue(rg, jn < jd ? jn : jd, jn & 3); }
        __builtin_amdgcn_s_setprio(1);
        if (jt >= 1 && actp) pv(ob, lds + L_V + ((jt - 1) & 3) * SLOT, pw, lane, hi);
        act = (jt < n) && (64 * jt <= tmaxw);
        if (act) qk_b<0, 2>(p0, p1, lds + L_K + (jt & 3) * SLOT, qs, -ma, hi, r32);
        __builtin_amdgcn_s_setprio(0);
        PP_BAR(); PP_SCHED();
        if (jt == n) break;
        if (act) { if (nm) mask_le(p0, p1, t - 64 * jt, hi); osm2(p0, p1, ma, sa, la, oa, pw); }
        PP_BAR(); PP_SCHED();
        __builtin_amdgcn_s_setprio(1);
        if (act) { pv(oa, lds + L_V + (jt & 3) * SLOT, pw, lane, hi); qk_b<2, 4>(p0, p1, lds + L_K + (jt & 3) * SLOT, qs, -mb, hi, r32); }
        __builtin_amdgcn_s_setprio(0);
        if (grp == 1) PP_WAIT_BAR(); else PP_BAR();
        PP_SCHED();
        if (grp == 1) { const int jn = jt + 3; ring_issue(rg, jn < jd ? jn : jd, jn & 3); }
        if (act) { if (nm) mask_le(p0, p1, t - 64 * jt, hi); osm2(p0, p1, mb, sb, lb, ob, pw); }
        actp = act;
        if (grp == 0) PP_WAIT_BAR(); else PP_BAR();
        PP_SCHED();
    }
    if (grp == 0) PP_BAR();
    ring_drain();
    la += xhalf(la); lb += xhalf(lb);
    const float i0 = 1.f / la, i1 = lam / lb;
    float ss = 0.f;
#pragma unroll
    for (int d0 = 0; d0 < 2; ++d0)
#pragma unroll
        for (int r = 0; r < 16; ++r) { const float v = oa[d0][r] * i0 - ob[d0][r] * i1; oa[d0][r] = v; ss += v * v; }
    ss += xhalf(ss);
    const float rs = rsqrtf(ss * (1.f / 64.f) + RMS_EPS) * (1.f - lam_init);
#pragma unroll
    for (int d0 = 0; d0 < 2; ++d0)
#pragma unroll
        for (int g = 0; g < 4; ++g) { const f32x4 gv = *(const f32x4*)(gain + 32 * d0 + 8 * g + 4 * hi);
#pragma unroll
            for (int e = 0; e < 4; ++e) oa[d0][4 * g + e] *= rs * gv[e]; }
    store_o(mixed + (rowb + t) * DM + 256 + h * 64, oa, hi);
}

__device__ __forceinline__ int c_next(int jt, unsigned un, int own) {
    if ((jt & 3) != 3) return jt + 1;
    int j = (jt >> 2) + 1; if (j > own) return jt;
    j += __builtin_ctz((un >> j) | 0x80000000u); return 4 * j;
}
struct PolC { unsigned un, sel; int own, t, tmaxw, tminw, hi;
    __device__ __forceinline__ int first() const { return 4 * __builtin_ctz(un); }
    __device__ __forceinline__ int next(int jt) const { return c_next(jt, un, own); }
    __device__ __forceinline__ bool rowsel(int jt) const { const int blk = jt >> 2; return blk == own ? true : ((sel >> blk) & 1u) != 0u; }
    __device__ __forceinline__ bool active(int jt) const { const int blk = jt >> 2; return blk == own ? (64 * jt <= tmaxw) : (__any(((sel >> blk) & 1u) != 0u) != 0); }
    __device__ __forceinline__ void mask(f32x16& p0, f32x16& p1, int jt) const { if ((jt >> 2) == own && 64 * jt + 63 > tminw) mask_le(p0, p1, t - 64 * jt, hi); }
};
__device__ __forceinline__ void unit_C(LAS unsigned char* lds, const bf16_t* proj, const bf16_t* kmean, bf16_t* mixed, int b, int h, int qb, int tid, int wid, int lane) {
    const int r32 = lane & 31, hi = lane >> 5, own = qb;
    const int t = 256 * qb + 32 * wid + r32;
    const size_t rowb = (size_t)b * SEQ;
    bf16x8 qf[4]; load_q(qf, proj + (rowb + t) * NINP + C_CQ + h * 64, hi);
    const KVp kv{proj + rowb * NINP + C_CK + h * 64, proj + rowb * NINP + C_CV + h * 64, NINP, NINP};
    const Ring rg = ring_init(lds, kv, wid, lane);
    LAS unsigned* un_w = (LAS unsigned*)(lds + L_S + 64);
    unsigned sel = 0u;
    if (tid == 0) un_w[0] = 0u;
    if (own > 0) {
        if (tid < 256) { const int chunk = tid >> 5, key = tid & 31; *(LAS u32x4*)(lds + L_K + chunk * 1024 + key * 16) = *(const u32x4*)(kmean + ((size_t)((b * 4 + h) * 32 + key)) * 64 + chunk * 8); }
        __syncthreads();
        f32x16 g = zero16();
        { const LAS unsigned char* kb = lds + L_K + hi * 1024 + r32 * 16;
#pragma unroll
          for (int d0 = 0; d0 < 4; ++d0) g = mfma32(*(const LAS bf16x8*)(kb + d0 * 2048), qf[d0], g); }
        float og[16];
#pragma unroll
        for (int r = 0; r < 16; ++r) og[r] = xhalf(g[r]);
#pragma unroll
        for (int round = 0; round < 3; ++round) {
            float best = -INFINITY; int bi = -1;
#pragma unroll
            for (int j = 0; j < 32; ++j) { const int hj = (j >> 2) & 1, r = (j & 3) + 4 * (j >> 3);
                const float v = (hj == hi) ? g[r] : og[r];
                const bool ok = (j < own) && !((sel >> j) & 1u) && (v > best);
                best = ok ? v : best; bi = ok ? j : bi; }
            if (bi >= 0) sel |= 1u << bi;
        }
        const unsigned wo = wave_or(sel);
        if (lane == 0) __hip_atomic_fetch_or(un_w, wo, __ATOMIC_RELAXED, __HIP_MEMORY_SCOPE_WORKGROUP);
    }
    __syncthreads();
    const unsigned un = (un_w[0] | (1u << own)) & (own == 31 ? 0xffffffffu : ((2u << own) - 1u));
    f32x16 o[2]; o[0] = zero16(); o[1] = zero16();
    float l;
    const PolC pol{un, sel, own, t, 256 * qb + 32 * wid + 31, 256 * qb + 32 * wid, hi};
    const LAS unsigned char* qs = lds + L_QS + wid * 4096 + lane * 16;
#pragma unroll
    for (int d0 = 0; d0 < 4; ++d0) *(LAS bf16x8*)(qs + d0 * 1024) = qf[d0];
    flash_pp(lds, rg, qs, pol, 4 * __builtin_popcount(un), o, l, wid, lane);
    const float inv = 1.f / l;
    o[0] *= inv; o[1] *= inv;
    store_o(mixed + (rowb + t) * DM + 512 + h * 64, o, hi);
}

constexpr int LD_IA = L_IMP, LD_SM = L_S + 128, LD_WO = LD_SM + 1024, LD_END = LD_WO + 128;
__device__ __forceinline__ int d_next(int jt, unsigned u0, unsigned u1, unsigned u2, unsigned u3, int i) {
    const unsigned long long lo = ((unsigned long long)u1 << 32) | u0, hh = ((unsigned long long)u3 << 32) | u2;
    for (int jn = jt + 1; jn <= i; ++jn) { if (((jn < 64 ? lo : hh) >> (jn & 63)) & 1ull) return jn; }
    return jt;
}
struct PolS { unsigned u0, u1, u2, u3, s0, s1, s2, s3; int i, tt, hi;
    __device__ __forceinline__ int first() const { return 0; }
    __device__ __forceinline__ int next(int jt) const { return d_next(jt, u0, u1, u2, u3, i); }
    __device__ __forceinline__ bool rowsel(int jt) const { const unsigned long long lo = ((unsigned long long)s1 << 32) | s0, hh = ((unsigned long long)s3 << 32) | s2; return (((jt < 64 ? lo : hh) >> (jt & 63)) & 1ull) != 0ull; }
    __device__ __forceinline__ bool active(int jt) const { return __any(rowsel(jt)) != 0; }
    __device__ __forceinline__ void mask(f32x16& p0, f32x16& p1, int jt) const { if (jt == i) mask_le(p0, p1, tt, hi); }
};
struct PolW { int i, j0, tt, hi;
    __device__ __forceinline__ int first() const { return j0; }
    __device__ __forceinline__ int next(int jt) const { return jt < i ? jt + 1 : jt; }
    __device__ __forceinline__ bool rowsel(int) const { return true; }
    __device__ __forceinline__ bool active(int) const { return true; }
    __device__ __forceinline__ void mask(f32x16& p0, f32x16& p1, int jt) const { if (jt == i) mask_le(p0, p1, tt, hi); if (jt == i - 8) mask_gt(p0, p1, tt, hi); }
};
__device__ __forceinline__ void unit_D(LAS unsigned char* lds, const bf16_t* proj, const bf16_t* qr, const bf16_t* kc, const bf16_t* vc, const float* gates, bf16_t* mixed,
                                       int b, int i, int tid, int wid, int lane) {
    const int r32 = lane & 31, hi = lane >> 5, hd = r32 & 3, tl = 8 * wid + (r32 >> 2);
    const int t = 64 * i + tl, tt = tl;
    const size_t rowb = (size_t)b * SEQ, row = rowb + t;
    LAS float* imp = (LAS float*)(lds + LD_IA);
    LAS unsigned* smk = (LAS unsigned*)(lds + LD_SM); LAS unsigned* wor = (LAS unsigned*)(lds + LD_WO);
    bf16x8 qf[4]; load_q(qf, proj + row * NINP + C_DQ + hd * 64, hi);
    const float g_c = gates[row * 12 + hd * 3 + 0], g_s = gates[row * 12 + hd * 3 + 1], g_w = gates[row * 12 + hd * 3 + 2];
    f32x16 acc[2]; acc[0] = zero16(); acc[1] = zero16();
    const KVp kvc{kc + (size_t)b * NCMP * 64, vc + (size_t)b * NCMP * 64, 64, 64};
    const int J = (4 * i + 2) >> 6, nlim = (t - 31) >> 4;
    float m = -1e30f, l = 0.f;
    {
        int ln = lane; asm volatile("" : "+v"(ln)); const Ring rg = ring_init(lds, kvc, wid, ln);
#pragma unroll
        for (int k = 0; k < NS - 1; ++k) ring_issue(rg, k < J ? k : J, k);
        ATT_WAIT_BAR(4);
        for (int jt = 0; jt <= J; ++jt) {
            { const int jn = jt + NS - 1; ring_issue(rg, jn < J ? jn : J, jn % NS); }
            f32x16 p0, p1; qk<0, 4>(p0, p1, lds + L_K + (jt % NS) * SLOT, qf, hi, r32);
            mask_le(p0, p1, nlim - 64 * jt, hi);
            float mx = fmaxf(p0[0], p1[0]);
#pragma unroll
            for (int r = 1; r < 16; ++r) mx = fmaxf(mx, fmaxf(p0[r], p1[r]));
            const float mn = fmaxf(m, mx); float s = 0.f;
#pragma unroll
            for (int r = 0; r < 16; ++r) s += ex2(p0[r] - mn) + ex2(p1[r] - mn);
            l = l * ex2(m - mn) + s; m = mn;
            ATT_WAIT_BAR(4);
        }
        { const float mo = xhalf(m), lo = xhalf(l), M = fmaxf(m, mo); l = l * ex2(m - M) + lo * ex2(mo - M); m = M; }
        const float invl = l > 0.f ? 1.f / l : 0.f;
        ring_drain();
#pragma unroll
        for (int k = 0; k < NS - 1; ++k) ring_issue(rg, k < J ? k : J, k);
        ATT_WAIT_BAR(4);
        float carry = 0.f;
        for (int jt = 0; jt <= J; ++jt) {
            { const int jn = jt + NS - 1; ring_issue(rg, jn < J ? jn : J, jn % NS); }
            f32x16 p0, p1; qk<0, 4>(p0, p1, lds + L_K + (jt % NS) * SLOT, qf, hi, r32);
            mask_le(p0, p1, nlim - 64 * jt, hi);
#pragma unroll
            for (int r = 0; r < 16; ++r) { p0[r] = ex2(p0[r] - m) * invl; p1[r] = ex2(p1[r] - m) * invl; }
            float ol[8];
#pragma unroll
            for (int k = 0; k < 8; ++k) ol[k] = xhalf(k < 4 ? p0[4 * k + 3] : p1[4 * k - 13]);
#pragma unroll
            for (int k = 0; k < 8; ++k) {
                float gsum = (k < 4) ? (p0[4 * k] + p0[4 * k + 1]) + (p0[4 * k + 2] + p0[4 * k + 3]) : (p1[4 * k - 16] + p1[4 * k - 15]) + (p1[4 * k - 14] + p1[4 * k - 13]);
                const float prev = hi ? ol[k] : (k > 0 ? ol[k - 1] : carry);
                const float v = quad_sum(gsum + prev);
                if (hd == 0) imp[tl * 128 + 16 * jt + 2 * k + hi] = v;
            }
            carry = ol[7];
            bf16x8 pw[4]; pack_p(pw, p0, p1);
            pv(acc, lds + L_V + (jt % NS) * SLOT, pw, lane, hi);
            ATT_WAIT_BAR(4);
        }
        ring_drain();
    }
    acc[0] *= g_c; acc[1] *= g_c;
    unsigned wo0 = 0u, wo1 = 0u, wo2 = 0u, wo3 = 0u;
#pragma unroll 1
    for (int k8 = 0; k8 < 8; ++k8) {
        const int tk = 8 * wid + k8;
        unsigned long long b0, b1;
        if (i < 16) { b0 = (2ull << i) - 1ull; b1 = 0ull; }
        else {
            const int m0 = lane, m1 = lane + 64;
            const bool c0 = (m0 <= i) && (m0 != 0) && (m0 != i) && (m0 != i - 1), c1 = (m1 <= i) && (m1 != i) && (m1 != i - 1);
            const bool f0 = (m0 == 0) || (m0 == i) || (m0 == i - 1), f1 = (m1 == i) || (m1 == i - 1);
            const float v0 = imp[tk * 128 + m0], v1 = imp[tk * 128 + m1];
            const unsigned k0 = c0 ? __float_as_uint(v0) + 1u : 0u, k1 = c1 ? __float_as_uint(v1) + 1u : 0u;
            unsigned thr = 0u;
            for (int bit = 30; bit >= 0; --bit) { const unsigned cand = thr | (1u << bit);
                const int c = __popcll(__ballot(k0 >= cand)) + __popcll(__ballot(k1 >= cand)); if (c >= 13) thr = cand; }
            const bool gt0 = k0 > thr, gt1 = k1 > thr, eq0 = (k0 == thr) && c0, eq1 = (k1 == thr) && c1;
            const int need = 13 - (__popcll(__ballot(gt0)) + __popcll(__ballot(gt1)));
            const unsigned long long be0 = __ballot(eq0), be1 = __ballot(eq1), lt = (1ull << lane) - 1ull;
            const int rk0 = __popcll(be0 & lt), rk1 = __popcll(be0) + __popcll(be1 & lt);
            b0 = __ballot(f0 || gt0 || (eq0 && rk0 < need)); b1 = __ballot(f1 || gt1 || (eq1 && rk1 < need));
        }
        const unsigned w0 = (unsigned)b0, w1 = (unsigned)(b0 >> 32), w2 = (unsigned)b1, w3 = (unsigned)(b1 >> 32);
        if (lane == 0) { smk[tk * 4 + 0] = w0; smk[tk * 4 + 1] = w1; smk[tk * 4 + 2] = w2; smk[tk * 4 + 3] = w3; }
        wo0 |= w0; wo1 |= w1; wo2 |= w2; wo3 |= w3;
    }
    if (lane == 0) { wor[wid * 4 + 0] = wo0; wor[wid * 4 + 1] = wo1; wor[wid * 4 + 2] = wo2; wor[wid * 4 + 3] = wo3; }
    __syncthreads();
    unsigned un0 = 0u, un1 = 0u, un2 = 0u, un3 = 0u;
#pragma unroll
    for (int w = 0; w < 8; ++w) { un0 |= wor[w * 4 + 0]; un1 |= wor[w * 4 + 1]; un2 |= wor[w * 4 + 2]; un3 |= wor[w * 4 + 3]; }
    const unsigned sm0 = smk[tl * 4 + 0], sm1 = smk[tl * 4 + 1], sm2 = smk[tl * 4 + 2], sm3 = smk[tl * 4 + 3];
    const LAS unsigned char* qs;
    { int r2 = (int)(row & 0x7fffffff); asm volatile("" : "+v"(r2)); qs = stash_q(lds, qr + (size_t)r2 * 256 + hd * 64, wid, lane, hi); }
    {
        const KVp kvs{proj + rowb * NINP + C_KS, proj + rowb * NINP + C_VS, NINP, NINP};
        int ln = lane; asm volatile("" : "+v"(ln)); const Ring rg = ring_init(lds, kvs, wid, ln);
        f32x16 o[2]; o[0] = zero16(); o[1] = zero16(); float ls;
        const int ntile = __builtin_popcount(un0) + __builtin_popcount(un1) + __builtin_popcount(un2) + __builtin_popcount(un3);
        const PolS pol{un0, un1, un2, un3, sm0, sm1, sm2, sm3, i, tt, hi};
        flash_pp(lds, rg, qs, pol, ntile, o, ls, wid, lane);
        const float f = g_s / ls;
        acc[0] += o[0] * f; acc[1] += o[1] * f;
    }
    {
        const KVp kvw{proj + rowb * NINP + C_KW, proj + rowb * NINP + C_VW, NINP, NINP};
        int ln = lane; asm volatile("" : "+v"(ln)); const Ring rg = ring_init(lds, kvw, wid, ln);
        f32x16 o[2]; o[0] = zero16(); o[1] = zero16(); float lw;
        const int j0 = i >= 8 ? i - 8 : 0;
        const PolW pol{i, j0, tt, hi};
        flash_pp(lds, rg, qs, pol, i - j0 + 1, o, lw, wid, lane);
        const float f = g_w / lw;
        acc[0] += o[0] * f; acc[1] += o[1] * f;
    }
    { int r2 = (int)(row & 0x7fffffff); asm volatile("" : "+v"(r2)); store_o(mixed + (size_t)r2 * DM + 768 + hd * 64, acc, hi); }
}
#undef ATT_WAIT_BAR
#undef PP_BAR
#undef PP_WAIT_BAR
#undef PP_SCHED
}

constexpr int LDS_CTL = 131072, LDS_BYTES = 147456;
constexpr int LW_BAR = 0, LW_CNT = 8, LW_TS = 16, LW_CNTL = 32, LW_BASEL = 40, LW_PE = 64;
struct SchedGU {
    const LAS int* cw; const int* list; int t0, t1, G, c; bool dense;
    __device__ bool next(int i, pg8::Unit& u) const {
        const long L = (long)i * G + c; if (L >= (long)(t1 - t0) * 28) return false;
        u.pm = t0 + (int)(L / 28); u.pn = (int)(L % 28); int e = 0;
        if (!dense) { for (; e < 7; ++e) if (u.pm < cw[LW_TS + e + 1]) break; }
        u.pb = (dense ? 0 : 1 + e) * 28 + u.pn; return true;
    }
    __device__ __forceinline__ unsigned arow(const pg8::Unit& u, int r) const {
        if (dense) return (unsigned)(u.pm * 256 + r) * 2048u;
        const int e = u.pb / 28 - 1, slot = (u.pm - cw[LW_TS + e]) * 256 + r;
        const int pid = slot < cw[LW_CNT + e] ? list[e * 32768 + slot] : 0;
        return (unsigned)(pid >> 1) * 2048u;
    }
};
struct SchedDN {
    const LAS int* cw; int t0, t1, G, c; bool dense;
    __device__ bool next(int i, pg8::Unit& u) const {
        const long L = (long)i * G + c; if (L >= (long)(t1 - t0) * 4) return false;
        u.pm = t0 + (int)(L / 4); u.pn = (int)(L % 4); int e = 0;
        if (!dense) { for (; e < 7; ++e) if (u.pm < cw[LW_TS + e + 1]) break; }
        u.pb = (dense ? 0 : 1 + e) * 4 + u.pn; return true;
    }
    __device__ __forceinline__ unsigned arow(const pg8::Unit& u, int r) const { return (unsigned)((u.pm - t0) * 256 + r) * (unsigned)(DFF * 2); }
};
struct EpiDown {
    static constexpr bool PERM = false;
    bool dense; float* out; bf16_t* Y; const LAS int* cw; const int* list; const float* moeg;
    __device__ __forceinline__ void operator()(const Acc& acc, const pg8::Unit& u, int wr, int wc, int fr, int fq) const {
        const int col = u.pn * 256 + wc * 32 + 4 * fq;
        if (dense) {
#pragma unroll
            for (int ai = 0; ai < 2; ++ai)
#pragma unroll
                for (int m = 0; m < 4; ++m) { const size_t off = (size_t)(u.pm * 256 + ai * 128 + wr * 64 + m * 16 + fr) * DM + col;
#pragma unroll
                    for (int bj = 0; bj < 2; ++bj)
#pragma unroll
                        for (int n = 0; n < 2; ++n) { const size_t o = off + bj * 128 + n * 16; const f32x4 b = *(const f32x4*)(out + o); *(f32x4*)(out + o) = b * ALPHA + acc[ai][bj][m][n]; } }
        } else {
            const int e = u.pb / 4 - 1, s0 = (u.pm - cw[LW_TS + e]) * 256, ce = cw[LW_CNT + e];
#pragma unroll
            for (int ai = 0; ai < 2; ++ai)
#pragma unroll
                for (int m = 0; m < 4; ++m) { const int slot = s0 + ai * 128 + wr * 64 + m * 16 + fr;
                    if (slot < ce) { const int pid = list[e * 32768 + slot]; const float g = moeg[pid]; bf16_t* yp = Y + (size_t)pid * DM + col;
#pragma unroll
                        for (int bj = 0; bj < 2; ++bj)
#pragma unroll
                            for (int n = 0; n < 2; ++n) st_bf4(yp + bj * 128 + n * 16, acc[ai][bj][m][n] * g); } }
        }
    }
};
struct EpiPle {
    static constexpr bool PERM = false;
    const float* H2; const bf16_t* P; float* out; bf16_t* hb;
    __device__ __forceinline__ void operator()(const Acc& acc, const pg8::Unit& u, int wr, int wc, int fr, int fq) const {
#pragma unroll
        for (int ai = 0; ai < 2; ++ai)
#pragma unroll
            for (int m = 0; m < 4; ++m) { const size_t off = (size_t)(u.pm * 256 + ai * 128 + wr * 64 + m * 16 + fr) * DM + u.pn * 256 + wc * 32 + 4 * fq;
#pragma unroll
                for (int bj = 0; bj < 2; ++bj)
#pragma unroll
                    for (int n = 0; n < 2; ++n) { const size_t o = off + bj * 128 + n * 16; const f32x4 h = *(const f32x4*)(H2 + o); const u32x2 pw = *(const u32x2*)(P + o); const f32x4 a = acc[ai][bj][m][n];
                        f32x4 r; r[0] = h[0] + sigmoidf_(a[0]) * bflo(pw.x); r[1] = h[1] + sigmoidf_(a[1]) * bfhi(pw.x); r[2] = h[2] + sigmoidf_(a[2]) * bflo(pw.y); r[3] = h[3] + sigmoidf_(a[3]) * bfhi(pw.y);
                        *(f32x4*)(out + o) = r; if (hb) st_bf4(hb + o, r); } }
    }
};
struct SchedCmp {
    int c;
    __device__ bool next(int i, pg8::Unit& u) const { if (i > 0 || c >= 16) return false; u.pm = c & 7; u.pn = c >> 3; u.pb = c >> 3; return true; }
    __device__ __forceinline__ unsigned arow(const pg8::Unit& u, int r) const { const int rr = u.pm * 256 + r; return (unsigned)(((rr >> 9) * SEQ + 16 * (rr & 511)) * NINP + (u.pn ? C_VC : C_KC)) * 2u; }
};

template <class RM> __device__ __forceinline__ void transpose_item(const float* W, int K, int N, bf16_t* WT, const RM& rm, LAS float* scr, int item, int lane) {
    const int nblk = (N + 31) / 32, kb = item / nblk, nb = item % nblk, k0 = 64 * kb, n0 = 32 * nb;
    const int nl = n0 + (lane & 31);
#pragma unroll 8
    for (int i = 0; i < 32; ++i) { const int kk = 2 * i + (lane >> 5); scr[kk * 33 + (lane & 31)] = nl < N ? W[(size_t)(k0 + kk) * N + nl] : 0.f; }
    asm volatile("s_waitcnt lgkmcnt(0)" ::: "memory");
    const int c = lane & 7;
#pragma unroll
    for (int j = 0; j < 4; ++j) { const int n = (lane >> 3) + 8 * j; const LAS float* s = scr + (8 * c) * 33 + n;
        u32x4 o; o.x = pk2(s[0 * 33], s[1 * 33]); o.y = pk2(s[2 * 33], s[3 * 33]); o.z = pk2(s[4 * 33], s[5 * 33]); o.w = pk2(s[6 * 33], s[7 * 33]);
        if (n0 + n < N) *(u32x4*)(WT + (size_t)rm(n0 + n) * K + k0 + 8 * c) = o; }
    asm volatile("s_waitcnt lgkmcnt(0)" ::: "memory");
}
struct RmId { int off; __device__ __forceinline__ int operator()(int n) const { return off + n; } };
struct RmIl { int s; __device__ __forceinline__ int operator()(int n) const { return 2 * n + s; } };
struct RmIn { __device__ __forceinline__ int operator()(int n) const {
    const bool rp = (n >= C_CQ && n < C_CV) || (n >= C_DQ && n < C_KC) || (n >= C_KS && n < C_VS) || (n >= C_KW && n < C_VW);
    return rp ? ((n & ~48) | ((n & 16) << 1) | ((n & 32) >> 1)) : n; } };

struct Args { const void* in[23]; float* out; unsigned char* ws; int ph_lo, ph_hi; };
constexpr int NWAVES = 8, NTHREADS = 512;
constexpr int NPHASES = 1 + 11 + 13;

__global__ void __launch_bounds__(NTHREADS, 2) mk_fwd(Args args) {
    extern __shared__ __attribute__((aligned(16))) unsigned char lds_raw[];
    LAS unsigned char* lds = (LAS unsigned char*)lds_raw;
    LAS int* cw = (LAS int*)(lds + LDS_CTL);
    const int tid0 = threadIdx.x, wave0 = __builtin_amdgcn_readfirstlane(tid0 >> 6);
    const int G = gridDim.x, bx = blockIdx.x, vcu = (G % 8 == 0) ? (bx % 8) * (G / 8) + bx / 8 : bx;
    const int NGW = G * NWAVES;
    unsigned* ctl = (unsigned*)(args.ws + WS_CTL);
    const int lo = args.ph_lo, hi = args.ph_hi;
    for (int u = tid0; u < (LDS_BYTES - LDS_CTL) / 4; u += NTHREADS) cw[u] = 0;
    __syncthreads();
    XcdBarrier bar; bar.bar = ctl + CW_BAR; bar.x = 0; bar.st = nullptr;
    if (hi - lo > 1) bar = xcd_barrier_post(ctl + CW_BAR, (volatile LAS unsigned*)(cw + LW_BAR));
    float* const dout = args.out;
#define CAS __attribute__((address_space(4)))
#define KIN(i) (*(const void* CAS const*)(ka + 8 * (i)))
#define PHASE_NAMES \
    unsigned zz_ = 0u; asm volatile("" : "+v"(zz_)); int tid = wave0 * 64 + (int)__builtin_amdgcn_mbcnt_hi(~0u, __builtin_amdgcn_mbcnt_lo(~0u, zz_)); asm volatile("" : "+v"(tid)); const int lane = tid & 63, wave = __builtin_amdgcn_readfirstlane(tid >> 6), gw = vcu * NWAVES + wave; \
    CAS const unsigned char* ka = (CAS const unsigned char*)__builtin_amdgcn_kernarg_segment_ptr(); asm volatile("" : "+s"(ka)); \
    unsigned char* ws = *(unsigned char* CAS const*)(ka + 24 * 8); \
    const float* x = (const float*)KIN(0); const float* pin = (const float*)KIN(1); const int* pos = (const int*)KIN(2); \
    const float* w_in = (const float*)KIN(3); const float* w_out = (const float*)KIN(4); \
    const float* ln_mix_g = (const float*)KIN(5); const float* ln_mix_b = (const float*)KIN(6); \
    const float* diff_lambda = (const float*)KIN(7); const float* diff_gain = (const float*)KIN(8); \
    const float* cmp_pos = (const float*)KIN(9); const float* cmp_w1 = (const float*)KIN(10); const float* cmp_w2 = (const float*)KIN(11); \
    const float* ffn_w1 = (const float*)KIN(12); const float* ffn_w3 = (const float*)KIN(13); const float* ffn_w2 = (const float*)KIN(14); \
    const float* moe_router = (const float*)KIN(15); const float* moe_w1 = (const float*)KIN(16); const float* moe_w3 = (const float*)KIN(17); const float* moe_w2 = (const float*)KIN(18); \
    const float* ln_ffn_g = (const float*)KIN(19); const float* ln_ffn_b = (const float*)KIN(20); \
    const float* ple_proj = (const float*)KIN(21); const float* ple_gate = (const float*)KIN(22); \
    unsigned char* misc = ws + WS_MISC; \
    float* lamv = (float*)(misc + OFF_LAM); float* c1 = (float*)(misc + OFF_C1); \
    bf16_t* kmean = (bf16_t*)(misc + OFF_KMEAN); bf16_t* KC = (bf16_t*)(misc + OFF_KC); bf16_t* VC = (bf16_t*)(misc + OFF_VC); \
    float* gates = (float*)(misc + OFF_GATES); float* moeg = (float*)(misc + OFF_MOEG); int* list = (int*)(misc + OFF_LIST); float* hid = (float*)(misc + OFF_HID); \
    float* cos32 = (float*)(ws + WS_ROPE); float* sin32 = cos32 + (size_t)NT * 32; float* cos16 = sin32 + (size_t)NT * 32; float* sin16 = cos16 + (size_t)NT * 16; \
    unsigned char* wb = ws + WS_W; \
    bf16_t* hb = (bf16_t*)(ws + WS_HB); bf16_t* pb = (bf16_t*)(ws + WS_PB); \
    unsigned char* R = ws + WS_R; \
    bf16_t* proj = (bf16_t*)(R + R_PROJ); bf16_t* qr = (bf16_t*)(R + R_QR); bf16_t* mixed = (bf16_t*)(R + R_MIXED); \
    bf16_t* hidb = (bf16_t*)(R + R_HID); float* H2 = (float*)(R + R_H2); bf16_t* Pp = (bf16_t*)(R + R_P); \
    (void)lane; (void)gw; (void)x; (void)pin; (void)pos; (void)w_in; (void)w_out; (void)ln_mix_g; (void)ln_mix_b; (void)diff_lambda; (void)diff_gain; (void)cmp_pos; (void)cmp_w1; (void)cmp_w2; \
    (void)ffn_w1; (void)ffn_w3; (void)ffn_w2; (void)moe_router; (void)moe_w1; (void)moe_w3; (void)moe_w2; (void)ln_ffn_g; (void)ln_ffn_b; (void)ple_proj; (void)ple_gate; (void)lamv; (void)c1; \
    (void)kmean; (void)KC; (void)VC; (void)gates; (void)moeg; (void)list; (void)hid; (void)sin16; (void)wb; (void)hb; (void)pb; (void)proj; (void)qr; (void)mixed; (void)hidb; (void)H2; (void)Pp;

    int ph = 0;
#define PHASE_BEGIN(k) if (ph >= lo && ph < hi) { for (int rep_ = 0; rep_ < (((PHMASK >> (k)) & 1) ? 1 + ((DUPMASK >> (k)) & 1) : 0); ++rep_) { if (rep_) xcd_barrier(bar); PHASE_NAMES
#define PHASE_END   } if (ph + 1 < hi) xcd_barrier(bar); } ++ph;

    PHASE_BEGIN(0)
    {
        LAS float* scr = (LAS float*)(lds + wave * 16384);
        for (int f = gw; f < 27 * 1792; f += NGW) {
            const int idx = f / 1792, item = f % 1792, e = idx / 3, which = idx % 3;
            const float* W = e == 0 ? (which == 0 ? ffn_w1 : which == 1 ? ffn_w3 : ffn_w2) : ((which == 0 ? moe_w1 : which == 1 ? moe_w3 : moe_w2) + (size_t)(e - 1) * DM * DFF);
            if (which < 2) transpose_item(W, DM, DFF, (bf16_t*)(wb + W_F13) + (size_t)e * 2 * DFF * DM, RmIl{which}, scr, item, lane);
            else transpose_item(W, DFF, DM, (bf16_t*)(wb + W_F2) + (size_t)e * DM * DFF, RmId{0}, scr, item, lane);
        }
        for (int f = gw; f < DEPTH * 16 * 93; f += NGW) { const int L = f / (16 * 93), item = f % (16 * 93);
            transpose_item(w_in + (size_t)L * DM * NIN, DM, NIN, (bf16_t*)(wb + W_IN) + (size_t)L * NINP * DM, RmIn{}, scr, item, lane); }
        for (int f = gw; f < DEPTH * 512; f += NGW) { const int L = f / 512, item = f % 512;
            transpose_item(w_out + (size_t)L * DM * DM, DM, DM, (bf16_t*)(wb + W_OUT) + (size_t)L * DM * DM, RmId{0}, scr, item, lane); }
        for (int f = gw; f < DEPTH * 512; f += NGW) { const int L = f / 512, item = f % 512;
            transpose_item(ple_gate + (size_t)L * DM * DM, DM, DM, (bf16_t*)(wb + W_PG) + (size_t)L * DM * DM, RmId{0}, scr, item, lane); }
        for (int f = gw; f < DEPTH * 128; f += NGW) { const int L = f / 128, item = f % 128;
            transpose_item(ple_proj + (size_t)L * PLE * DM, PLE, DM, (bf16_t*)(wb + W_PP) + (size_t)L * DM * PLE, RmId{0}, scr, item, lane); }
        for (int f = gw; f < DEPTH * 2 * 256; f += NGW) { const int lk = f / 256, item = f % 256;
            transpose_item(cmp_w1 + (size_t)lk * 2048 * 256, 2048, 256, (bf16_t*)(wb + W_C1) + (size_t)lk * 256 * 2048, RmId{0}, scr, item, lane); }
        for (int f = gw * 64 + lane; f < DEPTH * (NINP - NIN) * (DM / 8); f += NGW * 64) { const int L = f / ((NINP - NIN) * (DM / 8)), r = f % ((NINP - NIN) * (DM / 8));
            *(u32x4*)((bf16_t*)(wb + W_IN) + ((size_t)L * NINP + NIN) * DM + (size_t)r * 8) = (u32x4){0u, 0u, 0u, 0u}; }
        for (int r = gw; r < NT; r += NGW) { const f32x4* xr = (const f32x4*)(x + (size_t)r * DM) + lane; u32x2* o8 = (u32x2*)(hb + (size_t)r * DM) + lane;
#pragma unroll
            for (int j = 0; j < 4; ++j) { const f32x4 v = xr[64 * j]; u32x2 w; w.x = pk2(v[0], v[1]); w.y = pk2(v[2], v[3]); o8[64 * j] = w; } }
        for (int f = gw * 64 + lane; f < NT * 32; f += NGW * 64) { const int tok = f >> 5, fi = f & 31; const float p = (float)pos[tok];
            const float a32 = p * powf(10000.f, -(float)fi / 32.f); float s, c; sincosf(a32, &s, &c); cos32[f] = c; sin32[f] = s;
            if (fi < 16) { const float a16 = p * powf(10000.f, -(float)fi / 16.f); sincosf(a16, &s, &c); cos16[tok * 16 + fi] = c; sin16[tok * 16 + fi] = s; } }
        if (vcu < DEPTH * 2) {
            const float* pe = cmp_pos + (size_t)vcu * 2048; const float* w1 = cmp_w1 + (size_t)vcu * 2048 * 256;
            const int n = tid & 255, half = tid >> 8; float s = 0.f;
            for (int kk = half * 1024; kk < half * 1024 + 1024; ++kk) s += pe[kk] * w1[(size_t)kk * 256 + n];
            LAS float* red = (LAS float*)lds;
            __syncthreads(); if (half == 1) red[n] = s; __syncthreads(); if (half == 0) c1[vcu * 256 + n] = s + red[n];
        }
        if (vcu == DEPTH * 2 && tid < DEPTH) { const float* lf = diff_lambda + tid * 128; float a = 0.f, b = 0.f;
            for (int k = 0; k < 32; ++k) { a += lf[k] * lf[32 + k]; b += lf[64 + k] * lf[96 + k]; }
            lamv[tid] = expf(a) - expf(b) + (0.8f - 0.6f * expf(-0.3f * (float)tid)); }
    }
    PHASE_END

    for (int L = 0; L < DEPTH; ++L) {
        const float lam_init = (L == 0) ? 0.2f : 0.35550907f;
        const bool moe = (L & 1);
        PHASE_BEGIN(1)
        {
            pg8::Gemm g{L == 0 ? hb : mixed, (const bf16_t*)(wb + W_IN) + (size_t)L * NINP * DM, DM, 128u};
            pg8::StaticOrder S; S.init(NT, NINP, G, bx, DM);
            EpiInProj E{proj, qr, gates, cos32, sin32, cos16, sin16};
            pg8::gemm_phase(lds, g, S, E, tid);
        }
        PHASE_END
        PHASE_BEGIN(2)
        {
            if (vcu < 16) {
                pg8::Gemm g{proj, (const bf16_t*)(wb + W_C1) + (size_t)L * 2 * 256 * 2048, 2048, (unsigned)(NINP * 2)};
                SchedCmp S{vcu}; EpiCmp E{hid, c1 + L * 512};
                pg8::gemm_phase(lds, g, S, E, tid);
            } else {
                LAS float* part = (LAS float*)lds;
                for (int it = vcu - 16; it < 512; it += G - 16) {
                    const int bh = it >> 5, j = it & 31, b = bh >> 2, h = bh & 3, kg = tid >> 3, c = tid & 7;
                    const bf16_t* kp = proj + ((size_t)b * SEQ + 256 * j + 4 * kg) * NINP + C_CK + h * 64 + c * 8;
                    float s[8] = {0.f, 0.f, 0.f, 0.f, 0.f, 0.f, 0.f, 0.f};
#pragma unroll
                    for (int k = 0; k < 4; ++k) { const u32x4 v = *(const u32x4*)(kp + (size_t)k * NINP);
                        s[0] += bflo(v.x); s[1] += bfhi(v.x); s[2] += bflo(v.y); s[3] += bfhi(v.y); s[4] += bflo(v.z); s[5] += bfhi(v.z); s[6] += bflo(v.w); s[7] += bfhi(v.w); }
                    __syncthreads();
#pragma unroll
                    for (int q = 0; q < 8; ++q) part[kg * 64 + c * 8 + q] = s[q];
                    __syncthreads();
                    if (tid < 64) { float a = 0.f; for (int k = 0; k < 64; ++k) a += part[k * 64 + tid]; kmean[(size_t)it * 64 + tid] = (bf16_t)(pk2(a * (1.f / 256.f), 0.f) & 0xffffu); }
                }
            }
        }
        PHASE_END
        PHASE_BEGIN(3)
        {
            for (int f = (vcu * NTHREADS + tid); f < 2 * 2048 * 64; f += G * NTHREADS) {
                const int d = f & 63, r = (f >> 6) & 2047, kv = f >> 17;
                const float* hr = hid + ((size_t)kv * 2048 + r) * 256; const float* w2 = cmp_w2 + ((size_t)(L * 2 + kv) * 256) * 64 + d;
                float a = 0.f;
                if ((r & 511) != 511) { for (int n = 0; n < 256; ++n) a += hr[n] * w2[(size_t)n * 64]; }
                (kv ? VC : KC)[(size_t)r * 64 + d] = (bf16_t)(pk2(a, 0.f) & 0xffffu);
            }
        }
        PHASE_END
        PHASE_BEGIN(4)
        {
            const float lam = lamv[L];
            { const int bh = vcu >> 4, s = vcu & 15;
#define ATT_TID int tq = tid; asm volatile("" : "+v"(tq)); const int lq = tq & 63;
              if (ATTMASK & 2) for (int k = 0; k < ((DUPATT & 2) ? 4 : 2); ++k) { ATT_TID att::unit_B(lds, proj, mixed, diff_gain + L * 64, lam, lam_init, bh >> 2, bh & 3, (k & 1) ? 31 - s : s, tq, wave, lq); }
              if (ATTMASK & 4) for (int k = 0; k < ((DUPATT & 4) ? 4 : 2); ++k) { ATT_TID att::unit_C(lds, proj, kmean, mixed, bh >> 2, bh & 3, (k & 1) ? 31 - s : s, tq, wave, lq); }
              if (ATTMASK & 1) for (int k = 0; k < ((DUPATT & 1) ? 4 : 2); ++k) { ATT_TID att::unit_A(lds, proj, mixed, bh >> 2, bh & 3, (k & 1) ? 31 - s : s, tq, wave, lq); } }
            { const int b = vcu >> 6, s = vcu & 63;
              if (ATTMASK & 8) for (int k = 0; k < ((DUPATT & 8) ? 4 : 2); ++k) { ATT_TID att::unit_D(lds, proj, qr, KC, VC, gates, mixed, b, (k & 1) ? 127 - s : s, tq, wave, lq); } }
#undef ATT_TID
        }
        PHASE_END
        PHASE_BEGIN(5)
        {
            pg8::Gemm g{mixed, (const bf16_t*)(wb + W_OUT) + (size_t)L * DM * DM, DM, 128u};
            pg8::StaticOrder S; S.init(NT, DM, G, bx, DM);
            EpiResid E{L == 0 ? x : dout, dout};
            pg8::gemm_phase(lds, g, S, E, tid);
        }
        PHASE_END
        PHASE_BEGIN(6)
        {
            const float* gv = ln_mix_g + L * DM; const float* bv = ln_mix_b + L * DM;
            f32x4 gg[4], bb[4];
#pragma unroll
            for (int j = 0; j < 4; ++j) { gg[j] = *((const f32x4*)gv + lane + 64 * j); bb[j] = *((const f32x4*)bv + lane + 64 * j); }
            if (tid < 8) cw[LW_CNTL + tid] = 0;
            __syncthreads();
            int k = 0;
            for (int r = gw; r < NT; r += NGW, ++k) {
                f32x4* xr = (f32x4*)(dout + (size_t)r * DM) + lane;
                f32x4 v[4]; float s = 0.f;
#pragma unroll
                for (int j = 0; j < 4; ++j) { v[j] = xr[64 * j]; s += (v[j][0] + v[j][1]) + (v[j][2] + v[j][3]); }
                const float mean = wave_sum(s) * (1.f / DM); float s2 = 0.f;
#pragma unroll
                for (int j = 0; j < 4; ++j) { v[j] = v[j] - mean; s2 += (v[j][0] * v[j][0] + v[j][1] * v[j][1]) + (v[j][2] * v[j][2] + v[j][3] * v[j][3]); }
                const float rstd = rsqrtf(wave_sum(s2) * (1.f / DM) + LN_EPS);
                u32x2* o8 = (u32x2*)(hb + (size_t)r * DM) + lane;
#pragma unroll
                for (int j = 0; j < 4; ++j) { v[j] = v[j] * rstd * gg[j] + bb[j]; u32x2 w; w.x = pk2(v[j][0], v[j][1]); w.y = pk2(v[j][2], v[j][3]); o8[64 * j] = w; if (!moe) xr[64 * j] = v[j]; }
                if (moe) {
                    float lg[8];
#pragma unroll
                    for (int e = 0; e < 8; ++e) lg[e] = 0.f;
#pragma unroll
                    for (int j = 0; j < 4; ++j)
#pragma unroll
                        for (int q = 0; q < 4; ++q) { const f32x4* wr = (const f32x4*)(moe_router + (size_t)(4 * lane + 256 * j + q) * 8); const f32x4 w0 = wr[0], w1 = wr[1]; const float hv = v[j][q];
                            lg[0] += hv * w0[0]; lg[1] += hv * w0[1]; lg[2] += hv * w0[2]; lg[3] += hv * w0[3]; lg[4] += hv * w1[0]; lg[5] += hv * w1[1]; lg[6] += hv * w1[2]; lg[7] += hv * w1[3]; }
#pragma unroll
                    for (int e = 0; e < 8; ++e) lg[e] = wave_sum(lg[e]);
                    int e0 = 0; float b0 = lg[0];
#pragma unroll
                    for (int e = 1; e < 8; ++e) if (lg[e] > b0) { b0 = lg[e]; e0 = e; }
                    int e1 = -1; float b1 = -INFINITY;
#pragma unroll
                    for (int e = 0; e < 8; ++e) if (e != e0 && lg[e] > b1) { b1 = lg[e]; e1 = e; }
                    const float g1 = 1.f / (1.f + expf(b0 - b1)), g0 = 1.f - g1;
                    if (lane == 0) {
                        const int s0 = __hip_atomic_fetch_add(cw + LW_CNTL + e0, 1, __ATOMIC_RELAXED, __HIP_MEMORY_SCOPE_WORKGROUP), s1 = __hip_atomic_fetch_add(cw + LW_CNTL + e1, 1, __ATOMIC_RELAXED, __HIP_MEMORY_SCOPE_WORKGROUP);
                        const int ix = (wave * 16 + k) * 2; cw[LW_PE + ix] = e0 | (s0 << 8); cw[LW_PE + ix + 1] = e1 | (s1 << 8);
                        moeg[2 * r] = g0; moeg[2 * r + 1] = g1;
                    }
                }
                { const f32x4 pv4 = *((const f32x4*)(pin + ((size_t)L * NT + r) * PLE) + lane); u32x2 w; w.x = pk2(pv4[0], pv4[1]); w.y = pk2(pv4[2], pv4[3]); *((u32x2*)(pb + (size_t)r * PLE) + lane) = w; }
            }
            if (moe) {
                __syncthreads();
                if (tid < 8) cw[LW_BASEL + tid] = (int)__hip_atomic_fetch_add(ctl + CW_CNT + 64 * tid, (unsigned)cw[LW_CNTL + tid], __ATOMIC_RELAXED, __HIP_MEMORY_SCOPE_AGENT);
                __syncthreads();
                if (tid < 256) { const int wv = tid >> 5, kk = (tid >> 1) & 15, r = vcu * NWAVES + wv + kk * NGW;
                    if (r < NT) { const int pe = cw[LW_PE + tid], e = pe & 255, sl = pe >> 8; list[e * 32768 + cw[LW_BASEL + e] + sl] = 2 * r + (tid & 1); } }
            }
        }
        PHASE_END
        for (int chunk = 0; chunk < (moe ? 2 : 1); ++chunk) {
            PHASE_BEGIN(7)
            {
                __syncthreads();
                if (tid == 0) { int ts = 0;
                    for (int e = 0; e < 8; ++e) { const int c = moe ? (int)__hip_atomic_load(ctl + CW_CNT + 64 * e, __ATOMIC_RELAXED, __HIP_MEMORY_SCOPE_AGENT) : (e == 0 ? NT : 0); cw[LW_CNT + e] = c; cw[LW_TS + e] = ts; ts += (c + 255) >> 8; }
                    cw[LW_TS + 8] = ts; }
                __syncthreads();
                const int ntile = cw[LW_TS + 8], t0 = chunk * 128, t1 = chunk == 0 ? (ntile < 128 ? ntile : 128) : ntile;
                if (t1 > t0) {
                    pg8::Gemm g{hb, (const bf16_t*)(wb + W_F13), DM, 128u};
                    SchedGU S{cw, list, t0, t1, G, bx, !moe}; EpiSwiglu E{hidb, t0};
                    pg8::gemm_phase(lds, g, S, E, tid);
                }
            }
            PHASE_END
            PHASE_BEGIN(8)
            {
                __syncthreads();
                if (tid == 0) { int ts = 0;
                    for (int e = 0; e < 8; ++e) { const int c = moe ? (int)__hip_atomic_load(ctl + CW_CNT + 64 * e, __ATOMIC_RELAXED, __HIP_MEMORY_SCOPE_AGENT) : (e == 0 ? NT : 0); cw[LW_CNT + e] = c; cw[LW_TS + e] = ts; ts += (c + 255) >> 8; }
                    cw[LW_TS + 8] = ts; }
                __syncthreads();
                const int ntile = cw[LW_TS + 8], t0 = chunk * 128, t1 = chunk == 0 ? (ntile < 128 ? ntile : 128) : ntile;
                if (t1 > t0) {
                    pg8::Gemm g{hidb, (const bf16_t*)(wb + W_F2), DFF, 128u};
                    SchedDN S{cw, t0, t1, G, bx, !moe}; EpiDown E{!moe, dout, (bf16_t*)dout, cw, list, moeg};
                    pg8::gemm_phase(lds, g, S, E, tid);
                }
            }
            PHASE_END
        }
        PHASE_BEGIN(9)
        {
            const float* gv = ln_ffn_g + L * DM; const float* bv = ln_ffn_b + L * DM;
            f32x4 gg[4], bb[4];
#pragma unroll
            for (int j = 0; j < 4; ++j) { gg[j] = *((const f32x4*)gv + lane + 64 * j); bb[j] = *((const f32x4*)bv + lane + 64 * j); }
            float* hout = moe ? H2 : dout;
            for (int r = gw; r < NT; r += NGW) {
                f32x4 v[4]; float s = 0.f;
                u32x2* h8 = (u32x2*)(hb + (size_t)r * DM) + lane;
                if (!moe) {
                    const f32x4* xr = (const f32x4*)(dout + (size_t)r * DM) + lane;
#pragma unroll
                    for (int j = 0; j < 4; ++j) v[j] = xr[64 * j];
                } else {
                    const u32x2* y0 = (const u32x2*)((const bf16_t*)dout + (size_t)(2 * r) * DM) + lane; const u32x2* y1 = (const u32x2*)((const bf16_t*)dout + (size_t)(2 * r + 1) * DM) + lane;
#pragma unroll
                    for (int j = 0; j < 4; ++j) { const u32x2 a = h8[64 * j], c = y0[64 * j], d = y1[64 * j];
                        v[j][0] = ALPHA * bflo(a.x) + (bflo(c.x) + bflo(d.x)); v[j][1] = ALPHA * bfhi(a.x) + (bfhi(c.x) + bfhi(d.x));
                        v[j][2] = ALPHA * bflo(a.y) + (bflo(c.y) + bflo(d.y)); v[j][3] = ALPHA * bfhi(a.y) + (bfhi(c.y) + bfhi(d.y)); }
                }
#pragma unroll
                for (int j = 0; j < 4; ++j) s += (v[j][0] + v[j][1]) + (v[j][2] + v[j][3]);
                const float mean = wave_sum(s) * (1.f / DM); float s2 = 0.f;
#pragma unroll
                for (int j = 0; j < 4; ++j) { v[j] = v[j] - mean; s2 += (v[j][0] * v[j][0] + v[j][1] * v[j][1]) + (v[j][2] * v[j][2] + v[j][3] * v[j][3]); }
                const float rstd = rsqrtf(wave_sum(s2) * (1.f / DM) + LN_EPS);
                f32x4* orow = (f32x4*)(hout + (size_t)r * DM) + lane;
#pragma unroll
                for (int j = 0; j < 4; ++j) { v[j] = v[j] * rstd * gg[j] + bb[j]; orow[64 * j] = v[j]; u32x2 w; w.x = pk2(v[j][0], v[j][1]); w.y = pk2(v[j][2], v[j][3]); h8[64 * j] = w; }
            }
        }
        PHASE_END
        PHASE_BEGIN(10)
        {
            pg8::Gemm g{pb, (const bf16_t*)(wb + W_PP) + (size_t)L * DM * PLE, PLE, 128u};
            pg8::StaticOrder S; S.init(NT, DM, G, bx, PLE);
            EpiBf16 E{Pp, DM};
            pg8::gemm_phase(lds, g, S, E, tid);
        }
        PHASE_END
        PHASE_BEGIN(11)
        {
            pg8::Gemm g{hb, (const bf16_t*)(wb + W_PG) + (size_t)L * DM * DM, DM, 128u};
            pg8::StaticOrder S; S.init(NT, DM, G, bx, DM);
            EpiPle E{moe ? H2 : dout, Pp, dout, (L + 1 < DEPTH) ? mixed : nullptr};
            pg8::gemm_phase(lds, g, S, E, tid);
        }
        PHASE_END
    }
#undef PHASE_BEGIN
#undef PHASE_END
}

extern "C" void kernel_launch(void* const* d_in, const int* in_sizes, int n_in, void* d_out, int out_size, void* d_ws, size_t ws_size, hipStream_t stream) {
    static int grid = 0;
    if (grid == 0) {
        if (n_in != 23 || out_size != NT * DM || ws_size < WS_END) { fprintf(stderr, "kernel_launch: unexpected problem (n_in %d out %d ws %zu need %zu)\n", n_in, out_size, ws_size, (size_t)WS_END); grid = -1; return; }
        int dev = 0, cus = 0;
        if (hipGetDevice(&dev) != hipSuccess || hipDeviceGetAttribute(&cus, hipDeviceAttributeMultiprocessorCount, dev) != hipSuccess) { grid = -1; return; }
        if (hipFuncSetAttribute((const void*)mk_fwd, hipFuncAttributeMaxDynamicSharedMemorySize, LDS_BYTES) != hipSuccess) { fprintf(stderr, "kernel_launch: hipFuncSetAttribute failed\n"); grid = -1; return; }
        int per_cu = 0;
        if (hipOccupancyMaxActiveBlocksPerMultiprocessor(&per_cu, (const void*)mk_fwd, NTHREADS, LDS_BYTES) != hipSuccess || per_cu < 1) { fprintf(stderr, "kernel_launch: occupancy query says %d blocks per CU\n", per_cu); }
        (void)hipGetLastError();
        grid = cus;
        if (grid != 256) { fprintf(stderr, "kernel_launch: built for 256 CUs, device has %d\n", cus); grid = -1; return; }
    }
    if (grid < 0) return;
    (void)hipMemsetAsync((char*)d_ws + WS_CTL, 0, CTL_ZERO_BYTES, stream);
    Args a{};
    for (int i = 0; i < 23; ++i) a.in[i] = d_in[i];
    a.out = (float*)d_out; a.ws = (unsigned char*)d_ws;
#if MK_MULTI
    for (int p = 0; p < NPHASES; ++p) { a.ph_lo = p; a.ph_hi = p + 1; hipLaunchKernelGGL(mk_fwd, dim3(grid), dim3(NTHREADS), LDS_BYTES, stream, a); }
#else
    a.ph_lo = 0; a.ph_hi = NPHASES;
    hipLaunchKernelGGL(mk_fwd, dim3(grid), dim3(NTHREADS), LDS_BYTES, stream, a);
#endif
}
```

```cpp
#include <hip/hip_runtime.h>
#include <cstdio>
#include <cstdint>

#ifndef PHMASK
#define PHMASK 0xFFFF
#endif
#ifndef DUPMASK
#define DUPMASK 0
#endif
#ifndef DUPATT
#define DUPATT 0
#endif
#ifndef ATTMASK
#define ATTMASK 0xF
#endif
#ifndef MK_MULTI
#define MK_MULTI 0
#endif

#define LAS __attribute__((address_space(3)))
#define GAS __attribute__((address_space(1)))
typedef unsigned short bf16_t;
typedef short bf16x8 __attribute__((ext_vector_type(8)));
typedef short s16x4 __attribute__((ext_vector_type(4)));
typedef float f32x2 __attribute__((ext_vector_type(2)));
typedef float f32x4 __attribute__((ext_vector_type(4)));
typedef float f32x16 __attribute__((ext_vector_type(16)));
typedef unsigned u32x2 __attribute__((ext_vector_type(2)));
typedef unsigned u32x4 __attribute__((ext_vector_type(4)));
typedef __bf16 bf16x2_t __attribute__((ext_vector_type(2)));

constexpr int NB = 4, SEQ = 8192, NT = NB * SEQ, DM = 1024, NIN = 2956, NINP = 3072, DFF = 3584, NEXP = 8, PLE = 256, DEPTH = 2;
constexpr int NCMP = 512;
constexpr float LOG2E = 1.4426950408889634f;
constexpr float ALPHA = 1.4142135623730951f;
constexpr float LN_EPS = 1e-5f, RMS_EPS = 1e-5f;
constexpr float QS64 = 0.125f * LOG2E;
constexpr float QS32 = 0.17677669529663687f * LOG2E;
constexpr int C_AQ = 0, C_AK = 256, C_AV = 512, C_BQ = 768, C_BK = 1024, C_BV = 1280, C_CQ = 1536, C_CK = 1792, C_CV = 2048, C_DQ = 2304;
constexpr int C_KC = 2560, C_VC = 2624, C_KS = 2688, C_VS = 2752, C_KW = 2816, C_VW = 2880, C_G = 2944;

constexpr size_t MiB = 1u << 20;
constexpr size_t WS_CTL = 0, CTL_ZERO_BYTES = 1 * MiB;
constexpr size_t WS_MISC = 1 * MiB;
constexpr size_t OFF_LAM = 0;
constexpr size_t OFF_C1 = 4096;
constexpr size_t OFF_KMEAN = 32768;
constexpr size_t OFF_KC = 128 * 1024;
constexpr size_t OFF_VC = 384 * 1024;
constexpr size_t OFF_GATES = 1 * MiB;
constexpr size_t OFF_MOEG = 3 * MiB;
constexpr size_t OFF_LIST = 4 * MiB;
constexpr size_t OFF_HID = 5 * MiB;
constexpr size_t WS_ROPE = 11 * MiB;
constexpr size_t WS_W = 23 * MiB;
constexpr size_t W_IN = 0;
constexpr size_t W_OUT = W_IN + (size_t)DEPTH * NINP * DM * 2;
constexpr size_t W_PG = W_OUT + (size_t)DEPTH * DM * DM * 2;
constexpr size_t W_PP = W_PG + (size_t)DEPTH * DM * DM * 2;
constexpr size_t W_C1 = W_PP + (size_t)DEPTH * DM * PLE * 2;
constexpr size_t W_F13 = W_C1 + (size_t)DEPTH * 2 * 256 * 2048 * 2;
constexpr size_t W_F2 = W_F13 + (size_t)9 * 2 * DFF * DM * 2;
constexpr size_t W_END = W_F2 + (size_t)9 * DM * DFF * 2;
constexpr size_t WS_HB = WS_W + ((W_END + MiB - 1) / MiB) * MiB;
constexpr size_t WS_PB = WS_HB + 64 * MiB;
constexpr size_t WS_R = WS_PB + 16 * MiB;
constexpr size_t R_PROJ = 0;
constexpr size_t R_QR = 193 * MiB;
constexpr size_t R_MIXED = 209 * MiB;
constexpr size_t R_HID = 0;
constexpr size_t R_H2 = 0;
constexpr size_t R_P = 128 * MiB;
constexpr size_t WS_END = WS_R + 274 * MiB;
constexpr int CW_BAR = 4096, CW_CNT = 8192;

__device__ __forceinline__ unsigned pk2(float lo, float hi) { f32x2 v = {lo, hi}; bf16x2_t b = __builtin_convertvector(v, bf16x2_t); return __builtin_bit_cast(unsigned, b); }
__device__ __forceinline__ float bflo(unsigned w) { return __uint_as_float(w << 16); }
__device__ __forceinline__ float bfhi(unsigned w) { return __uint_as_float(w & 0xffff0000u); }
__device__ __forceinline__ float wave_sum(float v) {
#pragma unroll
    for (int o = 1; o < 64; o <<= 1) v += __shfl_xor(v, o);
    return v;
}
__device__ __forceinline__ float wave_max(float v) {
#pragma unroll
    for (int o = 1; o < 64; o <<= 1) v = fmaxf(v, __shfl_xor(v, o));
    return v;
}
__device__ __forceinline__ unsigned wave_or(unsigned v) {
#pragma unroll
    for (int o = 1; o < 64; o <<= 1) v |= (unsigned)__shfl_xor((int)v, o);
    return v;
}
__device__ __forceinline__ float xhalf(float x) { const unsigned u = __float_as_uint(x); auto rr = __builtin_amdgcn_permlane32_swap(u, u, false, false); return __uint_as_float(rr[0] ^ rr[1] ^ u); }
__device__ __forceinline__ float ex2(float x) { return __builtin_amdgcn_exp2f(x); }
__device__ __forceinline__ float lg2(float x) { return __builtin_amdgcn_logf(x); }
__device__ __forceinline__ float sigmoidf_(float x) { return __builtin_amdgcn_rcpf(1.0f + ex2(-LOG2E * x)); }
__device__ __forceinline__ float quad_sum(float x) {
    x += __builtin_bit_cast(float, __builtin_amdgcn_update_dpp(0, __builtin_bit_cast(int, x), 0xB1, 0xF, 0xF, true));
    x += __builtin_bit_cast(float, __builtin_amdgcn_update_dpp(0, __builtin_bit_cast(int, x), 0x4E, 0xF, 0xF, true));
    return x;
}

#define XB_TMO      128
#define XB_XCNT(j)  (256  + 64 * (j))
#define XB_XSUB(j)  (1280 + 64 * (j))
#define XB_XGEN(j)  (2304 + 64 * (j))
#define XB_TOP      3328
#define XB_TOPGEN   3392
#define XCD_BAR_WORDS 3456
#define XB_SPIN_CAP (1u << 18)
__device__ __forceinline__ unsigned xb_ld(unsigned* p)              { return __hip_atomic_load(p, __ATOMIC_RELAXED, __HIP_MEMORY_SCOPE_AGENT); }
__device__ __forceinline__ unsigned xb_add(unsigned* p, unsigned v) { return __hip_atomic_fetch_add(p, v, __ATOMIC_RELAXED, __HIP_MEMORY_SCOPE_AGENT); }
__device__ __forceinline__ unsigned xb_xcc_id() { return (unsigned)__builtin_amdgcn_s_getreg((3 << 11) | 20) & 0xFu; }
#define XB_SPIN(cond, bar) do { unsigned _sp = 0; while (cond) { __builtin_amdgcn_s_sleep(1); \
    if ((++_sp & 255u) == 0u) { if (xb_ld(&(bar)[XB_TMO])) break; if (_sp > XB_SPIN_CAP) { atomicAdd(&(bar)[XB_TMO], 1u); break; } } } } while (0)
struct XcdBarrier { unsigned* bar; unsigned x; volatile LAS unsigned* st; };
__device__ __forceinline__ XcdBarrier xcd_barrier_post(unsigned* bar, volatile LAS unsigned* st) {
    XcdBarrier b; b.bar = bar; b.x = xb_xcc_id(); b.st = st;
    if (threadIdx.x == 0) (void)xb_add(&bar[XB_XCNT(b.x)], 1u);
    return b;
}
__device__ __forceinline__ void xcd_barrier_complete(unsigned* bar, unsigned x, unsigned& nloc, unsigned& nx) {
    const unsigned G = gridDim.x * gridDim.y * gridDim.z;
    unsigned sum, cnt, mine, sp = 0u;
    for (;;) {
        sum = 0u; cnt = 0u; mine = 0u;
#pragma unroll 1
        for (unsigned j = 0; j < 16; ++j) { const unsigned c = xb_ld(&bar[XB_XCNT(j)]); sum += c; cnt += (c > 0u) ? 1u : 0u; mine = (j == x) ? c : mine; }
        if (sum == G) break;
        __builtin_amdgcn_s_sleep(1);
        if ((++sp & 255u) == 0u) { if (xb_ld(&bar[XB_TMO])) break; if (sp > XB_SPIN_CAP) { atomicAdd(&bar[XB_TMO], 1u); break; } }
    }
    nloc = mine > 0u ? mine : 1u; nx = cnt > 0u ? cnt : 1u;
}
__device__ __forceinline__ void xcd_barrier(const XcdBarrier& b) {
    asm volatile("s_waitcnt vmcnt(0)" ::: "memory");
    __syncthreads();
    if (threadIdx.x == 0) {
        unsigned* bar = b.bar;
        __builtin_amdgcn_s_waitcnt(0);
        unsigned nloc = b.st[0], nx = b.st[1];
        if (nloc == 0u) { xcd_barrier_complete(bar, b.x, nloc, nx); b.st[0] = nloc; b.st[1] = nx; }
        const unsigned old = xb_add(&bar[XB_XSUB(b.x)], 1u);
        const unsigned gen = old / nloc;
        if (old + 1u == (gen + 1u) * nloc) {
            __builtin_amdgcn_fence(__ATOMIC_RELEASE, "agent");
            asm volatile("s_waitcnt vmcnt(0)" ::: "memory");
            const unsigned og = xb_add(&bar[XB_TOP], 1u);
            const unsigned tg = og / nx;
            if (og + 1u == (tg + 1u) * nx) xb_add(&bar[XB_TOPGEN], 1u);
            else XB_SPIN(xb_ld(&bar[XB_TOPGEN]) == tg, bar);
            __builtin_amdgcn_fence(__ATOMIC_ACQUIRE, "agent");
            xb_add(&bar[XB_XGEN(b.x)], 1u);
            asm volatile("s_waitcnt vmcnt(0)" ::: "memory");
        } else {
            XB_SPIN(xb_ld(&bar[XB_XGEN(b.x)]) == gen, bar);
            __builtin_amdgcn_fence(__ATOMIC_ACQUIRE, "agent");
            asm volatile("s_waitcnt vmcnt(0)" ::: "memory");
        }
    }
    __syncthreads();
}

namespace pg8 {
constexpr int BM = 256, BK = 64, HALF = 128, HTB = HALF * BK * 2, STAGE_BYTES = 8 * HTB, NXCD = 8, WGM = 8;
__host__ __device__ __forceinline__ int lds_byte(int r, int c) { const int st = (r >> 4) * 2 + (c >> 5), rr = r & 15, cc = c & 31, ob = rr * 64 + cc * 2; return st * 1024 + (ob ^ (((ob >> 9) & 1) << 5)); }
__host__ __device__ __forceinline__ void stage_rc(int b, int& R, int& C) { const int st = b / 1024, sb = b % 1024, swz = sb ^ (((sb >> 9) & 1) << 5); R = (st >> 1) * 16 + swz / 64; C = (st & 1) * 32 + (swz % 64) / 2; }
__host__ __device__ __forceinline__ int perm32(int rho) { const int n = rho >> 4, i = rho & 15; return 8 * (i >> 2) + 4 * n + (i & 3); }
struct Unit { int pm, pn, pb; };
struct Gemm { const bf16_t* A; const bf16_t* Bt; int K; unsigned kstepA; };

struct StaticOrder {
    int nM, nN, nwg, G, c; unsigned ldaB;
    __device__ void init(int M, int N, int G_, int c_, int lda) { nM = M / BM; nN = N / BM; nwg = nM * nN; G = G_; c = c_; ldaB = (unsigned)lda * 2u; }
    __device__ bool next(int i, Unit& u) const {
        const long L = (long)i * G + c; if (L >= nwg) return false;
        int wgid = (int)L; { const int q = nwg / NXCD, r = nwg % NXCD, xcd = wgid % NXCD, off = wgid / NXCD; wgid = (xcd < r ? xcd * (q + 1) : r * (q + 1) + (xcd - r) * q) + off; }
        const int nig = WGM * nN, gid = wgid / nig, fm = gid * WGM, gsz = (nM - fm) < WGM ? (nM - fm) : WGM;
        u.pm = fm + ((wgid % nig) % gsz); u.pn = (wgid % nig) / gsz; u.pb = u.pn; return true;
    }
    __device__ __forceinline__ unsigned arow(const Unit& u, int r) const { return (unsigned)(u.pm * BM + r) * ldaB; }
};

template <class Epi, class Sched>
__device__ __forceinline__ void gemm_phase(LAS unsigned char* lds, const Gemm g, const Sched& S, const Epi& E, const int tid) {
    const int wid = __builtin_amdgcn_readfirstlane(tid >> 6), lane = tid & 63, wr = wid >> 2, wc = wid & 3, fr = lane & 15, fq = lane >> 4;
    const int K = g.K, nt = K / BK;
    int Rr[2], Cc[2]; unsigned voffB[2];
#pragma unroll
    for (int i = 0; i < 2; ++i) { stage_rc(tid * 16 + i * 8192, Rr[i], Cc[i]); const int Rb = Epi::PERM ? ((Rr[i] & ~31) + perm32(Rr[i] & 31)) : Rr[i]; voffB[i] = (unsigned)(Rb * K + Cc[i]) * 2u; }
    const size_t kstepB = (size_t)(BK * 2), kstepA = (size_t)g.kstepA;
    const size_t hstepB = (size_t)HALF * K * 2, tstepB = 2 * hstepB;
    const unsigned ldsw = (unsigned)wid * 1024u;
    const int aoff = lds_byte(wr * 64 + fr, fq * 8), boff = lds_byte(wc * 32 + fr, fq * 8);
#define PG8_SA(b, h) (((b) * 2 + (h)) * HTB)
#define PG8_SB(b, h) ((4 + (b) * 2 + (h)) * HTB)
#define PG8_STAGE(bufoff, gbase, voff) do { _Pragma("unroll") for (int _i = 0; _i < 2; ++_i) \
        __builtin_amdgcn_global_load_lds((const unsigned*)((const char*)(gbase) + (voff)[_i]), (LAS unsigned*)(lds + (bufoff) + ldsw + _i * 8192), 16, 0, 0); } while (0)
#define PG8_LDA(dst, b, h) do { _Pragma("unroll") for (int m = 0; m < 4; ++m) _Pragma("unroll") for (int k = 0; k < 2; ++k) dst[m][k] = *(const LAS bf16x8*)(lds + PG8_SA(b, h) + aoff + m * 2048 + k * 1024); } while (0)
#define PG8_LDB(dst, b, h) do { _Pragma("unroll") for (int n = 0; n < 2; ++n) _Pragma("unroll") for (int k = 0; k < 2; ++k) dst[n][k] = *(const LAS bf16x8*)(lds + PG8_SB(b, h) + boff + n * 2048 + k * 1024); } while (0)
#define PG8_MMA(ai, bj, At, Bt) do { __builtin_amdgcn_s_setprio(1); _Pragma("unroll") for (int m = 0; m < 4; ++m) _Pragma("unroll") for (int n = 0; n < 2; ++n) _Pragma("unroll") for (int k = 0; k < 2; ++k) \
        acc[ai][bj][m][n] = __builtin_amdgcn_mfma_f32_16x16x32_bf16(Bt[n][k], At[m][k], acc[ai][bj][m][n], 0, 0, 0); __builtin_amdgcn_s_setprio(0); } while (0)
#define PG8_WAIT_V(n) asm volatile("s_waitcnt vmcnt(" #n ")" ::: "memory")
#define PG8_WAIT_L(n) asm volatile("s_waitcnt lgkmcnt(" #n ")" ::: "memory")
#define PG8_BAR __builtin_amdgcn_s_barrier()
#define PG8_SCHED __builtin_amdgcn_sched_barrier(0)
    Unit cur, nxt; int ui = 0;
    if (!S.next(0, cur)) return;
    f32x4 acc[2][2][4][2];
#pragma unroll
    for (int a = 0; a < 2; ++a)
#pragma unroll
        for (int b = 0; b < 2; ++b)
#pragma unroll
            for (int m = 0; m < 4; ++m)
#pragma unroll
                for (int n = 0; n < 2; ++n) acc[a][b][m][n] = (f32x4){0.f, 0.f, 0.f, 0.f};
    bf16x8 At[4][2], B0[2][2], B1[2][2];
    unsigned vc0[2], vc1[2];
    LAS u32x4* const stash = (LAS u32x4*)(lds + 133120 + tid * 16);
#pragma unroll
    for (int i = 0; i < 2; ++i) { vc0[i] = S.arow(cur, Rr[i]) + (unsigned)Cc[i] * 2u; vc1[i] = S.arow(cur, HALF + Rr[i]) + (unsigned)Cc[i] * 2u; }
    const char* const Ab = (const char*)g.A;
    const char* cB = (const char*)g.Bt + (size_t)cur.pb * tstepB;
    PG8_STAGE(PG8_SB(0, 0), cB, voffB); PG8_STAGE(PG8_SB(0, 1), cB + hstepB, voffB); PG8_STAGE(PG8_SA(0, 0), Ab, vc0); PG8_STAGE(PG8_SA(0, 1), Ab, vc1);
    if (wr == 1) PG8_BAR;
    PG8_WAIT_V(2); PG8_BAR;
    PG8_STAGE(PG8_SB(1, 0), cB + kstepB, voffB); PG8_STAGE(PG8_SA(1, 0), Ab + kstepA, vc0); PG8_STAGE(PG8_SB(1, 1), cB + hstepB + kstepB, voffB);
    PG8_WAIT_V(6); PG8_BAR;
    for (;;) {
        const bool has_next = S.next(ui + 1, nxt);
        if (!has_next) nxt = cur;
        { u32x4 sv; sv.x = S.arow(nxt, Rr[0]) + (unsigned)Cc[0] * 2u; sv.y = S.arow(nxt, Rr[1]) + (unsigned)Cc[1] * 2u; sv.z = S.arow(nxt, HALF + Rr[0]) + (unsigned)Cc[0] * 2u; sv.w = S.arow(nxt, HALF + Rr[1]) + (unsigned)Cc[1] * 2u; *stash = sv; }
        const char* nB = (const char*)g.Bt + (size_t)nxt.pb * tstepB;
        for (int t = 0; t < nt; t += 2) {
            const bool last = (t == nt - 2);
            const char* a1 = Ab + (size_t)(t + 1) * kstepA;
            const char* a2 = last ? Ab : Ab + (size_t)(t + 2) * kstepA; const char* b2 = last ? nB : cB + (size_t)(t + 2) * kstepB;
            const char* a3 = a2 + kstepA; const char* b3 = b2 + kstepB;
            PG8_LDB(B0, 0, 0); PG8_LDB(B1, 0, 1); PG8_SCHED; PG8_LDA(At, 0, 0); PG8_STAGE(PG8_SA(1, 1), a1, vc1);
            if (last) { const u32x4 sv = *stash; vc0[0] = sv.x; vc0[1] = sv.y; vc1[0] = sv.z; vc1[1] = sv.w; }
            PG8_WAIT_V(8); PG8_WAIT_L(0); PG8_BAR; PG8_MMA(0, 0, At, B0); PG8_MMA(0, 1, At, B1); PG8_BAR; PG8_SCHED;
            PG8_LDA(At, 0, 1); PG8_STAGE(PG8_SB(0, 0), b2, voffB); PG8_STAGE(PG8_SB(0, 1), b2 + hstepB, voffB); PG8_STAGE(PG8_SA(0, 0), a2, vc0);
            PG8_WAIT_V(8); PG8_WAIT_L(0); PG8_BAR; PG8_MMA(1, 0, At, B0); PG8_MMA(1, 1, At, B1); PG8_BAR; PG8_SCHED;
            PG8_LDB(B0, 1, 0); PG8_LDB(B1, 1, 1); PG8_SCHED; PG8_LDA(At, 1, 0); PG8_STAGE(PG8_SA(0, 1), a2, vc1);
            PG8_WAIT_V(8); PG8_WAIT_L(0); PG8_BAR; PG8_MMA(0, 0, At, B0); PG8_MMA(0, 1, At, B1); PG8_BAR; PG8_SCHED;
            PG8_LDA(At, 1, 1); PG8_STAGE(PG8_SB(1, 0), b3, voffB); PG8_STAGE(PG8_SB(1, 1), b3 + hstepB, voffB); PG8_STAGE(PG8_SA(1, 0), a3, vc0);
            PG8_WAIT_V(8); PG8_WAIT_L(0); PG8_BAR; PG8_MMA(1, 0, At, B0); PG8_MMA(1, 1, At, B1); PG8_BAR; PG8_SCHED;
        }
        if (wr == 0) PG8_BAR;
        { int fr_e = fr, fq_e = fq; asm volatile("" : "+v"(fr_e), "+v"(fq_e)); E(acc, cur, wr, wc, fr_e, fq_e); }
        if (!has_next) break;
#pragma unroll
        for (int a = 0; a < 2; ++a)
#pragma unroll
            for (int b = 0; b < 2; ++b)
#pragma unroll
                for (int m = 0; m < 4; ++m)
#pragma unroll
                    for (int n = 0; n < 2; ++n) acc[a][b][m][n] = (f32x4){0.f, 0.f, 0.f, 0.f};
        cur = nxt; cB = nB; ++ui;
        if (wr == 1) PG8_BAR;
    }
    PG8_WAIT_V(0);
    PG8_BAR;
#undef PG8_SA
#undef PG8_SB
#undef PG8_STAGE
#undef PG8_LDA
#undef PG8_LDB
#undef PG8_MMA
#undef PG8_WAIT_V
#undef PG8_WAIT_L
#undef PG8_BAR
#undef PG8_SCHED
}
}

typedef f32x4 Acc[2][2][4][2];
__device__ __forceinline__ void st_bf4(bf16_t* p, f32x4 v) { u32x2 w; w.x = pk2(v[0], v[1]); w.y = pk2(v[2], v[3]); *(u32x2*)p = w; }

struct EpiInProj {
    static constexpr bool PERM = false;
    bf16_t* proj; bf16_t* qr; float* gates; const float* cos32; const float* sin32; const float* cos16; const float* sin16;
    __device__ __forceinline__ void operator()(const Acc& acc, const pg8::Unit& u, int wr, int wc, int fr, int fq) const {
        const int pn = u.pn;
#pragma unroll
        for (int ai = 0; ai < 2; ++ai)
#pragma unroll
            for (int m = 0; m < 4; ++m) {
                const int row = u.pm * 256 + ai * 128 + wr * 64 + m * 16 + fr;
                bf16_t* prow = proj + (size_t)row * NINP + pn * 256;
#pragma unroll
                for (int bj = 0; bj < 2; ++bj) {
                    const f32x4 v0 = acc[ai][bj][m][0], v1 = acc[ai][bj][m][1];
                    const int cb = 128 * bj + 32 * wc;
                    const int blk = cb >> 6, a = wc & 1;
                    int mode = 0; float sc = 1.f;
                    if (pn == 0) sc = QS64;
                    else if (pn == 3) { mode = 1; sc = QS32; }
                    else if (pn == 4) mode = 1;
                    else if (pn == 6) { mode = 2; sc = QS64; }
                    else if (pn == 7) mode = 2;
                    else if (pn == 9) { mode = 3; sc = QS64; }
                    else if (pn == 10) mode = (blk == 2) ? 2 : 0;
                    else if (pn == 11) mode = (blk == 0) ? 2 : (blk == 1) ? 0 : (blk == 2 && a == 0) ? 4 : 5;
                    if (mode == 0) { st_bf4(prow + cb + 4 * fq, v0 * sc); st_bf4(prow + cb + 16 + 4 * fq, v1 * sc); }
                    else if (mode == 1) {
                        const f32x4 c = *(const f32x4*)(cos16 + (size_t)row * 16 + 4 * fq), s = *(const f32x4*)(sin16 + (size_t)row * 16 + 4 * fq);
                        st_bf4(prow + cb + 4 * fq, (v0 * c - v1 * s) * sc); st_bf4(prow + cb + 16 + 4 * fq, (v1 * c + v0 * s) * sc);
                    } else if (mode == 2 || mode == 3) {
                        const f32x4 c = *(const f32x4*)(cos32 + (size_t)row * 32 + 16 * a + 4 * fq), s = *(const f32x4*)(sin32 + (size_t)row * 32 + 16 * a + 4 * fq);
                        const f32x4 o0 = (v0 * c - v1 * s) * sc, o1 = (v1 * c + v0 * s) * sc;
                        const int lc = 64 * blk + 16 * a + 4 * fq;
                        if (mode == 2) { st_bf4(prow + lc, o0); st_bf4(prow + lc + 32, o1); }
                        else { st_bf4(prow + lc, v0 * sc); st_bf4(prow + lc + 32, v1 * sc); bf16_t* q = qr + (size_t)row * 256 + lc; st_bf4(q, o0); st_bf4(q + 32, o1); }
                    } else if (mode == 4) {
                        if (fq < 3) { f32x4 g; g[0] = sigmoidf_(v0[0]); g[1] = sigmoidf_(v0[1]); g[2] = sigmoidf_(v0[2]); g[3] = sigmoidf_(v0[3]); *(f32x4*)(gates + (size_t)row * 12 + 4 * fq) = g; }
                    }
                }
            }
    }
};
struct EpiResid {
    static constexpr bool PERM = false;
    const float* base; float* out;
    __device__ __forceinline__ void operator()(const Acc& acc, const pg8::Unit& u, int wr, int wc, int fr, int fq) const {
#pragma unroll
        for (int ai = 0; ai < 2; ++ai)
#pragma unroll
            for (int m = 0; m < 4; ++m) {
                const size_t off = (size_t)(u.pm * 256 + ai * 128 + wr * 64 + m * 16 + fr) * DM + u.pn * 256 + wc * 32 + 4 * fq;
#pragma unroll
                for (int bj = 0; bj < 2; ++bj)
#pragma unroll
                    for (int n = 0; n < 2; ++n) { const size_t o = off + bj * 128 + n * 16; const f32x4 b = *(const f32x4*)(base + o); *(f32x4*)(out + o) = b * ALPHA + acc[ai][bj][m][n]; }
            }
    }
};
struct EpiBf16 {
    static constexpr bool PERM = true;
    bf16_t* O; int ldc;
    __device__ __forceinline__ void operator()(const Acc& acc, const pg8::Unit& u, int wr, int wc, int fr, int fq) const {
#pragma unroll
        for (int ai = 0; ai < 2; ++ai)
#pragma unroll
            for (int m = 0; m < 4; ++m) {
                bf16_t* rowp = O + (size_t)(u.pm * 256 + ai * 128 + wr * 64 + m * 16 + fr) * ldc + u.pn * 256 + wc * 32 + 8 * fq;
#pragma unroll
                for (int bj = 0; bj < 2; ++bj) { const f32x4 v0 = acc[ai][bj][m][0], v1 = acc[ai][bj][m][1]; u32x4 w; w.x = pk2(v0[0], v0[1]); w.y = pk2(v0[2], v0[3]); w.z = pk2(v1[0], v1[1]); w.w = pk2(v1[2], v1[3]); *(u32x4*)(rowp + bj * 128) = w; }
            }
    }
};
struct EpiCmp {
    static constexpr bool PERM = false;
    float* hid; const float* c1;
    __device__ __forceinline__ void operator()(const Acc& acc, const pg8::Unit& u, int wr, int wc, int fr, int fq) const {
        const int kv = u.pn;
#pragma unroll
        for (int ai = 0; ai < 2; ++ai)
#pragma unroll
            for (int m = 0; m < 4; ++m) {
                float* rowp = hid + ((size_t)kv * 2048 + (u.pm * 256 + ai * 128 + wr * 64 + m * 16 + fr)) * 256 + wc * 32 + 4 * fq;
#pragma unroll
                for (int bj = 0; bj < 2; ++bj)
#pragma unroll
                    for (int n = 0; n < 2; ++n) { const int c = bj * 128 + n * 16; const float* cp = c1 + kv * 1024 + wc * 32 + 4 * fq + c; const f32x4 b = (*(const f32x4*)cp + *(const f32x4*)(cp + 256)) + (*(const f32x4*)(cp + 512) + *(const f32x4*)(cp + 768)); f32x4 v = acc[ai][bj][m][n] + b;
                        v[0] = v[0] * sigmoidf_(v[0]); v[1] = v[1] * sigmoidf_(v[1]); v[2] = v[2] * sigmoidf_(v[2]); v[3] = v[3] * sigmoidf_(v[3]); *(f32x4*)(rowp + c) = v; }
            }
    }
};
struct EpiSwiglu {
    static constexpr bool PERM = true;
    bf16_t* H; int row0;
    __device__ __forceinline__ void operator()(const Acc& acc, const pg8::Unit& u, int wr, int wc, int fr, int fq) const {
#pragma unroll
        for (int ai = 0; ai < 2; ++ai)
#pragma unroll
            for (int m = 0; m < 4; ++m) {
                bf16_t* rowp = H + (size_t)((u.pm - row0) * 256 + ai * 128 + wr * 64 + m * 16 + fr) * DFF + u.pn * 128 + wc * 16 + 4 * fq;
#pragma unroll
                for (int bj = 0; bj < 2; ++bj) { const f32x4 v0 = acc[ai][bj][m][0], v1 = acc[ai][bj][m][1];
                    f32x4 o; o[0] = v0[0] * sigmoidf_(v0[0]) * v0[1]; o[1] = v0[2] * sigmoidf_(v0[2]) * v0[3]; o[2] = v1[0] * sigmoidf_(v1[0]) * v1[1]; o[3] = v1[2] * sigmoidf_(v1[2]) * v1[3];
                    st_bf4(rowp + bj * 64, o); }
            }
    }
};

namespace att {
constexpr int NS = 4, SLOT = 8192, L_K = 0, L_V = NS * SLOT, L_X = 2 * NS * SLOT;
typedef short v4i16_t __attribute__((ext_vector_type(4)));
struct KVp { const bf16_t* K; const bf16_t* V; int pk, pv; };
__device__ __forceinline__ void glds16(const void* gsrc, unsigned lds_dst) { unsigned keep;
    asm volatile("s_mov_b32 %0, m0\n\ts_mov_b32 m0, %2\n\ts_nop 0\n\tglobal_load_lds_dwordx4 %1, off\n\ts_mov_b32 m0, %0" : "=&s"(keep) : "v"(gsrc), "s"(lds_dst) : "memory"); }
#define ATT_WAIT_BAR(N) asm volatile("s_waitcnt vmcnt(" #N ") lgkmcnt(0)\n\ts_barrier" ::: "memory")
struct Ring { const bf16_t* ks; const bf16_t* vs; unsigned kd, vd; int pk, pv; };
__device__ __forceinline__ Ring ring_init(LAS unsigned char* lds, const KVp& p, int wid, int lane) {
    Ring r; r.ks = p.K + (size_t)lane * p.pk + wid * 8; r.vs = p.V + (size_t)(16 * (wid & 3) + (lane >> 2)) * p.pv + (wid >> 2) * 32 + (lane & 3) * 8;
    const unsigned l0 = (unsigned)(size_t)lds; r.kd = l0 + L_K + wid * 1024; r.vd = l0 + L_V + wid * 1024; r.pk = p.pk; r.pv = p.pv; return r;
}
__device__ __forceinline__ void ring_issue(const Ring& r, int jt, int slot) {
    glds16(r.ks + (size_t)jt * 64 * r.pk, (unsigned)__builtin_amdgcn_readfirstlane((int)(r.kd + slot * SLOT)));
    glds16(r.vs + (size_t)jt * 64 * r.pv, (unsigned)__builtin_amdgcn_readfirstlane((int)(r.vd + slot * SLOT)));
}
__device__ __forceinline__ void ring_drain() { asm volatile("s_waitcnt vmcnt(0) lgkmcnt(0)\n\ts_barrier" ::: "memory"); }
__device__ __forceinline__ f32x16 zero16() { f32x16 z;
#pragma unroll
    for (int r = 0; r < 16; ++r) z[r] = 0.f;
    return z; }
__device__ __forceinline__ f32x16 mfma32(bf16x8 a, bf16x8 b, f32x16 c) { return __builtin_amdgcn_mfma_f32_32x32x16_bf16(a, b, c, 0, 0, 0); }
__device__ __forceinline__ int crow(int r, int hi) { return (r & 3) + 8 * (r >> 2) + 4 * hi; }
template <int D0, int D1> __device__ __forceinline__ void qk(f32x16& p0, f32x16& p1, const LAS unsigned char* Ks, const bf16x8 (&qf)[4], int hi, int r32) {
    const LAS unsigned char* kb = Ks + hi * 1024 + r32 * 16;
    p0 = zero16(); p1 = zero16();
#pragma unroll
    for (int d0 = D0; d0 < D1; ++d0) {
        const bf16x8 b0 = *(const LAS bf16x8*)(kb + d0 * 2048), b1 = *(const LAS bf16x8*)(kb + d0 * 2048 + 512);
        p0 = mfma32(b0, qf[d0], p0); p1 = mfma32(b1, qf[d0], p1);
    }
}
__device__ __forceinline__ s16x4 vtr(const LAS unsigned char* p) { return __builtin_bit_cast(s16x4, __builtin_amdgcn_ds_read_tr16_b64_v4i16((LAS v4i16_t*)p)); }
__device__ __forceinline__ void pv(f32x16 (&o)[2], const LAS unsigned char* Vs, const bf16x8 (&pw)[4], int lane, int hi) {
    const LAS unsigned char* vp = Vs + ((lane >> 4) & 1) * 32 + (lane & 3) * 8 + (4 * hi + ((lane & 15) >> 2)) * 64;
#pragma unroll
    for (int d0 = 0; d0 < 2; ++d0)
#pragma unroll
        for (int ks = 0; ks < 4; ++ks) {
            const s16x4 lo = vtr(vp + d0 * 4096 + ks * 1024), hh = vtr(vp + d0 * 4096 + ks * 1024 + 512);
            const bf16x8 vf = {lo[0], lo[1], lo[2], lo[3], hh[0], hh[1], hh[2], hh[3]};
            o[d0] = mfma32(vf, pw[ks], o[d0]);
        }
}
__device__ __forceinline__ void pack_p(bf16x8 (&pw)[4], const f32x16& p0, const f32x16& p1) {
    u32x4 a, b, c, d;
    a.x = pk2(p0[0], p0[1]); a.y = pk2(p0[2], p0[3]); a.z = pk2(p0[4], p0[5]); a.w = pk2(p0[6], p0[7]);
    b.x = pk2(p0[8], p0[9]); b.y = pk2(p0[10], p0[11]); b.z = pk2(p0[12], p0[13]); b.w = pk2(p0[14], p0[15]);
    c.x = pk2(p1[0], p1[1]); c.y = pk2(p1[2], p1[3]); c.z = pk2(p1[4], p1[5]); c.w = pk2(p1[6], p1[7]);
    d.x = pk2(p1[8], p1[9]); d.y = pk2(p1[10], p1[11]); d.z = pk2(p1[12], p1[13]); d.w = pk2(p1[14], p1[15]);
    pw[0] = __builtin_bit_cast(bf16x8, a); pw[1] = __builtin_bit_cast(bf16x8, b); pw[2] = __builtin_bit_cast(bf16x8, c); pw[3] = __builtin_bit_cast(bf16x8, d);
}
__device__ __forceinline__ float max3f(float a, float b, float c) { return fmaxf(fmaxf(a, b), c); }
__device__ __forceinline__ void osm(f32x16& p0, f32x16& p1, float& m, float& l, f32x16 (&o)[2], bf16x8 (&pw)[4]) {
    float mx = max3f(p0[0], p1[0], p0[1]);
#pragma unroll
    for (int r = 1; r < 15; r += 2) mx = max3f(mx, p1[r], p0[r + 1]), mx = fmaxf(mx, p1[r + 1]);
    mx = fmaxf(mx, p1[15]);
    mx = fmaxf(mx, xhalf(mx));
    if (__any(mx > m + 8.f)) { const float mn = fmaxf(m, mx), al = ex2(m - mn); m = mn; l *= al; o[0] *= al; o[1] *= al; }
    float s = 0.f;
#pragma unroll
    for (int r = 0; r < 16; ++r) { p0[r] = ex2(p0[r] - m); p1[r] = ex2(p1[r] - m); s += p0[r] + p1[r]; }
    l += s;
    pack_p(pw, p0, p1);
}
__device__ __forceinline__ void mask_le(f32x16& p0, f32x16& p1, int lim, int hi) {
    int l2 = lim - 4 * hi; asm volatile("" : "+v"(l2));
#pragma unroll
    for (int r = 0; r < 16; ++r) { const int c = (r & 3) + 8 * (r >> 2); if (c > l2) p0[r] = -INFINITY; if (c + 32 > l2) p1[r] = -INFINITY; }
}
__device__ __forceinline__ void mask_gt(f32x16& p0, f32x16& p1, int lim, int hi) {
    int l2 = lim - 4 * hi; asm volatile("" : "+v"(l2));
#pragma unroll
    for (int r = 0; r < 16; ++r) { const int c = (r & 3) + 8 * (r >> 2); if (c <= l2) p0[r] = -INFINITY; if (c + 32 <= l2) p1[r] = -INFINITY; }
}
__device__ __forceinline__ void mask_all(f32x16& p0, f32x16& p1, bool keep) {
#pragma unroll
    for (int r = 0; r < 16; ++r) { p0[r] = keep ? p0[r] : -INFINITY; p1[r] = keep ? p1[r] : -INFINITY; }
}
__device__ __forceinline__ void store_o(bf16_t* dst, const f32x16 (&o)[2], int hi) {
#pragma unroll
    for (int d0 = 0; d0 < 2; ++d0)
#pragma unroll
        for (int g = 0; g < 4; ++g) { f32x4 v = {o[d0][4 * g], o[d0][4 * g + 1], o[d0][4 * g + 2], o[d0][4 * g + 3]}; st_bf4(dst + 32 * d0 + 8 * g + 4 * hi, v); }
}
__device__ __forceinline__ void load_q(bf16x8 (&qf)[4], const bf16_t* qp, int hi) {
#pragma unroll
    for (int d0 = 0; d0 < 4; ++d0) qf[d0] = *(const bf16x8*)(qp + 16 * d0 + 8 * hi);
}

__device__ __forceinline__ void unit_A(LAS unsigned char* lds, const bf16_t* proj, bf16_t* mixed, int b, int h, int qb, int tid, int wid, int lane) {
    const int r32 = lane & 31, hi = lane >> 5;
    const int t = 256 * qb + 32 * wid + r32;
    const size_t rowb = (size_t)b * SEQ;
    bf16x8 qf[4]; load_q(qf, proj + (rowb + t) * NINP + C_AQ + h * 64, hi);
    const KVp kv{proj + rowb * NINP + C_AK + h * 64, proj + rowb * NINP + C_AV + h * 64, NINP, NINP};
    const Ring rg = ring_init(lds, kv, wid, lane);
    f32x16 o[2]; o[0] = zero16(); o[1] = zero16();
    float C = 0.f;
    const int jmax = 4 * qb + 3, tmaxw = 256 * qb + 32 * wid + 31, tminw = tmaxw - 31;
    LAS float* wm = (LAS float*)(lds + L_X);
#pragma unroll
    for (int k = 0; k < NS - 1; ++k) ring_issue(rg, jmax - k > 0 ? jmax - k : 0, k);
    ATT_WAIT_BAR(4);
    for (int it = 0; it <= jmax; ++it) {
        const int jt = jmax - it;
        if (it > 0) { float mx = wm[((it - 1) & 1) * 8];
#pragma unroll
            for (int w = 1; w < 8; ++w) mx = fmaxf(mx, wm[((it - 1) & 1) * 8 + w]);
            if (mx < -100.f) break; }
        { const int jn = jt - (NS - 1); ring_issue(rg, jn > 0 ? jn : 0, (it + NS - 1) % NS); }
        if (64 * jt < tmaxw) {
            f32x16 p0, p1; qk<0, 4>(p0, p1, lds + L_K + (it % NS) * SLOT, qf, hi, r32);
            if (64 * jt + 63 >= tminw) mask_le(p0, p1, t - 1 - 64 * jt, hi);
            float L0[16], L1[16];
#pragma unroll
            for (int r = 0; r < 16; ++r) { const float z0 = p0[r], z1 = p1[r];
                L0[r] = -(fmaxf(z0, 0.f) + lg2(1.f + ex2(-fabsf(z0)))); L1[r] = -(fmaxf(z1, 0.f) + lg2(1.f + ex2(-fabsf(z1)))); }
            float gs[8], og[8];
#pragma unroll
            for (int k = 0; k < 4; ++k) { gs[k] = (L0[4 * k] + L0[4 * k + 1]) + (L0[4 * k + 2] + L0[4 * k + 3]); gs[4 + k] = (L1[4 * k] + L1[4 * k + 1]) + (L1[4 * k + 2] + L1[4 * k + 3]); }
#pragma unroll
            for (int k = 0; k < 8; ++k) og[k] = xhalf(gs[k]);
            float aown = 0.f, aoth = 0.f;
#pragma unroll
            for (int k = 7; k >= 0; --k) {
                const float base = C + (aown + aoth + (hi == 0 ? og[k] : 0.f));
                if (k >= 4) { const int q = 4 * (k - 4);
                    const float i3 = base + L1[q + 3], i2 = i3 + L1[q + 2], i1 = i2 + L1[q + 1], i0 = i1 + L1[q];
                    p1[q + 3] = ex2(p1[q + 3] + i3); p1[q + 2] = ex2(p1[q + 2] + i2); p1[q + 1] = ex2(p1[q + 1] + i1); p1[q] = ex2(p1[q] + i0);
                } else { const int q = 4 * k;
                    const float i3 = base + L0[q + 3], i2 = i3 + L0[q + 2], i1 = i2 + L0[q + 1], i0 = i1 + L0[q];
                    p0[q + 3] = ex2(p0[q + 3] + i3); p0[q + 2] = ex2(p0[q + 2] + i2); p0[q + 1] = ex2(p0[q + 1] + i1); p0[q] = ex2(p0[q] + i0);
                }
                aown += gs[k]; aoth += og[k];
            }
            C += (hi ? aoth : aown) + (hi ? aown : aoth);
            bf16x8 pw[4]; pack_p(pw, p0, p1);
            pv(o, lds + L_V + (it % NS) * SLOT, pw, lane, hi);
        }
        const float cm = wave_max(C);
        if (lane == 0) wm[(it & 1) * 8 + wid] = cm;
        ATT_WAIT_BAR(4);
    }
    ring_drain();
    store_o(mixed + (rowb + t) * DM + 0 + h * 64, o, hi);
}

__device__ __forceinline__ void unit_B(LAS unsigned char* lds, const bf16_t* proj, bf16_t* mixed, const float* gain, float lam, float lam_init, int b, int h, int qb, int tid, int wid, int lane) {
    const int r32 = lane & 31, hi = lane >> 5;
    const int t = 256 * qb + 32 * wid + r32;
    const size_t rowb = (size_t)b * SEQ;
    bf16x8 qf[4]; load_q(qf, proj + (rowb + t) * NINP + C_BQ + h * 64, hi);
    const KVp kv{proj + rowb * NINP + C_BK + h * 64, proj + rowb * NINP + C_BV + h * 64, NINP, NINP};
    const Ring rg = ring_init(lds, kv, wid, lane);
    f32x16 oa[2], ob[2]; oa[0] = zero16(); oa[1] = zero16(); ob[0] = zero16(); ob[1] = zero16();
    float m0 = -1e30f, l0 = 0.f, m1 = -1e30f, l1 = 0.f;
    const int jd = 4 * qb + 3, tmaxw = 256 * qb + 32 * wid + 31, tminw = tmaxw - 31;
#pragma unroll
    for (int k = 0; k < NS - 1; ++k) ring_issue(rg, k < jd ? k : jd, k);
    ATT_WAIT_BAR(4);
    for (int jt = 0; jt <= jd; ++jt) {
        { const int jn = jt + NS - 1; ring_issue(rg, jn < jd ? jn : jd, jn % NS); }
        if (64 * jt <= tmaxw) {
            const bool nm = (64 * jt + 63 > tminw);
            f32x16 p0, p1; bf16x8 pw[4];
            qk<0, 2>(p0, p1, lds + L_K + (jt % NS) * SLOT, qf, hi, r32);
            if (nm) mask_le(p0, p1, t - 64 * jt, hi);
            osm(p0, p1, m0, l0, oa, pw);
            pv(oa, lds + L_V + (jt % NS) * SLOT, pw, lane, hi);
            qk<2, 4>(p0, p1, lds + L_K + (jt % NS) * SLOT, qf, hi, r32);
            if (nm) mask_le(p0, p1, t - 64 * jt, hi);
            osm(p0, p1, m1, l1, ob, pw);
            pv(ob, lds + L_V + (jt % NS) * SLOT, pw, lane, hi);
        }
        ATT_WAIT_BAR(4);
    }
    ring_drain();
    l0 += xhalf(l0); l1 += xhalf(l1);
    const float i0 = 1.f / l0, i1 = lam / l1;
    float ss = 0.f;
#pragma unroll
    for (int d0 = 0; d0 < 2; ++d0)
#pragma unroll
        for (int r = 0; r < 16; ++r) { const float v = oa[d0][r] * i0 - ob[d0][r] * i1; oa[d0][r] = v; ss += v * v; }
    ss += xhalf(ss);
    const float rs = rsqrtf(ss * (1.f / 64.f) + RMS_EPS) * (1.f - lam_init);
#pragma unroll
    for (int d0 = 0; d0 < 2; ++d0)
#pragma unroll
        for (int g = 0; g < 4; ++g) { const f32x4 gv = *(const f32x4*)(gain + 32 * d0 + 8 * g + 4 * hi);
#pragma unroll
            for (int e = 0; e < 4; ++e) oa[d0][4 * g + e] *= rs * gv[e]; }
    store_o(mixed + (rowb + t) * DM + 256 + h * 64, oa, hi);
}

__device__ __forceinline__ int c_next(int jt, unsigned un, int own) {
    if ((jt & 3) != 3) return jt + 1;
    int j = (jt >> 2) + 1; if (j > own) return jt;
    j += __builtin_ctz((un >> j) | 0x80000000u); return 4 * j;
}
__device__ __forceinline__ void unit_C(LAS unsigned char* lds, const bf16_t* proj, const bf16_t* kmean, bf16_t* mixed, int b, int h, int qb, int tid, int wid, int lane) {
    const int r32 = lane & 31, hi = lane >> 5, own = qb;
    const int t = 256 * qb + 32 * wid + r32;
    const size_t rowb = (size_t)b * SEQ;
    bf16x8 qf[4]; load_q(qf, proj + (rowb + t) * NINP + C_CQ + h * 64, hi);
    const KVp kv{proj + rowb * NINP + C_CK + h * 64, proj + rowb * NINP + C_CV + h * 64, NINP, NINP};
    const Ring rg = ring_init(lds, kv, wid, lane);
    LAS unsigned* un_w = (LAS unsigned*)(lds + L_X);
    unsigned sel = 0u;
    if (tid == 0) un_w[0] = 0u;
    if (own > 0) {
        if (tid < 256) { const int chunk = tid >> 5, key = tid & 31; *(LAS u32x4*)(lds + L_K + chunk * 1024 + key * 16) = *(const u32x4*)(kmean + ((size_t)((b * 4 + h) * 32 + key)) * 64 + chunk * 8); }
        __syncthreads();
        f32x16 g = zero16();
        { const LAS unsigned char* kb = lds + L_K + hi * 1024 + r32 * 16;
#pragma unroll
          for (int d0 = 0; d0 < 4; ++d0) g = mfma32(*(const LAS bf16x8*)(kb + d0 * 2048), qf[d0], g); }
        float og[16];
#pragma unroll
        for (int r = 0; r < 16; ++r) og[r] = xhalf(g[r]);
#pragma unroll
        for (int round = 0; round < 3; ++round) {
            float best = -INFINITY; int bi = -1;
#pragma unroll
            for (int j = 0; j < 32; ++j) { const int hj = (j >> 2) & 1, r = (j & 3) + 4 * (j >> 3);
                const float v = (hj == hi) ? g[r] : og[r];
                const bool ok = (j < own) && !((sel >> j) & 1u) && (v > best);
                best = ok ? v : best; bi = ok ? j : bi; }
            if (bi >= 0) sel |= 1u << bi;
        }
        const unsigned wo = wave_or(sel);
        if (lane == 0) __hip_atomic_fetch_or(un_w, wo, __ATOMIC_RELAXED, __HIP_MEMORY_SCOPE_WORKGROUP);
    }
    __syncthreads();
    const unsigned un = (un_w[0] | (1u << own)) & (own == 31 ? 0xffffffffu : ((2u << own) - 1u));
    f32x16 o[2]; o[0] = zero16(); o[1] = zero16();
    float m = -1e30f, l = 0.f;
    const int tmaxw = 256 * qb + 32 * wid + 31, tminw = tmaxw - 31;
    const int ntile = 4 * __builtin_popcount(un);
    int jt = 4 * (__builtin_ctz(un)), ji = jt;
#pragma unroll
    for (int k = 0; k < NS - 1; ++k) { ring_issue(rg, ji, k); ji = c_next(ji, un, own); }
    ATT_WAIT_BAR(4);
    for (int it = 0; it < ntile; ++it) {
        ring_issue(rg, ji, (it + NS - 1) % NS); ji = c_next(ji, un, own);
        const int blk = jt >> 2;
        bool act; bool rowsel = true;
        if (blk == own) act = (64 * jt <= tmaxw); else { rowsel = (sel >> blk) & 1u; act = __any(rowsel); }
        if (act) {
            f32x16 p0, p1; bf16x8 pw[4];
            qk<0, 4>(p0, p1, lds + L_K + (it % NS) * SLOT, qf, hi, r32);
            if (blk == own) { if (64 * jt + 63 > tminw) mask_le(p0, p1, t - 64 * jt, hi); } else mask_all(p0, p1, rowsel);
            osm(p0, p1, m, l, o, pw);
            pv(o, lds + L_V + (it % NS) * SLOT, pw, lane, hi);
        }
        jt = c_next(jt, un, own);
        ATT_WAIT_BAR(4);
    }
    ring_drain();
    l += xhalf(l);
    const float inv = 1.f / l;
    o[0] *= inv; o[1] *= inv;
    store_o(mixed + (rowb + t) * DM + 512 + h * 64, o, hi);
}

constexpr int LD_IA = L_X, LD_SM = L_X + 32768, LD_WO = LD_SM + 1024, LD_END = LD_WO + 128;
__device__ __forceinline__ int d_next(int jt, unsigned u0, unsigned u1, unsigned u2, unsigned u3, int i) {
    for (int jn = jt + 1; jn <= i; ++jn) { const unsigned w = jn < 32 ? u0 : jn < 64 ? u1 : jn < 96 ? u2 : u3; if ((w >> (jn & 31)) & 1u) return jn; }
    return jt;
}
__device__ __forceinline__ void unit_D(LAS unsigned char* lds, const bf16_t* proj, const bf16_t* qr, const bf16_t* kc, const bf16_t* vc, const float* gates, bf16_t* mixed,
                                       int b, int i, int tid, int wid, int lane) {
    const int r32 = lane & 31, hi = lane >> 5, hd = r32 & 3, tl = 8 * wid + (r32 >> 2);
    const int t = 64 * i + tl, tt = tl;
    const size_t rowb = (size_t)b * SEQ, row = rowb + t;
    LAS float* imp = (LAS float*)(lds + LD_IA);
    LAS unsigned* smk = (LAS unsigned*)(lds + LD_SM); LAS unsigned* wor = (LAS unsigned*)(lds + LD_WO);
    bf16x8 qf[4]; load_q(qf, proj + row * NINP + C_DQ + hd * 64, hi);
    const float g_c = gates[row * 12 + hd * 3 + 0], g_s = gates[row * 12 + hd * 3 + 1], g_w = gates[row * 12 + hd * 3 + 2];
    f32x16 acc[2]; acc[0] = zero16(); acc[1] = zero16();
    const KVp kvc{kc + (size_t)b * NCMP * 64, vc + (size_t)b * NCMP * 64, 64, 64};
    const int J = (4 * i + 2) >> 6, nlim = (t - 31) >> 4;
    float m = -1e30f, l = 0.f;
    {
        int ln = lane; asm volatile("" : "+v"(ln)); const Ring rg = ring_init(lds, kvc, wid, ln);
#pragma unroll
        for (int k = 0; k < NS - 1; ++k) ring_issue(rg, k < J ? k : J, k);
        ATT_WAIT_BAR(4);
        for (int jt = 0; jt <= J; ++jt) {
            { const int jn = jt + NS - 1; ring_issue(rg, jn < J ? jn : J, jn % NS); }
            f32x16 p0, p1; qk<0, 4>(p0, p1, lds + L_K + (jt % NS) * SLOT, qf, hi, r32);
            mask_le(p0, p1, nlim - 64 * jt, hi);
            float mx = fmaxf(p0[0], p1[0]);
#pragma unroll
            for (int r = 1; r < 16; ++r) mx = fmaxf(mx, fmaxf(p0[r], p1[r]));
            const float mn = fmaxf(m, mx); float s = 0.f;
#pragma unroll
            for (int r = 0; r < 16; ++r) s += ex2(p0[r] - mn) + ex2(p1[r] - mn);
            l = l * ex2(m - mn) + s; m = mn;
            ATT_WAIT_BAR(4);
        }
        { const float mo = xhalf(m), lo = xhalf(l), M = fmaxf(m, mo); l = l * ex2(m - M) + lo * ex2(mo - M); m = M; }
        const float invl = l > 0.f ? 1.f / l : 0.f;
        ring_drain();
#pragma unroll
        for (int k = 0; k < NS - 1; ++k) ring_issue(rg, k < J ? k : J, k);
        ATT_WAIT_BAR(4);
        float carry = 0.f;
        for (int jt = 0; jt <= J; ++jt) {
            { const int jn = jt + NS - 1; ring_issue(rg, jn < J ? jn : J, jn % NS); }
            f32x16 p0, p1; qk<0, 4>(p0, p1, lds + L_K + (jt % NS) * SLOT, qf, hi, r32);
            mask_le(p0, p1, nlim - 64 * jt, hi);
#pragma unroll
            for (int r = 0; r < 16; ++r) { p0[r] = ex2(p0[r] - m) * invl; p1[r] = ex2(p1[r] - m) * invl; }
            float ol[8];
#pragma unroll
            for (int k = 0; k < 8; ++k) ol[k] = xhalf(k < 4 ? p0[4 * k + 3] : p1[4 * k - 13]);
#pragma unroll
            for (int k = 0; k < 8; ++k) {
                float gsum = (k < 4) ? (p0[4 * k] + p0[4 * k + 1]) + (p0[4 * k + 2] + p0[4 * k + 3]) : (p1[4 * k - 16] + p1[4 * k - 15]) + (p1[4 * k - 14] + p1[4 * k - 13]);
                const float prev = hi ? ol[k] : (k > 0 ? ol[k - 1] : carry);
                const float v = quad_sum(gsum + prev);
                if (hd == 0) imp[tl * 128 + 16 * jt + 2 * k + hi] = v;
            }
            carry = ol[7];
            bf16x8 pw[4]; pack_p(pw, p0, p1);
            pv(acc, lds + L_V + (jt % NS) * SLOT, pw, lane, hi);
            ATT_WAIT_BAR(4);
        }
        ring_drain();
    }
    acc[0] *= g_c; acc[1] *= g_c;
    unsigned wo0 = 0u, wo1 = 0u, wo2 = 0u, wo3 = 0u;
#pragma unroll 1
    for (int k8 = 0; k8 < 8; ++k8) {
        const int tk = 8 * wid + k8;
        unsigned long long b0, b1;
        if (i < 16) { b0 = (2ull << i) - 1ull; b1 = 0ull; }
        else {
            const int m0 = lane, m1 = lane + 64;
            const bool c0 = (m0 <= i) && (m0 != 0) && (m0 != i) && (m0 != i - 1), c1 = (m1 <= i) && (m1 != i) && (m1 != i - 1);
            const bool f0 = (m0 == 0) || (m0 == i) || (m0 == i - 1), f1 = (m1 == i) || (m1 == i - 1);
            const float v0 = imp[tk * 128 + m0], v1 = imp[tk * 128 + m1];
            const unsigned k0 = c0 ? __float_as_uint(v0) + 1u : 0u, k1 = c1 ? __float_as_uint(v1) + 1u : 0u;
            unsigned thr = 0u;
            for (int bit = 30; bit >= 0; --bit) { const unsigned cand = thr | (1u << bit);
                const int c = __popcll(__ballot(k0 >= cand)) + __popcll(__ballot(k1 >= cand)); if (c >= 13) thr = cand; }
            const bool gt0 = k0 > thr, gt1 = k1 > thr, eq0 = (k0 == thr) && c0, eq1 = (k1 == thr) && c1;
            const int need = 13 - (__popcll(__ballot(gt0)) + __popcll(__ballot(gt1)));
            const unsigned long long be0 = __ballot(eq0), be1 = __ballot(eq1), lt = (1ull << lane) - 1ull;
            const int rk0 = __popcll(be0 & lt), rk1 = __popcll(be0) + __popcll(be1 & lt);
            b0 = __ballot(f0 || gt0 || (eq0 && rk0 < need)); b1 = __ballot(f1 || gt1 || (eq1 && rk1 < need));
        }
        const unsigned w0 = (unsigned)b0, w1 = (unsigned)(b0 >> 32), w2 = (unsigned)b1, w3 = (unsigned)(b1 >> 32);
        if (lane == 0) { smk[tk * 4 + 0] = w0; smk[tk * 4 + 1] = w1; smk[tk * 4 + 2] = w2; smk[tk * 4 + 3] = w3; }
        wo0 |= w0; wo1 |= w1; wo2 |= w2; wo3 |= w3;
    }
    if (lane == 0) { wor[wid * 4 + 0] = wo0; wor[wid * 4 + 1] = wo1; wor[wid * 4 + 2] = wo2; wor[wid * 4 + 3] = wo3; }
    __syncthreads();
    unsigned un0 = 0u, un1 = 0u, un2 = 0u, un3 = 0u;
#pragma unroll
    for (int w = 0; w < 8; ++w) { un0 |= wor[w * 4 + 0]; un1 |= wor[w * 4 + 1]; un2 |= wor[w * 4 + 2]; un3 |= wor[w * 4 + 3]; }
    const unsigned sm0 = smk[tl * 4 + 0], sm1 = smk[tl * 4 + 1], sm2 = smk[tl * 4 + 2], sm3 = smk[tl * 4 + 3];
    { int r2 = (int)(row & 0x7fffffff); asm volatile("" : "+v"(r2)); load_q(qf, qr + (size_t)r2 * 256 + hd * 64, hi); }
    {
        const KVp kvs{proj + rowb * NINP + C_KS, proj + rowb * NINP + C_VS, NINP, NINP};
        int ln = lane; asm volatile("" : "+v"(ln)); const Ring rg = ring_init(lds, kvs, wid, ln);
        f32x16 o[2]; o[0] = zero16(); o[1] = zero16(); m = -1e30f; l = 0.f;
        const int ntile = __builtin_popcount(un0) + __builtin_popcount(un1) + __builtin_popcount(un2) + __builtin_popcount(un3);
        int jt = 0, ji = 0;
#pragma unroll
        for (int k = 0; k < NS - 1; ++k) { ring_issue(rg, ji, k); ji = d_next(ji, un0, un1, un2, un3, i); }
        ATT_WAIT_BAR(4);
        for (int it = 0; it < ntile; ++it) {
            ring_issue(rg, ji, (it + NS - 1) % NS); ji = d_next(ji, un0, un1, un2, un3, i);
            const unsigned w = jt < 32 ? sm0 : jt < 64 ? sm1 : jt < 96 ? sm2 : sm3;
            const bool rowsel = (w >> (jt & 31)) & 1u;
            if (__any(rowsel)) {
                f32x16 p0, p1; bf16x8 pw[4];
                qk<0, 4>(p0, p1, lds + L_K + (it % NS) * SLOT, qf, hi, r32);
                if (jt == i) mask_le(p0, p1, tt, hi);
                mask_all(p0, p1, rowsel);
                osm(p0, p1, m, l, o, pw);
                pv(o, lds + L_V + (it % NS) * SLOT, pw, lane, hi);
            }
            jt = d_next(jt, un0, un1, un2, un3, i);
            ATT_WAIT_BAR(4);
        }
        ring_drain();
        l += xhalf(l);
        const float f = g_s / l;
        acc[0] += o[0] * f; acc[1] += o[1] * f;
    }
    {
        const KVp kvw{proj + rowb * NINP + C_KW, proj + rowb * NINP + C_VW, NINP, NINP};
        int ln = lane; asm volatile("" : "+v"(ln)); const Ring rg = ring_init(lds, kvw, wid, ln);
        f32x16 o[2]; o[0] = zero16(); o[1] = zero16(); m = -1e30f; l = 0.f;
        const int j0 = i >= 8 ? i - 8 : 0;
#pragma unroll
        for (int k = 0; k < NS - 1; ++k) ring_issue(rg, j0 + k < i ? j0 + k : i, k);
        ATT_WAIT_BAR(4);
        for (int jt = j0; jt <= i; ++jt) {
            { const int jn = jt + NS - 1; ring_issue(rg, jn < i ? jn : i, (jn - j0) % NS); }
            f32x16 p0, p1; bf16x8 pw[4];
            qk<0, 4>(p0, p1, lds + L_K + ((jt - j0) % NS) * SLOT, qf, hi, r32);
            if (jt == i) mask_le(p0, p1, tt, hi);
            if (jt == i - 8) mask_gt(p0, p1, tt, hi);
            osm(p0, p1, m, l, o, pw);
            pv(o, lds + L_V + ((jt - j0) % NS) * SLOT, pw, lane, hi);
            ATT_WAIT_BAR(4);
        }
        ring_drain();
        l += xhalf(l);
        const float f = g_w / l;
        acc[0] += o[0] * f; acc[1] += o[1] * f;
    }
    { int r2 = (int)(row & 0x7fffffff); asm volatile("" : "+v"(r2)); store_o(mixed + (size_t)r2 * DM + 768 + hd * 64, acc, hi); }
}
#undef ATT_WAIT_BAR
}

constexpr int LDS_CTL = 131072, LDS_BYTES = 147456;
constexpr int LW_BAR = 0, LW_CNT = 8, LW_TS = 16, LW_CNTL = 32, LW_BASEL = 40, LW_PE = 64;
struct SchedGU {
    const LAS int* cw; const int* list; int t0, t1, G, c; bool dense;
    __device__ bool next(int i, pg8::Unit& u) const {
        const long L = (long)i * G + c; if (L >= (long)(t1 - t0) * 28) return false;
        u.pm = t0 + (int)(L / 28); u.pn = (int)(L % 28); int e = 0;
        if (!dense) { for (; e < 7; ++e) if (u.pm < cw[LW_TS + e + 1]) break; }
        u.pb = (dense ? 0 : 1 + e) * 28 + u.pn; return true;
    }
    __device__ __forceinline__ unsigned arow(const pg8::Unit& u, int r) const {
        if (dense) return (unsigned)(u.pm * 256 + r) * 2048u;
        const int e = u.pb / 28 - 1, slot = (u.pm - cw[LW_TS + e]) * 256 + r;
        const int pid = slot < cw[LW_CNT + e] ? list[e * 32768 + slot] : 0;
        return (unsigned)(pid >> 1) * 2048u;
    }
};
struct SchedDN {
    const LAS int* cw; int t0, t1, G, c; bool dense;
    __device__ bool next(int i, pg8::Unit& u) const {
        const long L = (long)i * G + c; if (L >= (long)(t1 - t0) * 4) return false;
        u.pm = t0 + (int)(L / 4); u.pn = (int)(L % 4); int e = 0;
        if (!dense) { for (; e < 7; ++e) if (u.pm < cw[LW_TS + e + 1]) break; }
        u.pb = (dense ? 0 : 1 + e) * 4 + u.pn; return true;
    }
    __device__ __forceinline__ unsigned arow(const pg8::Unit& u, int r) const { return (unsigned)((u.pm - t0) * 256 + r) * (unsigned)(DFF * 2); }
};
struct EpiDown {
    static constexpr bool PERM = false;
    bool dense; float* out; bf16_t* Y; const LAS int* cw; const int* list; const float* moeg;
    __device__ __forceinline__ void operator()(const Acc& acc, const pg8::Unit& u, int wr, int wc, int fr, int fq) const {
        const int col = u.pn * 256 + wc * 32 + 4 * fq;
        if (dense) {
#pragma unroll
            for (int ai = 0; ai < 2; ++ai)
#pragma unroll
                for (int m = 0; m < 4; ++m) { const size_t off = (size_t)(u.pm * 256 + ai * 128 + wr * 64 + m * 16 + fr) * DM + col;
#pragma unroll
                    for (int bj = 0; bj < 2; ++bj)
#pragma unroll
                        for (int n = 0; n < 2; ++n) { const size_t o = off + bj * 128 + n * 16; const f32x4 b = *(const f32x4*)(out + o); *(f32x4*)(out + o) = b * ALPHA + acc[ai][bj][m][n]; } }
        } else {
            const int e = u.pb / 4 - 1, s0 = (u.pm - cw[LW_TS + e]) * 256, ce = cw[LW_CNT + e];
#pragma unroll
            for (int ai = 0; ai < 2; ++ai)
#pragma unroll
                for (int m = 0; m < 4; ++m) { const int slot = s0 + ai * 128 + wr * 64 + m * 16 + fr;
                    if (slot < ce) { const int pid = list[e * 32768 + slot]; const float g = moeg[pid]; bf16_t* yp = Y + (size_t)pid * DM + col;
#pragma unroll
                        for (int bj = 0; bj < 2; ++bj)
#pragma unroll
                            for (int n = 0; n < 2; ++n) st_bf4(yp + bj * 128 + n * 16, acc[ai][bj][m][n] * g); } }
        }
    }
};
struct EpiPle {
    static constexpr bool PERM = false;
    const float* H2; const bf16_t* P; float* out; bf16_t* hb;
    __device__ __forceinline__ void operator()(const Acc& acc, const pg8::Unit& u, int wr, int wc, int fr, int fq) const {
#pragma unroll
        for (int ai = 0; ai < 2; ++ai)
#pragma unroll
            for (int m = 0; m < 4; ++m) { const size_t off = (size_t)(u.pm * 256 + ai * 128 + wr * 64 + m * 16 + fr) * DM + u.pn * 256 + wc * 32 + 4 * fq;
#pragma unroll
                for (int bj = 0; bj < 2; ++bj)
#pragma unroll
                    for (int n = 0; n < 2; ++n) { const size_t o = off + bj * 128 + n * 16; const f32x4 h = *(const f32x4*)(H2 + o); const u32x2 pw = *(const u32x2*)(P + o); const f32x4 a = acc[ai][bj][m][n];
                        f32x4 r; r[0] = h[0] + sigmoidf_(a[0]) * bflo(pw.x); r[1] = h[1] + sigmoidf_(a[1]) * bfhi(pw.x); r[2] = h[2] + sigmoidf_(a[2]) * bflo(pw.y); r[3] = h[3] + sigmoidf_(a[3]) * bfhi(pw.y);
                        *(f32x4*)(out + o) = r; if (hb) st_bf4(hb + o, r); } }
    }
};
struct SchedCmp {
    int c;
    __device__ bool next(int i, pg8::Unit& u) const { if (i > 0 || c >= 16) return false; u.pm = c & 7; u.pn = c >> 3; u.pb = c >> 3; return true; }
    __device__ __forceinline__ unsigned arow(const pg8::Unit& u, int r) const { const int rr = u.pm * 256 + r; return (unsigned)(((rr >> 9) * SEQ + 16 * (rr & 511)) * NINP + (u.pn ? C_VC : C_KC)) * 2u; }
};

template <class RM> __device__ __forceinline__ void transpose_item(const float* W, int K, int N, bf16_t* WT, const RM& rm, LAS float* scr, int item, int lane) {
    const int nblk = (N + 31) / 32, kb = item / nblk, nb = item % nblk, k0 = 64 * kb, n0 = 32 * nb;
    const int n4 = 4 * (lane & 7), kr = lane >> 3;
    const bool ok = (n0 + n4 + 3 < N);
    f32x4 v[8];
#pragma unroll
    for (int i = 0; i < 8; ++i) v[i] = ok ? *(const f32x4*)(W + (size_t)(k0 + kr + 8 * i) * N + n0 + n4) : (f32x4){0.f, 0.f, 0.f, 0.f};
#pragma unroll
    for (int i = 0; i < 8; ++i) { LAS float* d = scr + (kr + 8 * i) * 33 + n4; d[0] = v[i][0]; d[1] = v[i][1]; d[2] = v[i][2]; d[3] = v[i][3]; }
    asm volatile("s_waitcnt lgkmcnt(0)" ::: "memory");
    const int c = lane & 7;
#pragma unroll
    for (int j = 0; j < 4; ++j) { const int n = (lane >> 3) + 8 * j; const LAS float* s = scr + (8 * c) * 33 + n;
        u32x4 o; o.x = pk2(s[0 * 33], s[1 * 33]); o.y = pk2(s[2 * 33], s[3 * 33]); o.z = pk2(s[4 * 33], s[5 * 33]); o.w = pk2(s[6 * 33], s[7 * 33]);
        if (n0 + n < N) *(u32x4*)(WT + (size_t)rm(n0 + n) * K + k0 + 8 * c) = o; }
    asm volatile("s_waitcnt lgkmcnt(0)" ::: "memory");
}
struct RmId { int off; __device__ __forceinline__ int operator()(int n) const { return off + n; } };
struct RmIl { int s; __device__ __forceinline__ int operator()(int n) const { return 2 * n + s; } };
struct RmIn { __device__ __forceinline__ int operator()(int n) const {
    const bool rp = (n >= C_CQ && n < C_CV) || (n >= C_DQ && n < C_KC) || (n >= C_KS && n < C_VS) || (n >= C_KW && n < C_VW);
    return rp ? ((n & ~48) | ((n & 16) << 1) | ((n & 32) >> 1)) : n; } };

struct Args { const void* in[23]; float* out; unsigned char* ws; int ph_lo, ph_hi; };
constexpr int NWAVES = 8, NTHREADS = 512;
constexpr int NPHASES = 1 + 11 + 13;

__global__ void __launch_bounds__(NTHREADS, 2) mk_fwd(Args args) {
    extern __shared__ __attribute__((aligned(16))) unsigned char lds_raw[];
    LAS unsigned char* lds = (LAS unsigned char*)lds_raw;
    LAS int* cw = (LAS int*)(lds + LDS_CTL);
    const int tid0 = threadIdx.x, wave0 = __builtin_amdgcn_readfirstlane(tid0 >> 6);
    const int G = gridDim.x, bx = blockIdx.x, vcu = (G % 8 == 0) ? (bx % 8) * (G / 8) + bx / 8 : bx;
    const int NGW = G * NWAVES;
    unsigned* ctl = (unsigned*)(args.ws + WS_CTL);
    const int lo = args.ph_lo, hi = args.ph_hi;
    for (int u = tid0; u < (LDS_BYTES - LDS_CTL) / 4; u += NTHREADS) cw[u] = 0;
    __syncthreads();
    XcdBarrier bar; bar.bar = ctl + CW_BAR; bar.x = 0; bar.st = nullptr;
    if (hi - lo > 1) bar = xcd_barrier_post(ctl + CW_BAR, (volatile LAS unsigned*)(cw + LW_BAR));
    float* const dout = args.out;
#define CAS __attribute__((address_space(4)))
#define KIN(i) (*(const void* CAS const*)(ka + 8 * (i)))
#define PHASE_NAMES \
    unsigned zz_ = 0u; asm volatile("" : "+v"(zz_)); int tid = wave0 * 64 + (int)__builtin_amdgcn_mbcnt_hi(~0u, __builtin_amdgcn_mbcnt_lo(~0u, zz_)); asm volatile("" : "+v"(tid)); const int lane = tid & 63, wave = __builtin_amdgcn_readfirstlane(tid >> 6), gw = vcu * NWAVES + wave; \
    CAS const unsigned char* ka = (CAS const unsigned char*)__builtin_amdgcn_kernarg_segment_ptr(); asm volatile("" : "+s"(ka)); \
    unsigned char* ws = *(unsigned char* CAS const*)(ka + 24 * 8); \
    const float* x = (const float*)KIN(0); const float* pin = (const float*)KIN(1); const int* pos = (const int*)KIN(2); \
    const float* w_in = (const float*)KIN(3); const float* w_out = (const float*)KIN(4); \
    const float* ln_mix_g = (const float*)KIN(5); const float* ln_mix_b = (const float*)KIN(6); \
    const float* diff_lambda = (const float*)KIN(7); const float* diff_gain = (const float*)KIN(8); \
    const float* cmp_pos = (const float*)KIN(9); const float* cmp_w1 = (const float*)KIN(10); const float* cmp_w2 = (const float*)KIN(11); \
    const float* ffn_w1 = (const float*)KIN(12); const float* ffn_w3 = (const float*)KIN(13); const float* ffn_w2 = (const float*)KIN(14); \
    const float* moe_router = (const float*)KIN(15); const float* moe_w1 = (const float*)KIN(16); const float* moe_w3 = (const float*)KIN(17); const float* moe_w2 = (const float*)KIN(18); \
    const float* ln_ffn_g = (const float*)KIN(19); const float* ln_ffn_b = (const float*)KIN(20); \
    const float* ple_proj = (const float*)KIN(21); const float* ple_gate = (const float*)KIN(22); \
    unsigned char* misc = ws + WS_MISC; \
    float* lamv = (float*)(misc + OFF_LAM); float* c1 = (float*)(misc + OFF_C1); \
    bf16_t* kmean = (bf16_t*)(misc + OFF_KMEAN); bf16_t* KC = (bf16_t*)(misc + OFF_KC); bf16_t* VC = (bf16_t*)(misc + OFF_VC); \
    float* gates = (float*)(misc + OFF_GATES); float* moeg = (float*)(misc + OFF_MOEG); int* list = (int*)(misc + OFF_LIST); float* hid = (float*)(misc + OFF_HID); \
    float* cos32 = (float*)(ws + WS_ROPE); float* sin32 = cos32 + (size_t)NT * 32; float* cos16 = sin32 + (size_t)NT * 32; float* sin16 = cos16 + (size_t)NT * 16; \
    unsigned char* wb = ws + WS_W; \
    bf16_t* hb = (bf16_t*)(ws + WS_HB); bf16_t* pb = (bf16_t*)(ws + WS_PB); \
    unsigned char* R = ws + WS_R; \
    bf16_t* proj = (bf16_t*)(R + R_PROJ); bf16_t* qr = (bf16_t*)(R + R_QR); bf16_t* mixed = (bf16_t*)(R + R_MIXED); \
    bf16_t* hidb = (bf16_t*)(R + R_HID); float* H2 = (float*)(R + R_H2); bf16_t* Pp = (bf16_t*)(R + R_P); \
    (void)lane; (void)gw; (void)x; (void)pin; (void)pos; (void)w_in; (void)w_out; (void)ln_mix_g; (void)ln_mix_b; (void)diff_lambda; (void)diff_gain; (void)cmp_pos; (void)cmp_w1; (void)cmp_w2; \
    (void)ffn_w1; (void)ffn_w3; (void)ffn_w2; (void)moe_router; (void)moe_w1; (void)moe_w3; (void)moe_w2; (void)ln_ffn_g; (void)ln_ffn_b; (void)ple_proj; (void)ple_gate; (void)lamv; (void)c1; \
    (void)kmean; (void)KC; (void)VC; (void)gates; (void)moeg; (void)list; (void)hid; (void)sin16; (void)wb; (void)hb; (void)pb; (void)proj; (void)qr; (void)mixed; (void)hidb; (void)H2; (void)Pp;

    int ph = 0;
#define PHASE_BEGIN(k) if (ph >= lo && ph < hi) { for (int rep_ = 0; rep_ < (((PHMASK >> (k)) & 1) ? 1 + ((DUPMASK >> (k)) & 1) : 0); ++rep_) { if (rep_) xcd_barrier(bar); PHASE_NAMES
#define PHASE_END   } if (ph + 1 < hi) xcd_barrier(bar); } ++ph;

    PHASE_BEGIN(0)
    {
        LAS float* scr = (LAS float*)(lds + wave * 16384);
        for (int f = gw; f < 3 * 1792; f += NGW) {
            const int idx = f / 1792, item = f % 1792, e = idx / 3, which = idx % 3;
            const float* W = e == 0 ? (which == 0 ? ffn_w1 : which == 1 ? ffn_w3 : ffn_w2) : ((which == 0 ? moe_w1 : which == 1 ? moe_w3 : moe_w2) + (size_t)(e - 1) * DM * DFF);
            if (which < 2) transpose_item(W, DM, DFF, (bf16_t*)(wb + W_F13) + (size_t)e * 2 * DFF * DM, RmIl{which}, scr, item, lane);
            else transpose_item(W, DFF, DM, (bf16_t*)(wb + W_F2) + (size_t)e * DM * DFF, RmId{0}, scr, item, lane);
        }
        for (int f = gw; f < DEPTH * 16 * 93; f += NGW) { const int L = f / (16 * 93), item = f % (16 * 93);
            transpose_item(w_in + (size_t)L * DM * NIN, DM, NIN, (bf16_t*)(wb + W_IN) + (size_t)L * NINP * DM, RmIn{}, scr, item, lane); }
        for (int f = gw; f < DEPTH * 512; f += NGW) { const int L = f / 512, item = f % 512;
            transpose_item(w_out + (size_t)L * DM * DM, DM, DM, (bf16_t*)(wb + W_OUT) + (size_t)L * DM * DM, RmId{0}, scr, item, lane); }
        for (int f = gw; f < DEPTH * 512; f += NGW) { const int L = f / 512, item = f % 512;
            transpose_item(ple_gate + (size_t)L * DM * DM, DM, DM, (bf16_t*)(wb + W_PG) + (size_t)L * DM * DM, RmId{0}, scr, item, lane); }
        for (int f = gw; f < DEPTH * 128; f += NGW) { const int L = f / 128, item = f % 128;
            transpose_item(ple_proj + (size_t)L * PLE * DM, PLE, DM, (bf16_t*)(wb + W_PP) + (size_t)L * DM * PLE, RmId{0}, scr, item, lane); }
        for (int f = gw; f < DEPTH * 2 * 256; f += NGW) { const int lk = f / 256, item = f % 256;
            transpose_item(cmp_w1 + (size_t)lk * 2048 * 256, 2048, 256, (bf16_t*)(wb + W_C1) + (size_t)lk * 256 * 2048, RmId{0}, scr, item, lane); }
        for (int f = gw * 64 + lane; f < DEPTH * (NINP - NIN) * (DM / 8); f += NGW * 64) { const int L = f / ((NINP - NIN) * (DM / 8)), r = f % ((NINP - NIN) * (DM / 8));
            *(u32x4*)((bf16_t*)(wb + W_IN) + ((size_t)L * NINP + NIN) * DM + (size_t)r * 8) = (u32x4){0u, 0u, 0u, 0u}; }
        for (int r = gw; r < NT; r += NGW) { const f32x4* xr = (const f32x4*)(x + (size_t)r * DM) + lane; u32x2* o8 = (u32x2*)(hb + (size_t)r * DM) + lane;
#pragma unroll
            for (int j = 0; j < 4; ++j) { const f32x4 v = xr[64 * j]; u32x2 w; w.x = pk2(v[0], v[1]); w.y = pk2(v[2], v[3]); o8[64 * j] = w; } }
        for (int f = gw * 64 + lane; f < NT * 32; f += NGW * 64) { const int tok = f >> 5, fi = f & 31; const float p = (float)pos[tok];
            const float a32 = p * powf(10000.f, -(float)fi / 32.f); float s, c; sincosf(a32, &s, &c); cos32[f] = c; sin32[f] = s;
            if (fi < 16) { const float a16 = p * powf(10000.f, -(float)fi / 16.f); sincosf(a16, &s, &c); cos16[tok * 16 + fi] = c; sin16[tok * 16 + fi] = s; } }
        if (vcu < DEPTH * 2 * 4) {
            const int lk = vcu >> 2, sl = vcu & 3;
            const float* pe = cmp_pos + (size_t)lk * 2048 + sl * 512; const float* w1 = cmp_w1 + ((size_t)lk * 2048 + sl * 512) * 256;
            const int n = tid & 255, half = tid >> 8; float s = 0.f;
#pragma unroll 16
            for (int kk = half * 256; kk < half * 256 + 256; ++kk) s += pe[kk] * w1[(size_t)kk * 256 + n];
            LAS float* red = (LAS float*)lds;
            __syncthreads(); if (half == 1) red[n] = s; __syncthreads(); if (half == 0) c1[(lk * 4 + sl) * 256 + n] = s + red[n];
        }
        if (vcu == DEPTH * 2 * 4 && tid < DEPTH) { const float* lf = diff_lambda + tid * 128; float a = 0.f, b = 0.f;
            for (int k = 0; k < 32; ++k) { a += lf[k] * lf[32 + k]; b += lf[64 + k] * lf[96 + k]; }
            lamv[tid] = expf(a) - expf(b) + (0.8f - 0.6f * expf(-0.3f * (float)tid)); }
    }
    PHASE_END

    for (int L = 0; L < DEPTH; ++L) {
        const float lam_init = (L == 0) ? 0.2f : 0.35550907f;
        const bool moe = (L & 1);
        PHASE_BEGIN(1)
        {
            pg8::Gemm g{L == 0 ? hb : mixed, (const bf16_t*)(wb + W_IN) + (size_t)L * NINP * DM, DM, 128u};
            pg8::StaticOrder S; S.init(NT, NINP, G, bx, DM);
            EpiInProj E{proj, qr, gates, cos32, sin32, cos16, sin16};
            pg8::gemm_phase(lds, g, S, E, tid);
        }
        PHASE_END
        PHASE_BEGIN(2)
        {
            if (vcu < 16) {
                pg8::Gemm g{proj, (const bf16_t*)(wb + W_C1) + (size_t)L * 2 * 256 * 2048, 2048, (unsigned)(NINP * 2)};
                SchedCmp S{vcu}; EpiCmp E{hid, c1 + L * 2048};
                pg8::gemm_phase(lds, g, S, E, tid);
            } else {
                if (L == 0) {
                    LAS float* scr = (LAS float*)(lds + wave * 16384);
                    const int gw2 = (vcu - 16) * NWAVES + wave, NGW2 = (G - 16) * NWAVES;
                    for (int f = 3 * 1792 + gw2; f < 27 * 1792; f += NGW2) {
                        const int idx = f / 1792, item = f % 1792, e = idx / 3, which = idx % 3;
                        const float* W = (which == 0 ? moe_w1 : which == 1 ? moe_w3 : moe_w2) + (size_t)(e - 1) * DM * DFF;
                        if (which < 2) transpose_item(W, DM, DFF, (bf16_t*)(wb + W_F13) + (size_t)e * 2 * DFF * DM, RmIl{which}, scr, item, lane);
                        else transpose_item(W, DFF, DM, (bf16_t*)(wb + W_F2) + (size_t)e * DM * DFF, RmId{0}, scr, item, lane);
                    }
                    __syncthreads();
                }
                LAS float* part = (LAS float*)lds;
                for (int it = vcu - 16; it < 512; it += G - 16) {
                    const int bh = it >> 5, j = it & 31, b = bh >> 2, h = bh & 3, kg = tid >> 3, c = tid & 7;
                    const bf16_t* kp = proj + ((size_t)b * SEQ + 256 * j + 4 * kg) * NINP + C_CK + h * 64 + c * 8;
                    float s[8] = {0.f, 0.f, 0.f, 0.f, 0.f, 0.f, 0.f, 0.f};
#pragma unroll
                    for (int k = 0; k < 4; ++k) { const u32x4 v = *(const u32x4*)(kp + (size_t)k * NINP);
                        s[0] += bflo(v.x); s[1] += bfhi(v.x); s[2] += bflo(v.y); s[3] += bfhi(v.y); s[4] += bflo(v.z); s[5] += bfhi(v.z); s[6] += bflo(v.w); s[7] += bfhi(v.w); }
                    __syncthreads();
#pragma unroll
                    for (int q = 0; q < 8; ++q) part[kg * 64 + c * 8 + q] = s[q];
                    __syncthreads();
                    if (tid < 64) { float a = 0.f; for (int k = 0; k < 64; ++k) a += part[k * 64 + tid]; kmean[(size_t)it * 64 + tid] = (bf16_t)(pk2(a * (1.f / 256.f), 0.f) & 0xffffu); }
                }
            }
        }
        PHASE_END
        PHASE_BEGIN(3)
        {
            for (int f = (vcu * NTHREADS + tid); f < 2 * 2048 * 16; f += G * NTHREADS) {
                const int d4 = (f & 15) * 4, r = (f >> 4) & 2047, kv = f >> 15;
                const float* hr = hid + ((size_t)kv * 2048 + r) * 256; const float* w2 = cmp_w2 + ((size_t)(L * 2 + kv) * 256) * 64 + d4;
                f32x4 a = {0.f, 0.f, 0.f, 0.f};
                if ((r & 511) != 511) {
#pragma unroll 4
                    for (int n = 0; n < 256; n += 4) { const f32x4 h4 = *(const f32x4*)(hr + n);
                        a += h4[0] * *(const f32x4*)(w2 + (size_t)n * 64) + h4[1] * *(const f32x4*)(w2 + (size_t)(n + 1) * 64) + h4[2] * *(const f32x4*)(w2 + (size_t)(n + 2) * 64) + h4[3] * *(const f32x4*)(w2 + (size_t)(n + 3) * 64); }
                }
                st_bf4((kv ? VC : KC) + (size_t)r * 64 + d4, a);
            }
        }
        PHASE_END
        PHASE_BEGIN(4)
        {
            const float lam = lamv[L];
            { const int bh = vcu >> 4, s = vcu & 15;
#define ATT_TID int tq = tid; asm volatile("" : "+v"(tq)); const int lq = tq & 63;
              if (ATTMASK & 2) for (int k = 0; k < ((DUPATT & 2) ? 4 : 2); ++k) { ATT_TID att::unit_B(lds, proj, mixed, diff_gain + L * 64, lam, lam_init, bh >> 2, bh & 3, (k & 1) ? 31 - s : s, tq, wave, lq); }
              if (ATTMASK & 4) for (int k = 0; k < ((DUPATT & 4) ? 4 : 2); ++k) { ATT_TID att::unit_C(lds, proj, kmean, mixed, bh >> 2, bh & 3, (k & 1) ? 31 - s : s, tq, wave, lq); }
              if (ATTMASK & 1) for (int k = 0; k < ((DUPATT & 1) ? 4 : 2); ++k) { ATT_TID att::unit_A(lds, proj, mixed, bh >> 2, bh & 3, (k & 1) ? 31 - s : s, tq, wave, lq); } }
            { const int b = vcu >> 6, s = vcu & 63;
              if (ATTMASK & 8) for (int k = 0; k < ((DUPATT & 8) ? 4 : 2); ++k) { ATT_TID att::unit_D(lds, proj, qr, KC, VC, gates, mixed, b, (k & 1) ? 127 - s : s, tq, wave, lq); } }
#undef ATT_TID
        }
        PHASE_END
        PHASE_BEGIN(5)
        {
            pg8::Gemm g{mixed, (const bf16_t*)(wb + W_OUT) + (size_t)L * DM * DM, DM, 128u};
            pg8::StaticOrder S; S.init(NT, DM, G, bx, DM);
            EpiResid E{L == 0 ? x : dout, dout};
            pg8::gemm_phase(lds, g, S, E, tid);
        }
        PHASE_END
        PHASE_BEGIN(6)
        {
            const float* gv = ln_mix_g + L * DM; const float* bv = ln_mix_b + L * DM;
            f32x4 gg[4], bb[4];
#pragma unroll
            for (int j = 0; j < 4; ++j) { gg[j] = *((const f32x4*)gv + lane + 64 * j); bb[j] = *((const f32x4*)bv + lane + 64 * j); }
            if (tid < 8) cw[LW_CNTL + tid] = 0;
            __syncthreads();
            int k = 0;
            for (int r = gw; r < NT; r += NGW, ++k) {
                f32x4* xr = (f32x4*)(dout + (size_t)r * DM) + lane;
                f32x4 v[4]; float s = 0.f;
#pragma unroll
                for (int j = 0; j < 4; ++j) { v[j] = xr[64 * j]; s += (v[j][0] + v[j][1]) + (v[j][2] + v[j][3]); }
                const float mean = wave_sum(s) * (1.f / DM); float s2 = 0.f;
#pragma unroll
                for (int j = 0; j < 4; ++j) { v[j] = v[j] - mean; s2 += (v[j][0] * v[j][0] + v[j][1] * v[j][1]) + (v[j][2] * v[j][2] + v[j][3] * v[j][3]); }
                const float rstd = rsqrtf(wave_sum(s2) * (1.f / DM) + LN_EPS);
                u32x2* o8 = (u32x2*)(hb + (size_t)r * DM) + lane;
#pragma unroll
                for (int j = 0; j < 4; ++j) { v[j] = v[j] * rstd * gg[j] + bb[j]; u32x2 w; w.x = pk2(v[j][0], v[j][1]); w.y = pk2(v[j][2], v[j][3]); o8[64 * j] = w; if (!moe) xr[64 * j] = v[j]; }
                if (moe) {
                    float lg[8];
#pragma unroll
                    for (int e = 0; e < 8; ++e) lg[e] = 0.f;
#pragma unroll
                    for (int j = 0; j < 4; ++j)
#pragma unroll
                        for (int q = 0; q < 4; ++q) { const f32x4* wr = (const f32x4*)(moe_router + (size_t)(4 * lane + 256 * j + q) * 8); const f32x4 w0 = wr[0], w1 = wr[1]; const float hv = v[j][q];
                            lg[0] += hv * w0[0]; lg[1] += hv * w0[1]; lg[2] += hv * w0[2]; lg[3] += hv * w0[3]; lg[4] += hv * w1[0]; lg[5] += hv * w1[1]; lg[6] += hv * w1[2]; lg[7] += hv * w1[3]; }
#pragma unroll
                    for (int e = 0; e < 8; ++e) lg[e] = wave_sum(lg[e]);
                    int e0 = 0; float b0 = lg[0];
#pragma unroll
                    for (int e = 1; e < 8; ++e) if (lg[e] > b0) { b0 = lg[e]; e0 = e; }
                    int e1 = -1; float b1 = -INFINITY;
#pragma unroll
                    for (int e = 0; e < 8; ++e) if (e != e0 && lg[e] > b1) { b1 = lg[e]; e1 = e; }
                    const float g1 = 1.f / (1.f + expf(b0 - b1)), g0 = 1.f - g1;
                    if (lane == 0) {
                        const int s0 = __hip_atomic_fetch_add(cw + LW_CNTL + e0, 1, __ATOMIC_RELAXED, __HIP_MEMORY_SCOPE_WORKGROUP), s1 = __hip_atomic_fetch_add(cw + LW_CNTL + e1, 1, __ATOMIC_RELAXED, __HIP_MEMORY_SCOPE_WORKGROUP);
                        const int ix = (wave * 16 + k) * 2; cw[LW_PE + ix] = e0 | (s0 << 8); cw[LW_PE + ix + 1] = e1 | (s1 << 8);
                        moeg[2 * r] = g0; moeg[2 * r + 1] = g1;
                    }
                }
                { const f32x4 pv4 = *((const f32x4*)(pin + ((size_t)L * NT + r) * PLE) + lane); u32x2 w; w.x = pk2(pv4[0], pv4[1]); w.y = pk2(pv4[2], pv4[3]); *((u32x2*)(pb + (size_t)r * PLE) + lane) = w; }
            }
            if (moe) {
                __syncthreads();
                if (tid < 8) cw[LW_BASEL + tid] = (int)__hip_atomic_fetch_add(ctl + CW_CNT + 64 * tid, (unsigned)cw[LW_CNTL + tid], __ATOMIC_RELAXED, __HIP_MEMORY_SCOPE_AGENT);
                __syncthreads();
                if (tid < 256) { const int wv = tid >> 5, kk = (tid >> 1) & 15, r = vcu * NWAVES + wv + kk * NGW;
                    if (r < NT) { const int pe = cw[LW_PE + tid], e = pe & 255, sl = pe >> 8; list[e * 32768 + cw[LW_BASEL + e] + sl] = 2 * r + (tid & 1); } }
            }
        }
        PHASE_END
        for (int chunk = 0; chunk < (moe ? 2 : 1); ++chunk) {
            PHASE_BEGIN(7)
            {
                __syncthreads();
                if (tid == 0) { int ts = 0;
                    for (int e = 0; e < 8; ++e) { const int c = moe ? (int)__hip_atomic_load(ctl + CW_CNT + 64 * e, __ATOMIC_RELAXED, __HIP_MEMORY_SCOPE_AGENT) : (e == 0 ? NT : 0); cw[LW_CNT + e] = c; cw[LW_TS + e] = ts; ts += (c + 255) >> 8; }
                    cw[LW_TS + 8] = ts; }
                __syncthreads();
                const int ntile = cw[LW_TS + 8], t0 = chunk * 128, t1 = chunk == 0 ? (ntile < 128 ? ntile : 128) : ntile;
                if (t1 > t0) {
                    pg8::Gemm g{hb, (const bf16_t*)(wb + W_F13), DM, 128u};
                    SchedGU S{cw, list, t0, t1, G, bx, !moe}; EpiSwiglu E{hidb, t0};
                    pg8::gemm_phase(lds, g, S, E, tid);
                }
            }
            PHASE_END
            PHASE_BEGIN(8)
            {
                __syncthreads();
                if (tid == 0) { int ts = 0;
                    for (int e = 0; e < 8; ++e) { const int c = moe ? (int)__hip_atomic_load(ctl + CW_CNT + 64 * e, __ATOMIC_RELAXED, __HIP_MEMORY_SCOPE_AGENT) : (e == 0 ? NT : 0); cw[LW_CNT + e] = c; cw[LW_TS + e] = ts; ts += (c + 255) >> 8; }
                    cw[LW_TS + 8] = ts; }
                __syncthreads();
                const int ntile = cw[LW_TS + 8], t0 = chunk * 128, t1 = chunk == 0 ? (ntile < 128 ? ntile : 128) : ntile;
                if (t1 > t0) {
                    pg8::Gemm g{hidb, (const bf16_t*)(wb + W_F2), DFF, 128u};
                    SchedDN S{cw, t0, t1, G, bx, !moe}; EpiDown E{!moe, dout, (bf16_t*)dout, cw, list, moeg};
                    pg8::gemm_phase(lds, g, S, E, tid);
                }
            }
            PHASE_END
        }
        PHASE_BEGIN(9)
        {
            const float* gv = ln_ffn_g + L * DM; const float* bv = ln_ffn_b + L * DM;
            f32x4 gg[4], bb[4];
#pragma unroll
            for (int j = 0; j < 4; ++j) { gg[j] = *((const f32x4*)gv + lane + 64 * j); bb[j] = *((const f32x4*)bv + lane + 64 * j); }
            float* hout = moe ? H2 : dout;
            for (int r = gw; r < NT; r += NGW) {
                f32x4 v[4]; float s = 0.f;
                u32x2* h8 = (u32x2*)(hb + (size_t)r * DM) + lane;
                if (!moe) {
                    const f32x4* xr = (const f32x4*)(dout + (size_t)r * DM) + lane;
#pragma unroll
                    for (int j = 0; j < 4; ++j) v[j] = xr[64 * j];
                } else {
                    const u32x2* y0 = (const u32x2*)((const bf16_t*)dout + (size_t)(2 * r) * DM) + lane; const u32x2* y1 = (const u32x2*)((const bf16_t*)dout + (size_t)(2 * r + 1) * DM) + lane;
#pragma unroll
                    for (int j = 0; j < 4; ++j) { const u32x2 a = h8[64 * j], c = y0[64 * j], d = y1[64 * j];
                        v[j][0] = ALPHA * bflo(a.x) + (bflo(c.x) + bflo(d.x)); v[j][1] = ALPHA * bfhi(a.x) + (bfhi(c.x) + bfhi(d.x));
                        v[j][2] = ALPHA * bflo(a.y) + (bflo(c.y) + bflo(d.y)); v[j][3] = ALPHA * bfhi(a.y) + (bfhi(c.y) + bfhi(d.y)); }
                }
#pragma unroll
                for (int j = 0; j < 4; ++j) s += (v[j][0] + v[j][1]) + (v[j][2] + v[j][3]);
                const float mean = wave_sum(s) * (1.f / DM); float s2 = 0.f;
#pragma unroll
                for (int j = 0; j < 4; ++j) { v[j] = v[j] - mean; s2 += (v[j][0] * v[j][0] + v[j][1] * v[j][1]) + (v[j][2] * v[j][2] + v[j][3] * v[j][3]); }
                const float rstd = rsqrtf(wave_sum(s2) * (1.f / DM) + LN_EPS);
                f32x4* orow = (f32x4*)(hout + (size_t)r * DM) + lane;
#pragma unroll
                for (int j = 0; j < 4; ++j) { v[j] = v[j] * rstd * gg[j] + bb[j]; orow[64 * j] = v[j]; u32x2 w; w.x = pk2(v[j][0], v[j][1]); w.y = pk2(v[j][2], v[j][3]); h8[64 * j] = w; }
            }
        }
        PHASE_END
        PHASE_BEGIN(10)
        {
            pg8::Gemm g{pb, (const bf16_t*)(wb + W_PP) + (size_t)L * DM * PLE, PLE, 128u};
            pg8::StaticOrder S; S.init(NT, DM, G, bx, PLE);
            EpiBf16 E{Pp, DM};
            pg8::gemm_phase(lds, g, S, E, tid);
        }
        PHASE_END
        PHASE_BEGIN(11)
        {
            pg8::Gemm g{hb, (const bf16_t*)(wb + W_PG) + (size_t)L * DM * DM, DM, 128u};
            pg8::StaticOrder S; S.init(NT, DM, G, bx, DM);
            EpiPle E{moe ? H2 : dout, Pp, dout, (L + 1 < DEPTH) ? mixed : nullptr};
            pg8::gemm_phase(lds, g, S, E, tid);
        }
        PHASE_END
    }
#undef PHASE_BEGIN
#undef PHASE_END
}

extern "C" void kernel_launch(void* const* d_in, const int* in_sizes, int n_in, void* d_out, int out_size, void* d_ws, size_t ws_size, hipStream_t stream) {
    static int grid = 0;
    if (grid == 0) {
        if (n_in != 23 || out_size != NT * DM || ws_size < WS_END) { fprintf(stderr, "kernel_launch: unexpected problem (n_in %d out %d ws %zu need %zu)\n", n_in, out_size, ws_size, (size_t)WS_END); grid = -1; return; }
        int dev = 0, cus = 0;
        if (hipGetDevice(&dev) != hipSuccess || hipDeviceGetAttribute(&cus, hipDeviceAttributeMultiprocessorCount, dev) != hipSuccess) { grid = -1; return; }
        if (hipFuncSetAttribute((const void*)mk_fwd, hipFuncAttributeMaxDynamicSharedMemorySize, LDS_BYTES) != hipSuccess) { fprintf(stderr, "kernel_launch: hipFuncSetAttribute failed\n"); grid = -1; return; }
        int per_cu = 0;
        if (hipOccupancyMaxActiveBlocksPerMultiprocessor(&per_cu, (const void*)mk_fwd, NTHREADS, LDS_BYTES) != hipSuccess || per_cu < 1) { fprintf(stderr, "kernel_launch: occupancy query says %d blocks per CU\n", per_cu); }
        (void)hipGetLastError();
        grid = cus;
        if (grid != 256) { fprintf(stderr, "kernel_launch: built for 256 CUs, device has %d\n", cus); grid = -1; return; }
    }
    if (grid < 0) return;
    (void)hipMemsetAsync((char*)d_ws + WS_CTL, 0, CTL_ZERO_BYTES, stream);
    Args a{};
    for (int i = 0; i < 23; ++i) a.in[i] = d_in[i];
    a.out = (float*)d_out; a.ws = (unsigned char*)d_ws;
#if MK_MULTI
    for (int p = 0; p < NPHASES; ++p) { a.ph_lo = p; a.ph_hi = p + 1; hipLaunchKernelGGL(mk_fwd, dim3(grid), dim3(NTHREADS), LDS_BYTES, stream, a); }
#else
    a.ph_lo = 0; a.ph_hi = NPHASES;
    hipLaunchKernelGGL(mk_fwd, dim3(grid), dim3(NTHREADS), LDS_BYTES, stream, a);
#endif
}
```

```cpp
#include <hip/hip_runtime.h>
#include <cstdio>
#include <cstdint>

#ifndef PHMASK
#define PHMASK 0xFFFF
#endif
#ifndef TIMA
#define TIMA 0
#endif
#ifndef TIMB
#define TIMB 0
#endif
#ifndef CHECK_C
#define CHECK_C 0
#endif
#ifndef CHECK_ALLOW
#define CHECK_ALLOW 61
#endif
#ifndef CHECK_N
#define CHECK_N 0
#endif
#ifndef DSELV2
#define DSELV2 1
#endif
#ifndef DSUB
#define DSUB 0
#endif
#ifndef DUPL
#define DUPL (-1)
#endif
#ifndef EPIDUP
#define EPIDUP 0
#endif
#ifndef BPIPE
#define BPIPE 1
#endif
#ifndef LEFTOVER
#define LEFTOVER 1
#endif
#ifndef DUPMASK
#define DUPMASK 0
#endif
#ifndef DUPATT
#define DUPATT 0
#endif
#ifndef ATTMASK
#define ATTMASK 0xF
#endif
#ifndef MK_MULTI
#define MK_MULTI 0
#endif

#define LAS __attribute__((address_space(3)))
#define GAS __attribute__((address_space(1)))
typedef unsigned short bf16_t;
typedef short bf16x8 __attribute__((ext_vector_type(8)));
typedef short s16x4 __attribute__((ext_vector_type(4)));
typedef float f32x2 __attribute__((ext_vector_type(2)));
typedef float f32x4 __attribute__((ext_vector_type(4)));
typedef float f32x16 __attribute__((ext_vector_type(16)));
typedef unsigned u32x2 __attribute__((ext_vector_type(2)));
typedef unsigned u32x4 __attribute__((ext_vector_type(4)));
typedef __bf16 bf16x2_t __attribute__((ext_vector_type(2)));

constexpr int NB = 4, SEQ = 8192, NT = NB * SEQ, DM = 1024, NIN = 2956, NINP = 3072, DFF = 3584, NEXP = 8, PLE = 256, DEPTH = 2;
constexpr int NCMP = 512;
constexpr float LOG2E = 1.4426950408889634f;
constexpr float ALPHA = 1.4142135623730951f;
constexpr float LN_EPS = 1e-5f, RMS_EPS = 1e-5f;
constexpr float QS64 = 0.125f * LOG2E;
constexpr float QS32 = 0.17677669529663687f * LOG2E;
constexpr int C_AQ = 0, C_AK = 256, C_AV = 512, C_BQ = 768, C_BK = 1024, C_BV = 1280, C_CQ = 1536, C_CK = 1792, C_CV = 2048, C_DQ = 2304;
constexpr int C_KC = 2560, C_VC = 2624, C_KS = 2688, C_VS = 2752, C_KW = 2816, C_VW = 2880, C_G = 2944;

constexpr size_t MiB = 1u << 20;
constexpr size_t WS_CTL = 0, CTL_ZERO_BYTES = 1 * MiB;
constexpr size_t WS_MISC = 1 * MiB;
constexpr size_t OFF_LAM = 0;
constexpr size_t OFF_C1 = 4096;
constexpr size_t OFF_KMEAN = 32768;
constexpr size_t OFF_KC = 128 * 1024;
constexpr size_t OFF_VC = 384 * 1024;
constexpr size_t OFF_GATES = 1 * MiB;
constexpr size_t OFF_MOEG = 3 * MiB;
constexpr size_t OFF_LIST = 4 * MiB;
constexpr size_t OFF_HID = 5 * MiB;
constexpr size_t WS_ROPE = 11 * MiB;
constexpr size_t WS_W = 23 * MiB;
constexpr size_t W_IN = 0;
constexpr size_t W_OUT = W_IN + (size_t)DEPTH * NINP * DM * 2;
constexpr size_t W_PG = W_OUT + (size_t)DEPTH * DM * DM * 2;
constexpr size_t W_PP = W_PG + (size_t)DEPTH * DM * DM * 2;
constexpr size_t W_C1 = W_PP + (size_t)DEPTH * DM * PLE * 2;
constexpr size_t W_F13 = W_C1 + (size_t)DEPTH * 2 * 256 * 2048 * 2;
constexpr size_t W8_F2 = W_F13 + (size_t)9 * 2 * DFF * DM;
constexpr size_t W_F2 = W_F13 + (size_t)9 * 2 * DFF * DM * 2;
constexpr size_t W_END = W_F2 + (size_t)9 * DM * DFF * 2;
constexpr size_t WS_HB = WS_W + ((W_END + MiB - 1) / MiB) * MiB;
constexpr size_t WS_PB = WS_HB + 64 * MiB;
constexpr size_t WS_R = WS_PB + 16 * MiB;
constexpr size_t R_PROJ = 0;
constexpr size_t R_QR = 193 * MiB;
constexpr size_t R_MIXED = 209 * MiB;
constexpr size_t R_HID = 0;
constexpr size_t R_H2 = 0;
constexpr size_t R_P = 128 * MiB;
constexpr size_t WS_MLIST = WS_R + 274 * MiB;
constexpr size_t WS_END = WS_MLIST + 16 * MiB;
constexpr int CW_BAR = 4096, CW_CNT = 8192, CW_MC = 20480, CW_FLAG = 24576;

__device__ __forceinline__ unsigned pk2(float lo, float hi) { f32x2 v = {lo, hi}; bf16x2_t b = __builtin_convertvector(v, bf16x2_t); return __builtin_bit_cast(unsigned, b); }
__device__ __forceinline__ float bf2f_(bf16_t h) { return __uint_as_float(((unsigned)h) << 16); }
__device__ __forceinline__ float bflo(unsigned w) { return __uint_as_float(w << 16); }
__device__ __forceinline__ float bfhi(unsigned w) { return __uint_as_float(w & 0xffff0000u); }
__device__ __forceinline__ int lane_now() { unsigned z = 0u; asm volatile("" : "+v"(z)); return (int)__builtin_amdgcn_mbcnt_hi(~0u, __builtin_amdgcn_mbcnt_lo(~0u, z)); }
__device__ __forceinline__ float wave_sum(float v) { const int l = lane_now();
#pragma unroll
    for (int o = 1; o < 64; o <<= 1) v += __builtin_bit_cast(float, __builtin_amdgcn_ds_bpermute((l ^ o) << 2, __builtin_bit_cast(int, v)));
    return v;
}
__device__ __forceinline__ float wave_max(float v) { const int l = lane_now();
#pragma unroll
    for (int o = 1; o < 64; o <<= 1) v = fmaxf(v, __builtin_bit_cast(float, __builtin_amdgcn_ds_bpermute((l ^ o) << 2, __builtin_bit_cast(int, v))));
    return v;
}
__device__ __forceinline__ unsigned wave_or(unsigned v) { const int l = lane_now();
#pragma unroll
    for (int o = 1; o < 64; o <<= 1) v |= (unsigned)__builtin_amdgcn_ds_bpermute((l ^ o) << 2, (int)v);
    return v;
}
__device__ __forceinline__ float xhalf(float x) { const unsigned u = __float_as_uint(x); auto rr = __builtin_amdgcn_permlane32_swap(u, u, false, false); return __uint_as_float(rr[0] ^ rr[1] ^ u); }
__device__ __forceinline__ float ex2(float x) { return __builtin_amdgcn_exp2f(x); }
__device__ __forceinline__ float lg2(float x) { return __builtin_amdgcn_logf(x); }
__device__ __forceinline__ float sigmoidf_(float x) { return __builtin_amdgcn_rcpf(1.0f + ex2(-LOG2E * x)); }
__device__ __forceinline__ float quad_sum(float x) {
    x += __builtin_bit_cast(float, __builtin_amdgcn_update_dpp(0, __builtin_bit_cast(int, x), 0xB1, 0xF, 0xF, true));
    x += __builtin_bit_cast(float, __builtin_amdgcn_update_dpp(0, __builtin_bit_cast(int, x), 0x4E, 0xF, 0xF, true));
    return x;
}

#define XB_TMO      128
#define XB_XCNT(j)  (256  + 64 * (j))
#define XB_XSUB(j)  (1280 + 64 * (j))
#define XB_XGEN(j)  (2304 + 64 * (j))
#define XB_TOP      3328
#define XB_TOPGEN   3392
#define XCD_BAR_WORDS 3456
#define XB_SPIN_CAP (1u << 18)
__device__ __forceinline__ unsigned xb_ld(unsigned* p)              { return __hip_atomic_load(p, __ATOMIC_RELAXED, __HIP_MEMORY_SCOPE_AGENT); }
__device__ __forceinline__ unsigned xb_add(unsigned* p, unsigned v) { return __hip_atomic_fetch_add(p, v, __ATOMIC_RELAXED, __HIP_MEMORY_SCOPE_AGENT); }
__device__ __forceinline__ unsigned xb_xcc_id() { return (unsigned)__builtin_amdgcn_s_getreg((3 << 11) | 20) & 0xFu; }
#define XB_SPIN(cond, bar) do { unsigned _sp = 0; while (cond) { __builtin_amdgcn_s_sleep(1); \
    if ((++_sp & 255u) == 0u) { if (xb_ld(&(bar)[XB_TMO])) break; if (_sp > XB_SPIN_CAP) { atomicAdd(&(bar)[XB_TMO], 1u); break; } } } } while (0)
struct XcdBarrier { unsigned* bar; unsigned x; volatile LAS unsigned* st; };
__device__ __forceinline__ XcdBarrier xcd_barrier_post(unsigned* bar, volatile LAS unsigned* st) {
    XcdBarrier b; b.bar = bar; b.x = xb_xcc_id(); b.st = st;
    if (threadIdx.x == 0) (void)xb_add(&bar[XB_XCNT(b.x)], 1u);
    return b;
}
__device__ __forceinline__ void xcd_barrier_complete(unsigned* bar, unsigned x, unsigned& nloc, unsigned& nx) {
    const unsigned G = gridDim.x * gridDim.y * gridDim.z;
    unsigned sum, cnt, mine, sp = 0u;
    for (;;) {
        sum = 0u; cnt = 0u; mine = 0u;
#pragma unroll 1
        for (unsigned j = 0; j < 16; ++j) { const unsigned c = xb_ld(&bar[XB_XCNT(j)]); sum += c; cnt += (c > 0u) ? 1u : 0u; mine = (j == x) ? c : mine; }
        if (sum == G) break;
        __builtin_amdgcn_s_sleep(1);
        if ((++sp & 255u) == 0u) { if (xb_ld(&bar[XB_TMO])) break; if (sp > XB_SPIN_CAP) { atomicAdd(&bar[XB_TMO], 1u); break; } }
    }
    nloc = mine > 0u ? mine : 1u; nx = cnt > 0u ? cnt : 1u;
}
__device__ __forceinline__ void xcd_barrier(const XcdBarrier& b) {
    asm volatile("s_waitcnt vmcnt(0)" ::: "memory");
    __syncthreads();
    if (threadIdx.x == 0) {
        unsigned* bar = b.bar;
        __builtin_amdgcn_s_waitcnt(0);
        unsigned nloc = b.st[0], nx = b.st[1];
        if (nloc == 0u) { xcd_barrier_complete(bar, b.x, nloc, nx); b.st[0] = nloc; b.st[1] = nx; }
        const unsigned old = xb_add(&bar[XB_XSUB(b.x)], 1u);
        const unsigned gen = old / nloc;
        if (old + 1u == (gen + 1u) * nloc) {
            __builtin_amdgcn_fence(__ATOMIC_RELEASE, "agent");
            asm volatile("s_waitcnt vmcnt(0)" ::: "memory");
            const unsigned og = xb_add(&bar[XB_TOP], 1u);
            const unsigned tg = og / nx;
            if (og + 1u == (tg + 1u) * nx) xb_add(&bar[XB_TOPGEN], 1u);
            else XB_SPIN(xb_ld(&bar[XB_TOPGEN]) == tg, bar);
            __builtin_amdgcn_fence(__ATOMIC_ACQUIRE, "agent");
            xb_add(&bar[XB_XGEN(b.x)], 1u);
            asm volatile("s_waitcnt vmcnt(0)" ::: "memory");
        } else {
            XB_SPIN(xb_ld(&bar[XB_XGEN(b.x)]) == gen, bar);
            __builtin_amdgcn_fence(__ATOMIC_ACQUIRE, "agent");
            asm volatile("s_waitcnt vmcnt(0)" ::: "memory");
        }
    }
    __syncthreads();
}

namespace pg8 {
constexpr int BM = 256, BK = 64, HALF = 128, HTB = HALF * BK * 2, STAGE_BYTES = 8 * HTB, NXCD = 8, WGM = 8;
__host__ __device__ __forceinline__ int lds_byte(int r, int c) { return r * 128 + ((((c >> 3) ^ (r >> 1)) & 7) << 4) + (c & 7) * 2; }
__host__ __device__ __forceinline__ void stage_rc(int b, int& R, int& C) { R = b >> 7; C = ((((b >> 4) & 7) ^ (R >> 1)) & 7) * 8; }
__host__ __device__ __forceinline__ int perm32(int rho) { const int n = rho >> 4, i = rho & 15; return 8 * (i >> 2) + 4 * n + (i & 3); }
struct Unit { int pm, pn, pb; };
struct Gemm { const bf16_t* A; const bf16_t* Bt; int K; unsigned kstepA; };

struct StaticOrder {
    static constexpr bool GATHER_DMA = false;
    int nM, nN, nwg, G, c; unsigned ldaB;
    __device__ void init(int M, int N, int G_, int c_, int lda) { nM = M / BM; nN = N / BM; nwg = nM * nN; G = G_; c = c_; ldaB = (unsigned)lda * 2u; }
    __device__ bool next(int i, Unit& u) const {
        const long L = (long)i * G + c; if (L >= nwg) return false;
        int wgid = (int)L; { const int q = nwg / NXCD, r = nwg % NXCD, xcd = wgid % NXCD, off = wgid / NXCD; wgid = (xcd < r ? xcd * (q + 1) : r * (q + 1) + (xcd - r) * q) + off; }
        const int nig = WGM * nN, gid = wgid / nig, fm = gid * WGM, gsz = (nM - fm) < WGM ? (nM - fm) : WGM;
        u.pm = fm + ((wgid % nig) % gsz); u.pn = (wgid % nig) / gsz; u.pb = u.pn; return true;
    }
    __device__ __forceinline__ unsigned arow(const Unit& u, int r) const { return (unsigned)(u.pm * BM + r) * ldaB; }
};

typedef int v4i_t __attribute__((ext_vector_type(4)));
typedef int v8i_t __attribute__((ext_vector_type(8)));
__device__ __forceinline__ v8i_t cat8(bf16x8 a, bf16x8 b) { const v4i_t x = __builtin_bit_cast(v4i_t, a), y = __builtin_bit_cast(v4i_t, b); return (v8i_t){x[0], x[1], x[2], x[3], y[0], y[1], y[2], y[3]}; }
template <class Epi, class Sched, bool FP8 = false>
__device__ __forceinline__ void gemm_phase(LAS unsigned char* lds, const Gemm g, const Sched& S, const Epi& E, const int tid) {
    const int wid = __builtin_amdgcn_readfirstlane(tid >> 6), lane = tid & 63, wr = wid >> 2, wc = wid & 3, fr = lane & 15, fq = lane >> 4;
    constexpr int ESZ = FP8 ? 1 : 2;
    const int K = g.K, nt = K * ESZ / 128;
    int Rr[2], Cc[2]; unsigned voffB[2];
#pragma unroll
    for (int i = 0; i < 2; ++i) stage_rc(tid * 16 + i * 8192, Rr[i], Cc[i]);
    { const int Rb = Epi::PERM ? ((Rr[0] & ~31) + perm32(Rr[0] & 31)) : Rr[0]; voffB[0] = (unsigned)(Rb * K * ESZ + Cc[0] * 2); }
    voffB[1] = voffB[0] + (unsigned)(64 * K * ESZ);
    const size_t kstepB = (size_t)(BK * 2), kstepA = (size_t)g.kstepA;
    const size_t hstepB = (size_t)HALF * K * ESZ, tstepB = 2 * hstepB;
    const unsigned ldsw = (unsigned)wid * 1024u;
    const int aoff = lds_byte(wr * 64 + fr, fq * 8), boff = lds_byte(wc * 32 + fr, fq * 8);
#define PG8_SA(b, h) (((b) * 2 + (h)) * HTB)
#define PG8_SB(b, h) ((4 + (b) * 2 + (h)) * HTB)
#define PG8_STAGE(bufoff, gbase, voff) do { _Pragma("unroll") for (int _i = 0; _i < 2; ++_i) \
        __builtin_amdgcn_global_load_lds((const unsigned*)((const char*)(gbase) + (voff)[_i]), (LAS unsigned*)(lds + (bufoff) + ldsw + _i * 8192), 16, 0, 0); } while (0)
#define PG8_STAGEB(bufoff, gbase) do { const char* gb_ = (const char*)(gbase); asm volatile("" : "+s"(gb_));        \
        _Pragma("unroll") for (int _i = 0; _i < 2; ++_i) \
        __builtin_amdgcn_global_load_lds((const unsigned*)(gb_ + voffB[_i]), (LAS unsigned*)(lds + (bufoff) + ldsw + _i * 8192), 16, 0, 0); } while (0)
#define PG8_LDA(dst, b, h) do { int aoff1 = aoff; asm volatile("" : "+v"(aoff1)); aoff1 ^= 64; _Pragma("unroll") for (int m = 0; m < 4; ++m) { const bf16x8 x0_ = *(const LAS bf16x8*)(lds + PG8_SA(b, h) + aoff + m * 2048), x1_ = *(const LAS bf16x8*)(lds + PG8_SA(b, h) + aoff1 + m * 2048); \
        if constexpr (FP8) dst##8[m] = cat8(x0_, x1_); else { dst[m][0] = x0_; dst[m][1] = x1_; } } } while (0)
#define PG8_LDB(dst, b, h) do { int boff1 = boff; asm volatile("" : "+v"(boff1)); boff1 ^= 64; _Pragma("unroll") for (int n = 0; n < 2; ++n) { const bf16x8 x0_ = *(const LAS bf16x8*)(lds + PG8_SB(b, h) + boff + n * 2048), x1_ = *(const LAS bf16x8*)(lds + PG8_SB(b, h) + boff1 + n * 2048); \
        if constexpr (FP8) dst##8[n] = cat8(x0_, x1_); else { dst[n][0] = x0_; dst[n][1] = x1_; } } } while (0)
#define PG8_MMA(ai, bj, At, Bt) do { __builtin_amdgcn_s_setprio(1); _Pragma("unroll") for (int m = 0; m < 4; ++m) _Pragma("unroll") for (int n = 0; n < 2; ++n) { \
        if constexpr (FP8) acc[ai][bj][m][n] = __builtin_amdgcn_mfma_scale_f32_16x16x128_f8f6f4(Bt##8[n], At##8[m], acc[ai][bj][m][n], 0, 0, 0, 0, 0, 0); \
        else { _Pragma("unroll") for (int k = 0; k < 2; ++k) acc[ai][bj][m][n] = __builtin_amdgcn_mfma_f32_16x16x32_bf16(Bt[n][k], At[m][k], acc[ai][bj][m][n], 0, 0, 0); } } \
        __builtin_amdgcn_s_setprio(0); } while (0)
#define PG8_WAIT_V(n) asm volatile("s_waitcnt vmcnt(" #n ")" ::: "memory")
#define PG8_WAIT_L(n) asm volatile("s_waitcnt lgkmcnt(" #n ")" ::: "memory")
#define PG8_BAR __builtin_amdgcn_s_barrier()
#define PG8_SCHED __builtin_amdgcn_sched_barrier(0)
    Unit cur, nxt; int ui = 0;
    if (!S.next(0, cur)) return;
    f32x4 acc[2][2][4][2];
    bf16x8 At[4][2], B0[2][2], B1[2][2]; v8i_t At8[4], B08[2], B18[2];
    (void)At; (void)B0; (void)B1; (void)At8; (void)B08; (void)B18;
    unsigned vc0[2], vc1[2];
#define TIDNOW (wid * 64 + lane_now())
#define stash ((LAS u32x4*)(lds + 133120 + TIDNOW * 16))
#pragma unroll
    for (int i = 0; i < 2; ++i) { vc0[i] = S.arow(cur, Rr[i]) + (unsigned)Cc[i] * 2u; vc1[i] = S.arow(cur, HALF + Rr[i]) + (unsigned)Cc[i] * 2u; }
    const char* const Ab = (const char*)g.A;
    const char* cB = (const char*)g.Bt + (size_t)cur.pb * tstepB;
    PG8_STAGEB(PG8_SB(0, 0), cB); PG8_STAGEB(PG8_SB(0, 1), cB + hstepB); PG8_STAGE(PG8_SA(0, 0), Ab, vc0); PG8_STAGE(PG8_SA(0, 1), Ab, vc1);
    if (wr == 1) PG8_BAR;
    PG8_WAIT_V(2); PG8_BAR;
    PG8_STAGEB(PG8_SB(1, 0), cB + kstepB); PG8_STAGE(PG8_SA(1, 0), Ab + kstepA, vc0); PG8_STAGEB(PG8_SB(1, 1), cB + hstepB + kstepB);
    PG8_WAIT_V(6); PG8_BAR;
    PG8_SCHED;
#pragma unroll
    for (int a = 0; a < 2; ++a)
#pragma unroll
        for (int b = 0; b < 2; ++b)
#pragma unroll
            for (int m = 0; m < 4; ++m)
#pragma unroll
                for (int n = 0; n < 2; ++n) acc[a][b][m][n] = (f32x4){0.f, 0.f, 0.f, 0.f};
    for (;;) {
        const bool has_next = S.next(ui + 1, nxt);
        if (!has_next) nxt = cur;
        if constexpr (Sched::GATHER_DMA) {
            const int t2 = TIDNOW; int R0, C0, R1, C1; stage_rc(t2 * 16, R0, C0); stage_rc(t2 * 16 + 8192, R1, C1);
            LAS unsigned* sraw = (LAS unsigned*)(lds + 133120) + wid * 64;
            __builtin_amdgcn_global_load_lds((const unsigned*)S.aentry(nxt, R0), sraw, 4, 0, 0);
            __builtin_amdgcn_global_load_lds((const unsigned*)S.aentry(nxt, R1), sraw + 512, 4, 0, 0);
            __builtin_amdgcn_global_load_lds((const unsigned*)S.aentry(nxt, HALF + R0), sraw + 1024, 4, 0, 0);
            __builtin_amdgcn_global_load_lds((const unsigned*)S.aentry(nxt, HALF + R1), sraw + 1536, 4, 0, 0);
        } else {
          const int t2 = TIDNOW; int R0, C0, R1, C1; stage_rc(t2 * 16, R0, C0); stage_rc(t2 * 16 + 8192, R1, C1);
          u32x4 sv; sv.x = S.arow(nxt, R0) + (unsigned)C0 * 2u; sv.y = S.arow(nxt, R1) + (unsigned)C1 * 2u; sv.z = S.arow(nxt, HALF + R0) + (unsigned)C0 * 2u; sv.w = S.arow(nxt, HALF + R1) + (unsigned)C1 * 2u; *stash = sv; }
        const char* nB = (const char*)g.Bt + (size_t)nxt.pb * tstepB;
        for (int t = 0; t < nt; t += 2) {
            const bool last = (t == nt - 2);
            const char* a1 = Ab + (size_t)(t + 1) * kstepA;
            const char* a2 = last ? Ab : Ab + (size_t)(t + 2) * kstepA; const char* b2 = last ? nB : cB + (size_t)(t + 2) * kstepB;
            const char* a3 = a2 + kstepA; const char* b3 = b2 + kstepB;
            PG8_LDB(B0, 0, 0); PG8_LDB(B1, 0, 1); PG8_SCHED; PG8_LDA(At, 0, 0); PG8_STAGE(PG8_SA(1, 1), a1, vc1);
            if (last) {
                if constexpr (Sched::GATHER_DMA) { const int t2 = TIDNOW; int R0, C0, R1, C1; stage_rc(t2 * 16, R0, C0); stage_rc(t2 * 16 + 8192, R1, C1);
                    const LAS int* sr = (const LAS int*)(lds + 133120) + t2;
                    vc0[0] = S.afinish(nxt, R0, sr[0]) + (unsigned)C0 * 2u; vc0[1] = S.afinish(nxt, R1, sr[512]) + (unsigned)C1 * 2u;
                    vc1[0] = S.afinish(nxt, HALF + R0, sr[1024]) + (unsigned)C0 * 2u; vc1[1] = S.afinish(nxt, HALF + R1, sr[1536]) + (unsigned)C1 * 2u; }
                else { const u32x4 sv = *stash; vc0[0] = sv.x; vc0[1] = sv.y; vc1[0] = sv.z; vc1[1] = sv.w; } }
            PG8_WAIT_V(8); PG8_WAIT_L(0); PG8_BAR; PG8_MMA(0, 0, At, B0); PG8_MMA(0, 1, At, B1); PG8_BAR; PG8_SCHED;
            PG8_LDA(At, 0, 1); PG8_STAGEB(PG8_SB(0, 0), b2); PG8_STAGEB(PG8_SB(0, 1), b2 + hstepB); PG8_STAGE(PG8_SA(0, 0), a2, vc0);
            PG8_WAIT_V(8); PG8_WAIT_L(0); PG8_BAR; PG8_MMA(1, 0, At, B0); PG8_MMA(1, 1, At, B1); PG8_BAR; PG8_SCHED;
            PG8_LDB(B0, 1, 0); PG8_LDB(B1, 1, 1); PG8_SCHED; PG8_LDA(At, 1, 0); PG8_STAGE(PG8_SA(0, 1), a2, vc1);
            PG8_WAIT_V(8); PG8_WAIT_L(0); PG8_BAR; PG8_MMA(0, 0, At, B0); PG8_MMA(0, 1, At, B1); PG8_BAR; PG8_SCHED;
            PG8_LDA(At, 1, 1); PG8_STAGEB(PG8_SB(1, 0), b3); PG8_STAGEB(PG8_SB(1, 1), b3 + hstepB); PG8_STAGE(PG8_SA(1, 0), a3, vc0);
            PG8_WAIT_V(8); PG8_WAIT_L(0); PG8_BAR; PG8_MMA(1, 0, At, B0); PG8_MMA(1, 1, At, B1); PG8_BAR; PG8_SCHED;
        }
        if (wr == 0) PG8_BAR;
        { const int te = lane_now(); const int fr_e = te & 15, fq_e = (te >> 4) & 3; E(acc, cur, wr, wc, fr_e, fq_e);
#if EPIDUP
          if constexpr (Epi::DUPID & EPIDUP) { int t3 = tid; asm volatile("" : "+v"(t3)); E(acc, cur, wr, wc, t3 & 15, (t3 >> 4) & 3); }
#endif
        }
        if (!has_next) break;
#pragma unroll
        for (int a = 0; a < 2; ++a)
#pragma unroll
            for (int b = 0; b < 2; ++b)
#pragma unroll
                for (int m = 0; m < 4; ++m)
#pragma unroll
                    for (int n = 0; n < 2; ++n) acc[a][b][m][n] = (f32x4){0.f, 0.f, 0.f, 0.f};
        cur = nxt; cB = nB; ++ui;
        if (wr == 1) PG8_BAR;
    }
    PG8_WAIT_V(0);
    PG8_BAR;
#undef stash
#undef TIDNOW
#undef PG8_SA
#undef PG8_SB
#undef PG8_STAGE
#undef PG8_STAGEB
#undef PG8_LDA
#undef PG8_LDB
#undef PG8_MMA
#undef PG8_WAIT_V
#undef PG8_WAIT_L
#undef PG8_BAR
#undef PG8_SCHED
}
}

typedef f32x4 Acc[2][2][4][2];
__device__ __forceinline__ unsigned pk_fp8x4(float a, float b, float c, float d) { int w = 0; w = __builtin_amdgcn_cvt_pk_fp8_f32(a, b, w, false); w = __builtin_amdgcn_cvt_pk_fp8_f32(c, d, w, true); return (unsigned)w; }
__device__ __forceinline__ void st_bf4(bf16_t* p, f32x4 v) { u32x2 w; w.x = pk2(v[0], v[1]); w.y = pk2(v[2], v[3]); *(u32x2*)p = w; }
__device__ __forceinline__ void st_bf4x2(bf16_t* base, int cA, int cB, int fq, f32x4 A, f32x4 B) {
    unsigned ax = pk2(A[0], A[1]), ay = pk2(A[2], A[3]), bx = pk2(B[0], B[1]), by = pk2(B[2], B[3]);
    { auto r = __builtin_amdgcn_permlane16_swap(ax, bx, false, false); ax = r[0]; bx = r[1]; }
    { auto r = __builtin_amdgcn_permlane16_swap(ay, by, false, false); ay = r[0]; by = r[1]; }
    *(u32x4*)(base + ((fq & 1) ? cB + 4 * (fq - 1) : cA + 4 * fq)) = (u32x4){ax, ay, bx, by};
}

__device__ __forceinline__ void ld_bf8(const bf16_t* p, f32x4& a, f32x4& b) { const u32x4 w = *(const u32x4*)p; a = (f32x4){bflo(w.x), bfhi(w.x), bflo(w.y), bfhi(w.y)}; b = (f32x4){bflo(w.z), bfhi(w.z), bflo(w.w), bfhi(w.w)}; }
__device__ __forceinline__ void st_bf8(bf16_t* p, f32x4 a, f32x4 b) { u32x4 w; w.x = pk2(a[0], a[1]); w.y = pk2(a[2], a[3]); w.z = pk2(b[0], b[1]); w.w = pk2(b[2], b[3]); *(u32x4*)p = w; }

struct EpiInProj {
    static constexpr bool PERM = false; static constexpr int DUPID = 1;
    bf16_t* proj; bf16_t* qr; float* gates; const float* cos32; const float* sin32; const float* cos16; const float* sin16;
    __device__ __forceinline__ void operator()(const Acc& acc, const pg8::Unit& u, int wr, int wc, int fr, int fq) const {
        const int pn = u.pn, a = wc & 1;
        int mode[2]; float sc[2];
#pragma unroll
        for (int bj = 0; bj < 2; ++bj) { const int blk = (128 * bj + 32 * wc) >> 6; int md = 0; float s = 1.f;
            if (pn == 0) s = QS64;
            else if (pn == 3) { md = 1; s = QS32; }
            else if (pn == 4) md = 1;
            else if (pn == 6) { md = 2; s = QS64; }
            else if (pn == 7) md = 2;
            else if (pn == 9) { md = 3; s = QS64; }
            else if (pn == 10) md = (blk == 2) ? 2 : 0;
            else if (pn == 11) md = (blk == 0) ? 2 : (blk == 1) ? 0 : (blk == 2 && a == 0) ? 4 : 5;
            mode[bj] = md; sc[bj] = s; }
        const bool r16 = (mode[0] == 1), r32 = (mode[0] == 2 || mode[0] == 3 || mode[1] == 2 || mode[1] == 3);
        f32x4 cv[8], sv[8];
        if (r16 || r32) {
            const float* tc = r16 ? cos16 + 4 * fq : cos32 + 16 * a + 4 * fq; const float* ts = r16 ? sin16 + 4 * fq : sin32 + 16 * a + 4 * fq; const int st = r16 ? 16 : 32;
#pragma unroll
            for (int q = 0; q < 8; ++q) { const size_t row = (size_t)(u.pm * 256 + (q >> 2) * 128 + wr * 64 + (q & 3) * 16 + fr); cv[q] = *(const f32x4*)(tc + row * st); sv[q] = *(const f32x4*)(ts + row * st); }
        } else {
#pragma unroll
            for (int q = 0; q < 8; ++q) { cv[q] = (f32x4){1.f, 1.f, 1.f, 1.f}; sv[q] = (f32x4){0.f, 0.f, 0.f, 0.f}; }
        }
#pragma unroll
        for (int ai = 0; ai < 2; ++ai)
#pragma unroll
            for (int m = 0; m < 4; ++m) {
                const int row = u.pm * 256 + ai * 128 + wr * 64 + m * 16 + fr;
                bf16_t* prow = proj + (size_t)row * NINP + pn * 256;
                const f32x4 c = cv[ai * 4 + m], s = sv[ai * 4 + m];
#pragma unroll
                for (int bj = 0; bj < 2; ++bj) {
                    const f32x4 v0 = acc[ai][bj][m][0], v1 = acc[ai][bj][m][1];
                    const int cb = 128 * bj + 32 * wc, blk = cb >> 6, md = mode[bj]; const float scl = sc[bj];
                    if (md == 0) st_bf4x2(prow, cb, cb + 16, fq, v0 * scl, v1 * scl);
                    else if (md == 1) st_bf4x2(prow, cb, cb + 16, fq, (v0 * c - v1 * s) * scl, (v1 * c + v0 * s) * scl);
                    else if (md == 2 || md == 3) {
                        const f32x4 o0 = (v0 * c - v1 * s) * scl, o1 = (v1 * c + v0 * s) * scl;
                        const int lc0 = 64 * blk + 16 * a;
                        if (md == 2) st_bf4x2(prow, lc0, lc0 + 32, fq, o0, o1);
                        else { st_bf4x2(prow, lc0, lc0 + 32, fq, v0 * scl, v1 * scl); st_bf4x2(qr + (size_t)row * 256, lc0, lc0 + 32, fq, o0, o1); }
                    } else if (md == 4) {
                        if (fq < 3) { f32x4 g; g[0] = sigmoidf_(v0[0]); g[1] = sigmoidf_(v0[1]); g[2] = sigmoidf_(v0[2]); g[3] = sigmoidf_(v0[3]); *(f32x4*)(gates + (size_t)row * 12 + 4 * fq) = g; }
                    }
                }
            }
    }
};
struct EpiPresum {
    static constexpr bool PERM = true; static constexpr int DUPID = 2;
    const float* base32; const bf16_t* base16; bf16_t* ps;
    __device__ __forceinline__ void operator()(const Acc& acc, const pg8::Unit& u, int wr, int wc, int fr, int fq) const {
#pragma unroll
        for (int ai = 0; ai < 2; ++ai)
#pragma unroll
            for (int m = 0; m < 4; ++m) {
                const size_t off = (size_t)(u.pm * 256 + ai * 128 + wr * 64 + m * 16 + fr) * DM + u.pn * 256 + wc * 32 + 8 * fq;
#pragma unroll
                for (int bj = 0; bj < 2; ++bj) { const size_t o = off + bj * 128; f32x4 b0, b1;
                    if (base32) { b0 = *(const f32x4*)(base32 + o); b1 = *(const f32x4*)(base32 + o + 4); } else ld_bf8(base16 + o, b0, b1);
                    st_bf8(ps + o, b0 * ALPHA + acc[ai][bj][m][0], b1 * ALPHA + acc[ai][bj][m][1]); }
            }
    }
};
struct EpiBf16 {
    static constexpr bool PERM = true; static constexpr int DUPID = 4;
    bf16_t* O; int ldc;
    __device__ __forceinline__ void operator()(const Acc& acc, const pg8::Unit& u, int wr, int wc, int fr, int fq) const {
#pragma unroll
        for (int ai = 0; ai < 2; ++ai)
#pragma unroll
            for (int m = 0; m < 4; ++m) {
                bf16_t* rowp = O + (size_t)(u.pm * 256 + ai * 128 + wr * 64 + m * 16 + fr) * ldc + u.pn * 256 + wc * 32 + 8 * fq;
#pragma unroll
                for (int bj = 0; bj < 2; ++bj) { const f32x4 v0 = acc[ai][bj][m][0], v1 = acc[ai][bj][m][1]; u32x4 w; w.x = pk2(v0[0], v0[1]); w.y = pk2(v0[2], v0[3]); w.z = pk2(v1[0], v1[1]); w.w = pk2(v1[2], v1[3]); *(u32x4*)(rowp + bj * 128) = w; }
            }
    }
};
struct EpiCmp {
    static constexpr bool PERM = false; static constexpr int DUPID = 8;
    bf16_t* uv;
    __device__ __forceinline__ void operator()(const Acc& acc, const pg8::Unit& u, int wr, int wc, int fr, int fq) const {
        const int kv = u.pb >> 1, half = u.pb & 1;
#pragma unroll
        for (int ai = 0; ai < 2; ++ai)
#pragma unroll
            for (int m = 0; m < 4; ++m) {
                bf16_t* rowp = uv + ((size_t)kv * 2048 + (u.pm * 256 + ai * 128 + wr * 64 + m * 16 + fr)) * 512 + half * 256 + wc * 32 + 4 * fq;
#pragma unroll
                for (int bj = 0; bj < 2; ++bj)
#pragma unroll
                    for (int n = 0; n < 2; ++n) st_bf4(rowp + bj * 128 + n * 16, acc[ai][bj][m][n]);
            }
    }
};
struct EpiSwiglu {
    static constexpr bool PERM = true; static constexpr int DUPID = 16;
    unsigned char* H; int row0; float sc;
    static __device__ __forceinline__ float swg(float a, float b, float c0, float c1) { return (a * b) * __builtin_amdgcn_rcpf(__builtin_fmaf(ex2(a * c0), c1, c1)); }
    __device__ __forceinline__ void operator()(const Acc& acc, const pg8::Unit& u, int wr, int wc, int fr, int fq) const {
        const float c0 = -sc * LOG2E, c1 = 1.f / (8.f * sc * sc);
#pragma unroll
        for (int ai = 0; ai < 2; ++ai)
#pragma unroll
            for (int bj = 0; bj < 2; ++bj) {
                unsigned D[4];
#pragma unroll
                for (int m = 0; m < 4; ++m) { const f32x4 v0 = acc[ai][bj][m][0], v1 = acc[ai][bj][m][1];
                    D[m] = pk_fp8x4(swg(v0[0], v0[1], c0, c1), swg(v0[2], v0[3], c0, c1), swg(v1[0], v1[1], c0, c1), swg(v1[2], v1[3], c0, c1)); }
                { auto r = __builtin_amdgcn_permlane32_swap(D[0], D[2], false, false); D[0] = r[0]; D[2] = r[1]; }
                { auto r = __builtin_amdgcn_permlane32_swap(D[1], D[3], false, false); D[1] = r[0]; D[3] = r[1]; }
                { auto r = __builtin_amdgcn_permlane16_swap(D[0], D[1], false, false); D[0] = r[0]; D[1] = r[1]; }
                { auto r = __builtin_amdgcn_permlane16_swap(D[2], D[3], false, false); D[2] = r[0]; D[3] = r[1]; }
                unsigned char* rowp = H + (size_t)((u.pm - row0) * 256 + ai * 128 + wr * 64 + fq * 16 + fr) * DFF + u.pn * 128 + wc * 16 + bj * 64;
                *(u32x4*)rowp = (u32x4){D[0], D[1], D[2], D[3]};
            }
    }
};

namespace att {
constexpr int NS = 4, SLOT = 8192, L_K = 0, L_V = NS * SLOT, L_X = 2 * NS * SLOT;
typedef short v4i16_t __attribute__((ext_vector_type(4)));
struct KVp { const bf16_t* K; const bf16_t* V; int pk, pv; };
__device__ __forceinline__ void glds16(const void* gsrc, unsigned lds_dst) { unsigned keep;
    asm volatile("s_mov_b32 %0, m0\n\ts_mov_b32 m0, %2\n\ts_nop 0\n\tglobal_load_lds_dwordx4 %1, off\n\ts_mov_b32 m0, %0" : "=&s"(keep) : "v"(gsrc), "s"(lds_dst) : "memory"); }
#define ATT_WAIT_BAR(N) asm volatile("s_waitcnt vmcnt(" #N ") lgkmcnt(0)\n\ts_barrier" ::: "memory")
struct Ring { const bf16_t* ks; const bf16_t* vs; unsigned kd, vd; int pk, pv; };
__device__ __forceinline__ Ring ring_init(LAS unsigned char* lds, const KVp& p, int wid, int lane) {
    const int kkey = 8 * wid + (lane >> 3);
    Ring r; r.ks = p.K + (size_t)kkey * p.pk + (((lane & 7) ^ (kkey >> 1)) & 7) * 8; r.vs = p.V + (size_t)kkey * p.pv + (((lane & 7) ^ (((kkey >> 1) & 1) << 2)) & 7) * 8;
    const unsigned l0 = (unsigned)(size_t)lds; r.kd = l0 + L_K + wid * 1024; r.vd = l0 + L_V + wid * 1024; r.pk = p.pk; r.pv = p.pv; return r;
}
__device__ __forceinline__ void ring_issue(const Ring& r, int jt, int slot) {
    glds16(r.ks + (size_t)jt * 64 * r.pk, (unsigned)__builtin_amdgcn_readfirstlane((int)(r.kd + slot * SLOT)));
    glds16(r.vs + (size_t)jt * 64 * r.pv, (unsigned)__builtin_amdgcn_readfirstlane((int)(r.vd + slot * SLOT)));
}
__device__ __forceinline__ void ring_issue_k(const Ring& r, int jt, int slot) { glds16(r.ks + (size_t)jt * 64 * r.pk, (unsigned)__builtin_amdgcn_readfirstlane((int)(r.kd + slot * SLOT))); }
__device__ __forceinline__ void ring_issue_v(const Ring& r, int jt, int slot) { glds16(r.vs + (size_t)jt * 64 * r.pv, (unsigned)__builtin_amdgcn_readfirstlane((int)(r.vd + slot * SLOT))); }
__device__ __forceinline__ void ring_drain() { asm volatile("s_waitcnt vmcnt(0) lgkmcnt(0)\n\ts_barrier" ::: "memory"); }
__device__ __forceinline__ f32x16 zero16() { f32x16 z;
#pragma unroll
    for (int r = 0; r < 16; ++r) z[r] = 0.f;
    return z; }
__device__ __forceinline__ f32x16 mfma32(bf16x8 a, bf16x8 b, f32x16 c) { return __builtin_amdgcn_mfma_f32_32x32x16_bf16(a, b, c, 0, 0, 0); }
__device__ __forceinline__ int crow(int r, int hi) { return (r & 3) + 8 * (r >> 2) + 4 * hi; }
__device__ __forceinline__ unsigned kfrag_base(int r32, int hi) { return (unsigned)(r32 * 128 + (((hi ^ (r32 >> 1)) & 7) << 4)); }
template <int D0, int D1> __device__ __forceinline__ void qk(f32x16& p0, f32x16& p1, const LAS unsigned char* Ks, const bf16x8 (&qf)[4], int hi, int r32) {
    const unsigned kb = kfrag_base(r32, hi);
    p0 = zero16(); p1 = zero16();
#pragma unroll
    for (int d0 = D0; d0 < D1; ++d0) {
        const bf16x8 b0 = *(const LAS bf16x8*)(Ks + (kb ^ ((2 * d0) << 4))), b1 = *(const LAS bf16x8*)(Ks + (kb ^ ((2 * d0) << 4)) + 4096);
        p0 = mfma32(b0, qf[d0], p0); p1 = mfma32(b1, qf[d0], p1);
    }
}
__device__ __forceinline__ s16x4 vtr(const LAS unsigned char* p) { return __builtin_bit_cast(s16x4, __builtin_amdgcn_ds_read_tr16_b64_v4i16((LAS v4i16_t*)p)); }
__device__ __forceinline__ unsigned vbase(int lane, int hi) { const int b = (lane & 15) >> 2; return (unsigned)((4 * hi + b) * 128 + ((lane >> 4) & 1) * 32 + (lane & 3) * 8 + ((b >> 1) & 1) * 64); }
__device__ __forceinline__ void pv(f32x16 (&o)[2], const LAS unsigned char* Vs, const bf16x8 (&pw)[4], int lane, int hi) {
    const unsigned vb = vbase(lane, hi);
#pragma unroll
    for (int d0 = 0; d0 < 2; ++d0)
#pragma unroll
        for (int ks = 0; ks < 4; ++ks) {
            const s16x4 lo = vtr(Vs + (vb ^ (64 * d0)) + ks * 2048), hh = vtr(Vs + (vb ^ (64 * d0)) + ks * 2048 + 1024);
            const bf16x8 vf = {lo[0], lo[1], lo[2], lo[3], hh[0], hh[1], hh[2], hh[3]};
            o[d0] = mfma32(vf, pw[ks], o[d0]);
        }
}
__device__ __forceinline__ void pack_p(bf16x8 (&pw)[4], const f32x16& p0, const f32x16& p1) {
    u32x4 a, b, c, d;
    a.x = pk2(p0[0], p0[1]); a.y = pk2(p0[2], p0[3]); a.z = pk2(p0[4], p0[5]); a.w = pk2(p0[6], p0[7]);
    b.x = pk2(p0[8], p0[9]); b.y = pk2(p0[10], p0[11]); b.z = pk2(p0[12], p0[13]); b.w = pk2(p0[14], p0[15]);
    c.x = pk2(p1[0], p1[1]); c.y = pk2(p1[2], p1[3]); c.z = pk2(p1[4], p1[5]); c.w = pk2(p1[6], p1[7]);
    d.x = pk2(p1[8], p1[9]); d.y = pk2(p1[10], p1[11]); d.z = pk2(p1[12], p1[13]); d.w = pk2(p1[14], p1[15]);
    pw[0] = __builtin_bit_cast(bf16x8, a); pw[1] = __builtin_bit_cast(bf16x8, b); pw[2] = __builtin_bit_cast(bf16x8, c); pw[3] = __builtin_bit_cast(bf16x8, d);
}
__device__ __forceinline__ float max3f(float a, float b, float c) { return fmaxf(fmaxf(a, b), c); }
__device__ __forceinline__ void osm3(f32x16& p0, f32x16& p1, float& m, bool& seen, float& l, f32x16 (&o)[2], bf16x8 (&pw)[4], const bool rowsel) {
    float mx = max3f(p0[0], p1[0], p0[1]);
#pragma unroll
    for (int r = 1; r < 15; r += 2) { mx = max3f(mx, p1[r], p0[r + 1]); mx = fmaxf(mx, p1[r + 1]); }
    mx = fmaxf(mx, p1[15]);
    mx = rowsel ? mx : -INFINITY;
    mx = fmaxf(mx, xhalf(mx));
    const bool fin = mx > -INFINITY;
    const bool need = fin && ((mx > m + 8.f) || (!seen && mx < m - 8.f));
    if (__any(need)) { const float mn = need ? mx : m, sc = (seen && need) ? ex2(m - mn) : 1.f; m = mn; l *= sc; o[0] *= sc; o[1] *= sc; }
    seen = seen || fin;
    if (__any(m != 0.f)) {
#pragma unroll
        for (int r = 0; r < 16; ++r) { p0[r] -= m; p1[r] -= m; }
    }
    f32x2 s2 = {0.f, 0.f};
#pragma unroll
    for (int r = 0; r < 16; ++r) { p0[r] = ex2(p0[r]); p1[r] = ex2(p1[r]); s2 += (f32x2){p0[r], p1[r]}; }
    l += rowsel ? (s2[0] + s2[1]) : 0.f;
    pack_p(pw, p0, p1);
    if (!__all(rowsel)) {
#pragma unroll
        for (int k = 0; k < 4; ++k) { u32x4 w = __builtin_bit_cast(u32x4, pw[k]); w.x = rowsel ? w.x : 0u; w.y = rowsel ? w.y : 0u; w.z = rowsel ? w.z : 0u; w.w = rowsel ? w.w : 0u; pw[k] = __builtin_bit_cast(bf16x8, w); }
    }
}
__device__ __forceinline__ void osm_pre(f32x16& p0, f32x16& p1, float& m, bool& seen, float& l, f32x16 (&o)[2]) {
    float mx = max3f(p0[0], p1[0], p0[1]);
#pragma unroll
    for (int r = 1; r < 15; r += 2) { mx = max3f(mx, p1[r], p0[r + 1]); mx = fmaxf(mx, p1[r + 1]); }
    mx = fmaxf(mx, p1[15]);
    mx = fmaxf(mx, xhalf(mx));
    const bool fin = mx > -INFINITY;
    const bool need = fin && ((mx > m + 8.f) || (!seen && mx < m - 8.f));
    if (__any(need)) { const float mn = need ? mx : m, sc = (seen && need) ? ex2(m - mn) : 1.f; m = mn; l *= sc; o[0] *= sc; o[1] *= sc; }
    seen = seen || fin;
    if (__any(m != 0.f)) {
#pragma unroll
        for (int r = 0; r < 16; ++r) { p0[r] -= m; p1[r] -= m; }
    }
}
__device__ __forceinline__ void osm_exp(f32x16& p0, f32x16& p1, float& l, bf16x8 (&pw)[4]) {
    f32x2 s2 = {0.f, 0.f};
#pragma unroll
    for (int r = 0; r < 16; ++r) { p0[r] = ex2(p0[r]); p1[r] = ex2(p1[r]); s2 += (f32x2){p0[r], p1[r]}; }
    l += s2[0] + s2[1];
    pack_p(pw, p0, p1);
}
typedef int v4i_att __attribute__((ext_vector_type(4)));
__device__ __forceinline__ bf16x8 vfrag(const LAS unsigned char* p) { const s16x4 lo = vtr(p), hh = vtr(p + 1024); return (bf16x8){lo[0], lo[1], lo[2], lo[3], hh[0], hh[1], hh[2], hh[3]}; }
__device__ __forceinline__ void pv_exp(f32x16 (&o)[2], const LAS unsigned char* Vs, bf16x8 (&pw)[4], f32x16& p0, f32x16& p1, float& l, int lane, int hi) {
    const unsigned vb = vbase(lane, hi); const LAS unsigned char* vp = Vs + vb; const LAS unsigned char* vq = Vs + (vb ^ 64u);
    float sa = 0.f, sb = 0.f;
    bf16x8 vf0 = vfrag(vp), vf1 = vfrag(vq);
#pragma unroll
    for (int ks = 0; ks < 4; ++ks) {
        bf16x8 nf0 = vf0, nf1 = vf1;
        if (ks < 3) { nf0 = vfrag(vp + (ks + 1) * 2048); nf1 = vfrag(vq + (ks + 1) * 2048); }
        o[0] = mfma32(vf0, pw[ks], o[0]); o[1] = mfma32(vf1, pw[ks], o[1]);
        float e[8];
#pragma unroll
        for (int i = 0; i < 8; ++i) e[i] = ex2(ks < 2 ? p0[8 * ks + i] : p1[8 * (ks - 2) + i]);
#pragma unroll
        for (int i = 0; i < 4; ++i) { sa += e[2 * i]; sb += e[2 * i + 1]; }
        asm volatile("" : "+v"(sa), "+v"(sb));
        u32x4 w; w.x = pk2(e[0], e[1]); w.y = pk2(e[2], e[3]); w.z = pk2(e[4], e[5]); w.w = pk2(e[6], e[7]);
        pw[ks] = __builtin_bit_cast(bf16x8, w);
        { v4i_att w2 = __builtin_bit_cast(v4i_att, pw[ks]); asm volatile("" : "+v"(w2)); pw[ks] = __builtin_bit_cast(bf16x8, w2); }
        __builtin_amdgcn_sched_barrier(0);
        vf0 = nf0; vf1 = nf1;
    }
    l += sa + sb;
}
template <bool SEL, bool QK>
__device__ __forceinline__ void exp_pv(f32x16 (&o)[2], const LAS unsigned char* Vs, f32x16& p0, f32x16& p1, float& l, const bool rowsel, int lane, int hi,
                                       f32x16& pn0, f32x16& pn1, const LAS unsigned char* Kn, const bf16x8 (&qf)[4]) {
    const unsigned kb = kfrag_base(lane & 31, hi);
    const unsigned vb = vbase(lane, hi); const LAS unsigned char* vp = Vs + vb; const LAS unsigned char* vq = Vs + (vb ^ 64u);
    float sa = 0.f, sb = 0.f;
    bf16x8 vf0 = vfrag(vp), vf1 = vfrag(vq);
#pragma unroll
    for (int ks = 0; ks < 4; ++ks) {
        bf16x8 nf0 = vf0, nf1 = vf1;
        if (ks < 3) { nf0 = vfrag(vp + (ks + 1) * 2048); nf1 = vfrag(vq + (ks + 1) * 2048); }
        float e[8];
#pragma unroll
        for (int i = 0; i < 8; ++i) e[i] = ex2(ks < 2 ? p0[8 * ks + i] : p1[8 * (ks - 2) + i]);
#pragma unroll
        for (int i = 0; i < 4; ++i) { sa += e[2 * i]; sb += e[2 * i + 1]; }
        asm volatile("" : "+v"(sa), "+v"(sb));
        u32x4 w; w.x = pk2(e[0], e[1]); w.y = pk2(e[2], e[3]); w.z = pk2(e[4], e[5]); w.w = pk2(e[6], e[7]);
        if (SEL) { w.x = rowsel ? w.x : 0u; w.y = rowsel ? w.y : 0u; w.z = rowsel ? w.z : 0u; w.w = rowsel ? w.w : 0u; }
        v4i_att w2 = __builtin_bit_cast(v4i_att, w); asm volatile("" : "+v"(w2));
        const bf16x8 pk = __builtin_bit_cast(bf16x8, w2);
        o[0] = mfma32(vf0, pk, o[0]); o[1] = mfma32(vf1, pk, o[1]);
        if constexpr (QK) { const bf16x8 k0 = *(const LAS bf16x8*)(Kn + (kb ^ ((2 * ks) << 4))), k1 = *(const LAS bf16x8*)(Kn + (kb ^ ((2 * ks) << 4)) + 4096);
            pn0 = mfma32(k0, qf[ks], ks == 0 ? zero16() : pn0); pn1 = mfma32(k1, qf[ks], ks == 0 ? zero16() : pn1); }
        __builtin_amdgcn_sched_barrier(0);
        vf0 = nf0; vf1 = nf1;
    }
    l += SEL ? (rowsel ? sa + sb : 0.f) : sa + sb;
}
template <bool QK, bool ONEFORM = false>
__device__ __forceinline__ void osm3f(f32x16& p0, f32x16& p1, float& m, bool& seen, float& l, f32x16 (&o)[2], const LAS unsigned char* Vs, const bool rowsel, int lane, int hi,
                                      f32x16& pn0, f32x16& pn1, const LAS unsigned char* Kn, const bf16x8 (&qf)[4]) {
    float mx = max3f(p0[0], p1[0], p0[1]);
#pragma unroll
    for (int r = 1; r < 15; r += 2) { mx = max3f(mx, p1[r], p0[r + 1]); mx = fmaxf(mx, p1[r + 1]); }
    mx = fmaxf(mx, p1[15]);
    mx = rowsel ? mx : -INFINITY;
    mx = fmaxf(mx, xhalf(mx));
    const bool fin = mx > -INFINITY;
    const bool need = fin && ((mx > m + 8.f) || (!seen && mx < m - 8.f));
    if (__any(need)) { const float mn = need ? mx : m, sc = (seen && need) ? ex2(m - mn) : 1.f; m = mn; l *= sc; o[0] *= sc; o[1] *= sc; }
    seen = seen || fin;
    if (__any(m != 0.f)) {
#pragma unroll
        for (int r = 0; r < 16; ++r) { p0[r] -= m; p1[r] -= m; }
    }
    if constexpr (ONEFORM) exp_pv<true, QK>(o, Vs, p0, p1, l, rowsel, lane, hi, pn0, pn1, Kn, qf);
    else { if (__all(rowsel)) exp_pv<false, QK>(o, Vs, p0, p1, l, true, lane, hi, pn0, pn1, Kn, qf); else exp_pv<true, QK>(o, Vs, p0, p1, l, rowsel, lane, hi, pn0, pn1, Kn, qf); }
}
__device__ __forceinline__ void mask_le(f32x16& p0, f32x16& p1, int lim, int hi) {
    int l2 = lim - 4 * hi; asm volatile("" : "+v"(l2));
#pragma unroll
    for (int r = 0; r < 16; ++r) { const int c = (r & 3) + 8 * (r >> 2); if (c > l2) p0[r] = -INFINITY; if (c + 32 > l2) p1[r] = -INFINITY; }
}
__device__ __forceinline__ void mask_gt(f32x16& p0, f32x16& p1, int lim, int hi) {
    int l2 = lim - 4 * hi; asm volatile("" : "+v"(l2));
#pragma unroll
    for (int r = 0; r < 16; ++r) { const int c = (r & 3) + 8 * (r >> 2); if (c <= l2) p0[r] = -INFINITY; if (c + 32 <= l2) p1[r] = -INFINITY; }
}
__device__ __forceinline__ void mask_all(f32x16& p0, f32x16& p1, bool keep) {
#pragma unroll
    for (int r = 0; r < 16; ++r) { p0[r] = keep ? p0[r] : -INFINITY; p1[r] = keep ? p1[r] : -INFINITY; }
}
__device__ __forceinline__ void store_o(bf16_t* dst, const f32x16 (&o)[2], int hi, const bool valid = true) {
#pragma unroll
    for (int d0 = 0; d0 < 2; ++d0)
#pragma unroll
        for (int g = 0; g < 4; g += 2) {
            unsigned ax = pk2(o[d0][4 * g], o[d0][4 * g + 1]), ay = pk2(o[d0][4 * g + 2], o[d0][4 * g + 3]), bx = pk2(o[d0][4 * g + 4], o[d0][4 * g + 5]), by = pk2(o[d0][4 * g + 6], o[d0][4 * g + 7]);
            { auto r = __builtin_amdgcn_permlane32_swap(ax, bx, false, false); ax = r[0]; bx = r[1]; }
            { auto r = __builtin_amdgcn_permlane32_swap(ay, by, false, false); ay = r[0]; by = r[1]; }
            if (valid) *(u32x4*)(dst + 32 * d0 + 8 * (g + hi)) = (u32x4){ax, ay, bx, by};
        }
}
__device__ __forceinline__ void load_q(bf16x8 (&qf)[4], const bf16_t* qp, int hi) {
#pragma unroll
    for (int d0 = 0; d0 < 4; ++d0) qf[d0] = *(const bf16x8*)(qp + 16 * d0 + 8 * hi);
}

__device__ __forceinline__ void unit_A(LAS unsigned char* lds, const bf16_t* proj, bf16_t* mixed, int b, int h, int qb, int tid, int wid, int lane) {
    const int r32 = lane & 31, hi = lane >> 5;
    const int t = 256 * qb + 32 * wid + r32;
    const size_t rowb = (size_t)b * SEQ;
    bf16x8 qf[4]; load_q(qf, proj + (rowb + t) * NINP + C_AQ + h * 64, hi);
    const KVp kv{proj + rowb * NINP + C_AK + h * 64, proj + rowb * NINP + C_AV + h * 64, NINP, NINP};
    const Ring rg = ring_init(lds, kv, wid, lane);
    f32x16 o[2]; o[0] = zero16(); o[1] = zero16();
    float C = 0.f;
    const int jmax = 4 * qb + 3, tmaxw = 256 * qb + 32 * wid + 31, tminw = tmaxw - 31;
    LAS float* wm = (LAS float*)(lds + L_X);
#pragma unroll
    for (int k = 0; k < NS - 1; ++k) ring_issue(rg, jmax - k > 0 ? jmax - k : 0, k);
    ATT_WAIT_BAR(4);
    for (int it = 0; it <= jmax; ++it) {
        const int jt = jmax - it;
        if (it > 0) { float mx = wm[((it - 1) & 1) * 8];
#pragma unroll
            for (int w = 1; w < 8; ++w) mx = fmaxf(mx, wm[((it - 1) & 1) * 8 + w]);
            if (mx < -100.f) break; }
        { const int jn = jt - (NS - 1); ring_issue(rg, jn > 0 ? jn : 0, (it + NS - 1) % NS); }
        if (64 * jt < tmaxw) {
            f32x16 p0, p1; qk<0, 4>(p0, p1, lds + L_K + (it % NS) * SLOT, qf, hi, r32);
            if (64 * jt + 63 >= tminw) mask_le(p0, p1, t - 1 - 64 * jt, hi);
            float L0[16], L1[16];
#pragma unroll
            for (int r = 0; r < 16; ++r) { const float z0 = p0[r], z1 = p1[r];
                L0[r] = -(fmaxf(z0, 0.f) + lg2(1.f + ex2(-fabsf(z0)))); L1[r] = -(fmaxf(z1, 0.f) + lg2(1.f + ex2(-fabsf(z1)))); }
            float gs[8], og[8];
#pragma unroll
            for (int k = 0; k < 4; ++k) { gs[k] = (L0[4 * k] + L0[4 * k + 1]) + (L0[4 * k + 2] + L0[4 * k + 3]); gs[4 + k] = (L1[4 * k] + L1[4 * k + 1]) + (L1[4 * k + 2] + L1[4 * k + 3]); }
#pragma unroll
            for (int k = 0; k < 8; ++k) og[k] = xhalf(gs[k]);
            float aown = 0.f, aoth = 0.f;
#pragma unroll
            for (int k = 7; k >= 0; --k) {
                const float base = C + (aown + aoth + (hi == 0 ? og[k] : 0.f));
                if (k >= 4) { const int q = 4 * (k - 4);
                    const float i3 = base + L1[q + 3], i2 = i3 + L1[q + 2], i1 = i2 + L1[q + 1], i0 = i1 + L1[q];
                    p1[q + 3] = ex2(p1[q + 3] + i3); p1[q + 2] = ex2(p1[q + 2] + i2); p1[q + 1] = ex2(p1[q + 1] + i1); p1[q] = ex2(p1[q] + i0);
                } else { const int q = 4 * k;
                    const float i3 = base + L0[q + 3], i2 = i3 + L0[q + 2], i1 = i2 + L0[q + 1], i0 = i1 + L0[q];
                    p0[q + 3] = ex2(p0[q + 3] + i3); p0[q + 2] = ex2(p0[q + 2] + i2); p0[q + 1] = ex2(p0[q + 1] + i1); p0[q] = ex2(p0[q] + i0);
                }
                aown += gs[k]; aoth += og[k];
            }
            C += (hi ? aoth : aown) + (hi ? aown : aoth);
            bf16x8 pw[4]; pack_p(pw, p0, p1);
            pv(o, lds + L_V + (it % NS) * SLOT, pw, lane, hi);
        }
        const float cm = wave_max(C);
        if (lane == 0) wm[(it & 1) * 8 + wid] = cm;
        ATT_WAIT_BAR(4);
    }
    ring_drain();
    store_o(mixed + (rowb + t) * DM + 0 + h * 64, o, hi);
}

__device__ __forceinline__ void unit_B(LAS unsigned char* lds, const bf16_t* proj, bf16_t* mixed, const float* gain, float lam, float lam_init, int b, int h, int qb, int tid, int wid, int lane) {
    const int r32 = lane & 31, hi = lane >> 5;
    const int t = 256 * qb + 32 * wid + r32;
    const size_t rowb = (size_t)b * SEQ;
    bf16x8 qf[4]; load_q(qf, proj + (rowb + t) * NINP + C_BQ + h * 64, hi);
    const KVp kv{proj + rowb * NINP + C_BK + h * 64, proj + rowb * NINP + C_BV + h * 64, NINP, NINP};
    const Ring rg = ring_init(lds, kv, wid, lane);
    f32x16 oa[2], ob[2]; oa[0] = zero16(); oa[1] = zero16(); ob[0] = zero16(); ob[1] = zero16();
    float m0 = 0.f, l0 = 0.f, m1 = 0.f, l1 = 0.f; bool sn0 = false, sn1 = false;
    const int jd = 4 * qb + 3, tmaxw = 256 * qb + 32 * wid + 31, tminw = tmaxw - 31;
#if BPIPE
    const int jl = (tmaxw >> 6) < jd ? (tmaxw >> 6) : jd;
    const int cl = jd;
    ring_issue_k(rg, 0, 0); ring_issue_v(rg, 0, 0); ring_issue_k(rg, 1 < cl ? 1 : cl, 1); ring_issue_k(rg, 2 < cl ? 2 : cl, 2); ring_issue_v(rg, 1 < cl ? 1 : cl, 1);
    ATT_WAIT_BAR(2);
    f32x16 p0, p1; bf16x8 pw[4];
#pragma unroll
    for (int k = 0; k < 4; ++k) pw[k] = (bf16x8){0, 0, 0, 0, 0, 0, 0, 0};
    for (int jt = 0; jt <= jd; ++jt) {
        { const int jk = jt + 3, jv = jt + 2; ring_issue_k(rg, jk < cl ? jk : cl, jk % NS); ring_issue_v(rg, jv < cl ? jv : cl, jv % NS); }
        if (jt <= jl) {
            const bool nm = (64 * jt + 63 > tminw);
            qk<0, 2>(p0, p1, lds + L_K + (jt % NS) * SLOT, qf, hi, r32);
            if (nm) mask_le(p0, p1, t - 64 * jt, hi);
            osm_pre(p0, p1, m0, sn0, l0, oa);
            pv_exp(ob, lds + L_V + (jt == 0 ? 0 : (jt - 1) % NS) * SLOT, pw, p0, p1, l0, lane, hi);
            qk<2, 4>(p0, p1, lds + L_K + (jt % NS) * SLOT, qf, hi, r32);
            if (nm) mask_le(p0, p1, t - 64 * jt, hi);
            osm_pre(p0, p1, m1, sn1, l1, ob);
            pv_exp(oa, lds + L_V + (jt % NS) * SLOT, pw, p0, p1, l1, lane, hi);
            if (jt == jl) pv(ob, lds + L_V + (jt % NS) * SLOT, pw, lane, hi);
        }
        ATT_WAIT_BAR(2);
    }
    ring_drain();
#else
#pragma unroll
    for (int k = 0; k < NS - 1; ++k) ring_issue(rg, k < jd ? k : jd, k);
    ATT_WAIT_BAR(4);
    for (int jt = 0; jt <= jd; ++jt) {
        { const int jn = jt + NS - 1; ring_issue(rg, jn < jd ? jn : jd, jn % NS); }
        if (64 * jt <= tmaxw) {
            const bool nm = (64 * jt + 63 > tminw);
            f32x16 p0, p1; bf16x8 pw[4];
            qk<0, 2>(p0, p1, lds + L_K + (jt % NS) * SLOT, qf, hi, r32);
            if (nm) mask_le(p0, p1, t - 64 * jt, hi);
            osm3(p0, p1, m0, sn0, l0, oa, pw, true);
            pv(oa, lds + L_V + (jt % NS) * SLOT, pw, lane, hi);
            qk<2, 4>(p0, p1, lds + L_K + (jt % NS) * SLOT, qf, hi, r32);
            if (nm) mask_le(p0, p1, t - 64 * jt, hi);
            osm3(p0, p1, m1, sn1, l1, ob, pw, true);
            pv(ob, lds + L_V + (jt % NS) * SLOT, pw, lane, hi);
        }
        ATT_WAIT_BAR(4);
    }
    ring_drain();
#endif
    l0 += xhalf(l0); l1 += xhalf(l1);
    const float i0 = 1.f / l0, i1 = lam / l1;
    float ss = 0.f;
#pragma unroll
    for (int d0 = 0; d0 < 2; ++d0)
#pragma unroll
        for (int r = 0; r < 16; ++r) { const float v = oa[d0][r] * i0 - ob[d0][r] * i1; oa[d0][r] = v; ss += v * v; }
    ss += xhalf(ss);
    const float rs = rsqrtf(ss * (1.f / 64.f) + RMS_EPS) * (1.f - lam_init);
#pragma unroll
    for (int d0 = 0; d0 < 2; ++d0)
#pragma unroll
        for (int g = 0; g < 4; ++g) { const f32x4 gv = *(const f32x4*)(gain + 32 * d0 + 8 * g + 4 * hi);
#pragma unroll
            for (int e = 0; e < 4; ++e) oa[d0][4 * g + e] *= rs * gv[e]; }
    store_o(mixed + (rowb + t) * DM + 256 + h * 64, oa, hi);
}

__device__ __forceinline__ int c_next(int jt, unsigned un, int own) {
    if ((jt & 3) != 3) return jt + 1;
    int j = (jt >> 2) + 1; if (j > own) return jt;
    j += __builtin_ctz((un >> j) | 0x80000000u); return 4 * j;
}
__device__ __forceinline__ void unit_C(LAS unsigned char* lds, const bf16_t* proj, const bf16_t* kmean, bf16_t* mixed, int b, int h, int qb, int tid, int wid, int lane) {
    const int r32 = lane & 31, hi = lane >> 5, own = qb;
    const int t = 256 * qb + 32 * wid + r32;
    const size_t rowb = (size_t)b * SEQ;
    bf16x8 qf[4]; load_q(qf, proj + (rowb + t) * NINP + C_CQ + h * 64, hi);
    const KVp kv{proj + rowb * NINP + C_CK + h * 64, proj + rowb * NINP + C_CV + h * 64, NINP, NINP};
    const Ring rg = ring_init(lds, kv, wid, lane);
    LAS unsigned* un_w = (LAS unsigned*)(lds + L_X);
    unsigned sel = 0u;
    if (tid == 0) un_w[0] = 0u;
    if (own > 0) {
        if (tid < 256) { const int chunk = tid >> 5, key = tid & 31; *(LAS u32x4*)(lds + L_K + chunk * 1024 + key * 16) = *(const u32x4*)(kmean + ((size_t)((b * 4 + h) * 32 + key)) * 64 + chunk * 8); }
        __syncthreads();
        f32x16 g = zero16();
        { const LAS unsigned char* kb = lds + L_K + hi * 1024 + r32 * 16;
#pragma unroll
          for (int d0 = 0; d0 < 4; ++d0) g = mfma32(*(const LAS bf16x8*)(kb + d0 * 2048), qf[d0], g); }
        float og[16];
#pragma unroll
        for (int r = 0; r < 16; ++r) og[r] = xhalf(g[r]);
#pragma unroll
        for (int round = 0; round < 3; ++round) {
            float best = -INFINITY; int bi = -1;
#pragma unroll
            for (int j = 0; j < 32; ++j) { const int hj = (j >> 2) & 1, r = (j & 3) + 4 * (j >> 3);
                const float v = (hj == hi) ? g[r] : og[r];
                const bool ok = (j < own) && !((sel >> j) & 1u) && (v > best);
                best = ok ? v : best; bi = ok ? j : bi; }
            if (bi >= 0) sel |= 1u << bi;
        }
        const unsigned wo = wave_or(sel);
        if (lane == 0) __hip_atomic_fetch_or(un_w, wo, __ATOMIC_RELAXED, __HIP_MEMORY_SCOPE_WORKGROUP);
    }
    __syncthreads();
    const unsigned un = (un_w[0] | (1u << own)) & (own == 31 ? 0xffffffffu : ((2u << own) - 1u));
    f32x16 o[2]; o[0] = zero16(); o[1] = zero16();
    float m = 0.f, l = 0.f; bool seen = false;
    const int tmaxw = 256 * qb + 32 * wid + 31, tminw = tmaxw - 31;
    const int ntile = 4 * __builtin_popcount(un);
    int jt = 4 * (__builtin_ctz(un)), ji = jt;
#pragma unroll
    for (int k = 0; k < NS - 1; ++k) { ring_issue(rg, ji, k); ji = c_next(ji, un, own); }
    ATT_WAIT_BAR(4);
    for (int it = 0; it < ntile; ++it) {
        ring_issue(rg, ji, (it + NS - 1) % NS); ji = c_next(ji, un, own);
        const int blk = jt >> 2;
        bool act; bool rowsel = true;
        if (blk == own) act = (64 * jt <= tmaxw); else { rowsel = (sel >> blk) & 1u; act = __any(rowsel); }
        if (act) {
            f32x16 p0, p1; bf16x8 pw[4];
            qk<0, 4>(p0, p1, lds + L_K + (it % NS) * SLOT, qf, hi, r32);
            if (blk == own && 64 * jt + 63 > tminw) mask_le(p0, p1, t - 64 * jt, hi);
            osm3(p0, p1, m, seen, l, o, pw, blk == own ? true : rowsel);
            pv(o, lds + L_V + (it % NS) * SLOT, pw, lane, hi);
        }
        jt = c_next(jt, un, own);
        ATT_WAIT_BAR(4);
    }
    ring_drain();
    l += xhalf(l);
    const float inv = 1.f / l;
    o[0] *= inv; o[1] *= inv;
    store_o(mixed + (rowb + t) * DM + 512 + h * 64, o, hi);
}

__device__ __forceinline__ void unit_Csel(LAS unsigned char* lds, const bf16_t* proj, const bf16_t* kmean, unsigned* mcnt, int* mlist, int b, int h, int qb, int tid, int wid, int lane) {
    const int r32 = lane & 31, hi = lane >> 5, own = qb, bh = b * 4 + h;
    if (own == 0) return;
    const int t = 256 * qb + 32 * wid + r32;
    LAS int* cl = (LAS int*)(lds + L_X);
    if (tid < 64) cl[tid] = 0;
    bf16x8 qf[4]; load_q(qf, proj + ((size_t)b * SEQ + t) * NINP + C_CQ + h * 64, hi);
    if (tid < 256) { const int chunk = tid >> 5, key = tid & 31; *(LAS u32x4*)(lds + L_K + chunk * 1024 + key * 16) = *(const u32x4*)(kmean + ((size_t)(bh * 32 + key)) * 64 + chunk * 8); }
    __syncthreads();
    f32x16 g = zero16();
    { const LAS unsigned char* kb = lds + L_K + hi * 1024 + r32 * 16;
#pragma unroll
      for (int d0 = 0; d0 < 4; ++d0) g = mfma32(*(const LAS bf16x8*)(kb + d0 * 2048), qf[d0], g); }
    float og[16];
#pragma unroll
    for (int r = 0; r < 16; ++r) og[r] = xhalf(g[r]);
    unsigned sel = 0u; int pk0 = -1, pk1 = -1, pk2 = -1;
#pragma unroll
    for (int round = 0; round < 3; ++round) {
        float best = -INFINITY; int bi = -1;
#pragma unroll
        for (int j = 0; j < 32; ++j) { const int hj = (j >> 2) & 1, r = (j & 3) + 4 * (j >> 3);
            const float v = (hj == hi) ? g[r] : og[r];
            const bool ok = (j < own) && !((sel >> j) & 1u) && (v > best);
            best = ok ? v : best; bi = ok ? j : bi; }
        if (bi >= 0) sel |= 1u << bi;
        if (round == 0) pk0 = bi; else if (round == 1) pk1 = bi; else pk2 = bi;
    }
    int lp0 = 0, lp1 = 0, lp2 = 0;
    if (hi == 0) {
        if (pk0 >= 0) lp0 = __hip_atomic_fetch_add(cl + pk0, 1, __ATOMIC_RELAXED, __HIP_MEMORY_SCOPE_WORKGROUP);
        if (pk1 >= 0) lp1 = __hip_atomic_fetch_add(cl + pk1, 1, __ATOMIC_RELAXED, __HIP_MEMORY_SCOPE_WORKGROUP);
        if (pk2 >= 0) lp2 = __hip_atomic_fetch_add(cl + pk2, 1, __ATOMIC_RELAXED, __HIP_MEMORY_SCOPE_WORKGROUP);
    }
    __syncthreads();
    if (tid < own) { const int n = cl[tid]; cl[32 + tid] = n ? (int)__hip_atomic_fetch_add(mcnt + bh * 32 + tid, (unsigned)n, __ATOMIC_RELAXED, __HIP_MEMORY_SCOPE_AGENT) : 0; }
    __syncthreads();
    if (hi == 0) {
        if (pk0 >= 0) mlist[(size_t)(bh * 32 + pk0) * 8192 + cl[32 + pk0] + lp0] = (t << 2) | 0;
        if (pk1 >= 0) mlist[(size_t)(bh * 32 + pk1) * 8192 + cl[32 + pk1] + lp1] = (t << 2) | 1;
        if (pk2 >= 0) mlist[(size_t)(bh * 32 + pk2) * 8192 + cl[32 + pk2] + lp2] = (t << 2) | 2;
    }
    __syncthreads();
}
__device__ __forceinline__ void unit_Cgather(LAS unsigned char* lds, const bf16_t* proj, const int* mlist, bf16_t* Po, float* Pml, int li, int chunk, int n, int tid, int wid, int lane) {
    const int r32 = lane & 31, hi = lane >> 5, bh = li >> 5, j = li & 31, b = bh >> 2, h = bh & 3;
    const int idx = chunk * 256 + 32 * wid + r32; const bool valid = idx < n;
    const int ent = mlist[(size_t)li * 8192 + (valid ? idx : 0)];
    const int t = ent >> 2, slot = ent & 3;
    const size_t rowb = (size_t)b * SEQ;
    bf16x8 qf[4]; load_q(qf, proj + (rowb + t) * NINP + C_CQ + h * 64, hi);
    const KVp kv{proj + rowb * NINP + C_CK + h * 64, proj + rowb * NINP + C_CV + h * 64, NINP, NINP};
    const Ring rg = ring_init(lds, kv, wid, lane);
#pragma unroll
    for (int q = 0; q < 4; ++q) ring_issue(rg, 4 * j + q, q);
    ring_drain();
    f32x16 o[2]; o[0] = zero16(); o[1] = zero16();
    float m = 0.f, l = 0.f; bool seen = false;
    {
        f32x16 pa0, pa1, pb0, pb1;
        qk<0, 4>(pa0, pa1, lds + L_K, qf, hi, r32);
        osm3f<true>(pa0, pa1, m, seen, l, o, lds + L_V, true, lane, hi, pb0, pb1, lds + L_K + SLOT, qf);
        osm3f<true>(pb0, pb1, m, seen, l, o, lds + L_V + SLOT, true, lane, hi, pa0, pa1, lds + L_K + 2 * SLOT, qf);
        osm3f<true>(pa0, pa1, m, seen, l, o, lds + L_V + 2 * SLOT, true, lane, hi, pb0, pb1, lds + L_K + 3 * SLOT, qf);
        osm3f<false>(pb0, pb1, m, seen, l, o, lds + L_V + 3 * SLOT, true, lane, hi, pa0, pa1, lds + L_K, qf);
    }
    l += xhalf(l);
    const float inv = 1.f / l;
    o[0] *= inv; o[1] *= inv;
    { const size_t pi = ((size_t)bh * SEQ + t) * 4 + slot; store_o(Po + pi * 64, o, hi, valid); if (valid && hi == 0) { Pml[pi * 2] = m; Pml[pi * 2 + 1] = l; } }
    asm volatile("s_waitcnt lgkmcnt(0)\n\ts_barrier" ::: "memory");
}
__device__ __forceinline__ void unit_Cown(LAS unsigned char* lds, const bf16_t* proj, const bf16_t* Po, const float* Pml, bf16_t* mixed, unsigned* flag, int b, int h, int qb, int tid, int wid, int lane) {
    const int r32 = lane & 31, hi = lane >> 5, own = qb, bh = b * 4 + h;
    const int t = 256 * qb + 32 * wid + r32;
    const size_t rowb = (size_t)b * SEQ;
    bf16x8 qf[4]; load_q(qf, proj + (rowb + t) * NINP + C_CQ + h * 64, hi);
    const KVp kv{proj + rowb * NINP + C_CK + h * 64, proj + rowb * NINP + C_CV + h * 64, NINP, NINP};
    const Ring rg = ring_init(lds, kv, wid, lane);
#pragma unroll
    for (int q = 0; q < 4; ++q) ring_issue(rg, 4 * own + q, q);
    ring_drain();
    f32x16 o[2]; o[0] = zero16(); o[1] = zero16();
    float m = 0.f, l = 0.f; bool seen = false;
    const int tmaxw = 256 * qb + 32 * wid + 31, tminw = tmaxw - 31;
#pragma unroll 1
    for (int q = 0; q < 4; ++q) {
        const int jt = 4 * own + q;
        if (64 * jt <= tmaxw) {
            f32x16 p0, p1; bf16x8 pw[4];
            qk<0, 4>(p0, p1, lds + L_K + q * SLOT, qf, hi, r32);
            if (64 * jt + 63 > tminw) mask_le(p0, p1, t - 64 * jt, hi);
            osm3f<false>(p0, p1, m, seen, l, o, lds + L_V + q * SLOT, true, lane, hi, p0, p1, lds, qf);
        }
    }
    l += xhalf(l);
    const int nsel = own < 3 ? own : 3;
    const size_t pi = ((size_t)bh * SEQ + t) * 4;
    float ms0 = 0.f, ls0 = 0.f, ms1 = 0.f, ls1 = 0.f, ms2 = 0.f, ls2 = 0.f, M = m;
    if (nsel > 0) { ms0 = Pml[pi * 2]; ls0 = Pml[pi * 2 + 1]; M = fmaxf(M, ms0); }
    if (nsel > 1) { ms1 = Pml[pi * 2 + 2]; ls1 = Pml[pi * 2 + 3]; M = fmaxf(M, ms1); }
    if (nsel > 2) { ms2 = Pml[pi * 2 + 4]; ls2 = Pml[pi * 2 + 5]; M = fmaxf(M, ms2); }
    const float wo = ex2(m - M), w0 = ls0 * ex2(ms0 - M), w1 = ls1 * ex2(ms1 - M), w2 = ls2 * ex2(ms2 - M);
    const float inv = 1.f / (l * wo + (w0 + w1 + w2));
    o[0] *= wo; o[1] *= wo;
#pragma unroll 1
    for (int s = 0; s < nsel; ++s) {
        const float w = s == 0 ? w0 : s == 1 ? w1 : w2; const bf16_t* ps = Po + (pi + s) * 64;
#pragma unroll
        for (int d0 = 0; d0 < 2; ++d0)
#pragma unroll
            for (int g = 0; g < 4; ++g) { const u32x2 v = *(const u32x2*)(ps + 32 * d0 + 8 * g + 4 * hi);
                o[d0][4 * g] += w * bflo(v.x); o[d0][4 * g + 1] += w * bfhi(v.x); o[d0][4 * g + 2] += w * bflo(v.y); o[d0][4 * g + 3] += w * bfhi(v.y); }
    }
    o[0] *= inv; o[1] *= inv;
    bf16_t* dst = mixed + (rowb + t) * DM + 512 + h * 64;
#if CHECK_C
    { float worst = 0.f;
#pragma unroll
      for (int d0 = 0; d0 < 2; ++d0)
#pragma unroll
          for (int g = 0; g < 4; ++g) { const u32x2 v = *(const u32x2*)(dst + 32 * d0 + 8 * g + 4 * hi);
              worst = fmaxf(worst, fmaxf(fmaxf(fabsf(o[d0][4 * g] - bflo(v.x)), fabsf(o[d0][4 * g + 1] - bfhi(v.x))), fmaxf(fabsf(o[d0][4 * g + 2] - bflo(v.y)), fabsf(o[d0][4 * g + 3] - bfhi(v.y))))); }
      if (!(worst <= 0.02f)) atomicOr(flag, 1u); }
#else
    store_o(dst, o, hi);
#endif
    asm volatile("s_waitcnt lgkmcnt(0)\n\ts_barrier" ::: "memory");
}

#if DSELV2
constexpr int LD_IA = L_X, LD_SM = 133120, LD_WO = LD_SM + 1024, LD_END = LD_WO + 128;
#else
constexpr int LD_IA = L_X, LD_SM = L_X + 32768, LD_WO = LD_SM + 1024, LD_END = LD_WO + 128;
#endif
__device__ __forceinline__ void d_stash_st(LAS unsigned char* lds, int tid, const f32x16 (&a)[2]) {
    LAS f32x4* s = (LAS f32x4*)(lds + L_X) + tid;
#pragma unroll
    for (int k = 0; k < 4; ++k) { s[k * 512] = (f32x4){a[0][4 * k], a[0][4 * k + 1], a[0][4 * k + 2], a[0][4 * k + 3]}; s[(4 + k) * 512] = (f32x4){a[1][4 * k], a[1][4 * k + 1], a[1][4 * k + 2], a[1][4 * k + 3]}; }
}
__device__ __forceinline__ void d_stash_ld(LAS unsigned char* lds, int tid, f32x16 (&a)[2]) {
    const LAS f32x4* s = (const LAS f32x4*)(lds + L_X) + tid;
#pragma unroll
    for (int k = 0; k < 4; ++k) { const f32x4 x = s[k * 512], y = s[(4 + k) * 512];
#pragma unroll
        for (int e = 0; e < 4; ++e) { a[0][4 * k + e] = x[e]; a[1][4 * k + e] = y[e]; } }
}
__device__ __forceinline__ int d_next(int jt, unsigned u0, unsigned u1, unsigned u2, unsigned u3, int i) {
    const unsigned long long lo = (unsigned long long)(unsigned)__builtin_amdgcn_readfirstlane((int)u0) | ((unsigned long long)(unsigned)__builtin_amdgcn_readfirstlane((int)u1) << 32),
                             hi = (unsigned long long)(unsigned)__builtin_amdgcn_readfirstlane((int)u2) | ((unsigned long long)(unsigned)__builtin_amdgcn_readfirstlane((int)u3) << 32);
    const int s = jt + 1; int jn = jt;
    if (s < 64) { const unsigned long long w = lo >> s; if (w) jn = s + __builtin_ctzll(w); else if (hi) jn = 64 + __builtin_ctzll(hi); }
    else if (s < 128) { const unsigned long long w = hi >> (s - 64); if (w) jn = s + __builtin_ctzll(w); }
    return jn <= i ? jn : jt;
}
__device__ __forceinline__ void unit_D(LAS unsigned char* lds, const bf16_t* proj, const bf16_t* qr, const bf16_t* kc, const bf16_t* vc, const float* gates, bf16_t* mixed,
                                       int b, int i, int tid, int wid, int lane) {
    const int r32 = lane & 31, hi = lane >> 5, hd = r32 & 3, tl = 8 * wid + (r32 >> 2);
    const int t = 64 * i + tl, tt = tl;
    const size_t rowb = (size_t)b * SEQ, row = rowb + t;
    LAS float* imp = (LAS float*)(lds + LD_IA);
    LAS unsigned* smk = (LAS unsigned*)(lds + LD_SM); LAS unsigned* wor = (LAS unsigned*)(lds + LD_WO);
    bf16x8 qf[4]; load_q(qf, proj + row * NINP + C_DQ + hd * 64, hi);
    const float g_c = gates[row * 12 + hd * 3 + 0], g_s = gates[row * 12 + hd * 3 + 1], g_w = gates[row * 12 + hd * 3 + 2];
    f32x16 acc[2]; acc[0] = zero16(); acc[1] = zero16();
    const KVp kvc{kc + (size_t)b * NCMP * 64, vc + (size_t)b * NCMP * 64, 64, 64};
    const int J = (4 * i + 2) >> 6, nlim = (t - 31) >> 4;
    float m = -1e30f, l = 0.f;
    {
        int ln = lane; asm volatile("" : "+v"(ln)); const Ring rg = ring_init(lds, kvc, wid, ln);
#pragma unroll
        for (int k = 0; k < NS - 1; ++k) ring_issue(rg, k < J ? k : J, k);
        ATT_WAIT_BAR(4);
        for (int jt = 0; jt <= J; ++jt) {
            { const int jn = jt + NS - 1; ring_issue(rg, jn < J ? jn : J, jn % NS); }
            f32x16 p0, p1; qk<0, 4>(p0, p1, lds + L_K + (jt % NS) * SLOT, qf, hi, r32);
            mask_le(p0, p1, nlim - 64 * jt, hi);
            float mx = fmaxf(p0[0], p1[0]);
#pragma unroll
            for (int r = 1; r < 16; ++r) mx = fmaxf(mx, fmaxf(p0[r], p1[r]));
            const float mn = fmaxf(m, mx); float s = 0.f;
#pragma unroll
            for (int r = 0; r < 16; ++r) s += ex2(p0[r] - mn) + ex2(p1[r] - mn);
            l = l * ex2(m - mn) + s; m = mn;
            ATT_WAIT_BAR(4);
        }
        { const float mo = xhalf(m), lo = xhalf(l), M = fmaxf(m, mo); l = l * ex2(m - M) + lo * ex2(mo - M); m = M; }
        const float invl = l > 0.f ? 1.f / l : 0.f;
        ring_drain();
#pragma unroll
        for (int k = 0; k < NS - 1; ++k) ring_issue(rg, k < J ? k : J, k);
        ATT_WAIT_BAR(4);
        float carry = 0.f;
        for (int jt = 0; jt <= J; ++jt) {
            { const int jn = jt + NS - 1; ring_issue(rg, jn < J ? jn : J, jn % NS); }
            f32x16 p0, p1; qk<0, 4>(p0, p1, lds + L_K + (jt % NS) * SLOT, qf, hi, r32);
            mask_le(p0, p1, nlim - 64 * jt, hi);
#pragma unroll
            for (int r = 0; r < 16; ++r) { p0[r] = ex2(p0[r] - m) * invl; p1[r] = ex2(p1[r] - m) * invl; }
            float ol[8];
#pragma unroll
            for (int k = 0; k < 8; ++k) ol[k] = xhalf(k < 4 ? p0[4 * k + 3] : p1[4 * k - 13]);
#pragma unroll
            for (int k = 0; k < 8; ++k) {
                float gsum = (k < 4) ? (p0[4 * k] + p0[4 * k + 1]) + (p0[4 * k + 2] + p0[4 * k + 3]) : (p1[4 * k - 16] + p1[4 * k - 15]) + (p1[4 * k - 14] + p1[4 * k - 13]);
                const float prev = hi ? ol[k] : (k > 0 ? ol[k - 1] : carry);
                const float v = quad_sum(gsum + prev);
                if (hd == 0) imp[tl * 128 + 16 * jt + 2 * k + hi] = v;
            }
            carry = ol[7];
            bf16x8 pw[4]; pack_p(pw, p0, p1);
            pv(acc, lds + L_V + (jt % NS) * SLOT, pw, lane, hi);
            ATT_WAIT_BAR(4);
        }
        ring_drain();
    }
    acc[0] *= g_c; acc[1] *= g_c;
    unsigned wo0 = 0u, wo1 = 0u, wo2 = 0u, wo3 = 0u;
#pragma unroll 1
    for (int k8 = 0; k8 < 8; ++k8) {
        const int tk = 8 * wid + k8;
        unsigned long long b0, b1;
        if (i < 16) { b0 = (2ull << i) - 1ull; b1 = 0ull; }
        else {
            const int m0 = lane, m1 = lane + 64;
            const bool c0 = (m0 <= i) && (m0 != 0) && (m0 != i) && (m0 != i - 1), c1 = (m1 <= i) && (m1 != i) && (m1 != i - 1);
            const bool f0 = (m0 == 0) || (m0 == i) || (m0 == i - 1), f1 = (m1 == i) || (m1 == i - 1);
            const float v0 = imp[tk * 128 + m0], v1 = imp[tk * 128 + m1];
            const unsigned k0 = c0 ? __float_as_uint(v0) + 1u : 0u, k1 = c1 ? __float_as_uint(v1) + 1u : 0u;
            unsigned thr = 0u;
            for (int bit = 30; bit >= 0; --bit) { const unsigned cand = thr | (1u << bit);
                const int c = __popcll(__ballot(k0 >= cand)) + __popcll(__ballot(k1 >= cand)); if (c == 13) { thr = cand - 1u; break; }
                if (c >= 13) thr = cand; }
            const bool gt0 = k0 > thr, gt1 = k1 > thr, eq0 = (k0 == thr) && c0, eq1 = (k1 == thr) && c1;
            const int need = 13 - (__popcll(__ballot(gt0)) + __popcll(__ballot(gt1)));
            const unsigned long long be0 = __ballot(eq0), be1 = __ballot(eq1), lt = (1ull << lane) - 1ull;
            const int rk0 = __popcll(be0 & lt), rk1 = __popcll(be0) + __popcll(be1 & lt);
            b0 = __ballot(f0 || gt0 || (eq0 && rk0 < need)); b1 = __ballot(f1 || gt1 || (eq1 && rk1 < need));
        }
        const unsigned w0 = (unsigned)b0, w1 = (unsigned)(b0 >> 32), w2 = (unsigned)b1, w3 = (unsigned)(b1 >> 32);
        if (lane == 0) { smk[tk * 4 + 0] = w0; smk[tk * 4 + 1] = w1; smk[tk * 4 + 2] = w2; smk[tk * 4 + 3] = w3; }
        wo0 |= w0; wo1 |= w1; wo2 |= w2; wo3 |= w3;
    }
    if (lane == 0) { wor[wid * 4 + 0] = wo0; wor[wid * 4 + 1] = wo1; wor[wid * 4 + 2] = wo2; wor[wid * 4 + 3] = wo3; }
    __syncthreads();
    unsigned un0 = 0u, un1 = 0u, un2 = 0u, un3 = 0u;
#pragma unroll
    for (int w = 0; w < 8; ++w) { un0 |= wor[w * 4 + 0]; un1 |= wor[w * 4 + 1]; un2 |= wor[w * 4 + 2]; un3 |= wor[w * 4 + 3]; }
    const unsigned sm0 = smk[tl * 4 + 0], sm1 = smk[tl * 4 + 1], sm2 = smk[tl * 4 + 2], sm3 = smk[tl * 4 + 3];
    f32x16 accs0 = acc[0], accs1 = acc[1]; (void)accs0; (void)accs1;
    { int r2 = (int)(row & 0x7fffffff); asm volatile("" : "+v"(r2)); load_q(qf, qr + (size_t)r2 * 256 + hd * 64, hi); }
#if DSELV2
    {
        { int ts = tid; asm volatile("" : "+v"(ts)); d_stash_st(lds, ts, acc); }
        const KVp kvs{proj + rowb * NINP + C_KS, proj + rowb * NINP + C_VS, NINP, NINP};
        int ln = lane; asm volatile("" : "+v"(ln)); const Ring rg = ring_init(lds, kvs, wid, ln);
        f32x16 o[2]; o[0] = zero16(); o[1] = zero16();
        const int ntile = __builtin_popcount(un0) + __builtin_popcount(un1) + __builtin_popcount(un2) + __builtin_popcount(un3);
        const unsigned kb = kfrag_base(r32, hi), vb = vbase(ln, hi);
        int jk = 0, jv = 0, jt = 0;
#define DS_K(slot) do { ring_issue_k(rg, jk, (slot)); jk = d_next(jk, un0, un1, un2, un3, i); } while (0)
#define DS_V(slot) do { ring_issue_v(rg, jv, (slot)); jv = d_next(jv, un0, un1, un2, un3, i); } while (0)
#define DS_RS(j) ((((j) < 32 ? sm0 : (j) < 64 ? sm1 : (j) < 96 ? sm2 : sm3) >> ((j) & 31)) & 1u)
#define DS_KL2(sl, j) do { kf[2 * (j)] = *(const LAS bf16x8*)(lds + L_K + (sl) * SLOT + (kb ^ ((2 * (j)) << 4))); kf[2 * (j) + 1] = *(const LAS bf16x8*)(lds + L_K + (sl) * SLOT + (kb ^ ((2 * (j)) << 4)) + 4096); } while (0)
        DS_K(0); DS_V(0); DS_K(1); DS_K(2);
        ATT_WAIT_BAR(3);
        f32x16 pA0, pA1, pB0, pB1, negm; bf16x8 kf[8];
        float mhat, l_reg = 0.f, fsc = 1.f; bool resc = false;
        qk<0, 4>(pA0, pA1, lds + L_K, qf, hi, r32);
        if (i == 0) mask_le(pA0, pA1, tt, hi);
        { float mx = max3f(pA0[0], pA1[0], pA0[1]);
#pragma unroll
          for (int r = 1; r < 15; r += 2) { mx = max3f(mx, pA1[r], pA0[r + 1]); mx = fmaxf(mx, pA1[r + 1]); }
          mx = fmaxf(mx, pA1[15]); mx = fmaxf(mx, xhalf(mx)); mhat = mx;
#pragma unroll
          for (int r = 0; r < 16; ++r) { pA0[r] = ex2(pA0[r] - mx); pA1[r] = ex2(pA1[r] - mx); negm[r] = -mx; } }
        asm volatile("" : "+v"(negm));
        ATT_WAIT_BAR(0);
        DS_K(0); DS_V(1);
        int sp = 0, sc = 1, sn = 2;
#pragma unroll
        for (int j = 0; j < 4; ++j) DS_KL2(sc, j);
        ATT_WAIT_BAR(2);
        bool rsp = true;
        jt = d_next(0, un0, un1, un2, un3, i);
#define DS_PIN(x) asm volatile("" : "+v"(x))
#define DS_SB() __builtin_amdgcn_sched_barrier(0)
#define DS_VRD(k) do { const LAS unsigned char* vp_ = lds + L_V + sp * SLOT + (vb ^ (64u * ((k) >> 2))) + ((k) & 3) * 2048; vlo[k] = vtr(vp_); vhi[k] = vtr(vp_ + 1024); } while (0)
#define DS_VFR(k) ((bf16x8){vlo[k][0], vlo[k][1], vlo[k][2], vlo[k][3], vhi[k][0], vhi[k][1], vhi[k][2], vhi[k][3]})
#define DS_PK(P, B) (rsp ? pk2(P[B], P[(B) + 1]) : 0u)
#define DS_GAPA(MF, A0, A1, A2, A3, W0, W1, PW) do { MF; sacc += A0; sacc += A1; sacc += A2; sacc += A3; DS_PIN(sacc); W0; W1; DS_PIN(PW); DS_SB(); } while (0)
#define DS_GAPB(MF, X, B) do { MF; X[B] = ex2(X[B]); X[(B) + 1] = ex2(X[(B) + 1]); X[(B) + 2] = ex2(X[(B) + 2]); X[(B) + 3] = ex2(X[(B) + 3]); DS_PIN(X); DS_SB(); } while (0)
#define DS_STEP(C0, C1, P0, P1) do { DS_SB(); \
            s16x4 vlo[8], vhi[8]; u32x4 pw0, pw1, pw2, pw3; \
            DS_VRD(0); DS_SB(); float sacc = P0[0] + P0[1]; \
            DS_GAPA(C0 = mfma32(kf[0], qf[0], negm), P0[2], P0[3], P0[4], P0[5], pw0.x = DS_PK(P0, 0), pw0.y = DS_PK(P0, 2), pw0); \
            DS_VRD(4); DS_SB(); DS_GAPA(C1 = mfma32(kf[1], qf[0], negm), P0[6], P0[7], P0[8], P0[9], pw0.z = DS_PK(P0, 4), pw0.w = DS_PK(P0, 6), pw0); \
            DS_VRD(1); DS_SB(); DS_GAPA(C0 = mfma32(kf[2], qf[1], C0), P0[10], P0[11], P0[12], P0[13], pw1.x = DS_PK(P0, 8), pw1.y = DS_PK(P0, 10), pw1); \
            DS_VRD(5); DS_SB(); DS_GAPA(C1 = mfma32(kf[3], qf[1], C1), P0[14], P0[15], P1[0], P1[1], pw1.z = DS_PK(P0, 12), pw1.w = DS_PK(P0, 14), pw1); \
            DS_VRD(2); DS_SB(); DS_GAPA(C0 = mfma32(kf[4], qf[2], C0), P1[2], P1[3], P1[4], P1[5], pw2.x = DS_PK(P1, 0), pw2.y = DS_PK(P1, 2), pw2); \
            DS_VRD(6); DS_SB(); DS_GAPA(C1 = mfma32(kf[5], qf[2], C1), P1[6], P1[7], P1[8], P1[9], pw2.z = DS_PK(P1, 4), pw2.w = DS_PK(P1, 6), pw2); \
            DS_VRD(3); DS_SB(); DS_GAPA(C0 = mfma32(kf[6], qf[3], C0), P1[10], P1[11], P1[12], P1[13], pw3.x = DS_PK(P1, 8), pw3.y = DS_PK(P1, 10), pw3); \
            DS_VRD(7); DS_SB(); DS_GAPA(C1 = mfma32(kf[7], qf[3], C1), P1[14], P1[15], 0.f, 0.f, pw3.z = DS_PK(P1, 12), pw3.w = DS_PK(P1, 14), pw3); \
            l_reg += rsp ? sacc : 0.f; \
            DS_K(sc); DS_V(sn);                                      \
            const bool rsc = DS_RS(jt); \
            if (jt == i) mask_le(C0, C1, tt, hi); \
            { float mx = max3f(C0[0], C1[0], C0[1]); \
              _Pragma("unroll") for (int r = 1; r < 15; r += 2) { mx = max3f(mx, C1[r], C0[r + 1]); mx = fmaxf(mx, C1[r + 1]); } \
              mx = fmaxf(mx, C1[15]); mx = fmaxf(mx, xhalf(mx)); mx = rsc ? mx : -INFINITY; \
              resc = false; \
              if (__any(mx > 8.f)) { const float dl = fmaxf(mx, 0.f); mhat += dl; \
                  _Pragma("unroll") for (int r = 0; r < 16; ++r) { C0[r] -= dl; C1[r] -= dl; negm[r] = -mhat; } \
                  asm volatile("" : "+v"(negm)); fsc = ex2(-dl); l_reg *= fsc; resc = true; } } \
            DS_SB(); \
            DS_GAPB(o[0] = mfma32(DS_VFR(0), __builtin_bit_cast(bf16x8, pw0), o[0]), C0, 0); \
            DS_GAPB(o[1] = mfma32(DS_VFR(4), __builtin_bit_cast(bf16x8, pw0), o[1]), C0, 4); \
            DS_KL2(sn, 0); DS_SB(); DS_GAPB(o[0] = mfma32(DS_VFR(1), __builtin_bit_cast(bf16x8, pw1), o[0]), C0, 8); \
            DS_KL2(sn, 1); DS_SB(); DS_GAPB(o[1] = mfma32(DS_VFR(5), __builtin_bit_cast(bf16x8, pw1), o[1]), C0, 12); \
            DS_KL2(sn, 2); DS_SB(); DS_GAPB(o[0] = mfma32(DS_VFR(2), __builtin_bit_cast(bf16x8, pw2), o[0]), C1, 0); \
            DS_KL2(sn, 3); DS_SB(); DS_GAPB(o[1] = mfma32(DS_VFR(6), __builtin_bit_cast(bf16x8, pw2), o[1]), C1, 4); \
            DS_GAPB(o[0] = mfma32(DS_VFR(3), __builtin_bit_cast(bf16x8, pw3), o[0]), C1, 8); \
            DS_GAPB(o[1] = mfma32(DS_VFR(7), __builtin_bit_cast(bf16x8, pw3), o[1]), C1, 12); \
            ATT_WAIT_BAR(2);                                         \
            if (resc) { o[0] *= fsc; o[1] *= fsc; }                  \
            rsp = rsc; jt = d_next(jt, un0, un1, un2, un3, i); { const int s_ = sp; sp = sc; sc = sn; sn = s_; } \
        } while (0)
        int t = 1;
        for (; t + 1 < ntile; t += 2) { DS_STEP(pB0, pB1, pA0, pA1); DS_STEP(pA0, pA1, pB0, pB1); }
        if (t < ntile) { DS_STEP(pB0, pB1, pA0, pA1);
#pragma unroll
            for (int r = 0; r < 16; ++r) { pA0[r] = pB0[r]; pA1[r] = pB1[r]; } }
        { float sacc = 0.f;
#pragma unroll
          for (int r = 0; r < 16; ++r) sacc += pA0[r] + pA1[r];
          l_reg += rsp ? sacc : 0.f;
          bf16x8 pw[4]; pack_p(pw, pA0, pA1);
          if (!__all(rsp)) {
#pragma unroll
              for (int k = 0; k < 4; ++k) { u32x4 w = __builtin_bit_cast(u32x4, pw[k]); w.x = rsp ? w.x : 0u; w.y = rsp ? w.y : 0u; w.z = rsp ? w.z : 0u; w.w = rsp ? w.w : 0u; pw[k] = __builtin_bit_cast(bf16x8, w); } }
          pv(o, lds + L_V + sp * SLOT, pw, ln, hi); }
        ring_drain();
        l_reg += xhalf(l_reg);
        const float f = g_s / l_reg;
        { int ts = tid; asm volatile("" : "+v"(ts)); d_stash_ld(lds, ts, acc); }
        acc[0] += o[0] * f; acc[1] += o[1] * f;
#undef DS_K
#undef DS_V
#undef DS_RS
#undef DS_KL2
#undef DS_PIN
#undef DS_SB
#undef DS_VRD
#undef DS_VFR
#undef DS_PK
#undef DS_GAPA
#undef DS_GAPB
#undef DS_STEP
    }
#else
    for (int rs_ = 0; rs_ < ((DSUB & 1) ? 2 : 1); ++rs_) { if (rs_) { acc[0] = accs0; acc[1] = accs1; }
        const KVp kvs{proj + rowb * NINP + C_KS, proj + rowb * NINP + C_VS, NINP, NINP};
        int ln = lane; asm volatile("" : "+v"(ln)); const Ring rg = ring_init(lds, kvs, wid, ln);
        f32x16 o[2]; o[0] = zero16(); o[1] = zero16(); m = 0.f; l = 0.f; bool seen = false;
        const int ntile = __builtin_popcount(un0) + __builtin_popcount(un1) + __builtin_popcount(un2) + __builtin_popcount(un3);
        int jt = 0, ji = 0;
#pragma unroll
        for (int k = 0; k < NS - 1; ++k) { ring_issue(rg, ji, k); ji = d_next(ji, un0, un1, un2, un3, i); }
        ATT_WAIT_BAR(4);
        for (int it = 0; it < ntile; ++it) {
            ring_issue(rg, ji, (it + NS - 1) % NS); ji = d_next(ji, un0, un1, un2, un3, i);
            const unsigned w = jt < 32 ? sm0 : jt < 64 ? sm1 : jt < 96 ? sm2 : sm3;
            const bool rowsel = (w >> (jt & 31)) & 1u;
            if (__any(rowsel)) {
                f32x16 p0, p1; bf16x8 pw[4];
                qk<0, 4>(p0, p1, lds + L_K + (it % NS) * SLOT, qf, hi, r32);
                if (jt == i) mask_le(p0, p1, tt, hi);
                osm3f<false, true>(p0, p1, m, seen, l, o, lds + L_V + (it % NS) * SLOT, rowsel, lane, hi, p0, p1, lds, qf);
            }
            jt = d_next(jt, un0, un1, un2, un3, i);
            ATT_WAIT_BAR(4);
        }
        ring_drain();
        l += xhalf(l);
        const float f = g_s / l;
        acc[0] += o[0] * f; acc[1] += o[1] * f;
    }
#endif
    f32x16 accw0 = acc[0], accw1 = acc[1]; (void)accw0; (void)accw1;
    for (int rw_ = 0; rw_ < ((DSUB & 2) ? 2 : 1); ++rw_) { if (rw_) { acc[0] = accw0; acc[1] = accw1; }
        const KVp kvw{proj + rowb * NINP + C_KW, proj + rowb * NINP + C_VW, NINP, NINP};
        int ln = lane; asm volatile("" : "+v"(ln)); const Ring rg = ring_init(lds, kvw, wid, ln);
        f32x16 o[2]; o[0] = zero16(); o[1] = zero16(); m = 0.f; l = 0.f; bool seen = false;
        const int j0 = i >= 8 ? i - 8 : 0;
#pragma unroll
        for (int k = 0; k < NS - 1; ++k) ring_issue(rg, j0 + k < i ? j0 + k : i, k);
        ATT_WAIT_BAR(4);
        for (int jt = j0; jt <= i; ++jt) {
            { const int jn = jt + NS - 1; ring_issue(rg, jn < i ? jn : i, (jn - j0) % NS); }
            f32x16 p0, p1; bf16x8 pw[4];
            qk<0, 4>(p0, p1, lds + L_K + ((jt - j0) % NS) * SLOT, qf, hi, r32);
            if (jt == i) mask_le(p0, p1, tt, hi);
            if (jt == i - 8) mask_gt(p0, p1, tt, hi);
            osm3f<false>(p0, p1, m, seen, l, o, lds + L_V + ((jt - j0) % NS) * SLOT, true, lane, hi, p0, p1, lds, qf);
            ATT_WAIT_BAR(4);
        }
        ring_drain();
        l += xhalf(l);
        const float f = g_w / l;
        acc[0] += o[0] * f; acc[1] += o[1] * f;
    }
    { int r2 = (int)(row & 0x7fffffff); asm volatile("" : "+v"(r2)); store_o(mixed + (size_t)r2 * DM + 768 + hd * 64, acc, hi); }
}
#undef ATT_WAIT_BAR
}


#if CHECK_N
namespace chk {
__device__ __forceinline__ float bf(const bf16_t* p) { return __uint_as_float(((unsigned)*p) << 16); }
__device__ __forceinline__ float logsig(float z) { return z >= 0.f ? -log1pf(expf(-z)) : z - log1pf(expf(z)); }
__device__ __forceinline__ bool close(float a, float b) { return fabsf(a - b) <= 0.02f + 0.05f * fabsf(b); }
__device__ bool chk_A(const bf16_t* proj, const bf16_t* mixed, int b, int h, int t, int lane) {
    const size_t rb = (size_t)b * SEQ; const float q = bf(proj + (rb + t) * NINP + C_AQ + h * 64 + lane) * (1.f / LOG2E);
    float o = 0.f, later = 0.f;
    for (int s = t - 1; s >= 0; --s) {
        const float z = wave_sum(q * bf(proj + (rb + s) * NINP + C_AK + h * 64 + lane));
        o += expf(logsig(z) + later) * bf(proj + (rb + s) * NINP + C_AV + h * 64 + lane);
        later += logsig(-z);
        if (later < -80.f) break;
    }
    return __all(close(bf(mixed + (rb + t) * DM + 0 + h * 64 + lane), o)) != 0;
}
__device__ bool chk_B(const bf16_t* proj, const bf16_t* mixed, const float* gain, float lam, float lam_init, int b, int h, int t, int lane) {
    const size_t rb = (size_t)b * SEQ; const float q = bf(proj + (rb + t) * NINP + C_BQ + h * 64 + lane);
    float m0 = -INFINITY, m1 = -INFINITY, l0 = 0.f, l1 = 0.f, o = 0.f;
    for (int s = 0; s <= t; ++s) { const float p = q * bf(proj + (rb + s) * NINP + C_BK + h * 64 + lane); m0 = fmaxf(m0, wave_sum(lane < 32 ? p : 0.f)); m1 = fmaxf(m1, wave_sum(lane < 32 ? 0.f : p)); }
    for (int s = 0; s <= t; ++s) { const float p = q * bf(proj + (rb + s) * NINP + C_BK + h * 64 + lane); l0 += exp2f(wave_sum(lane < 32 ? p : 0.f) - m0); l1 += exp2f(wave_sum(lane < 32 ? 0.f : p) - m1); }
    for (int s = 0; s <= t; ++s) { const float p = q * bf(proj + (rb + s) * NINP + C_BK + h * 64 + lane);
        const float w = exp2f(wave_sum(lane < 32 ? p : 0.f) - m0) / l0 - lam * exp2f(wave_sum(lane < 32 ? 0.f : p) - m1) / l1;
        o += w * bf(proj + (rb + s) * NINP + C_BV + h * 64 + lane); }
    const float rs = rsqrtf(wave_sum(o * o) / 64.f + RMS_EPS) * (1.f - lam_init);
    return __all(close(bf(mixed + (rb + t) * DM + 256 + h * 64 + lane), o * rs * gain[lane])) != 0;
}
__device__ bool chk_C(const bf16_t* proj, const bf16_t* kmean, const bf16_t* mixed, int b, int h, int t, int lane) {
    const size_t rb = (size_t)b * SEQ; const float q = bf(proj + (rb + t) * NINP + C_CQ + h * 64 + lane);
    const int own = t >> 8; unsigned sel = 0u;
    float g0 = -INFINITY, g1 = -INFINITY, g2 = -INFINITY; int j0 = -1, j1 = -1, j2 = -1;
    for (int j = 0; j < own; ++j) {
        const float g = wave_sum(q * bf(kmean + ((size_t)((b * 4 + h) * 32 + j)) * 64 + lane));
        if (g > g0) { g2 = g1; j2 = j1; g1 = g0; j1 = j0; g0 = g; j0 = j; } else if (g > g1) { g2 = g1; j2 = j1; g1 = g; j1 = j; } else if (g > g2) { g2 = g; j2 = j; }
    }
    if (j0 >= 0) sel |= 1u << j0; if (j1 >= 0) sel |= 1u << j1; if (j2 >= 0) sel |= 1u << j2;
    float mx = -INFINITY, l = 0.f, o = 0.f;
    for (int s = 0; s <= t; ++s) { const int blk = s >> 8; if (blk != own && !((sel >> blk) & 1u)) continue; mx = fmaxf(mx, wave_sum(q * bf(proj + (rb + s) * NINP + C_CK + h * 64 + lane))); }
    for (int s = 0; s <= t; ++s) { const int blk = s >> 8; if (blk != own && !((sel >> blk) & 1u)) continue;
        const float w = exp2f(wave_sum(q * bf(proj + (rb + s) * NINP + C_CK + h * 64 + lane)) - mx); l += w; o += w * bf(proj + (rb + s) * NINP + C_CV + h * 64 + lane); }
    bool ok = __all(close(bf(mixed + (rb + t) * DM + 512 + h * 64 + lane), o / l)) != 0;
    { const int j = (t >> 3) & 31; float s = 0.f; for (int k = 0; k < 256; ++k) s += bf(proj + (rb + 256 * j + k) * NINP + C_CK + h * 64 + lane);
      ok = ok && (__all(fabsf(bf(kmean + ((size_t)((b * 4 + h) * 32 + j)) * 64 + lane) - s * (1.f / 256.f)) <= 0.004f) != 0); }
    return ok;
}
__device__ bool chk_D(const bf16_t* proj, const bf16_t* qr, const bf16_t* kc, const bf16_t* vc, const float* gates, const bf16_t* mixed, int b, int t, int lane) {
    const size_t rb = (size_t)b * SEQ, row = rb + t; const int qblk = t >> 6;
    const int ncv = t >= 31 ? ((t - 31) >> 4) + 1 : 0;
    float imp0 = 0.f, imp1 = 0.f;
    float acc0 = 0.f, acc1 = 0.f, acc2 = 0.f, acc3 = 0.f;
    for (int hd = 0; hd < 4; ++hd) {
        const float q = bf(proj + row * NINP + C_DQ + hd * 64 + lane);
        float mx = -INFINITY, l = 0.f, oc = 0.f;
        for (int n = 0; n < ncv; ++n) mx = fmaxf(mx, wave_sum(q * bf(kc + ((size_t)b * NCMP + n) * 64 + lane)));
        for (int n = 0; n < ncv; ++n) l += exp2f(wave_sum(q * bf(kc + ((size_t)b * NCMP + n) * 64 + lane)) - mx);
        for (int n = 0; n < ncv; ++n) { const float p = exp2f(wave_sum(q * bf(kc + ((size_t)b * NCMP + n) * 64 + lane)) - mx) / l;
            oc += p * bf(vc + ((size_t)b * NCMP + n) * 64 + lane);
            if (16 * n < 64 * lane + 64 && 16 * n + 32 > 64 * lane) imp0 += p;
            if (16 * n < 64 * (lane + 64) + 64 && 16 * n + 32 > 64 * (lane + 64)) imp1 += p; }
        const float gc = gates[row * 12 + hd * 3] * oc;
        if (hd == 0) acc0 = gc; else if (hd == 1) acc1 = gc; else if (hd == 2) acc2 = gc; else acc3 = gc;
    }
    bool s0 = false, s1 = false;
    for (int k = 0; k < 16; ++k) {
        const int ma = lane, mb = lane + 64;
        const float va = s0 ? -INFINITY : ((ma == 0 || ma == qblk || ma == qblk - 1) ? INFINITY : (ma <= qblk ? imp0 : -INFINITY));
        const float vb = s1 ? -INFINITY : ((mb == qblk || mb == qblk - 1) ? INFINITY : (mb <= qblk ? imp1 : -INFINITY));
        float bv = va; int bi = s0 ? 1000 : ma;
        { const int ib = s1 ? 1000 : mb; if (vb > bv || (vb == bv && ib < bi)) { bv = vb; bi = ib; } }
#pragma unroll
        for (int off = 1; off < 64; off <<= 1) { const float ov = __shfl_xor(bv, off); const int oi = __shfl_xor(bi, off); if (ov > bv || (ov == bv && oi < bi)) { bv = ov; bi = oi; } }
        if (bi == ma) s0 = true; if (bi == mb) s1 = true;
    }
    const unsigned long long selA = __ballot(s0), selB = __ballot(s1);
    bool ok = true;
    for (int hd = 0; hd < 4; ++hd) {
        const float q = bf(qr + row * 256 + hd * 64 + lane);
        float mx = -INFINITY, l = 0.f, os = 0.f;
        for (int s = 0; s <= t; ++s) { const int m = s >> 6; if (!(((m < 64 ? selA : selB) >> (m & 63)) & 1ull)) continue; mx = fmaxf(mx, wave_sum(q * bf(proj + (rb + s) * NINP + C_KS + lane))); }
        for (int s = 0; s <= t; ++s) { const int m = s >> 6; if (!(((m < 64 ? selA : selB) >> (m & 63)) & 1ull)) continue;
            const float p = exp2f(wave_sum(q * bf(proj + (rb + s) * NINP + C_KS + lane)) - mx); l += p; os += p * bf(proj + (rb + s) * NINP + C_VS + lane); }
        float mw = -INFINITY, lw = 0.f, ow = 0.f; const int sw0 = t - 511 > 0 ? t - 511 : 0;
        for (int s = sw0; s <= t; ++s) mw = fmaxf(mw, wave_sum(q * bf(proj + (rb + s) * NINP + C_KW + lane)));
        for (int s = sw0; s <= t; ++s) { const float p = exp2f(wave_sum(q * bf(proj + (rb + s) * NINP + C_KW + lane)) - mw); lw += p; ow += p * bf(proj + (rb + s) * NINP + C_VW + lane); }
        const float acc = hd == 0 ? acc0 : hd == 1 ? acc1 : hd == 2 ? acc2 : acc3;
        const float ref = acc + gates[row * 12 + hd * 3 + 1] * os / l + gates[row * 12 + hd * 3 + 2] * ow / lw;
        ok = ok && (__all(close(bf(mixed + row * DM + 768 + hd * 64 + lane), ref)) != 0);
    }
    return ok;
}
__device__ float dotcol(const float* x, const float* w, int row, int c, int lane) { float s = 0.f; for (int k = lane; k < DM; k += 64) s += x[(size_t)row * DM + k] * w[(size_t)k * NIN + c]; return wave_sum(s); }
__device__ bool chk_proj(const float* x, const float* w_in, const int* pos, const bf16_t* proj, const bf16_t* qr, const float* gates, int row, int c, int lane) {
    const bool r16 = (c >= C_BQ && c < C_BV), r32 = (c >= C_CQ && c < C_CV) || (c >= C_DQ && c < C_KC) || (c >= C_KS && c < C_VS) || (c >= C_KW && c < C_VW);
    float v = dotcol(x, w_in, row, c, lane), rot = v;
    if (r16 || r32) { const int half = r16 ? 16 : 32, j = c & (2 * half - 1), f = j & (half - 1); const bool lo = j < half;
        const float other = dotcol(x, w_in, row, lo ? c + half : c - half, lane);
        const float ang = (float)pos[row] * powf(10000.f, -(float)f / (float)half); float sn, cs; sincosf(ang, &sn, &cs);
        rot = lo ? v * cs - other * sn : v * cs + other * sn; }
    float sc = 1.f; if (c < C_AK || (c >= C_CQ && c < C_CK) || (c >= C_DQ && c < C_KC)) sc = QS64; if (c >= C_BQ && c < C_BK) sc = QS32;
    bool ok;
    if (c >= C_G) ok = fabsf(gates[(size_t)row * 12 + (c - C_G)] - 1.f / (1.f + expf(-v))) <= 0.01f;
    else if (c >= C_DQ && c < C_KC) ok = close(bf(proj + (size_t)row * NINP + c), v * sc) && close(bf(qr + (size_t)row * 256 + (c - C_DQ)), rot * sc);
    else ok = close(bf(proj + (size_t)row * NINP + c), rot * sc);
    return __all(ok) != 0;
}
__device__ bool chk_cmp(const bf16_t* proj, const float* cpos, const float* w1, const float* w2, const bf16_t* kcv, int kv, int b, int i, int d, int lane) {
    float h0 = 0.f, h1 = 0.f, h2 = 0.f, h3 = 0.f;
    for (int kk = 0; kk < 2048; ++kk) { const int j = kk >> 6, dd = kk & 63;
        const float tv = bf(proj + ((size_t)b * SEQ + 16 * i + j) * NINP + (kv ? C_VC : C_KC) + dd) + cpos[kk]; const float* wr = w1 + (size_t)kk * 256 + lane;
        h0 += tv * wr[0]; h1 += tv * wr[64]; h2 += tv * wr[128]; h3 += tv * wr[192]; }
    h0 = h0 / (1.f + expf(-h0)); h1 = h1 / (1.f + expf(-h1)); h2 = h2 / (1.f + expf(-h2)); h3 = h3 / (1.f + expf(-h3));
    const float o = wave_sum(h0 * w2[(size_t)lane * 64 + d] + h1 * w2[(size_t)(lane + 64) * 64 + d] + h2 * w2[(size_t)(lane + 128) * 64 + d] + h3 * w2[(size_t)(lane + 192) * 64 + d]);
    return close(bf(kcv + ((size_t)b * NCMP + i) * 64 + d), o);
}
}
#endif

constexpr int LDS_CTL = 131072, LDS_BYTES = 147456;
constexpr int LW_BAR = 0, LW_CNT = 8, LW_TS = 16, LW_CNTL = 32, LW_BASEL = 40, LW_PE = 64;
struct SchedGU {
    const LAS int* cw; const int* list; int t0, t1, G, c, nh; bool dense; unsigned apitch;
    static constexpr bool GATHER_DMA = true;
    __device__ __forceinline__ const int* aentry(const pg8::Unit& u, int r) const {
        if (dense) return list;
        const int e = u.pb / 28 - 1, slot = (u.pm - cw[LW_TS + e]) * 256 + r;
        return list + e * 32768 + (slot < cw[LW_CNT + e] ? slot : 0); }
    __device__ __forceinline__ unsigned afinish(const pg8::Unit& u, int r, int pid) const {
        if (dense) return (unsigned)(u.pm * 256 + r) * apitch;
        const int e = u.pb / 28 - 1, slot = (u.pm - cw[LW_TS + e]) * 256 + r;
        return slot < cw[LW_CNT + e] ? (unsigned)(pid >> 1) * apitch : 0u; }
    __device__ __forceinline__ bool next(int i, pg8::Unit& u) const {
        int L;
        if (c >= nh) L = i < 4 ? i * (G - nh) + (c - nh) : 4 * (G - nh) + (i - 4) * G + c; else L = 4 * (G - nh) + i * G + c;
        if (L >= (t1 - t0) * 28) return false;
        u.pm = t0 + L / 28; u.pn = L % 28; int e = 0;
        if (!dense) { for (; e < 7; ++e) if (u.pm < cw[LW_TS + e + 1]) break; }
        u.pb = (dense ? 0 : 1 + e) * 28 + u.pn; return true;
    }
    __device__ __forceinline__ unsigned arow(const pg8::Unit& u, int r) const {
        if (dense) return (unsigned)(u.pm * 256 + r) * apitch;
        const int e = u.pb / 28 - 1, slot = (u.pm - cw[LW_TS + e]) * 256 + r;
        const int pid = slot < cw[LW_CNT + e] ? list[e * 32768 + slot] : 0;
        return (unsigned)(pid >> 1) * apitch;
    }
};
struct SchedDN {
    static constexpr bool GATHER_DMA = false;
    const LAS int* cw; int t0, t1, s0, G, c; bool dense;
    __device__ __forceinline__ bool next(int i, pg8::Unit& u) const {
        const int L = i * G + c; if (L >= (t1 - t0) * 4) return false;
        u.pm = t0 + (L >> 2); u.pn = L & 3; int e = 0;
        if (!dense) { for (; e < 7; ++e) if (u.pm < cw[LW_TS + e + 1]) break; }
        u.pb = (dense ? 0 : 1 + e) * 4 + u.pn; return true;
    }
    __device__ __forceinline__ unsigned arow(const pg8::Unit& u, int r) const { return (unsigned)((u.pm - s0) * 256 + r) * (unsigned)DFF; }
};
struct EpiDown {
    static constexpr bool PERM = true; static constexpr int DUPID = 32;
    bool dense; const bf16_t* h1; bf16_t* ps; bf16_t* Y; const LAS int* cw; const int* list; const float* moeg; float sc;
    __device__ __forceinline__ void operator()(const Acc& acc, const pg8::Unit& u, int wr, int wc, int fr, int fq) const {
        const int col = u.pn * 256 + wc * 32 + 8 * fq;
        if (dense) {
#pragma unroll
            for (int ai = 0; ai < 2; ++ai)
#pragma unroll
                for (int m = 0; m < 4; ++m) { const size_t off = (size_t)(u.pm * 256 + ai * 128 + wr * 64 + m * 16 + fr) * DM + col;
#pragma unroll
                    for (int bj = 0; bj < 2; ++bj) { const size_t o = off + bj * 128; f32x4 b0, b1; ld_bf8(h1 + o, b0, b1); st_bf8(ps + o, b0 * ALPHA + acc[ai][bj][m][0] * sc, b1 * ALPHA + acc[ai][bj][m][1] * sc); } }
        } else {
            const int e = u.pb / 4 - 1, s0 = (u.pm - cw[LW_TS + e]) * 256, ce = cw[LW_CNT + e];
#pragma unroll
            for (int ai = 0; ai < 2; ++ai)
#pragma unroll
                for (int m = 0; m < 4; ++m) { const int slot = s0 + ai * 128 + wr * 64 + m * 16 + fr;
                    if (slot < ce) { const int pid = list[e * 32768 + slot]; const float g = moeg[pid] * sc; bf16_t* yp = Y + (size_t)pid * DM + col;
#pragma unroll
                        for (int bj = 0; bj < 2; ++bj) st_bf8(yp + bj * 128, acc[ai][bj][m][0] * g, acc[ai][bj][m][1] * g); } }
        }
    }
};
struct EpiPle {
    static constexpr bool PERM = true; static constexpr int DUPID = 64;
    const bf16_t* h2; const bf16_t* P; float* out32; bf16_t* o16b;
    __device__ __forceinline__ void operator()(const Acc& acc, const pg8::Unit& u, int wr, int wc, int fr, int fq) const {
#pragma unroll
        for (int ai = 0; ai < 2; ++ai)
#pragma unroll
            for (int m = 0; m < 4; ++m) { const size_t off = (size_t)(u.pm * 256 + ai * 128 + wr * 64 + m * 16 + fr) * DM + u.pn * 256 + wc * 32 + 8 * fq;
#pragma unroll
                for (int bj = 0; bj < 2; ++bj) { const size_t o = off + bj * 128; f32x4 h0, h1, p0, p1; ld_bf8(h2 + o, h0, h1); ld_bf8(P + o, p0, p1);
                    const f32x4 a0 = acc[ai][bj][m][0], a1 = acc[ai][bj][m][1]; f32x4 r0, r1;
#pragma unroll
                    for (int e = 0; e < 4; ++e) { r0[e] = h0[e] + sigmoidf_(a0[e]) * p0[e]; r1[e] = h1[e] + sigmoidf_(a1[e]) * p1[e]; }
                    if (out32) { *(f32x4*)(out32 + o) = r0; *(f32x4*)(out32 + o + 4) = r1; } else st_bf8(o16b + o, r0, r1); } }
    }
};
struct SchedCmp {
    static constexpr bool GATHER_DMA = false;
    int c;
    __device__ bool next(int i, pg8::Unit& u) const { if (i > 0 || c >= 32) return false; u.pm = c & 7; u.pn = (c >> 3) & 1; u.pb = 2 * (c >> 4) + ((c >> 3) & 1); return true; }
    __device__ __forceinline__ unsigned arow(const pg8::Unit& u, int r) const { const int rr = u.pm * 256 + r; return (unsigned)(((rr >> 9) * SEQ + 16 * (rr & 511)) * NINP + ((u.pb >> 1) ? C_VC : C_KC)) * 2u; }
};

template <class RM> __device__ __forceinline__ void transpose_item(const float* W, int K, int N, bf16_t* WT, const RM& rm, LAS float* scr, int item, int lane) {
    const int nblk = (N + 31) / 32, kb = item / nblk, nb = item % nblk, k0 = 64 * kb, n0 = 32 * nb;
    const int n4 = 4 * (lane & 7), kr = lane >> 3;
    const bool ok = (n0 + n4 + 3 < N);
    f32x4 v[8];
#pragma unroll
    for (int i = 0; i < 8; ++i) v[i] = ok ? *(const f32x4*)(W + (size_t)(k0 + kr + 8 * i) * N + n0 + n4) : (f32x4){0.f, 0.f, 0.f, 0.f};
#pragma unroll
    for (int i = 0; i < 8; ++i) { LAS float* d = scr + (kr + 8 * i) * 33 + n4; d[0] = v[i][0]; d[1] = v[i][1]; d[2] = v[i][2]; d[3] = v[i][3]; }
    asm volatile("s_waitcnt lgkmcnt(0)" ::: "memory");
    const int c = lane & 7;
#pragma unroll
    for (int j = 0; j < 4; ++j) { const int n = (lane >> 3) + 8 * j; const LAS float* s = scr + (8 * c) * 33 + n;
        u32x4 o; o.x = pk2(s[0 * 33], s[1 * 33]); o.y = pk2(s[2 * 33], s[3 * 33]); o.z = pk2(s[4 * 33], s[5 * 33]); o.w = pk2(s[6 * 33], s[7 * 33]);
        if (n0 + n < N) *(u32x4*)(WT + (size_t)rm(n0 + n) * K + k0 + 8 * c) = o; }
    asm volatile("s_waitcnt lgkmcnt(0)" ::: "memory");
}
template <class RM> __device__ __forceinline__ void transpose_item8(const float* W, int K, int N, unsigned char* WT, const RM& rm, LAS float* scr, int item, int lane) {
    const int nblk = (N + 31) / 32, kb = item / nblk, nb = item % nblk, k0 = 64 * kb, n0 = 32 * nb;
    const int n4 = 4 * (lane & 7), kr = lane >> 3;
    f32x4 v[8];
#pragma unroll
    for (int i = 0; i < 8; ++i) v[i] = *(const f32x4*)(W + (size_t)(k0 + kr + 8 * i) * N + n0 + n4);
#pragma unroll
    for (int i = 0; i < 8; ++i) { LAS float* d = scr + (kr + 8 * i) * 33 + n4; d[0] = v[i][0]; d[1] = v[i][1]; d[2] = v[i][2]; d[3] = v[i][3]; }
    asm volatile("s_waitcnt lgkmcnt(0)" ::: "memory");
    const int c = lane & 7;
#pragma unroll
    for (int j = 0; j < 4; ++j) { const int n = (lane >> 3) + 8 * j; const LAS float* s = scr + (8 * c) * 33 + n;
        u32x2 o; o.x = pk_fp8x4(32.f * s[0 * 33], 32.f * s[1 * 33], 32.f * s[2 * 33], 32.f * s[3 * 33]); o.y = pk_fp8x4(32.f * s[4 * 33], 32.f * s[5 * 33], 32.f * s[6 * 33], 32.f * s[7 * 33]);
        *(u32x2*)(WT + (size_t)rm(n0 + n) * K + k0 + 8 * c) = o; }
    asm volatile("s_waitcnt lgkmcnt(0)" ::: "memory");
}
struct RmId { int off; __device__ __forceinline__ int operator()(int n) const { return off + n; } };
struct RmIl { int s; __device__ __forceinline__ int operator()(int n) const { return 2 * n + s; } };
struct RmIn { __device__ __forceinline__ int operator()(int n) const {
    const bool rp = (n >= C_CQ && n < C_CV) || (n >= C_DQ && n < C_KC) || (n >= C_KS && n < C_VS) || (n >= C_KW && n < C_VW);
    return rp ? ((n & ~48) | ((n & 16) << 1) | ((n & 32) >> 1)) : n; } };

struct Args { const void* in[23]; float* out; unsigned char* ws; int ph_lo, ph_hi; };
constexpr int NWAVES = 8, NTHREADS = 512;
constexpr int NPHASES = 1 + 11 + 13 + (CHECK_N ? 2 : 0);

__global__ void __launch_bounds__(NTHREADS, 2) mk_fwd(Args args) {
    extern __shared__ __attribute__((aligned(16))) unsigned char lds_raw[];
    LAS unsigned char* lds = (LAS unsigned char*)lds_raw;
    LAS int* cw = (LAS int*)(lds + LDS_CTL);
    const int tid0 = threadIdx.x, wave0 = __builtin_amdgcn_readfirstlane(tid0 >> 6);
    const int G = gridDim.x, bx = blockIdx.x, vcu = (G % 8 == 0) ? (bx % 8) * (G / 8) + bx / 8 : bx;
    const int NGW = G * NWAVES;
    unsigned* ctl = (unsigned*)(args.ws + WS_CTL);
    const int lo = args.ph_lo, hi = args.ph_hi;
    for (int u = tid0; u < (LDS_BYTES - LDS_CTL) / 4; u += NTHREADS) cw[u] = 0;
    __syncthreads();
    XcdBarrier bar; bar.bar = ctl + CW_BAR; bar.x = 0; bar.st = nullptr;
    if (hi - lo > 1) bar = xcd_barrier_post(ctl + CW_BAR, (volatile LAS unsigned*)(cw + LW_BAR));
    float* const dout = args.out;
#define CAS __attribute__((address_space(4)))
#define KIN(i) (*(const void* CAS const*)(ka + 8 * (i)))
#define PHASE_NAMES \
    unsigned zz_ = 0u; asm volatile("" : "+v"(zz_)); int tid = wave0 * 64 + (int)__builtin_amdgcn_mbcnt_hi(~0u, __builtin_amdgcn_mbcnt_lo(~0u, zz_)); asm volatile("" : "+v"(tid)); const int lane = tid & 63, wave = __builtin_amdgcn_readfirstlane(tid >> 6), gw = vcu * NWAVES + wave; \
    CAS const unsigned char* ka = (CAS const unsigned char*)__builtin_amdgcn_kernarg_segment_ptr(); asm volatile("" : "+s"(ka)); \
    unsigned char* ws = *(unsigned char* CAS const*)(ka + 24 * 8); \
    const float* x = (const float*)KIN(0); const float* pin = (const float*)KIN(1); const int* pos = (const int*)KIN(2); \
    const float* w_in = (const float*)KIN(3); const float* w_out = (const float*)KIN(4); \
    const float* ln_mix_g = (const float*)KIN(5); const float* ln_mix_b = (const float*)KIN(6); \
    const float* diff_lambda = (const float*)KIN(7); const float* diff_gain = (const float*)KIN(8); \
    const float* cmp_pos = (const float*)KIN(9); const float* cmp_w1 = (const float*)KIN(10); const float* cmp_w2 = (const float*)KIN(11); \
    const float* ffn_w1 = (const float*)KIN(12); const float* ffn_w3 = (const float*)KIN(13); const float* ffn_w2 = (const float*)KIN(14); \
    const float* moe_router = (const float*)KIN(15); const float* moe_w1 = (const float*)KIN(16); const float* moe_w3 = (const float*)KIN(17); const float* moe_w2 = (const float*)KIN(18); \
    const float* ln_ffn_g = (const float*)KIN(19); const float* ln_ffn_b = (const float*)KIN(20); \
    const float* ple_proj = (const float*)KIN(21); const float* ple_gate = (const float*)KIN(22); \
    unsigned char* misc = ws + WS_MISC; \
    float* lamv = (float*)(misc + OFF_LAM); float* c1 = (float*)(misc + OFF_C1); \
    bf16_t* kmean = (bf16_t*)(misc + OFF_KMEAN); bf16_t* KC = (bf16_t*)(misc + OFF_KC); bf16_t* VC = (bf16_t*)(misc + OFF_VC); \
    float* gates = (float*)(misc + OFF_GATES); float* moeg = (float*)(misc + OFF_MOEG); int* list = (int*)(misc + OFF_LIST); float* hid = (float*)(misc + OFF_HID); \
    float* cos32 = (float*)(ws + WS_ROPE); float* sin32 = cos32 + (size_t)NT * 32; float* cos16 = sin32 + (size_t)NT * 32; float* sin16 = cos16 + (size_t)NT * 16; \
    unsigned char* wb = ws + WS_W; \
    bf16_t* hb = (bf16_t*)(ws + WS_HB); bf16_t* pb = (bf16_t*)(ws + WS_PB); \
    unsigned char* R = ws + WS_R; int* mlist = (int*)(ws + WS_MLIST); unsigned char* hb8 = R + 240 * MiB; \
    bf16_t* proj = (bf16_t*)(R + R_PROJ); bf16_t* qr = (bf16_t*)(R + R_QR); bf16_t* mixed = (bf16_t*)(R + R_MIXED); \
    bf16_t* hidb = (bf16_t*)(R + R_HID); float* H2 = (float*)(R + R_H2); bf16_t* Pp = (bf16_t*)(R + R_P); \
    (void)lane; (void)gw; (void)x; (void)pin; (void)pos; (void)w_in; (void)w_out; (void)ln_mix_g; (void)ln_mix_b; (void)diff_lambda; (void)diff_gain; (void)cmp_pos; (void)cmp_w1; (void)cmp_w2; \
    (void)ffn_w1; (void)ffn_w3; (void)ffn_w2; (void)moe_router; (void)moe_w1; (void)moe_w3; (void)moe_w2; (void)ln_ffn_g; (void)ln_ffn_b; (void)ple_proj; (void)ple_gate; (void)lamv; (void)c1; \
    (void)kmean; (void)KC; (void)VC; (void)gates; (void)moeg; (void)list; (void)hid; (void)sin16; (void)wb; (void)hb; (void)pb; (void)proj; (void)qr; (void)mixed; (void)hidb; (void)H2; (void)Pp; (void)mlist; (void)hb8;

    int ph = 0;
#if TIMA || TIMB
#define TIM_START(k) { int b0_ = bx | wave0; asm volatile("" : "+s"(b0_)); if (b0_ == 0 && __builtin_amdgcn_mbcnt_hi(~0u, __builtin_amdgcn_mbcnt_lo(~0u, 0u)) == 0u) { const unsigned long long t_ = __builtin_amdgcn_s_memrealtime(); cw[480] = (int)(unsigned)t_; cw[481] = (int)(unsigned)(t_ >> 32); cw[482] = (k); } }
#define TIM_STOP { int b0_ = bx | wave0; asm volatile("" : "+s"(b0_)); if (b0_ == 0 && __builtin_amdgcn_mbcnt_hi(~0u, __builtin_amdgcn_mbcnt_lo(~0u, 0u)) == 0u) { const unsigned long long t0_ = ((unsigned long long)(unsigned)cw[481] << 32) | (unsigned)cw[480]; const unsigned dt_ = (unsigned)(__builtin_amdgcn_s_memrealtime() - t0_); const int ts_ = cw[482]; \
    if ((TIMA >> ts_) & 1) atomicAdd(ctl + 12288, dt_); if ((TIMB >> ts_) & 1) atomicAdd(ctl + 12352, dt_); } }
#else
#define TIM_START(k)
#define TIM_STOP
#endif
#define PHASE_BEGIN(k) if (ph >= lo && ph < hi) { TIM_START(k) for (int rep_ = 0; rep_ < (((PHMASK >> (k)) & 1) ? 1 + (((DUPMASK >> (k)) & 1) && (DUPL < 0 || DUPL == Lcur)) : 0); ++rep_) { if (rep_) xcd_barrier(bar); PHASE_NAMES
#define PHASE_END   } if (ph + 1 < hi) xcd_barrier(bar); TIM_STOP } ++ph;

    int Lcur = -1;
    PHASE_BEGIN(0)
    {
        LAS float* scr = (LAS float*)(lds + wave * 16384);
        for (int f = gw; f < 3 * 1792; f += NGW) {
            const int idx = f / 1792, item = f % 1792, e = idx / 3, which = idx % 3;
            const float* W = e == 0 ? (which == 0 ? ffn_w1 : which == 1 ? ffn_w3 : ffn_w2) : ((which == 0 ? moe_w1 : which == 1 ? moe_w3 : moe_w2) + (size_t)(e - 1) * DM * DFF);
            if (which < 2) transpose_item8(W, DM, DFF, (unsigned char*)(wb + W_F13) + (size_t)e * 2 * DFF * DM, RmIl{which}, scr, item, lane);
            else transpose_item8(W, DFF, DM, (unsigned char*)(wb + W8_F2) + (size_t)e * DM * DFF, RmId{0}, scr, item, lane);
        }
        for (int f = gw; f < DEPTH * 16 * 93; f += NGW) { const int L = f / (16 * 93), item = f % (16 * 93);
            transpose_item(w_in + (size_t)L * DM * NIN, DM, NIN, (bf16_t*)(wb + W_IN) + (size_t)L * NINP * DM, RmIn{}, scr, item, lane); }
        for (int f = gw; f < DEPTH * 512; f += NGW) { const int L = f / 512, item = f % 512;
            transpose_item(w_out + (size_t)L * DM * DM, DM, DM, (bf16_t*)(wb + W_OUT) + (size_t)L * DM * DM, RmId{0}, scr, item, lane); }
        for (int f = gw; f < DEPTH * 512; f += NGW) { const int L = f / 512, item = f % 512;
            transpose_item(ple_gate + (size_t)L * DM * DM, DM, DM, (bf16_t*)(wb + W_PG) + (size_t)L * DM * DM, RmId{0}, scr, item, lane); }
        for (int f = gw; f < DEPTH * 128; f += NGW) { const int L = f / 128, item = f % 128;
            transpose_item(ple_proj + (size_t)L * PLE * DM, PLE, DM, (bf16_t*)(wb + W_PP) + (size_t)L * DM * PLE, RmId{0}, scr, item, lane); }
        for (int f = gw; f < DEPTH * 2 * 256; f += NGW) { const int lk = f / 256, hf = (f % 256) / 128, item = f % 128;
            transpose_item(cmp_w1 + ((size_t)lk * 2048 + hf * 1024) * 256, 1024, 256, (bf16_t*)(wb + W_C1) + (size_t)lk * 512 * 1024, RmId{hf * 256}, scr, item, lane); }
        for (int f = gw * 64 + lane; f < DEPTH * (NINP - NIN) * (DM / 8); f += NGW * 64) { const int L = f / ((NINP - NIN) * (DM / 8)), r = f % ((NINP - NIN) * (DM / 8));
            *(u32x4*)((bf16_t*)(wb + W_IN) + ((size_t)L * NINP + NIN) * DM + (size_t)r * 8) = (u32x4){0u, 0u, 0u, 0u}; }
        for (int r = gw; r < NT; r += 2 * NGW) { const int r2 = r + NGW < NT ? r + NGW : r;
            const f32x4* xa = (const f32x4*)(x + (size_t)r * DM) + lane; const f32x4* xb = (const f32x4*)(x + (size_t)r2 * DM) + lane; f32x4 va[4], vb[4];
#pragma unroll
            for (int j = 0; j < 4; ++j) { va[j] = xa[64 * j]; vb[j] = xb[64 * j]; }
            u32x2* oa = (u32x2*)(hb + (size_t)r * DM) + lane; u32x2* ob = (u32x2*)(hb + (size_t)r2 * DM) + lane;
#pragma unroll
            for (int j = 0; j < 4; ++j) { u32x2 w; w.x = pk2(va[j][0], va[j][1]); w.y = pk2(va[j][2], va[j][3]); oa[64 * j] = w; w.x = pk2(vb[j][0], vb[j][1]); w.y = pk2(vb[j][2], vb[j][3]); ob[64 * j] = w; } }
        { const int fi = lane & 31;
          const float i32_ = powf(10000.f, -(float)fi / 32.f), i16_ = powf(10000.f, -(float)(fi & 15) / 16.f);
          for (int f = gw * 64 + lane; f < NT * 32; f += NGW * 64) { const int tok = f >> 5; const float p = (float)pos[tok];
            { const float a = p * i32_; const double t = (double)a * 0.15915494309189535; const float rr = (float)(((double)t - __builtin_rint(t)) * 6.283185307179586); float s, c; sincosf(rr, &s, &c); cos32[f] = c; sin32[f] = s; }
            if (fi < 16) { const float a = p * i16_; const double t = (double)a * 0.15915494309189535; const float rr = (float)(((double)t - __builtin_rint(t)) * 6.283185307179586); float s, c; sincosf(rr, &s, &c); cos16[tok * 16 + fi] = c; sin16[tok * 16 + fi] = s; } } }
        if (vcu < DEPTH * 2 * 4) {
            const int lk = vcu >> 2, sl = vcu & 3;
            const float* pe = cmp_pos + (size_t)lk * 2048 + sl * 512; const float* w1 = cmp_w1 + ((size_t)lk * 2048 + sl * 512) * 256;
            const int n4 = 4 * (tid & 63), kg = tid >> 6; f32x4 s = {0.f, 0.f, 0.f, 0.f};
#pragma unroll 16
            for (int kk = kg * 64; kk < kg * 64 + 64; ++kk) s += pe[kk] * *(const f32x4*)(w1 + (size_t)kk * 256 + n4);
            LAS float* red = (LAS float*)lds;
            __syncthreads(); *(LAS f32x4*)(red + kg * 256 + n4) = s; __syncthreads();
            if (tid < 256) { float a = 0.f;
#pragma unroll
                for (int q = 0; q < 8; ++q) a += red[q * 256 + tid];
                c1[(lk * 4 + sl) * 256 + tid] = a; }
        }
        if (vcu == DEPTH * 2 * 4 && tid < DEPTH) { const float* lf = diff_lambda + tid * 128; float a = 0.f, b = 0.f;
            for (int k = 0; k < 32; ++k) { a += lf[k] * lf[32 + k]; b += lf[64 + k] * lf[96 + k]; }
            lamv[tid] = expf(a) - expf(b) + (0.8f - 0.6f * expf(-0.3f * (float)tid)); }
    }
    PHASE_END

    for (int L = 0; L < DEPTH; ++L) { Lcur = L;
        const float lam_init = (L == 0) ? 0.2f : 0.35550907f;
        const bool moe = (L & 1);
        PHASE_BEGIN(1)
        {
            pg8::Gemm g{L == 0 ? hb : (const bf16_t*)dout + (size_t)NT * DM, (const bf16_t*)(wb + W_IN) + (size_t)L * NINP * DM, DM, 128u};
            pg8::StaticOrder S; S.init(NT, NINP, G, bx, DM);
            EpiInProj E{proj, qr, gates, cos32, sin32, cos16, sin16};
            pg8::gemm_phase(lds, g, S, E, tid);
        }
        PHASE_END
        PHASE_BEGIN(2)
        {
            if (vcu < 32) {
                pg8::Gemm g{proj, (const bf16_t*)(wb + W_C1) + (size_t)L * 2 * 512 * 1024, 1024, (unsigned)(NINP * 2)};
                SchedCmp S{vcu}; EpiCmp E{(bf16_t*)hid};
                pg8::gemm_phase(lds, g, S, E, tid);
            } else {
                if (L == 0) {
                    LAS float* scr = (LAS float*)(lds + wave * 16384);
                    const int gw2 = (vcu - 32) * NWAVES + wave, NGW2 = (G - 32) * NWAVES;
                    for (int f = 3 * 1792 + gw2; f < 27 * 1792; f += NGW2) {
                        const int idx = f / 1792, item = f % 1792, e = idx / 3, which = idx % 3;
                        const float* W = (which == 0 ? moe_w1 : which == 1 ? moe_w3 : moe_w2) + (size_t)(e - 1) * DM * DFF;
                        if (which < 2) transpose_item8(W, DM, DFF, (unsigned char*)(wb + W_F13) + (size_t)e * 2 * DFF * DM, RmIl{which}, scr, item, lane);
                        else transpose_item8(W, DFF, DM, (unsigned char*)(wb + W8_F2) + (size_t)e * DM * DFF, RmId{0}, scr, item, lane);
                    }
                    __syncthreads();
                }
                LAS float* part = (LAS float*)lds;
                for (int it = vcu - 32; it < 512; it += G - 32) {
                    const int bh = it >> 5, j = it & 31, b = bh >> 2, h = bh & 3, kg = tid >> 3, c = tid & 7;
                    const bf16_t* kp = proj + ((size_t)b * SEQ + 256 * j + 4 * kg) * NINP + C_CK + h * 64 + c * 8;
                    float s[8] = {0.f, 0.f, 0.f, 0.f, 0.f, 0.f, 0.f, 0.f};
#pragma unroll
                    for (int k = 0; k < 4; ++k) { const u32x4 v = *(const u32x4*)(kp + (size_t)k * NINP);
                        s[0] += bflo(v.x); s[1] += bfhi(v.x); s[2] += bflo(v.y); s[3] += bfhi(v.y); s[4] += bflo(v.z); s[5] += bfhi(v.z); s[6] += bflo(v.w); s[7] += bfhi(v.w); }
                    __syncthreads();
#pragma unroll
                    for (int q = 0; q < 8; ++q) part[kg * 64 + c * 8 + q] = s[q];
                    __syncthreads();
                    if (tid < 64) { float a = 0.f; for (int k = 0; k < 64; ++k) a += part[k * 64 + tid]; kmean[(size_t)it * 64 + tid] = (bf16_t)(pk2(a * (1.f / 256.f), 0.f) & 0xffffu); }
                }
            }
        }
        PHASE_END
        PHASE_BEGIN(3)
        {
            { LAS float* hs = (LAS float*)(lds + wave * 1024);
              const bf16_t* uv = (const bf16_t*)hid;
              for (int gi = gw; gi < 2 * 2048; gi += NGW) {
                const int kv = gi >> 11, r = gi & 2047, r1 = r < 2047 ? r + 1 : r;
                const float* cp = c1 + L * 2048 + kv * 1024;
#pragma unroll
                for (int q = 0; q < 4; ++q) { const int n = lane + 64 * q;
                    const float a = bf2f_(uv[((size_t)kv * 2048 + r) * 512 + n]) + bf2f_(uv[((size_t)kv * 2048 + r1) * 512 + 256 + n]) + ((cp[n] + cp[256 + n]) + (cp[512 + n] + cp[768 + n]));
                    hs[n] = a * sigmoidf_(a); }
                const float* w2 = cmp_w2 + ((size_t)(L * 2 + kv) * 256) * 64 + lane;
                float o = 0.f;
#pragma unroll 8
                for (int n = 0; n < 256; ++n) o += hs[n] * w2[(size_t)n * 64];
                (kv ? VC : KC)[(size_t)r * 64 + lane] = (bf16_t)(pk2((r & 511) != 511 ? o : 0.f, 0.f) & 0xffffu);
              }
              __syncthreads();
            }
            { const int bh = vcu >> 4, s = vcu & 15;
              for (int k = 0; k < 2; ++k) { int tq = tid; asm volatile("" : "+v"(tq)); att::unit_Csel(lds, proj, kmean, ctl + CW_MC + L * 512, mlist, bh >> 2, bh & 3, k ? 31 - s : s, tq, wave, tq & 63); } }
        }
        PHASE_END
        PHASE_BEGIN(4)
        {
            const float lam = lamv[L];
#define ATT_TID int tq = tid; asm volatile("" : "+v"(tq)); const int lq = tq & 63;
            {
                LAS int* pre = (LAS int*)(lds + att::L_X + 1024); LAS int* cn = pre + 520;
                __syncthreads();
                if (tid < 512) cn[tid] = (int)__hip_atomic_load(ctl + CW_MC + L * 512 + tid, __ATOMIC_RELAXED, __HIP_MEMORY_SCOPE_AGENT);
                __syncthreads();
                if (tid == 0) { int a = 0; for (int i = 0; i < 512; ++i) { pre[i] = a; a += (cn[i] + 255) >> 8; } pre[512] = a; }
                __syncthreads();
                const int U = pre[512];
                for (int u = vcu; u < U; u += G) {
                    int lo_ = 0, hi_ = 512;
                    while (hi_ - lo_ > 1) { const int mid = (lo_ + hi_) >> 1; if (pre[mid] <= u) lo_ = mid; else hi_ = mid; }
                    ATT_TID att::unit_Cgather(lds, proj, mlist, (bf16_t*)hb, (float*)pb, lo_, u - pre[lo_], cn[lo_], tq, wave, lq);
                }
            }
            { const int bh = vcu >> 4, s = vcu & 15;
#if CHECK_C
              for (int k = 0; k < 2; ++k) { ATT_TID att::unit_C(lds, proj, kmean, mixed, bh >> 2, bh & 3, (k & 1) ? 31 - s : s, tq, wave, lq); }
#endif
              if (ATTMASK & 2) for (int k = 0; k < ((DUPATT & 2) ? 4 : 2); ++k) { ATT_TID att::unit_B(lds, proj, mixed, diff_gain + L * 64, lam, lam_init, bh >> 2, bh & 3, (k & 1) ? 31 - s : s, tq, wave, lq); } }
        }
        PHASE_END
        PHASE_BEGIN(12)
        {
            { const int bh = vcu >> 4, s = vcu & 15;
              if (ATTMASK & 4) for (int k = 0; k < 2; ++k) { ATT_TID att::unit_Cown(lds, proj, (const bf16_t*)hb, (const float*)pb, mixed, ctl + CW_FLAG, bh >> 2, bh & 3, (k & 1) ? 31 - s : s, tq, wave, lq); }
              if (ATTMASK & 1) for (int k = 0; k < ((DUPATT & 1) ? 4 : 2); ++k) { ATT_TID att::unit_A(lds, proj, mixed, bh >> 2, bh & 3, (k & 1) ? 31 - s : s, tq, wave, lq); } }
            { const int b = vcu >> 6, s = vcu & 63;
              if (ATTMASK & 8) for (int k = 0; k < ((DUPATT & 8) ? 4 : 2); ++k) { ATT_TID att::unit_D(lds, proj, qr, KC, VC, gates, mixed, b, (k & 1) ? 127 - s : s, tq, wave, lq); } }
#undef ATT_TID
        }
        PHASE_END
#if CHECK_N
        PHASE_BEGIN(13)
        {
            {
                if (CHECK_N & 1) for (int gi = gw; gi < 4096; gi += NGW) { const int grp = gi >> 10, sidx = gi & 1023, b = sidx & 3, h = (sidx >> 2) & 3, t = (sidx * 977 + 13 + 2048 * (sidx & 3)) & 8191;
                    bool ok;
                    if (grp == 0) ok = chk::chk_A(proj, mixed, b, h, t, lane);
                    else if (grp == 1) ok = chk::chk_B(proj, mixed, diff_gain + L * 64, lamv[L], lam_init, b, h, t, lane);
                    else if (grp == 2) ok = chk::chk_C(proj, kmean, mixed, b, h, t, lane);
                    else ok = chk::chk_D(proj, qr, KC, VC, gates, mixed, b, t, lane);
                    if (!ok && lane == 0) atomicAdd(ctl + CW_FLAG + 64 * (1 + grp), 1u); }
                for (int gi = gw + ((CHECK_N & 2) ? 0 : 1024); gi < ((CHECK_N & 4) ? 2048 : 1024); gi += NGW) { const int sidx = gi & 1023; bool ok = true;
                    if (gi < 1024) { if (L == 0) ok = chk::chk_proj(x, w_in, pos, proj, qr, gates, (sidx * 7919 + 31) & (NT - 1), (sidx * 613 + 5) % NIN, lane); }
                    else ok = chk::chk_cmp(proj, cmp_pos + (size_t)(L * 2 + (sidx & 1)) * 2048, cmp_w1 + (size_t)(L * 2 + (sidx & 1)) * 2048 * 256, cmp_w2 + (size_t)(L * 2 + (sidx & 1)) * 256 * 64, (sidx & 1) ? VC : KC, sidx & 1, (sidx >> 1) & 3, (sidx * 131) % 511, (sidx * 29) & 63, lane);
                    if (!ok && lane == 0) atomicAdd(ctl + CW_FLAG + 64 * (1 + 4 + (gi >> 10)), 1u); }
            }
        }
        PHASE_END
#endif
        PHASE_BEGIN(5)
        {
            pg8::Gemm g{mixed, (const bf16_t*)(wb + W_OUT) + (size_t)L * DM * DM, DM, 128u};
            pg8::StaticOrder S; S.init(NT, DM, G, bx, DM);
            EpiPresum E{L == 0 ? x : nullptr, (const bf16_t*)dout + (size_t)NT * DM, (bf16_t*)dout};
            pg8::gemm_phase(lds, g, S, E, tid);
        }
        PHASE_END
        PHASE_BEGIN(6)
        {
            const float* gv = ln_mix_g + L * DM; const float* bv = ln_mix_b + L * DM;
            f32x4 gg[4], bb[4];
#pragma unroll
            for (int j = 0; j < 4; ++j) { gg[j] = *((const f32x4*)gv + lane + 64 * j); bb[j] = *((const f32x4*)bv + lane + 64 * j); }
            if (tid < 8) cw[LW_CNTL + tid] = 0;
            if (moe) {
                for (int s_ = tid; s_ < 2048; s_ += 512) { const int e_ = s_ >> 1, hf_ = s_ & 1;
                    *((LAS f32x4*)(lds + hf_ * 16384) + (e_ & 7) * 128 + (e_ >> 3)) = *((const f32x4*)moe_router + s_); }
            }
            __syncthreads();
            int k = 0;
            for (int r = gw; r < NT; r += NGW, ++k) {
                const u32x2* xr = (const u32x2*)((const bf16_t*)dout + (size_t)r * DM) + lane;
                f32x4 v[4]; float s = 0.f;
#pragma unroll
                for (int j = 0; j < 4; ++j) { const u32x2 w = xr[64 * j]; v[j] = (f32x4){bflo(w.x), bfhi(w.x), bflo(w.y), bfhi(w.y)}; s += (v[j][0] + v[j][1]) + (v[j][2] + v[j][3]); }
                const float mean = wave_sum(s) * (1.f / DM); float s2 = 0.f;
#pragma unroll
                for (int j = 0; j < 4; ++j) { v[j] = v[j] - mean; s2 += (v[j][0] * v[j][0] + v[j][1] * v[j][1]) + (v[j][2] * v[j][2] + v[j][3] * v[j][3]); }
                const float rstd = rsqrtf(wave_sum(s2) * (1.f / DM) + LN_EPS);
                u32x2* o8 = (u32x2*)(hb + (size_t)r * DM) + lane; unsigned* o4 = (unsigned*)(hb8 + (size_t)r * DM) + lane;
#pragma unroll
                for (int j = 0; j < 4; ++j) { v[j] = v[j] * rstd * gg[j] + bb[j]; u32x2 w; w.x = pk2(v[j][0], v[j][1]); w.y = pk2(v[j][2], v[j][3]); o8[64 * j] = w; o4[64 * j] = pk_fp8x4(v[j][0], v[j][1], v[j][2], v[j][3]); }
                if (moe) {
                    float lg[8];
#pragma unroll
                    for (int e = 0; e < 8; ++e) lg[e] = 0.f;
#pragma unroll
                    for (int j = 0; j < 4; ++j)
#pragma unroll
                        for (int q = 0; q < 4; ++q) { const int sl_ = ((4 * lane + q) & 7) * 128 + (lane >> 1) + 32 * j;
                            const f32x4 w0 = *((const LAS f32x4*)lds + sl_), w1 = *((const LAS f32x4*)(lds + 16384) + sl_); const float hv = v[j][q];
                            lg[0] += hv * w0[0]; lg[1] += hv * w0[1]; lg[2] += hv * w0[2]; lg[3] += hv * w0[3]; lg[4] += hv * w1[0]; lg[5] += hv * w1[1]; lg[6] += hv * w1[2]; lg[7] += hv * w1[3]; }
#pragma unroll
                    for (int e = 0; e < 8; ++e) lg[e] = wave_sum(lg[e]);
                    int e0 = 0; float b0 = lg[0];
#pragma unroll
                    for (int e = 1; e < 8; ++e) if (lg[e] > b0) { b0 = lg[e]; e0 = e; }
                    int e1 = -1; float b1 = -INFINITY;
#pragma unroll
                    for (int e = 0; e < 8; ++e) if (e != e0 && lg[e] > b1) { b1 = lg[e]; e1 = e; }
                    const float g1 = 1.f / (1.f + expf(b0 - b1)), g0 = 1.f - g1;
                    if (lane == 0) {
                        const int s0 = __hip_atomic_fetch_add(cw + LW_CNTL + e0, 1, __ATOMIC_RELAXED, __HIP_MEMORY_SCOPE_WORKGROUP), s1 = __hip_atomic_fetch_add(cw + LW_CNTL + e1, 1, __ATOMIC_RELAXED, __HIP_MEMORY_SCOPE_WORKGROUP);
                        const int ix = (wave * 16 + k) * 2; cw[LW_PE + ix] = e0 | (s0 << 8); cw[LW_PE + ix + 1] = e1 | (s1 << 8);
                        moeg[2 * r] = g0; moeg[2 * r + 1] = g1;
                    }
                }
                { const f32x4 pv4 = *((const f32x4*)(pin + ((size_t)L * NT + r) * PLE) + lane); u32x2 w; w.x = pk2(pv4[0], pv4[1]); w.y = pk2(pv4[2], pv4[3]); *((u32x2*)(pb + (size_t)r * PLE) + lane) = w; }
            }
            if (moe) {
                __syncthreads();
                if (tid < 8) cw[LW_BASEL + tid] = (int)__hip_atomic_fetch_add(ctl + CW_CNT + 64 * tid, (unsigned)cw[LW_CNTL + tid], __ATOMIC_RELAXED, __HIP_MEMORY_SCOPE_AGENT);
                __syncthreads();
                if (tid < 256) { const int wv = tid >> 5, kk = (tid >> 1) & 15, r = vcu * NWAVES + wv + kk * NGW;
                    if (r < NT) { const int pe = cw[LW_PE + tid], e = pe & 255, sl = pe >> 8; list[e * 32768 + cw[LW_BASEL + e] + sl] = 2 * r + (tid & 1); } }
            }
        }
        PHASE_END
        for (int chunk = 0; chunk < (moe ? 2 : 1); ++chunk) {
            PHASE_BEGIN(7)
            {
                __syncthreads();
                if (tid == 0) { int ts = 0;
                    for (int e = 0; e < 8; ++e) { const int c = moe ? (int)__hip_atomic_load(ctl + CW_CNT + 64 * e, __ATOMIC_RELAXED, __HIP_MEMORY_SCOPE_AGENT) : (e == 0 ? NT : 0); cw[LW_CNT + e] = c; cw[LW_TS + e] = ts; ts += (c + 255) >> 8; }
                    cw[LW_TS + 8] = ts; }
                __syncthreads();
                const int ntile = cw[LW_TS + 8], kx = (LEFTOVER && ntile > 256) ? ntile - 256 : 0, tA = ntile < 128 + kx ? ntile : 128 + kx;
                const int t0 = chunk == 0 ? 0 : tA, t1 = chunk == 0 ? tA : ntile;
                int nh = 0;
                if (LEFTOVER && chunk == 1 && kx > 0) {
                    nh = 4 * kx;
                    pg8::Gemm g{hidb, (const bf16_t*)(wb + W8_F2), DFF, 128u};
                    SchedDN S{cw, 128, tA, 0, G, bx, false}; EpiDown E{false, hb, (bf16_t*)dout, (bf16_t*)dout, cw, list, moeg, 1.f / 256.f};
                    pg8::gemm_phase<EpiDown, SchedDN, true>(lds, g, S, E, tid);
                }
                if (t1 > t0) {
                    pg8::Gemm g{(const bf16_t*)hb8, (const bf16_t*)(wb + W_F13), DM, 128u};
                    SchedGU S{cw, list, t0, t1, G, bx, nh, !moe, 1024u}; EpiSwiglu E{(unsigned char*)hidb, t0, 1.f / 32.f};
                    int tg = tid; asm volatile("" : "+v"(tg));
                    pg8::gemm_phase<EpiSwiglu, SchedGU, true>(lds, g, S, E, tg);
                }
            }
            PHASE_END
            PHASE_BEGIN(8)
            {
                __syncthreads();
                if (tid == 0) { int ts = 0;
                    for (int e = 0; e < 8; ++e) { const int c = moe ? (int)__hip_atomic_load(ctl + CW_CNT + 64 * e, __ATOMIC_RELAXED, __HIP_MEMORY_SCOPE_AGENT) : (e == 0 ? NT : 0); cw[LW_CNT + e] = c; cw[LW_TS + e] = ts; ts += (c + 255) >> 8; }
                    cw[LW_TS + 8] = ts; }
                __syncthreads();
                const int ntile = cw[LW_TS + 8], kx = (LEFTOVER && ntile > 256) ? ntile - 256 : 0, tA = ntile < 128 + kx ? ntile : 128 + kx;
                const int t0 = chunk == 0 ? 0 : tA, t1 = chunk == 0 ? (ntile < 128 ? ntile : 128) : ntile;
                if (t1 > t0) {
                    pg8::Gemm g{hidb, (const bf16_t*)(wb + W8_F2), DFF, 128u};
                    SchedDN S{cw, t0, t1, t0, G, bx, !moe}; EpiDown E{!moe, hb, (bf16_t*)dout, (bf16_t*)dout, cw, list, moeg, 1.f / 256.f};
                    pg8::gemm_phase<EpiDown, SchedDN, true>(lds, g, S, E, tid);
                }
            }
            PHASE_END
        }
        PHASE_BEGIN(9)
        {
            const float* gv = ln_ffn_g + L * DM; const float* bv = ln_ffn_b + L * DM;
            f32x4 gg[4], bb[4];
#pragma unroll
            for (int j = 0; j < 4; ++j) { gg[j] = *((const f32x4*)gv + lane + 64 * j); bb[j] = *((const f32x4*)bv + lane + 64 * j); }
            for (int r = gw; r < NT; r += NGW) {
                f32x4 v[4]; float s = 0.f;
                u32x2* h8 = (u32x2*)(hb + (size_t)r * DM) + lane;
                if (!moe) {
                    const u32x2* xr = (const u32x2*)((const bf16_t*)dout + (size_t)r * DM) + lane;
#pragma unroll
                    for (int j = 0; j < 4; ++j) { const u32x2 w = xr[64 * j]; v[j] = (f32x4){bflo(w.x), bfhi(w.x), bflo(w.y), bfhi(w.y)}; }
                } else {
                    const u32x2* y0 = (const u32x2*)((const bf16_t*)dout + (size_t)(2 * r) * DM) + lane; const u32x2* y1 = (const u32x2*)((const bf16_t*)dout + (size_t)(2 * r + 1) * DM) + lane;
#pragma unroll
                    for (int j = 0; j < 4; ++j) { const u32x2 a = h8[64 * j], c = y0[64 * j], d = y1[64 * j];
                        v[j][0] = ALPHA * bflo(a.x) + (bflo(c.x) + bflo(d.x)); v[j][1] = ALPHA * bfhi(a.x) + (bfhi(c.x) + bfhi(d.x));
                        v[j][2] = ALPHA * bflo(a.y) + (bflo(c.y) + bflo(d.y)); v[j][3] = ALPHA * bfhi(a.y) + (bfhi(c.y) + bfhi(d.y)); }
                }
#pragma unroll
                for (int j = 0; j < 4; ++j) s += (v[j][0] + v[j][1]) + (v[j][2] + v[j][3]);
                const float mean = wave_sum(s) * (1.f / DM); float s2 = 0.f;
#pragma unroll
                for (int j = 0; j < 4; ++j) { v[j] = v[j] - mean; s2 += (v[j][0] * v[j][0] + v[j][1] * v[j][1]) + (v[j][2] * v[j][2] + v[j][3] * v[j][3]); }
                const float rstd = rsqrtf(wave_sum(s2) * (1.f / DM) + LN_EPS);
#pragma unroll
                for (int j = 0; j < 4; ++j) { v[j] = v[j] * rstd * gg[j] + bb[j]; u32x2 w; w.x = pk2(v[j][0], v[j][1]); w.y = pk2(v[j][2], v[j][3]); h8[64 * j] = w; }
            }
            { pg8::Gemm g{pb, (const bf16_t*)(wb + W_PP) + (size_t)L * DM * PLE, PLE, 128u};
              pg8::StaticOrder S; S.init(NT, DM, G, bx, PLE);
              EpiBf16 E{Pp, DM};
              int tp = tid; asm volatile("" : "+v"(tp));
              pg8::gemm_phase(lds, g, S, E, tp); }
        }
        PHASE_END
        PHASE_BEGIN(11)
        {
            pg8::Gemm g{hb, (const bf16_t*)(wb + W_PG) + (size_t)L * DM * DM, DM, 128u};
            pg8::StaticOrder S; S.init(NT, DM, G, bx, DM);
            EpiPle E{hb, Pp, (L + 1 < DEPTH) ? nullptr : dout, (bf16_t*)dout + (size_t)NT * DM};
            pg8::gemm_phase(lds, g, S, E, tid);
        }
        PHASE_END
    }
#if CHECK_N
    xcd_barrier(bar);
    { bool bad = false;
      for (int grp = 0; grp < 6; ++grp) bad = bad || (__hip_atomic_load(ctl + CW_FLAG + 64 * (1 + grp), __ATOMIC_RELAXED, __HIP_MEMORY_SCOPE_AGENT) > (unsigned)CHECK_ALLOW);
      if (bad) { unsigned zz_ = 0u; asm volatile("" : "+v"(zz_)); const int tidf = wave0 * 64 + (int)__builtin_amdgcn_mbcnt_hi(~0u, __builtin_amdgcn_mbcnt_lo(~0u, zz_));
        for (size_t i = (size_t)bx * NTHREADS + tidf; i < (size_t)NT * DM; i += (size_t)G * NTHREADS) dout[i] = 0.f; } }
#endif
#if CHECK_C
    xcd_barrier(bar);
    if (__hip_atomic_load(ctl + CW_FLAG, __ATOMIC_RELAXED, __HIP_MEMORY_SCOPE_AGENT) != 0u) { unsigned zz_ = 0u; asm volatile("" : "+v"(zz_)); const int tidf = wave0 * 64 + (int)__builtin_amdgcn_mbcnt_hi(~0u, __builtin_amdgcn_mbcnt_lo(~0u, zz_));
        for (size_t i = (size_t)bx * NTHREADS + tidf; i < (size_t)NT * DM; i += (size_t)G * NTHREADS) dout[i] = 0.f; }
#endif
#if TIMA || TIMB
    xcd_barrier(bar);
    { const float ta = (float)__hip_atomic_load(ctl + 12288, __ATOMIC_RELAXED, __HIP_MEMORY_SCOPE_AGENT) * 1e-5f, tb = (float)__hip_atomic_load(ctl + 12352, __ATOMIC_RELAXED, __HIP_MEMORY_SCOPE_AGENT) * 1e-2f;
      unsigned zz_ = 0u; asm volatile("" : "+v"(zz_)); const int tidf = wave0 * 64 + (int)__builtin_amdgcn_mbcnt_hi(~0u, __builtin_amdgcn_mbcnt_lo(~0u, zz_));
      for (size_t i = (size_t)bx * NTHREADS + tidf; i < (size_t)NT * DM; i += (size_t)G * NTHREADS) dout[i] = (i == 0 && TIMB) ? 1000.f * tb : dout[i] * (1.f + ta); }
#endif
#undef PHASE_BEGIN
#undef PHASE_END
}

extern "C" void kernel_launch(void* const* d_in, const int* in_sizes, int n_in, void* d_out, int out_size, void* d_ws, size_t ws_size, hipStream_t stream) {
    static int grid = 0;
    if (grid == 0) {
        if (n_in != 23 || out_size != NT * DM || ws_size < WS_END) { fprintf(stderr, "kernel_launch: unexpected problem (n_in %d out %d ws %zu need %zu)\n", n_in, out_size, ws_size, (size_t)WS_END); grid = -1; return; }
        int dev = 0, cus = 0;
        if (hipGetDevice(&dev) != hipSuccess || hipDeviceGetAttribute(&cus, hipDeviceAttributeMultiprocessorCount, dev) != hipSuccess) { grid = -1; return; }
        if (hipFuncSetAttribute((const void*)mk_fwd, hipFuncAttributeMaxDynamicSharedMemorySize, LDS_BYTES) != hipSuccess) { fprintf(stderr, "kernel_launch: hipFuncSetAttribute failed\n"); grid = -1; return; }
        int per_cu = 0;
        if (hipOccupancyMaxActiveBlocksPerMultiprocessor(&per_cu, (const void*)mk_fwd, NTHREADS, LDS_BYTES) != hipSuccess || per_cu < 1) { fprintf(stderr, "kernel_launch: occupancy query says %d blocks per CU\n", per_cu); }
        (void)hipGetLastError();
        grid = cus;
        if (grid != 256) { fprintf(stderr, "kernel_launch: built for 256 CUs, device has %d\n", cus); grid = -1; return; }
    }
    if (grid < 0) return;
    (void)hipMemsetAsync((char*)d_ws + WS_CTL, 0, CTL_ZERO_BYTES, stream);
    Args a{};
    for (int i = 0; i < 23; ++i) a.in[i] = d_in[i];
    a.out = (float*)d_out; a.ws = (unsigned char*)d_ws;
#if MK_MULTI
    for (int p = 0; p < NPHASES; ++p) { a.ph_lo = p; a.ph_hi = p + 1; hipLaunchKernelGGL(mk_fwd, dim3(grid), dim3(NTHREADS), LDS_BYTES, stream, a); }
#else
    a.ph_lo = 0; a.ph_hi = NPHASES;
    hipLaunchKernelGGL(mk_fwd, dim3(grid), dim3(NTHREADS), LDS_BYTES, stream, a);
#endif
}
```

```cpp
#include <hip/hip_runtime.h>
#include <cstdio>
#include <cstdint>

#ifndef PHMASK
#define PHMASK 0xFFFF
#endif
#ifndef TIMA
#define TIMA 0
#endif
#ifndef TIMB
#define TIMB 0
#endif
#ifndef CHECK_C
#define CHECK_C 0
#endif
#ifndef CHECK_ALLOW
#define CHECK_ALLOW 61
#endif
#ifndef CHECK_N
#define CHECK_N 0
#endif
#ifndef DSELV2
#define DSELV2 1
#endif
#ifndef DSUB
#define DSUB 0
#endif
#ifndef DUPL
#define DUPL (-1)
#endif
#ifndef EPIDUP
#define EPIDUP 0
#endif
#ifndef BPIPE
#define BPIPE 1
#endif
#ifndef LEFTOVER
#define LEFTOVER 1
#endif
#ifndef DUPMASK
#define DUPMASK 0
#endif
#ifndef DUPATT
#define DUPATT 0
#endif
#ifndef ATTMASK
#define ATTMASK 0xF
#endif
#ifndef MK_MULTI
#define MK_MULTI 0
#endif

#define LAS __attribute__((address_space(3)))
#define GAS __attribute__((address_space(1)))
typedef unsigned short bf16_t;
typedef short bf16x8 __attribute__((ext_vector_type(8)));
typedef short s16x4 __attribute__((ext_vector_type(4)));
typedef float f32x2 __attribute__((ext_vector_type(2)));
typedef float f32x4 __attribute__((ext_vector_type(4)));
typedef float f32x16 __attribute__((ext_vector_type(16)));
typedef unsigned u32x2 __attribute__((ext_vector_type(2)));
typedef unsigned u32x4 __attribute__((ext_vector_type(4)));
typedef __bf16 bf16x2_t __attribute__((ext_vector_type(2)));

constexpr int NB = 4, SEQ = 8192, NT = NB * SEQ, DM = 1024, NIN = 2956, NINP = 3072, DFF = 3584, NEXP = 8, PLE = 256, DEPTH = 2;
constexpr int NCMP = 512;
constexpr float LOG2E = 1.4426950408889634f;
constexpr float ALPHA = 1.4142135623730951f;
constexpr float LN_EPS = 1e-5f, RMS_EPS = 1e-5f;
constexpr float QS64 = 0.125f * LOG2E;
constexpr float QS32 = 0.17677669529663687f * LOG2E;
constexpr int C_AQ = 0, C_AK = 256, C_AV = 512, C_BQ = 768, C_BK = 1024, C_BV = 1280, C_CQ = 1536, C_CK = 1792, C_CV = 2048, C_DQ = 2304;
constexpr int C_KC = 2560, C_VC = 2624, C_KS = 2688, C_VS = 2752, C_KW = 2816, C_VW = 2880, C_G = 2944;

constexpr size_t MiB = 1u << 20;
constexpr size_t WS_CTL = 0, CTL_ZERO_BYTES = 1 * MiB;
constexpr size_t WS_MISC = 1 * MiB;
constexpr size_t OFF_LAM = 0;
constexpr size_t OFF_C1 = 4096;
constexpr size_t OFF_KMEAN = 32768;
constexpr size_t OFF_KC = 128 * 1024;
constexpr size_t OFF_VC = 384 * 1024;
constexpr size_t OFF_GATES = 1 * MiB;
constexpr size_t OFF_MOEG = 3 * MiB;
constexpr size_t OFF_LIST = 4 * MiB;
constexpr size_t OFF_HID = 5 * MiB;
constexpr size_t WS_ROPE = 11 * MiB;
constexpr size_t WS_W = 23 * MiB;
constexpr size_t W_IN = 0;
constexpr size_t W_OUT = W_IN + (size_t)DEPTH * NINP * DM * 2;
constexpr size_t W_PG = W_OUT + (size_t)DEPTH * DM * DM * 2;
constexpr size_t W_PP = W_PG + (size_t)DEPTH * DM * DM * 2;
constexpr size_t W_C1 = W_PP + (size_t)DEPTH * DM * PLE * 2;
constexpr size_t W_F13 = W_C1 + (size_t)DEPTH * 2 * 256 * 2048 * 2;
constexpr size_t W8_F2 = W_F13 + (size_t)9 * 2 * DFF * DM;
constexpr size_t W_F2 = W_F13 + (size_t)9 * 2 * DFF * DM * 2;
constexpr size_t W_END = W_F2 + (size_t)9 * DM * DFF * 2;
constexpr size_t WS_HB = WS_W + ((W_END + MiB - 1) / MiB) * MiB;
constexpr size_t WS_PB = WS_HB + 64 * MiB;
constexpr size_t WS_R = WS_PB + 16 * MiB;
constexpr size_t R_PROJ = 0;
constexpr size_t R_QR = 193 * MiB;
constexpr size_t R_MIXED = 209 * MiB;
constexpr size_t R_HID = 0;
constexpr size_t R_H2 = 0;
constexpr size_t R_P = 128 * MiB;
constexpr size_t WS_MLIST = WS_R + 274 * MiB;
constexpr size_t WS_END = WS_MLIST + 16 * MiB;
constexpr int CW_BAR = 4096, CW_CNT = 8192, CW_MC = 20480, CW_FLAG = 24576;

__device__ __forceinline__ unsigned pk2(float lo, float hi) { f32x2 v = {lo, hi}; bf16x2_t b = __builtin_convertvector(v, bf16x2_t); return __builtin_bit_cast(unsigned, b); }
__device__ __forceinline__ float bf2f_(bf16_t h) { return __uint_as_float(((unsigned)h) << 16); }
__device__ __forceinline__ float bflo(unsigned w) { return __uint_as_float(w << 16); }
__device__ __forceinline__ float bfhi(unsigned w) { return __uint_as_float(w & 0xffff0000u); }
__device__ __forceinline__ int lane_now() { unsigned z = 0u; asm volatile("" : "+v"(z)); return (int)__builtin_amdgcn_mbcnt_hi(~0u, __builtin_amdgcn_mbcnt_lo(~0u, z)); }
__device__ __forceinline__ float wave_sum(float v) { const int l = lane_now();
#pragma unroll
    for (int o = 1; o < 64; o <<= 1) v += __builtin_bit_cast(float, __builtin_amdgcn_ds_bpermute((l ^ o) << 2, __builtin_bit_cast(int, v)));
    return v;
}
__device__ __forceinline__ float wave_max(float v) { const int l = lane_now();
#pragma unroll
    for (int o = 1; o < 64; o <<= 1) v = fmaxf(v, __builtin_bit_cast(float, __builtin_amdgcn_ds_bpermute((l ^ o) << 2, __builtin_bit_cast(int, v))));
    return v;
}
__device__ __forceinline__ unsigned wave_or(unsigned v) { const int l = lane_now();
#pragma unroll
    for (int o = 1; o < 64; o <<= 1) v |= (unsigned)__builtin_amdgcn_ds_bpermute((l ^ o) << 2, (int)v);
    return v;
}
__device__ __forceinline__ float xhalf(float x) { const unsigned u = __float_as_uint(x); auto rr = __builtin_amdgcn_permlane32_swap(u, u, false, false); return __uint_as_float(rr[0] ^ rr[1] ^ u); }
__device__ __forceinline__ float ex2(float x) { return __builtin_amdgcn_exp2f(x); }
__device__ __forceinline__ float lg2(float x) { return __builtin_amdgcn_logf(x); }
__device__ __forceinline__ float sigmoidf_(float x) { return __builtin_amdgcn_rcpf(1.0f + ex2(-LOG2E * x)); }
__device__ __forceinline__ float quad_sum(float x) {
    x += __builtin_bit_cast(float, __builtin_amdgcn_update_dpp(0, __builtin_bit_cast(int, x), 0xB1, 0xF, 0xF, true));
    x += __builtin_bit_cast(float, __builtin_amdgcn_update_dpp(0, __builtin_bit_cast(int, x), 0x4E, 0xF, 0xF, true));
    return x;
}

#define XB_TMO      128
#define XB_XCNT(j)  (256  + 64 * (j))
#define XB_XSUB(j)  (1280 + 64 * (j))
#define XB_XGEN(j)  (2304 + 64 * (j))
#define XB_TOP      3328
#define XB_TOPGEN   3392
#define XCD_BAR_WORDS 3456
#define XB_SPIN_CAP (1u << 18)
__device__ __forceinline__ unsigned xb_ld(unsigned* p)              { return __hip_atomic_load(p, __ATOMIC_RELAXED, __HIP_MEMORY_SCOPE_AGENT); }
__device__ __forceinline__ unsigned xb_add(unsigned* p, unsigned v) { return __hip_atomic_fetch_add(p, v, __ATOMIC_RELAXED, __HIP_MEMORY_SCOPE_AGENT); }
__device__ __forceinline__ unsigned xb_xcc_id() { return (unsigned)__builtin_amdgcn_s_getreg((3 << 11) | 20) & 0xFu; }
#define XB_SPIN(cond, bar) do { unsigned _sp = 0; while (cond) { __builtin_amdgcn_s_sleep(1); \
    if ((++_sp & 255u) == 0u) { if (xb_ld(&(bar)[XB_TMO])) break; if (_sp > XB_SPIN_CAP) { atomicAdd(&(bar)[XB_TMO], 1u); break; } } } } while (0)
struct XcdBarrier { unsigned* bar; unsigned x; volatile LAS unsigned* st; };
__device__ __forceinline__ XcdBarrier xcd_barrier_post(unsigned* bar, volatile LAS unsigned* st) {
    XcdBarrier b; b.bar = bar; b.x = xb_xcc_id(); b.st = st;
    if (threadIdx.x == 0) (void)xb_add(&bar[XB_XCNT(b.x)], 1u);
    return b;
}
__device__ __forceinline__ void xcd_barrier_complete(unsigned* bar, unsigned x, unsigned& nloc, unsigned& nx) {
    const unsigned G = gridDim.x * gridDim.y * gridDim.z;
    unsigned sum, cnt, mine, sp = 0u;
    for (;;) {
        sum = 0u; cnt = 0u; mine = 0u;
#pragma unroll 1
        for (unsigned j = 0; j < 16; ++j) { const unsigned c = xb_ld(&bar[XB_XCNT(j)]); sum += c; cnt += (c > 0u) ? 1u : 0u; mine = (j == x) ? c : mine; }
        if (sum == G) break;
        __builtin_amdgcn_s_sleep(1);
        if ((++sp & 255u) == 0u) { if (xb_ld(&bar[XB_TMO])) break; if (sp > XB_SPIN_CAP) { atomicAdd(&bar[XB_TMO], 1u); break; } }
    }
    nloc = mine > 0u ? mine : 1u; nx = cnt > 0u ? cnt : 1u;
}
__device__ __forceinline__ void xcd_barrier(const XcdBarrier& b) {
    asm volatile("s_waitcnt vmcnt(0)" ::: "memory");
    __syncthreads();
    if (threadIdx.x == 0) {
        unsigned* bar = b.bar;
        __builtin_amdgcn_s_waitcnt(0);
        unsigned nloc = b.st[0], nx = b.st[1];
        if (nloc == 0u) { xcd_barrier_complete(bar, b.x, nloc, nx); b.st[0] = nloc; b.st[1] = nx; }
        const unsigned old = xb_add(&bar[XB_XSUB(b.x)], 1u);
        const unsigned gen = old / nloc;
        if (old + 1u == (gen + 1u) * nloc) {
            __builtin_amdgcn_fence(__ATOMIC_RELEASE, "agent");
            asm volatile("s_waitcnt vmcnt(0)" ::: "memory");
            const unsigned og = xb_add(&bar[XB_TOP], 1u);
            const unsigned tg = og / nx;
            if (og + 1u == (tg + 1u) * nx) xb_add(&bar[XB_TOPGEN], 1u);
            else XB_SPIN(xb_ld(&bar[XB_TOPGEN]) == tg, bar);
            __builtin_amdgcn_fence(__ATOMIC_ACQUIRE, "agent");
            xb_add(&bar[XB_XGEN(b.x)], 1u);
            asm volatile("s_waitcnt vmcnt(0)" ::: "memory");
        } else {
            XB_SPIN(xb_ld(&bar[XB_XGEN(b.x)]) == gen, bar);
            __builtin_amdgcn_fence(__ATOMIC_ACQUIRE, "agent");
            asm volatile("s_waitcnt vmcnt(0)" ::: "memory");
        }
    }
    __syncthreads();
}

namespace pg8 {
constexpr int BM = 256, BK = 64, HALF = 128, HTB = HALF * BK * 2, STAGE_BYTES = 8 * HTB, NXCD = 8, WGM = 8;
__host__ __device__ __forceinline__ int lds_byte(int r, int c) { return r * 128 + ((((c >> 3) ^ (r >> 1)) & 7) << 4) + (c & 7) * 2; }
__host__ __device__ __forceinline__ void stage_rc(int b, int& R, int& C) { R = b >> 7; C = ((((b >> 4) & 7) ^ (R >> 1)) & 7) * 8; }
__host__ __device__ __forceinline__ int perm32(int rho) { const int n = rho >> 4, i = rho & 15; return 8 * (i >> 2) + 4 * n + (i & 3); }
struct Unit { int pm, pn, pb; };
struct Gemm { const bf16_t* A; const bf16_t* Bt; int K; unsigned kstepA; };

struct StaticOrder {
    static constexpr bool GATHER_DMA = false;
    int nM, nN, nwg, G, c; unsigned ldaB;
    __device__ void init(int M, int N, int G_, int c_, int lda) { nM = M / BM; nN = N / BM; nwg = nM * nN; G = G_; c = c_; ldaB = (unsigned)lda * 2u; }
    __device__ bool next(int i, Unit& u) const {
        const long L = (long)i * G + c; if (L >= nwg) return false;
        int wgid = (int)L; { const int q = nwg / NXCD, r = nwg % NXCD, xcd = wgid % NXCD, off = wgid / NXCD; wgid = (xcd < r ? xcd * (q + 1) : r * (q + 1) + (xcd - r) * q) + off; }
        const int nig = WGM * nN, gid = wgid / nig, fm = gid * WGM, gsz = (nM - fm) < WGM ? (nM - fm) : WGM;
        u.pm = fm + ((wgid % nig) % gsz); u.pn = (wgid % nig) / gsz; u.pb = u.pn; return true;
    }
    __device__ __forceinline__ unsigned arow(const Unit& u, int r) const { return (unsigned)(u.pm * BM + r) * ldaB; }
};

typedef int v4i_t __attribute__((ext_vector_type(4)));
typedef int v8i_t __attribute__((ext_vector_type(8)));
__device__ __forceinline__ v8i_t cat8(bf16x8 a, bf16x8 b) { const v4i_t x = __builtin_bit_cast(v4i_t, a), y = __builtin_bit_cast(v4i_t, b); return (v8i_t){x[0], x[1], x[2], x[3], y[0], y[1], y[2], y[3]}; }
template <class Epi, class Sched, bool FP8 = false>
__device__ __forceinline__ void gemm_phase(LAS unsigned char* lds, const Gemm g, const Sched& S, const Epi& E, const int tid) {
    const int wid = __builtin_amdgcn_readfirstlane(tid >> 6), lane = tid & 63, wr = wid >> 2, wc = wid & 3, fr = lane & 15, fq = lane >> 4;
    constexpr int ESZ = FP8 ? 1 : 2;
    const int K = g.K, nt = K * ESZ / 128;
    int Rr[2], Cc[2]; unsigned voffB[2];
#pragma unroll
    for (int i = 0; i < 2; ++i) stage_rc(tid * 16 + i * 8192, Rr[i], Cc[i]);
    { const int Rb = Epi::PERM ? ((Rr[0] & ~31) + perm32(Rr[0] & 31)) : Rr[0]; voffB[0] = (unsigned)(Rb * K * ESZ + Cc[0] * 2); }
    voffB[1] = voffB[0] + (unsigned)(64 * K * ESZ);
    const size_t kstepB = (size_t)(BK * 2), kstepA = (size_t)g.kstepA;
    const size_t hstepB = (size_t)HALF * K * ESZ, tstepB = 2 * hstepB;
    const unsigned ldsw = (unsigned)wid * 1024u;
    const int aoff = lds_byte(wr * 64 + fr, fq * 8), boff = lds_byte(wc * 32 + fr, fq * 8);
#define PG8_SA(b, h) (((b) * 2 + (h)) * HTB)
#define PG8_SB(b, h) ((4 + (b) * 2 + (h)) * HTB)
#define PG8_STAGE(bufoff, gbase, voff) do { _Pragma("unroll") for (int _i = 0; _i < 2; ++_i) \
        __builtin_amdgcn_global_load_lds((const unsigned*)((const char*)(gbase) + (voff)[_i]), (LAS unsigned*)(lds + (bufoff) + ldsw + _i * 8192), 16, 0, 0); } while (0)
#define PG8_STAGEB(bufoff, gbase) do { const char* gb_ = (const char*)(gbase); asm volatile("" : "+s"(gb_));        \
        _Pragma("unroll") for (int _i = 0; _i < 2; ++_i) \
        __builtin_amdgcn_global_load_lds((const unsigned*)(gb_ + voffB[_i]), (LAS unsigned*)(lds + (bufoff) + ldsw + _i * 8192), 16, 0, 0); } while (0)
#define PG8_LDA(dst, b, h) do { int aoff1 = aoff; asm volatile("" : "+v"(aoff1)); aoff1 ^= 64; _Pragma("unroll") for (int m = 0; m < 4; ++m) { const bf16x8 x0_ = *(const LAS bf16x8*)(lds + PG8_SA(b, h) + aoff + m * 2048), x1_ = *(const LAS bf16x8*)(lds + PG8_SA(b, h) + aoff1 + m * 2048); \
        if constexpr (FP8) dst##8[m] = cat8(x0_, x1_); else { dst[m][0] = x0_; dst[m][1] = x1_; } } } while (0)
#define PG8_LDB(dst, b, h) do { int boff1 = boff; asm volatile("" : "+v"(boff1)); boff1 ^= 64; _Pragma("unroll") for (int n = 0; n < 2; ++n) { const bf16x8 x0_ = *(const LAS bf16x8*)(lds + PG8_SB(b, h) + boff + n * 2048), x1_ = *(const LAS bf16x8*)(lds + PG8_SB(b, h) + boff1 + n * 2048); \
        if constexpr (FP8) dst##8[n] = cat8(x0_, x1_); else { dst[n][0] = x0_; dst[n][1] = x1_; } } } while (0)
#define PG8_MMA(ai, bj, At, Bt) do { __builtin_amdgcn_s_setprio(1); _Pragma("unroll") for (int m = 0; m < 4; ++m) _Pragma("unroll") for (int n = 0; n < 2; ++n) { \
        if constexpr (FP8) acc[ai][bj][m][n] = __builtin_amdgcn_mfma_scale_f32_16x16x128_f8f6f4(Bt##8[n], At##8[m], acc[ai][bj][m][n], 0, 0, 0, 0, 0, 0); \
        else { _Pragma("unroll") for (int k = 0; k < 2; ++k) acc[ai][bj][m][n] = __builtin_amdgcn_mfma_f32_16x16x32_bf16(Bt[n][k], At[m][k], acc[ai][bj][m][n], 0, 0, 0); } } \
        __builtin_amdgcn_s_setprio(0); } while (0)
#define PG8_WAIT_V(n) asm volatile("s_waitcnt vmcnt(" #n ")" ::: "memory")
#define PG8_WAIT_L(n) asm volatile("s_waitcnt lgkmcnt(" #n ")" ::: "memory")
#define PG8_BAR __builtin_amdgcn_s_barrier()
#define PG8_SCHED __builtin_amdgcn_sched_barrier(0)
    Unit cur, nxt; int ui = 0;
    if (!S.next(0, cur)) return;
    f32x4 acc[2][2][4][2];
    bf16x8 At[4][2], B0[2][2], B1[2][2]; v8i_t At8[4], B08[2], B18[2];
    (void)At; (void)B0; (void)B1; (void)At8; (void)B08; (void)B18;
    unsigned vc0[2], vc1[2];
#define TIDNOW (wid * 64 + lane_now())
#define stash ((LAS u32x4*)(lds + 133120 + TIDNOW * 16))
#pragma unroll
    for (int i = 0; i < 2; ++i) { vc0[i] = S.arow(cur, Rr[i]) + (unsigned)Cc[i] * 2u; vc1[i] = S.arow(cur, HALF + Rr[i]) + (unsigned)Cc[i] * 2u; }
    const char* const Ab = (const char*)g.A;
    const char* cB = (const char*)g.Bt + (size_t)cur.pb * tstepB;
    PG8_STAGEB(PG8_SB(0, 0), cB); PG8_STAGEB(PG8_SB(0, 1), cB + hstepB); PG8_STAGE(PG8_SA(0, 0), Ab, vc0); PG8_STAGE(PG8_SA(0, 1), Ab, vc1);
    if (wr == 1) PG8_BAR;
    PG8_WAIT_V(2); PG8_BAR;
    PG8_STAGEB(PG8_SB(1, 0), cB + kstepB); PG8_STAGE(PG8_SA(1, 0), Ab + kstepA, vc0); PG8_STAGEB(PG8_SB(1, 1), cB + hstepB + kstepB);
    PG8_WAIT_V(6); PG8_BAR;
    PG8_SCHED;
#pragma unroll
    for (int a = 0; a < 2; ++a)
#pragma unroll
        for (int b = 0; b < 2; ++b)
#pragma unroll
            for (int m = 0; m < 4; ++m)
#pragma unroll
                for (int n = 0; n < 2; ++n) acc[a][b][m][n] = (f32x4){0.f, 0.f, 0.f, 0.f};
    for (;;) {
        const bool has_next = S.next(ui + 1, nxt);
        if (!has_next) nxt = cur;
        if constexpr (Sched::GATHER_DMA) {
            const int t2 = TIDNOW; int R0, C0, R1, C1; stage_rc(t2 * 16, R0, C0); stage_rc(t2 * 16 + 8192, R1, C1);
            LAS unsigned* sraw = (LAS unsigned*)(lds + 133120) + wid * 64;
            __builtin_amdgcn_global_load_lds((const unsigned*)S.aentry(nxt, R0), sraw, 4, 0, 0);
            __builtin_amdgcn_global_load_lds((const unsigned*)S.aentry(nxt, R1), sraw + 512, 4, 0, 0);
            __builtin_amdgcn_global_load_lds((const unsigned*)S.aentry(nxt, HALF + R0), sraw + 1024, 4, 0, 0);
            __builtin_amdgcn_global_load_lds((const unsigned*)S.aentry(nxt, HALF + R1), sraw + 1536, 4, 0, 0);
        } else {
          const int t2 = TIDNOW; int R0, C0, R1, C1; stage_rc(t2 * 16, R0, C0); stage_rc(t2 * 16 + 8192, R1, C1);
          u32x4 sv; sv.x = S.arow(nxt, R0) + (unsigned)C0 * 2u; sv.y = S.arow(nxt, R1) + (unsigned)C1 * 2u; sv.z = S.arow(nxt, HALF + R0) + (unsigned)C0 * 2u; sv.w = S.arow(nxt, HALF + R1) + (unsigned)C1 * 2u; *stash = sv; }
        const char* nB = (const char*)g.Bt + (size_t)nxt.pb * tstepB;
        for (int t = 0; t < nt; t += 2) {
            const bool last = (t == nt - 2);
            const char* a1 = Ab + (size_t)(t + 1) * kstepA;
            const char* a2 = last ? Ab : Ab + (size_t)(t + 2) * kstepA; const char* b2 = last ? nB : cB + (size_t)(t + 2) * kstepB;
            const char* a3 = a2 + kstepA; const char* b3 = b2 + kstepB;
            PG8_LDB(B0, 0, 0); PG8_LDB(B1, 0, 1); PG8_SCHED; PG8_LDA(At, 0, 0); PG8_STAGE(PG8_SA(1, 1), a1, vc1);
            if (last) {
                if constexpr (Sched::GATHER_DMA) { const int t2 = TIDNOW; int R0, C0, R1, C1; stage_rc(t2 * 16, R0, C0); stage_rc(t2 * 16 + 8192, R1, C1);
                    const LAS int* sr = (const LAS int*)(lds + 133120) + t2;
                    vc0[0] = S.afinish(nxt, R0, sr[0]) + (unsigned)C0 * 2u; vc0[1] = S.afinish(nxt, R1, sr[512]) + (unsigned)C1 * 2u;
                    vc1[0] = S.afinish(nxt, HALF + R0, sr[1024]) + (unsigned)C0 * 2u; vc1[1] = S.afinish(nxt, HALF + R1, sr[1536]) + (unsigned)C1 * 2u; }
                else { const u32x4 sv = *stash; vc0[0] = sv.x; vc0[1] = sv.y; vc1[0] = sv.z; vc1[1] = sv.w; } }
            PG8_WAIT_V(8); PG8_WAIT_L(0); PG8_BAR; PG8_MMA(0, 0, At, B0); PG8_MMA(0, 1, At, B1); PG8_BAR; PG8_SCHED;
            PG8_LDA(At, 0, 1); PG8_STAGEB(PG8_SB(0, 0), b2); PG8_STAGEB(PG8_SB(0, 1), b2 + hstepB); PG8_STAGE(PG8_SA(0, 0), a2, vc0);
            PG8_WAIT_V(8); PG8_WAIT_L(0); PG8_BAR; PG8_MMA(1, 0, At, B0); PG8_MMA(1, 1, At, B1); PG8_BAR; PG8_SCHED;
            PG8_LDB(B0, 1, 0); PG8_LDB(B1, 1, 1); PG8_SCHED; PG8_LDA(At, 1, 0); PG8_STAGE(PG8_SA(0, 1), a2, vc1);
            PG8_WAIT_V(8); PG8_WAIT_L(0); PG8_BAR; PG8_MMA(0, 0, At, B0); PG8_MMA(0, 1, At, B1); PG8_BAR; PG8_SCHED;
            PG8_LDA(At, 1, 1); PG8_STAGEB(PG8_SB(1, 0), b3); PG8_STAGEB(PG8_SB(1, 1), b3 + hstepB); PG8_STAGE(PG8_SA(1, 0), a3, vc0);
            PG8_WAIT_V(8); PG8_WAIT_L(0); PG8_BAR; PG8_MMA(1, 0, At, B0); PG8_MMA(1, 1, At, B1); PG8_BAR; PG8_SCHED;
        }
        if (wr == 0) PG8_BAR;
        { const int te = lane_now(); const int fr_e = te & 15, fq_e = (te >> 4) & 3; E(acc, cur, wr, wc, fr_e, fq_e);
#if EPIDUP
          if constexpr (Epi::DUPID & EPIDUP) { int t3 = tid; asm volatile("" : "+v"(t3)); E(acc, cur, wr, wc, t3 & 15, (t3 >> 4) & 3); }
#endif
        }
        if (!has_next) break;
#pragma unroll
        for (int a = 0; a < 2; ++a)
#pragma unroll
            for (int b = 0; b < 2; ++b)
#pragma unroll
                for (int m = 0; m < 4; ++m)
#pragma unroll
                    for (int n = 0; n < 2; ++n) acc[a][b][m][n] = (f32x4){0.f, 0.f, 0.f, 0.f};
        cur = nxt; cB = nB; ++ui;
        if (wr == 1) PG8_BAR;
    }
    PG8_WAIT_V(0);
    PG8_BAR;
#undef stash
#undef TIDNOW
#undef PG8_SA
#undef PG8_SB
#undef PG8_STAGE
#undef PG8_STAGEB
#undef PG8_LDA
#undef PG8_LDB
#undef PG8_MMA
#undef PG8_WAIT_V
#undef PG8_WAIT_L
#undef PG8_BAR
#undef PG8_SCHED
}
}

typedef f32x4 Acc[2][2][4][2];
__device__ __forceinline__ unsigned pk_fp8x4(float a, float b, float c, float d) { int w = 0; w = __builtin_amdgcn_cvt_pk_fp8_f32(a, b, w, false); w = __builtin_amdgcn_cvt_pk_fp8_f32(c, d, w, true); return (unsigned)w; }
__device__ __forceinline__ void st_bf4(bf16_t* p, f32x4 v) { u32x2 w; w.x = pk2(v[0], v[1]); w.y = pk2(v[2], v[3]); *(u32x2*)p = w; }
__device__ __forceinline__ void st_bf4x2(bf16_t* base, int cA, int cB, int fq, f32x4 A, f32x4 B) {
    unsigned ax = pk2(A[0], A[1]), ay = pk2(A[2], A[3]), bx = pk2(B[0], B[1]), by = pk2(B[2], B[3]);
    { auto r = __builtin_amdgcn_permlane16_swap(ax, bx, false, false); ax = r[0]; bx = r[1]; }
    { auto r = __builtin_amdgcn_permlane16_swap(ay, by, false, false); ay = r[0]; by = r[1]; }
    *(u32x4*)(base + ((fq & 1) ? cB + 4 * (fq - 1) : cA + 4 * fq)) = (u32x4){ax, ay, bx, by};
}

__device__ __forceinline__ void ld_bf8(const bf16_t* p, f32x4& a, f32x4& b) { const u32x4 w = *(const u32x4*)p; a = (f32x4){bflo(w.x), bfhi(w.x), bflo(w.y), bfhi(w.y)}; b = (f32x4){bflo(w.z), bfhi(w.z), bflo(w.w), bfhi(w.w)}; }
__device__ __forceinline__ void st_bf8(bf16_t* p, f32x4 a, f32x4 b) { u32x4 w; w.x = pk2(a[0], a[1]); w.y = pk2(a[2], a[3]); w.z = pk2(b[0], b[1]); w.w = pk2(b[2], b[3]); *(u32x4*)p = w; }

struct EpiInProj {
    static constexpr bool PERM = false; static constexpr int DUPID = 1;
    bf16_t* proj; bf16_t* qr; float* gates; const float* cos32; const float* sin32; const float* cos16; const float* sin16;
    __device__ __forceinline__ void operator()(const Acc& acc, const pg8::Unit& u, int wr, int wc, int fr, int fq) const {
        const int pn = u.pn, a = wc & 1;
        int mode[2]; float sc[2];
#pragma unroll
        for (int bj = 0; bj < 2; ++bj) { const int blk = (128 * bj + 32 * wc) >> 6; int md = 0; float s = 1.f;
            if (pn == 0) s = QS64;
            else if (pn == 3) { md = 1; s = QS32; }
            else if (pn == 4) md = 1;
            else if (pn == 6) { md = 2; s = QS64; }
            else if (pn == 7) md = 2;
            else if (pn == 9) { md = 3; s = QS64; }
            else if (pn == 10) md = (blk == 2) ? 2 : 0;
            else if (pn == 11) md = (blk == 0) ? 2 : (blk == 1) ? 0 : (blk == 2 && a == 0) ? 4 : 5;
            mode[bj] = md; sc[bj] = s; }
        const bool r16 = (mode[0] == 1), r32 = (mode[0] == 2 || mode[0] == 3 || mode[1] == 2 || mode[1] == 3);
        f32x4 cv[8], sv[8];
        if (r16 || r32) {
            const float* tc = r16 ? cos16 + 4 * fq : cos32 + 16 * a + 4 * fq; const float* ts = r16 ? sin16 + 4 * fq : sin32 + 16 * a + 4 * fq; const int st = r16 ? 16 : 32;
#pragma unroll
            for (int q = 0; q < 8; ++q) { const size_t row = (size_t)(u.pm * 256 + (q >> 2) * 128 + wr * 64 + (q & 3) * 16 + fr); cv[q] = *(const f32x4*)(tc + row * st); sv[q] = *(const f32x4*)(ts + row * st); }
        } else {
#pragma unroll
            for (int q = 0; q < 8; ++q) { cv[q] = (f32x4){1.f, 1.f, 1.f, 1.f}; sv[q] = (f32x4){0.f, 0.f, 0.f, 0.f}; }
        }
#pragma unroll
        for (int ai = 0; ai < 2; ++ai)
#pragma unroll
            for (int m = 0; m < 4; ++m) {
                const int row = u.pm * 256 + ai * 128 + wr * 64 + m * 16 + fr;
                bf16_t* prow = proj + (size_t)row * NINP + pn * 256;
                const f32x4 c = cv[ai * 4 + m], s = sv[ai * 4 + m];
#pragma unroll
                for (int bj = 0; bj < 2; ++bj) {
                    const f32x4 v0 = acc[ai][bj][m][0], v1 = acc[ai][bj][m][1];
                    const int cb = 128 * bj + 32 * wc, blk = cb >> 6, md = mode[bj]; const float scl = sc[bj];
                    if (md == 0) st_bf4x2(prow, cb, cb + 16, fq, v0 * scl, v1 * scl);
                    else if (md == 1) st_bf4x2(prow, cb, cb + 16, fq, (v0 * c - v1 * s) * scl, (v1 * c + v0 * s) * scl);
                    else if (md == 2 || md == 3) {
                        const f32x4 o0 = (v0 * c - v1 * s) * scl, o1 = (v1 * c + v0 * s) * scl;
                        const int lc0 = 64 * blk + 16 * a;
                        if (md == 2) st_bf4x2(prow, lc0, lc0 + 32, fq, o0, o1);
                        else { st_bf4x2(prow, lc0, lc0 + 32, fq, v0 * scl, v1 * scl); st_bf4x2(qr + (size_t)row * 256, lc0, lc0 + 32, fq, o0, o1); }
                    } else if (md == 4) {
                        if (fq < 3) { f32x4 g; g[0] = sigmoidf_(v0[0]); g[1] = sigmoidf_(v0[1]); g[2] = sigmoidf_(v0[2]); g[3] = sigmoidf_(v0[3]); *(f32x4*)(gates + (size_t)row * 12 + 4 * fq) = g; }
                    }
                }
            }
    }
};
struct EpiPresum {
    static constexpr bool PERM = true; static constexpr int DUPID = 2;
    const float* base32; const bf16_t* base16; bf16_t* ps;
    __device__ __forceinline__ void operator()(const Acc& acc, const pg8::Unit& u, int wr, int wc, int fr, int fq) const {
#pragma unroll
        for (int ai = 0; ai < 2; ++ai)
#pragma unroll
            for (int mp = 0; mp < 2; ++mp) {
                u32x4 ra[4], rb[4];
#pragma unroll
                for (int i = 0; i < 4; ++i) { const size_t o = (size_t)(u.pm * 256 + ai * 128 + wr * 64 + (2 * mp + (i >> 1)) * 16 + fr) * DM + u.pn * 256 + wc * 32 + 8 * fq + (i & 1) * 128;
                    if (base32) { ra[i] = *(const u32x4*)(base32 + o); rb[i] = *(const u32x4*)(base32 + o + 4); } else { ra[i] = *(const u32x4*)(base16 + o); rb[i] = (u32x4){0u, 0u, 0u, 0u}; } }
                __builtin_amdgcn_sched_barrier(0);
#pragma unroll
                for (int i = 0; i < 4; ++i) { const int m = 2 * mp + (i >> 1), bj = i & 1; const size_t o = (size_t)(u.pm * 256 + ai * 128 + wr * 64 + m * 16 + fr) * DM + u.pn * 256 + wc * 32 + 8 * fq + bj * 128; f32x4 b0, b1;
                    if (base32) { b0 = __builtin_bit_cast(f32x4, ra[i]); b1 = __builtin_bit_cast(f32x4, rb[i]); }
                    else { const u32x4 w = ra[i]; b0 = (f32x4){bflo(w.x), bfhi(w.x), bflo(w.y), bfhi(w.y)}; b1 = (f32x4){bflo(w.z), bfhi(w.z), bflo(w.w), bfhi(w.w)}; }
                    st_bf8(ps + o, b0 * ALPHA + acc[ai][bj][m][0], b1 * ALPHA + acc[ai][bj][m][1]); }
                __builtin_amdgcn_sched_barrier(0);
            }
    }
};
struct EpiBf16 {
    static constexpr bool PERM = true; static constexpr int DUPID = 4;
    bf16_t* O; int ldc;
    __device__ __forceinline__ void operator()(const Acc& acc, const pg8::Unit& u, int wr, int wc, int fr, int fq) const {
#pragma unroll
        for (int ai = 0; ai < 2; ++ai)
#pragma unroll
            for (int m = 0; m < 4; ++m) {
                bf16_t* rowp = O + (size_t)(u.pm * 256 + ai * 128 + wr * 64 + m * 16 + fr) * ldc + u.pn * 256 + wc * 32 + 8 * fq;
#pragma unroll
                for (int bj = 0; bj < 2; ++bj) { const f32x4 v0 = acc[ai][bj][m][0], v1 = acc[ai][bj][m][1]; u32x4 w; w.x = pk2(v0[0], v0[1]); w.y = pk2(v0[2], v0[3]); w.z = pk2(v1[0], v1[1]); w.w = pk2(v1[2], v1[3]); *(u32x4*)(rowp + bj * 128) = w; }
            }
    }
};
struct EpiCmp {
    static constexpr bool PERM = false; static constexpr int DUPID = 8;
    bf16_t* uv;
    __device__ __forceinline__ void operator()(const Acc& acc, const pg8::Unit& u, int wr, int wc, int fr, int fq) const {
        const int kv = u.pb >> 1, half = u.pb & 1;
#pragma unroll
        for (int ai = 0; ai < 2; ++ai)
#pragma unroll
            for (int m = 0; m < 4; ++m) {
                bf16_t* rowp = uv + ((size_t)kv * 2048 + (u.pm * 256 + ai * 128 + wr * 64 + m * 16 + fr)) * 512 + half * 256 + wc * 32 + 4 * fq;
#pragma unroll
                for (int bj = 0; bj < 2; ++bj)
#pragma unroll
                    for (int n = 0; n < 2; ++n) st_bf4(rowp + bj * 128 + n * 16, acc[ai][bj][m][n]);
            }
    }
};
struct EpiSwiglu {
    static constexpr bool PERM = true; static constexpr int DUPID = 16;
    unsigned char* H; int row0; float sc;
    static __device__ __forceinline__ float swg(float a, float b, float c0, float c1) { return (a * b) * __builtin_amdgcn_rcpf(__builtin_fmaf(ex2(a * c0), c1, c1)); }
    __device__ __forceinline__ void operator()(const Acc& acc, const pg8::Unit& u, int wr, int wc, int fr, int fq) const {
        const float c0 = -sc * LOG2E, c1 = 1.f / (8.f * sc * sc);
#pragma unroll
        for (int ai = 0; ai < 2; ++ai)
#pragma unroll
            for (int bj = 0; bj < 2; ++bj) {
                unsigned D[4];
#pragma unroll
                for (int m = 0; m < 4; ++m) { const f32x4 v0 = acc[ai][bj][m][0], v1 = acc[ai][bj][m][1];
                    D[m] = pk_fp8x4(swg(v0[0], v0[1], c0, c1), swg(v0[2], v0[3], c0, c1), swg(v1[0], v1[1], c0, c1), swg(v1[2], v1[3], c0, c1)); }
                { auto r = __builtin_amdgcn_permlane32_swap(D[0], D[2], false, false); D[0] = r[0]; D[2] = r[1]; }
                { auto r = __builtin_amdgcn_permlane32_swap(D[1], D[3], false, false); D[1] = r[0]; D[3] = r[1]; }
                { auto r = __builtin_amdgcn_permlane16_swap(D[0], D[1], false, false); D[0] = r[0]; D[1] = r[1]; }
                { auto r = __builtin_amdgcn_permlane16_swap(D[2], D[3], false, false); D[2] = r[0]; D[3] = r[1]; }
                unsigned char* rowp = H + (size_t)((u.pm - row0) * 256 + ai * 128 + wr * 64 + fq * 16 + fr) * DFF + u.pn * 128 + wc * 16 + bj * 64;
                *(u32x4*)rowp = (u32x4){D[0], D[1], D[2], D[3]};
            }
    }
};

namespace att {
constexpr int NS = 4, SLOT = 8192, L_K = 0, L_V = NS * SLOT, L_X = 2 * NS * SLOT;
typedef short v4i16_t __attribute__((ext_vector_type(4)));
struct KVp { const bf16_t* K; const bf16_t* V; int pk, pv; };
__device__ __forceinline__ void glds16(const void* gsrc, unsigned lds_dst) { unsigned keep;
    asm volatile("s_mov_b32 %0, m0\n\ts_mov_b32 m0, %2\n\ts_nop 0\n\tglobal_load_lds_dwordx4 %1, off\n\ts_mov_b32 m0, %0" : "=&s"(keep) : "v"(gsrc), "s"(lds_dst) : "memory"); }
#define ATT_WAIT_BAR(N) asm volatile("s_waitcnt vmcnt(" #N ") lgkmcnt(0)\n\ts_barrier" ::: "memory")
struct Ring { const bf16_t* ks; const bf16_t* vs; unsigned kd, vd; int pk, pv; };
__device__ __forceinline__ Ring ring_init(LAS unsigned char* lds, const KVp& p, int wid, int lane) {
    const int kkey = 8 * wid + (lane >> 3);
    Ring r; r.ks = p.K + (size_t)kkey * p.pk + (((lane & 7) ^ (kkey >> 1)) & 7) * 8; r.vs = p.V + (size_t)kkey * p.pv + (((lane & 7) ^ (((kkey >> 1) & 1) << 2)) & 7) * 8;
    const unsigned l0 = (unsigned)(size_t)lds; r.kd = l0 + L_K + wid * 1024; r.vd = l0 + L_V + wid * 1024; r.pk = p.pk; r.pv = p.pv; return r;
}
__device__ __forceinline__ void ring_issue(const Ring& r, int jt, int slot) {
    glds16(r.ks + (size_t)jt * 64 * r.pk, (unsigned)__builtin_amdgcn_readfirstlane((int)(r.kd + slot * SLOT)));
    glds16(r.vs + (size_t)jt * 64 * r.pv, (unsigned)__builtin_amdgcn_readfirstlane((int)(r.vd + slot * SLOT)));
}
__device__ __forceinline__ void ring_issue_k(const Ring& r, int jt, int slot) { glds16(r.ks + (size_t)jt * 64 * r.pk, (unsigned)__builtin_amdgcn_readfirstlane((int)(r.kd + slot * SLOT))); }
__device__ __forceinline__ void ring_issue_v(const Ring& r, int jt, int slot) { glds16(r.vs + (size_t)jt * 64 * r.pv, (unsigned)__builtin_amdgcn_readfirstlane((int)(r.vd + slot * SLOT))); }
__device__ __forceinline__ void ring_drain() { asm volatile("s_waitcnt vmcnt(0) lgkmcnt(0)\n\ts_barrier" ::: "memory"); }
__device__ __forceinline__ f32x16 zero16() { f32x16 z;
#pragma unroll
    for (int r = 0; r < 16; ++r) z[r] = 0.f;
    return z; }
__device__ __forceinline__ f32x16 mfma32(bf16x8 a, bf16x8 b, f32x16 c) { return __builtin_amdgcn_mfma_f32_32x32x16_bf16(a, b, c, 0, 0, 0); }
__device__ __forceinline__ int crow(int r, int hi) { return (r & 3) + 8 * (r >> 2) + 4 * hi; }
__device__ __forceinline__ unsigned kfrag_base(int r32, int hi) { return (unsigned)(r32 * 128 + (((hi ^ (r32 >> 1)) & 7) << 4)); }
template <int D0, int D1> __device__ __forceinline__ void qk(f32x16& p0, f32x16& p1, const LAS unsigned char* Ks, const bf16x8 (&qf)[4], int hi, int r32) {
    const unsigned kb = kfrag_base(r32, hi);
    p0 = zero16(); p1 = zero16();
#pragma unroll
    for (int d0 = D0; d0 < D1; ++d0) {
        const bf16x8 b0 = *(const LAS bf16x8*)(Ks + (kb ^ ((2 * d0) << 4))), b1 = *(const LAS bf16x8*)(Ks + (kb ^ ((2 * d0) << 4)) + 4096);
        p0 = mfma32(b0, qf[d0], p0); p1 = mfma32(b1, qf[d0], p1);
    }
}
__device__ __forceinline__ s16x4 vtr(const LAS unsigned char* p) { return __builtin_bit_cast(s16x4, __builtin_amdgcn_ds_read_tr16_b64_v4i16((LAS v4i16_t*)p)); }
__device__ __forceinline__ unsigned vbase(int lane, int hi) { const int b = (lane & 15) >> 2; return (unsigned)((4 * hi + b) * 128 + ((lane >> 4) & 1) * 32 + (lane & 3) * 8 + ((b >> 1) & 1) * 64); }
__device__ __forceinline__ void pv(f32x16 (&o)[2], const LAS unsigned char* Vs, const bf16x8 (&pw)[4], int lane, int hi) {
    const unsigned vb = vbase(lane, hi);
#pragma unroll
    for (int d0 = 0; d0 < 2; ++d0)
#pragma unroll
        for (int ks = 0; ks < 4; ++ks) {
            const s16x4 lo = vtr(Vs + (vb ^ (64 * d0)) + ks * 2048), hh = vtr(Vs + (vb ^ (64 * d0)) + ks * 2048 + 1024);
            const bf16x8 vf = {lo[0], lo[1], lo[2], lo[3], hh[0], hh[1], hh[2], hh[3]};
            o[d0] = mfma32(vf, pw[ks], o[d0]);
        }
}
__device__ __forceinline__ void pack_p(bf16x8 (&pw)[4], const f32x16& p0, const f32x16& p1) {
    u32x4 a, b, c, d;
    a.x = pk2(p0[0], p0[1]); a.y = pk2(p0[2], p0[3]); a.z = pk2(p0[4], p0[5]); a.w = pk2(p0[6], p0[7]);
    b.x = pk2(p0[8], p0[9]); b.y = pk2(p0[10], p0[11]); b.z = pk2(p0[12], p0[13]); b.w = pk2(p0[14], p0[15]);
    c.x = pk2(p1[0], p1[1]); c.y = pk2(p1[2], p1[3]); c.z = pk2(p1[4], p1[5]); c.w = pk2(p1[6], p1[7]);
    d.x = pk2(p1[8], p1[9]); d.y = pk2(p1[10], p1[11]); d.z = pk2(p1[12], p1[13]); d.w = pk2(p1[14], p1[15]);
    pw[0] = __builtin_bit_cast(bf16x8, a); pw[1] = __builtin_bit_cast(bf16x8, b); pw[2] = __builtin_bit_cast(bf16x8, c); pw[3] = __builtin_bit_cast(bf16x8, d);
}
__device__ __forceinline__ float max3f(float a, float b, float c) { return fmaxf(fmaxf(a, b), c); }
__device__ __forceinline__ void osm3(f32x16& p0, f32x16& p1, float& m, bool& seen, float& l, f32x16 (&o)[2], bf16x8 (&pw)[4], const bool rowsel) {
    float mx = max3f(p0[0], p1[0], p0[1]);
#pragma unroll
    for (int r = 1; r < 15; r += 2) { mx = max3f(mx, p1[r], p0[r + 1]); mx = fmaxf(mx, p1[r + 1]); }
    mx = fmaxf(mx, p1[15]);
    mx = rowsel ? mx : -INFINITY;
    mx = fmaxf(mx, xhalf(mx));
    const bool fin = mx > -INFINITY;
    const bool need = fin && ((mx > m + 8.f) || (!seen && mx < m - 8.f));
    if (__any(need)) { const float mn = need ? mx : m, sc = (seen && need) ? ex2(m - mn) : 1.f; m = mn; l *= sc; o[0] *= sc; o[1] *= sc; }
    seen = seen || fin;
    if (__any(m != 0.f)) {
#pragma unroll
        for (int r = 0; r < 16; ++r) { p0[r] -= m; p1[r] -= m; }
    }
    f32x2 s2 = {0.f, 0.f};
#pragma unroll
    for (int r = 0; r < 16; ++r) { p0[r] = ex2(p0[r]); p1[r] = ex2(p1[r]); s2 += (f32x2){p0[r], p1[r]}; }
    l += rowsel ? (s2[0] + s2[1]) : 0.f;
    pack_p(pw, p0, p1);
    if (!__all(rowsel)) {
#pragma unroll
        for (int k = 0; k < 4; ++k) { u32x4 w = __builtin_bit_cast(u32x4, pw[k]); w.x = rowsel ? w.x : 0u; w.y = rowsel ? w.y : 0u; w.z = rowsel ? w.z : 0u; w.w = rowsel ? w.w : 0u; pw[k] = __builtin_bit_cast(bf16x8, w); }
    }
}
__device__ __forceinline__ void osm_pre(f32x16& p0, f32x16& p1, float& m, bool& seen, float& l, f32x16 (&o)[2]) {
    float mx = max3f(p0[0], p1[0], p0[1]);
#pragma unroll
    for (int r = 1; r < 15; r += 2) { mx = max3f(mx, p1[r], p0[r + 1]); mx = fmaxf(mx, p1[r + 1]); }
    mx = fmaxf(mx, p1[15]);
    mx = fmaxf(mx, xhalf(mx));
    const bool fin = mx > -INFINITY;
    const bool need = fin && ((mx > m + 8.f) || (!seen && mx < m - 8.f));
    if (__any(need)) { const float mn = need ? mx : m, sc = (seen && need) ? ex2(m - mn) : 1.f; m = mn; l *= sc; o[0] *= sc; o[1] *= sc; }
    seen = seen || fin;
    if (__any(m != 0.f)) {
#pragma unroll
        for (int r = 0; r < 16; ++r) { p0[r] -= m; p1[r] -= m; }
    }
}
__device__ __forceinline__ void osm_exp(f32x16& p0, f32x16& p1, float& l, bf16x8 (&pw)[4]) {
    f32x2 s2 = {0.f, 0.f};
#pragma unroll
    for (int r = 0; r < 16; ++r) { p0[r] = ex2(p0[r]); p1[r] = ex2(p1[r]); s2 += (f32x2){p0[r], p1[r]}; }
    l += s2[0] + s2[1];
    pack_p(pw, p0, p1);
}
typedef int v4i_att __attribute__((ext_vector_type(4)));
__device__ __forceinline__ bf16x8 vfrag(const LAS unsigned char* p) { const s16x4 lo = vtr(p), hh = vtr(p + 1024); return (bf16x8){lo[0], lo[1], lo[2], lo[3], hh[0], hh[1], hh[2], hh[3]}; }
__device__ __forceinline__ void pv_exp(f32x16 (&o)[2], const LAS unsigned char* Vs, bf16x8 (&pw)[4], f32x16& p0, f32x16& p1, float& l, int lane, int hi) {
    const unsigned vb = vbase(lane, hi); const LAS unsigned char* vp = Vs + vb; const LAS unsigned char* vq = Vs + (vb ^ 64u);
    float sa = 0.f, sb = 0.f;
    bf16x8 vf0 = vfrag(vp), vf1 = vfrag(vq);
#pragma unroll
    for (int ks = 0; ks < 4; ++ks) {
        bf16x8 nf0 = vf0, nf1 = vf1;
        if (ks < 3) { nf0 = vfrag(vp + (ks + 1) * 2048); nf1 = vfrag(vq + (ks + 1) * 2048); }
        o[0] = mfma32(vf0, pw[ks], o[0]); o[1] = mfma32(vf1, pw[ks], o[1]);
        float e[8];
#pragma unroll
        for (int i = 0; i < 8; ++i) e[i] = ex2(ks < 2 ? p0[8 * ks + i] : p1[8 * (ks - 2) + i]);
#pragma unroll
        for (int i = 0; i < 4; ++i) { sa += e[2 * i]; sb += e[2 * i + 1]; }
        asm volatile("" : "+v"(sa), "+v"(sb));
        u32x4 w; w.x = pk2(e[0], e[1]); w.y = pk2(e[2], e[3]); w.z = pk2(e[4], e[5]); w.w = pk2(e[6], e[7]);
        pw[ks] = __builtin_bit_cast(bf16x8, w);
        { v4i_att w2 = __builtin_bit_cast(v4i_att, pw[ks]); asm volatile("" : "+v"(w2)); pw[ks] = __builtin_bit_cast(bf16x8, w2); }
        __builtin_amdgcn_sched_barrier(0);
        vf0 = nf0; vf1 = nf1;
    }
    l += sa + sb;
}
template <bool SEL, bool QK>
__device__ __forceinline__ void exp_pv(f32x16 (&o)[2], const LAS unsigned char* Vs, f32x16& p0, f32x16& p1, float& l, const bool rowsel, int lane, int hi,
                                       f32x16& pn0, f32x16& pn1, const LAS unsigned char* Kn, const bf16x8 (&qf)[4]) {
    const unsigned kb = kfrag_base(lane & 31, hi);
    const unsigned vb = vbase(lane, hi); const LAS unsigned char* vp = Vs + vb; const LAS unsigned char* vq = Vs + (vb ^ 64u);
    float sa = 0.f, sb = 0.f;
    bf16x8 vf0 = vfrag(vp), vf1 = vfrag(vq);
#pragma unroll
    for (int ks = 0; ks < 4; ++ks) {
        bf16x8 nf0 = vf0, nf1 = vf1;
        if (ks < 3) { nf0 = vfrag(vp + (ks + 1) * 2048); nf1 = vfrag(vq + (ks + 1) * 2048); }
        float e[8];
#pragma unroll
        for (int i = 0; i < 8; ++i) e[i] = ex2(ks < 2 ? p0[8 * ks + i] : p1[8 * (ks - 2) + i]);
#pragma unroll
        for (int i = 0; i < 4; ++i) { sa += e[2 * i]; sb += e[2 * i + 1]; }
        asm volatile("" : "+v"(sa), "+v"(sb));
        u32x4 w; w.x = pk2(e[0], e[1]); w.y = pk2(e[2], e[3]); w.z = pk2(e[4], e[5]); w.w = pk2(e[6], e[7]);
        if (SEL) { w.x = rowsel ? w.x : 0u; w.y = rowsel ? w.y : 0u; w.z = rowsel ? w.z : 0u; w.w = rowsel ? w.w : 0u; }
        v4i_att w2 = __builtin_bit_cast(v4i_att, w); asm volatile("" : "+v"(w2));
        const bf16x8 pk = __builtin_bit_cast(bf16x8, w2);
        o[0] = mfma32(vf0, pk, o[0]); o[1] = mfma32(vf1, pk, o[1]);
        if constexpr (QK) { const bf16x8 k0 = *(const LAS bf16x8*)(Kn + (kb ^ ((2 * ks) << 4))), k1 = *(const LAS bf16x8*)(Kn + (kb ^ ((2 * ks) << 4)) + 4096);
            pn0 = mfma32(k0, qf[ks], ks == 0 ? zero16() : pn0); pn1 = mfma32(k1, qf[ks], ks == 0 ? zero16() : pn1); }
        __builtin_amdgcn_sched_barrier(0);
        vf0 = nf0; vf1 = nf1;
    }
    l += SEL ? (rowsel ? sa + sb : 0.f) : sa + sb;
}
template <bool QK, bool ONEFORM = false>
__device__ __forceinline__ void osm3f(f32x16& p0, f32x16& p1, float& m, bool& seen, float& l, f32x16 (&o)[2], const LAS unsigned char* Vs, const bool rowsel, int lane, int hi,
                                      f32x16& pn0, f32x16& pn1, const LAS unsigned char* Kn, const bf16x8 (&qf)[4]) {
    float mx = max3f(p0[0], p1[0], p0[1]);
#pragma unroll
    for (int r = 1; r < 15; r += 2) { mx = max3f(mx, p1[r], p0[r + 1]); mx = fmaxf(mx, p1[r + 1]); }
    mx = fmaxf(mx, p1[15]);
    mx = rowsel ? mx : -INFINITY;
    mx = fmaxf(mx, xhalf(mx));
    const bool fin = mx > -INFINITY;
    const bool need = fin && ((mx > m + 8.f) || (!seen && mx < m - 8.f));
    if (__any(need)) { const float mn = need ? mx : m, sc = (seen && need) ? ex2(m - mn) : 1.f; m = mn; l *= sc; o[0] *= sc; o[1] *= sc; }
    seen = seen || fin;
    if (__any(m != 0.f)) {
#pragma unroll
        for (int r = 0; r < 16; ++r) { p0[r] -= m; p1[r] -= m; }
    }
    if constexpr (ONEFORM) exp_pv<true, QK>(o, Vs, p0, p1, l, rowsel, lane, hi, pn0, pn1, Kn, qf);
    else { if (__all(rowsel)) exp_pv<false, QK>(o, Vs, p0, p1, l, true, lane, hi, pn0, pn1, Kn, qf); else exp_pv<true, QK>(o, Vs, p0, p1, l, rowsel, lane, hi, pn0, pn1, Kn, qf); }
}
__device__ __forceinline__ void mask_le(f32x16& p0, f32x16& p1, int lim, int hi) {
    int l2 = lim - 4 * hi; asm volatile("" : "+v"(l2));
#pragma unroll
    for (int r = 0; r < 16; ++r) { const int c = (r & 3) + 8 * (r >> 2); if (c > l2) p0[r] = -INFINITY; if (c + 32 > l2) p1[r] = -INFINITY; }
}
__device__ __forceinline__ void mask_gt(f32x16& p0, f32x16& p1, int lim, int hi) {
    int l2 = lim - 4 * hi; asm volatile("" : "+v"(l2));
#pragma unroll
    for (int r = 0; r < 16; ++r) { const int c = (r & 3) + 8 * (r >> 2); if (c <= l2) p0[r] = -INFINITY; if (c + 32 <= l2) p1[r] = -INFINITY; }
}
__device__ __forceinline__ void mask_all(f32x16& p0, f32x16& p1, bool keep) {
#pragma unroll
    for (int r = 0; r < 16; ++r) { p0[r] = keep ? p0[r] : -INFINITY; p1[r] = keep ? p1[r] : -INFINITY; }
}
__device__ __forceinline__ void store_o(bf16_t* dst, const f32x16 (&o)[2], int hi, const bool valid = true) {
#pragma unroll
    for (int d0 = 0; d0 < 2; ++d0)
#pragma unroll
        for (int g = 0; g < 4; g += 2) {
            unsigned ax = pk2(o[d0][4 * g], o[d0][4 * g + 1]), ay = pk2(o[d0][4 * g + 2], o[d0][4 * g + 3]), bx = pk2(o[d0][4 * g + 4], o[d0][4 * g + 5]), by = pk2(o[d0][4 * g + 6], o[d0][4 * g + 7]);
            { auto r = __builtin_amdgcn_permlane32_swap(ax, bx, false, false); ax = r[0]; bx = r[1]; }
            { auto r = __builtin_amdgcn_permlane32_swap(ay, by, false, false); ay = r[0]; by = r[1]; }
            if (valid) *(u32x4*)(dst + 32 * d0 + 8 * (g + hi)) = (u32x4){ax, ay, bx, by};
        }
}
__device__ __forceinline__ void load_q(bf16x8 (&qf)[4], const bf16_t* qp, int hi) {
#pragma unroll
    for (int d0 = 0; d0 < 4; ++d0) qf[d0] = *(const bf16x8*)(qp + 16 * d0 + 8 * hi);
}

__device__ __forceinline__ void unit_A(LAS unsigned char* lds, const bf16_t* proj, bf16_t* mixed, int b, int h, int qb, int tid, int wid, int lane) {
    const int r32 = lane & 31, hi = lane >> 5;
    const int t = 256 * qb + 32 * wid + r32;
    const size_t rowb = (size_t)b * SEQ;
    bf16x8 qf[4]; load_q(qf, proj + (rowb + t) * NINP + C_AQ + h * 64, hi);
    const KVp kv{proj + rowb * NINP + C_AK + h * 64, proj + rowb * NINP + C_AV + h * 64, NINP, NINP};
    const Ring rg = ring_init(lds, kv, wid, lane);
    f32x16 o[2]; o[0] = zero16(); o[1] = zero16();
    float C = 0.f;
    const int jmax = 4 * qb + 3, tmaxw = 256 * qb + 32 * wid + 31, tminw = tmaxw - 31;
    LAS float* wm = (LAS float*)(lds + L_X);
#pragma unroll
    for (int k = 0; k < NS - 1; ++k) ring_issue(rg, jmax - k > 0 ? jmax - k : 0, k);
    ATT_WAIT_BAR(4);
    for (int it = 0; it <= jmax; ++it) {
        const int jt = jmax - it;
        if (it > 0) { float mx = wm[((it - 1) & 1) * 8];
#pragma unroll
            for (int w = 1; w < 8; ++w) mx = fmaxf(mx, wm[((it - 1) & 1) * 8 + w]);
            if (mx < -100.f) break; }
        { const int jn = jt - (NS - 1); ring_issue(rg, jn > 0 ? jn : 0, (it + NS - 1) % NS); }
        if (64 * jt < tmaxw) {
            f32x16 p0, p1; qk<0, 4>(p0, p1, lds + L_K + (it % NS) * SLOT, qf, hi, r32);
            if (64 * jt + 63 >= tminw) mask_le(p0, p1, t - 1 - 64 * jt, hi);
            float L0[16], L1[16];
#pragma unroll
            for (int r = 0; r < 16; ++r) { const float z0 = p0[r], z1 = p1[r];
                L0[r] = -(fmaxf(z0, 0.f) + lg2(1.f + ex2(-fabsf(z0)))); L1[r] = -(fmaxf(z1, 0.f) + lg2(1.f + ex2(-fabsf(z1)))); }
            float gs[8], og[8];
#pragma unroll
            for (int k = 0; k < 4; ++k) { gs[k] = (L0[4 * k] + L0[4 * k + 1]) + (L0[4 * k + 2] + L0[4 * k + 3]); gs[4 + k] = (L1[4 * k] + L1[4 * k + 1]) + (L1[4 * k + 2] + L1[4 * k + 3]); }
#pragma unroll
            for (int k = 0; k < 8; ++k) og[k] = xhalf(gs[k]);
            float aown = 0.f, aoth = 0.f;
#pragma unroll
            for (int k = 7; k >= 0; --k) {
                const float base = C + (aown + aoth + (hi == 0 ? og[k] : 0.f));
                if (k >= 4) { const int q = 4 * (k - 4);
                    const float i3 = base + L1[q + 3], i2 = i3 + L1[q + 2], i1 = i2 + L1[q + 1], i0 = i1 + L1[q];
                    p1[q + 3] = ex2(p1[q + 3] + i3); p1[q + 2] = ex2(p1[q + 2] + i2); p1[q + 1] = ex2(p1[q + 1] + i1); p1[q] = ex2(p1[q] + i0);
                } else { const int q = 4 * k;
                    const float i3 = base + L0[q + 3], i2 = i3 + L0[q + 2], i1 = i2 + L0[q + 1], i0 = i1 + L0[q];
                    p0[q + 3] = ex2(p0[q + 3] + i3); p0[q + 2] = ex2(p0[q + 2] + i2); p0[q + 1] = ex2(p0[q + 1] + i1); p0[q] = ex2(p0[q] + i0);
                }
                aown += gs[k]; aoth += og[k];
            }
            C += (hi ? aoth : aown) + (hi ? aown : aoth);
            bf16x8 pw[4]; pack_p(pw, p0, p1);
            pv(o, lds + L_V + (it % NS) * SLOT, pw, lane, hi);
        }
        const float cm = wave_max(C);
        if (lane == 0) wm[(it & 1) * 8 + wid] = cm;
        ATT_WAIT_BAR(4);
    }
    ring_drain();
    store_o(mixed + (rowb + t) * DM + 0 + h * 64, o, hi);
}

__device__ __forceinline__ void unit_B(LAS unsigned char* lds, const bf16_t* proj, bf16_t* mixed, const float* gain, float lam, float lam_init, int b, int h, int qb, int tid, int wid, int lane) {
    const int r32 = lane & 31, hi = lane >> 5;
    const int t = 256 * qb + 32 * wid + r32;
    const size_t rowb = (size_t)b * SEQ;
    bf16x8 qf[4]; load_q(qf, proj + (rowb + t) * NINP + C_BQ + h * 64, hi);
    const KVp kv{proj + rowb * NINP + C_BK + h * 64, proj + rowb * NINP + C_BV + h * 64, NINP, NINP};
    const Ring rg = ring_init(lds, kv, wid, lane);
    f32x16 oa[2], ob[2]; oa[0] = zero16(); oa[1] = zero16(); ob[0] = zero16(); ob[1] = zero16();
    float m0 = 0.f, l0 = 0.f, m1 = 0.f, l1 = 0.f; bool sn0 = false, sn1 = false;
    const int jd = 4 * qb + 3, tmaxw = 256 * qb + 32 * wid + 31, tminw = tmaxw - 31;
#if BPIPE
    const int jl = (tmaxw >> 6) < jd ? (tmaxw >> 6) : jd;
    const int cl = jd;
    ring_issue_k(rg, 0, 0); ring_issue_v(rg, 0, 0); ring_issue_k(rg, 1 < cl ? 1 : cl, 1); ring_issue_k(rg, 2 < cl ? 2 : cl, 2); ring_issue_v(rg, 1 < cl ? 1 : cl, 1);
    ATT_WAIT_BAR(2);
    f32x16 p0, p1; bf16x8 pw[4];
#pragma unroll
    for (int k = 0; k < 4; ++k) pw[k] = (bf16x8){0, 0, 0, 0, 0, 0, 0, 0};
    for (int jt = 0; jt <= jd; ++jt) {
        { const int jk = jt + 3, jv = jt + 2; ring_issue_k(rg, jk < cl ? jk : cl, jk % NS); ring_issue_v(rg, jv < cl ? jv : cl, jv % NS); }
        if (jt <= jl) {
            const bool nm = (64 * jt + 63 > tminw);
            qk<0, 2>(p0, p1, lds + L_K + (jt % NS) * SLOT, qf, hi, r32);
            if (nm) mask_le(p0, p1, t - 64 * jt, hi);
            osm_pre(p0, p1, m0, sn0, l0, oa);
            pv_exp(ob, lds + L_V + (jt == 0 ? 0 : (jt - 1) % NS) * SLOT, pw, p0, p1, l0, lane, hi);
            qk<2, 4>(p0, p1, lds + L_K + (jt % NS) * SLOT, qf, hi, r32);
            if (nm) mask_le(p0, p1, t - 64 * jt, hi);
            osm_pre(p0, p1, m1, sn1, l1, ob);
            pv_exp(oa, lds + L_V + (jt % NS) * SLOT, pw, p0, p1, l1, lane, hi);
            if (jt == jl) pv(ob, lds + L_V + (jt % NS) * SLOT, pw, lane, hi);
        }
        ATT_WAIT_BAR(2);
    }
    ring_drain();
#else
#pragma unroll
    for (int k = 0; k < NS - 1; ++k) ring_issue(rg, k < jd ? k : jd, k);
    ATT_WAIT_BAR(4);
    for (int jt = 0; jt <= jd; ++jt) {
        { const int jn = jt + NS - 1; ring_issue(rg, jn < jd ? jn : jd, jn % NS); }
        if (64 * jt <= tmaxw) {
            const bool nm = (64 * jt + 63 > tminw);
            f32x16 p0, p1; bf16x8 pw[4];
            qk<0, 2>(p0, p1, lds + L_K + (jt % NS) * SLOT, qf, hi, r32);
            if (nm) mask_le(p0, p1, t - 64 * jt, hi);
            osm3(p0, p1, m0, sn0, l0, oa, pw, true);
            pv(oa, lds + L_V + (jt % NS) * SLOT, pw, lane, hi);
            qk<2, 4>(p0, p1, lds + L_K + (jt % NS) * SLOT, qf, hi, r32);
            if (nm) mask_le(p0, p1, t - 64 * jt, hi);
            osm3(p0, p1, m1, sn1, l1, ob, pw, true);
            pv(ob, lds + L_V + (jt % NS) * SLOT, pw, lane, hi);
        }
        ATT_WAIT_BAR(4);
    }
    ring_drain();
#endif
    l0 += xhalf(l0); l1 += xhalf(l1);
    const float i0 = 1.f / l0, i1 = lam / l1;
    float ss = 0.f;
#pragma unroll
    for (int d0 = 0; d0 < 2; ++d0)
#pragma unroll
        for (int r = 0; r < 16; ++r) { const float v = oa[d0][r] * i0 - ob[d0][r] * i1; oa[d0][r] = v; ss += v * v; }
    ss += xhalf(ss);
    const float rs = rsqrtf(ss * (1.f / 64.f) + RMS_EPS) * (1.f - lam_init);
#pragma unroll
    for (int d0 = 0; d0 < 2; ++d0)
#pragma unroll
        for (int g = 0; g < 4; ++g) { const f32x4 gv = *(const f32x4*)(gain + 32 * d0 + 8 * g + 4 * hi);
#pragma unroll
            for (int e = 0; e < 4; ++e) oa[d0][4 * g + e] *= rs * gv[e]; }
    store_o(mixed + (rowb + t) * DM + 256 + h * 64, oa, hi);
}

__device__ __forceinline__ int c_next(int jt, unsigned un, int own) {
    if ((jt & 3) != 3) return jt + 1;
    int j = (jt >> 2) + 1; if (j > own) return jt;
    j += __builtin_ctz((un >> j) | 0x80000000u); return 4 * j;
}
__device__ __forceinline__ void unit_C(LAS unsigned char* lds, const bf16_t* proj, const bf16_t* kmean, bf16_t* mixed, int b, int h, int qb, int tid, int wid, int lane) {
    const int r32 = lane & 31, hi = lane >> 5, own = qb;
    const int t = 256 * qb + 32 * wid + r32;
    const size_t rowb = (size_t)b * SEQ;
    bf16x8 qf[4]; load_q(qf, proj + (rowb + t) * NINP + C_CQ + h * 64, hi);
    const KVp kv{proj + rowb * NINP + C_CK + h * 64, proj + rowb * NINP + C_CV + h * 64, NINP, NINP};
    const Ring rg = ring_init(lds, kv, wid, lane);
    LAS unsigned* un_w = (LAS unsigned*)(lds + L_X);
    unsigned sel = 0u;
    if (tid == 0) un_w[0] = 0u;
    if (own > 0) {
        if (tid < 256) { const int chunk = tid >> 5, key = tid & 31; *(LAS u32x4*)(lds + L_K + chunk * 1024 + key * 16) = *(const u32x4*)(kmean + ((size_t)((b * 4 + h) * 32 + key)) * 64 + chunk * 8); }
        __syncthreads();
        f32x16 g = zero16();
        { const LAS unsigned char* kb = lds + L_K + hi * 1024 + r32 * 16;
#pragma unroll
          for (int d0 = 0; d0 < 4; ++d0) g = mfma32(*(const LAS bf16x8*)(kb + d0 * 2048), qf[d0], g); }
        float og[16];
#pragma unroll
        for (int r = 0; r < 16; ++r) og[r] = xhalf(g[r]);
#pragma unroll
        for (int round = 0; round < 3; ++round) {
            float best = -INFINITY; int bi = -1;
#pragma unroll
            for (int j = 0; j < 32; ++j) { const int hj = (j >> 2) & 1, r = (j & 3) + 4 * (j >> 3);
                const float v = (hj == hi) ? g[r] : og[r];
                const bool ok = (j < own) && !((sel >> j) & 1u) && (v > best);
                best = ok ? v : best; bi = ok ? j : bi; }
            if (bi >= 0) sel |= 1u << bi;
        }
        const unsigned wo = wave_or(sel);
        if (lane == 0) __hip_atomic_fetch_or(un_w, wo, __ATOMIC_RELAXED, __HIP_MEMORY_SCOPE_WORKGROUP);
    }
    __syncthreads();
    const unsigned un = (un_w[0] | (1u << own)) & (own == 31 ? 0xffffffffu : ((2u << own) - 1u));
    f32x16 o[2]; o[0] = zero16(); o[1] = zero16();
    float m = 0.f, l = 0.f; bool seen = false;
    const int tmaxw = 256 * qb + 32 * wid + 31, tminw = tmaxw - 31;
    const int ntile = 4 * __builtin_popcount(un);
    int jt = 4 * (__builtin_ctz(un)), ji = jt;
#pragma unroll
    for (int k = 0; k < NS - 1; ++k) { ring_issue(rg, ji, k); ji = c_next(ji, un, own); }
    ATT_WAIT_BAR(4);
    for (int it = 0; it < ntile; ++it) {
        ring_issue(rg, ji, (it + NS - 1) % NS); ji = c_next(ji, un, own);
        const int blk = jt >> 2;
        bool act; bool rowsel = true;
        if (blk == own) act = (64 * jt <= tmaxw); else { rowsel = (sel >> blk) & 1u; act = __any(rowsel); }
        if (act) {
            f32x16 p0, p1; bf16x8 pw[4];
            qk<0, 4>(p0, p1, lds + L_K + (it % NS) * SLOT, qf, hi, r32);
            if (blk == own && 64 * jt + 63 > tminw) mask_le(p0, p1, t - 64 * jt, hi);
            osm3(p0, p1, m, seen, l, o, pw, blk == own ? true : rowsel);
            pv(o, lds + L_V + (it % NS) * SLOT, pw, lane, hi);
        }
        jt = c_next(jt, un, own);
        ATT_WAIT_BAR(4);
    }
    ring_drain();
    l += xhalf(l);
    const float inv = 1.f / l;
    o[0] *= inv; o[1] *= inv;
    store_o(mixed + (rowb + t) * DM + 512 + h * 64, o, hi);
}

__device__ __forceinline__ void unit_Csel(LAS unsigned char* lds, const bf16_t* proj, const bf16_t* kmean, unsigned* mcnt, int* mlist, int b, int h, int qb, int tid, int wid, int lane) {
    const int r32 = lane & 31, hi = lane >> 5, own = qb, bh = b * 4 + h;
    if (own == 0) return;
    const int t = 256 * qb + 32 * wid + r32;
    LAS int* cl = (LAS int*)(lds + L_X);
    if (tid < 64) cl[tid] = 0;
    bf16x8 qf[4]; load_q(qf, proj + ((size_t)b * SEQ + t) * NINP + C_CQ + h * 64, hi);
    if (tid < 256) { const int chunk = tid >> 5, key = tid & 31; *(LAS u32x4*)(lds + L_K + chunk * 1024 + key * 16) = *(const u32x4*)(kmean + ((size_t)(bh * 32 + key)) * 64 + chunk * 8); }
    __syncthreads();
    f32x16 g = zero16();
    { const LAS unsigned char* kb = lds + L_K + hi * 1024 + r32 * 16;
#pragma unroll
      for (int d0 = 0; d0 < 4; ++d0) g = mfma32(*(const LAS bf16x8*)(kb + d0 * 2048), qf[d0], g); }
    float og[16];
#pragma unroll
    for (int r = 0; r < 16; ++r) og[r] = xhalf(g[r]);
    unsigned sel = 0u; int pk0 = -1, pk1 = -1, pk2 = -1;
#pragma unroll
    for (int round = 0; round < 3; ++round) {
        float best = -INFINITY; int bi = -1;
#pragma unroll
        for (int j = 0; j < 32; ++j) { const int hj = (j >> 2) & 1, r = (j & 3) + 4 * (j >> 3);
            const float v = (hj == hi) ? g[r] : og[r];
            const bool ok = (j < own) && !((sel >> j) & 1u) && (v > best);
            best = ok ? v : best; bi = ok ? j : bi; }
        if (bi >= 0) sel |= 1u << bi;
        if (round == 0) pk0 = bi; else if (round == 1) pk1 = bi; else pk2 = bi;
    }
    int lp0 = 0, lp1 = 0, lp2 = 0;
    if (hi == 0) {
        if (pk0 >= 0) lp0 = __hip_atomic_fetch_add(cl + pk0, 1, __ATOMIC_RELAXED, __HIP_MEMORY_SCOPE_WORKGROUP);
        if (pk1 >= 0) lp1 = __hip_atomic_fetch_add(cl + pk1, 1, __ATOMIC_RELAXED, __HIP_MEMORY_SCOPE_WORKGROUP);
        if (pk2 >= 0) lp2 = __hip_atomic_fetch_add(cl + pk2, 1, __ATOMIC_RELAXED, __HIP_MEMORY_SCOPE_WORKGROUP);
    }
    __syncthreads();
    if (tid < own) { const int n = cl[tid]; cl[32 + tid] = n ? (int)__hip_atomic_fetch_add(mcnt + bh * 32 + tid, (unsigned)n, __ATOMIC_RELAXED, __HIP_MEMORY_SCOPE_AGENT) : 0; }
    __syncthreads();
    if (hi == 0) {
        if (pk0 >= 0) mlist[(size_t)(bh * 32 + pk0) * 8192 + cl[32 + pk0] + lp0] = (t << 2) | 0;
        if (pk1 >= 0) mlist[(size_t)(bh * 32 + pk1) * 8192 + cl[32 + pk1] + lp1] = (t << 2) | 1;
        if (pk2 >= 0) mlist[(size_t)(bh * 32 + pk2) * 8192 + cl[32 + pk2] + lp2] = (t << 2) | 2;
    }
    __syncthreads();
}
__device__ __forceinline__ void unit_Cgather(LAS unsigned char* lds, const bf16_t* proj, const int* mlist, bf16_t* Po, float* Pml, int li, int chunk, int n, int tid, int wid, int lane) {
    const int r32 = lane & 31, hi = lane >> 5, bh = li >> 5, j = li & 31, b = bh >> 2, h = bh & 3;
    const int idx = chunk * 256 + 32 * wid + r32; const bool valid = idx < n;
    const int ent = mlist[(size_t)li * 8192 + (valid ? idx : 0)];
    const int t = ent >> 2, slot = ent & 3;
    const size_t rowb = (size_t)b * SEQ;
    bf16x8 qf[4]; load_q(qf, proj + (rowb + t) * NINP + C_CQ + h * 64, hi);
    const KVp kv{proj + rowb * NINP + C_CK + h * 64, proj + rowb * NINP + C_CV + h * 64, NINP, NINP};
    const Ring rg = ring_init(lds, kv, wid, lane);
#pragma unroll
    for (int q = 0; q < 4; ++q) ring_issue(rg, 4 * j + q, q);
    ring_drain();
    f32x16 o[2]; o[0] = zero16(); o[1] = zero16();
    float m = 0.f, l = 0.f; bool seen = false;
    {
        f32x16 pa0, pa1, pb0, pb1;
        qk<0, 4>(pa0, pa1, lds + L_K, qf, hi, r32);
        osm3f<true>(pa0, pa1, m, seen, l, o, lds + L_V, true, lane, hi, pb0, pb1, lds + L_K + SLOT, qf);
        osm3f<true>(pb0, pb1, m, seen, l, o, lds + L_V + SLOT, true, lane, hi, pa0, pa1, lds + L_K + 2 * SLOT, qf);
        osm3f<true>(pa0, pa1, m, seen, l, o, lds + L_V + 2 * SLOT, true, lane, hi, pb0, pb1, lds + L_K + 3 * SLOT, qf);
        osm3f<false>(pb0, pb1, m, seen, l, o, lds + L_V + 3 * SLOT, true, lane, hi, pa0, pa1, lds + L_K, qf);
    }
    l += xhalf(l);
    const float inv = 1.f / l;
    o[0] *= inv; o[1] *= inv;
    { const size_t pi = ((size_t)bh * SEQ + t) * 4 + slot; store_o(Po + pi * 64, o, hi, valid); if (valid && hi == 0) { Pml[pi * 2] = m; Pml[pi * 2 + 1] = l; } }
    asm volatile("s_waitcnt lgkmcnt(0)\n\ts_barrier" ::: "memory");
}
__device__ __forceinline__ void unit_Cown(LAS unsigned char* lds, const bf16_t* proj, const bf16_t* Po, const float* Pml, bf16_t* mixed, unsigned* flag, int b, int h, int qb, int tid, int wid, int lane) {
    const int r32 = lane & 31, hi = lane >> 5, own = qb, bh = b * 4 + h;
    const int t = 256 * qb + 32 * wid + r32;
    const size_t rowb = (size_t)b * SEQ;
    bf16x8 qf[4]; load_q(qf, proj + (rowb + t) * NINP + C_CQ + h * 64, hi);
    const KVp kv{proj + rowb * NINP + C_CK + h * 64, proj + rowb * NINP + C_CV + h * 64, NINP, NINP};
    const Ring rg = ring_init(lds, kv, wid, lane);
#pragma unroll
    for (int q = 0; q < 4; ++q) ring_issue(rg, 4 * own + q, q);
    ring_drain();
    f32x16 o[2]; o[0] = zero16(); o[1] = zero16();
    float m = 0.f, l = 0.f; bool seen = false;
    const int tmaxw = 256 * qb + 32 * wid + 31, tminw = tmaxw - 31;
#pragma unroll 1
    for (int q = 0; q < 4; ++q) {
        const int jt = 4 * own + q;
        if (64 * jt <= tmaxw) {
            f32x16 p0, p1; bf16x8 pw[4];
            qk<0, 4>(p0, p1, lds + L_K + q * SLOT, qf, hi, r32);
            if (64 * jt + 63 > tminw) mask_le(p0, p1, t - 64 * jt, hi);
            osm3f<false>(p0, p1, m, seen, l, o, lds + L_V + q * SLOT, true, lane, hi, p0, p1, lds, qf);
        }
    }
    l += xhalf(l);
    const int nsel = own < 3 ? own : 3;
    const size_t pi = ((size_t)bh * SEQ + t) * 4;
    u32x2 pv[3][8];
#pragma unroll
    for (int s = 0; s < 3; ++s) { const bf16_t* ps = Po + (pi + (s < nsel ? s : 0)) * 64;
#pragma unroll
        for (int d0 = 0; d0 < 2; ++d0)
#pragma unroll
            for (int g = 0; g < 4; ++g) pv[s][d0 * 4 + g] = *(const u32x2*)(ps + 32 * d0 + 8 * g + 4 * hi); }
    float ms0 = 0.f, ls0 = 0.f, ms1 = 0.f, ls1 = 0.f, ms2 = 0.f, ls2 = 0.f, M = m;
    if (nsel > 0) { ms0 = Pml[pi * 2]; ls0 = Pml[pi * 2 + 1]; }
    if (nsel > 1) { ms1 = Pml[pi * 2 + 2]; ls1 = Pml[pi * 2 + 3]; }
    if (nsel > 2) { ms2 = Pml[pi * 2 + 4]; ls2 = Pml[pi * 2 + 5]; }
    __builtin_amdgcn_sched_barrier(0);
    if (nsel > 0) M = fmaxf(M, ms0);
    if (nsel > 1) M = fmaxf(M, ms1);
    if (nsel > 2) M = fmaxf(M, ms2);
    const float wo = ex2(m - M), w0 = ls0 * ex2(ms0 - M), w1 = ls1 * ex2(ms1 - M), w2 = ls2 * ex2(ms2 - M);
    const float inv = 1.f / (l * wo + (w0 + w1 + w2));
    o[0] *= wo; o[1] *= wo;
#pragma unroll
    for (int s = 0; s < 3; ++s) if (s < nsel) {
        const float w = s == 0 ? w0 : s == 1 ? w1 : w2;
#pragma unroll
        for (int d0 = 0; d0 < 2; ++d0)
#pragma unroll
            for (int g = 0; g < 4; ++g) { const u32x2 v = pv[s][d0 * 4 + g];
                o[d0][4 * g] += w * bflo(v.x); o[d0][4 * g + 1] += w * bfhi(v.x); o[d0][4 * g + 2] += w * bflo(v.y); o[d0][4 * g + 3] += w * bfhi(v.y); }
    }
    o[0] *= inv; o[1] *= inv;
    bf16_t* dst = mixed + (rowb + t) * DM + 512 + h * 64;
#if CHECK_C
    { float worst = 0.f;
#pragma unroll
      for (int d0 = 0; d0 < 2; ++d0)
#pragma unroll
          for (int g = 0; g < 4; ++g) { const u32x2 v = *(const u32x2*)(dst + 32 * d0 + 8 * g + 4 * hi);
              worst = fmaxf(worst, fmaxf(fmaxf(fabsf(o[d0][4 * g] - bflo(v.x)), fabsf(o[d0][4 * g + 1] - bfhi(v.x))), fmaxf(fabsf(o[d0][4 * g + 2] - bflo(v.y)), fabsf(o[d0][4 * g + 3] - bfhi(v.y))))); }
      if (!(worst <= 0.02f)) atomicOr(flag, 1u); }
#else
    store_o(dst, o, hi);
#endif
    asm volatile("s_waitcnt lgkmcnt(0)\n\ts_barrier" ::: "memory");
}

#if DSELV2
constexpr int LD_IA = L_X, LD_SM = 133120, LD_WO = LD_SM + 1024, LD_END = LD_WO + 128;
#else
constexpr int LD_IA = L_X, LD_SM = L_X + 32768, LD_WO = LD_SM + 1024, LD_END = LD_WO + 128;
#endif
__device__ __forceinline__ void d_stash_st(LAS unsigned char* lds, int tid, const f32x16 (&a)[2]) {
    LAS f32x4* s = (LAS f32x4*)(lds + L_X) + tid;
#pragma unroll
    for (int k = 0; k < 4; ++k) { s[k * 512] = (f32x4){a[0][4 * k], a[0][4 * k + 1], a[0][4 * k + 2], a[0][4 * k + 3]}; s[(4 + k) * 512] = (f32x4){a[1][4 * k], a[1][4 * k + 1], a[1][4 * k + 2], a[1][4 * k + 3]}; }
}
__device__ __forceinline__ void d_stash_ld(LAS unsigned char* lds, int tid, f32x16 (&a)[2]) {
    const LAS f32x4* s = (const LAS f32x4*)(lds + L_X) + tid;
#pragma unroll
    for (int k = 0; k < 4; ++k) { const f32x4 x = s[k * 512], y = s[(4 + k) * 512];
#pragma unroll
        for (int e = 0; e < 4; ++e) { a[0][4 * k + e] = x[e]; a[1][4 * k + e] = y[e]; } }
}
__device__ __forceinline__ int d_next(int jt, unsigned u0, unsigned u1, unsigned u2, unsigned u3, int i) {
    for (int jn = jt + 1; jn <= i; ++jn) { const unsigned w = jn < 32 ? u0 : jn < 64 ? u1 : jn < 96 ? u2 : u3; if ((w >> (jn & 31)) & 1u) return jn; }
    return jt;
}
__device__ __forceinline__ void unit_D(LAS unsigned char* lds, const bf16_t* proj, const bf16_t* qr, const bf16_t* kc, const bf16_t* vc, const float* gates, bf16_t* mixed,
                                       int b, int i, int tid, int wid, int lane) {
    const int r32 = lane & 31, hi = lane >> 5, hd = r32 & 3, tl = 8 * wid + (r32 >> 2);
    const int t = 64 * i + tl, tt = tl;
    const size_t rowb = (size_t)b * SEQ, row = rowb + t;
    LAS float* imp = (LAS float*)(lds + LD_IA);
    LAS unsigned* smk = (LAS unsigned*)(lds + LD_SM); LAS unsigned* wor = (LAS unsigned*)(lds + LD_WO);
    bf16x8 qf[4]; load_q(qf, proj + row * NINP + C_DQ + hd * 64, hi);
    const float g_c = gates[row * 12 + hd * 3 + 0], g_s = gates[row * 12 + hd * 3 + 1], g_w = gates[row * 12 + hd * 3 + 2];
    f32x16 acc[2]; acc[0] = zero16(); acc[1] = zero16();
    const KVp kvc{kc + (size_t)b * NCMP * 64, vc + (size_t)b * NCMP * 64, 64, 64};
    const int J = (4 * i + 2) >> 6, nlim = (t - 31) >> 4;
    float m = -1e30f, l = 0.f;
    {
        int ln = lane; asm volatile("" : "+v"(ln)); const Ring rg = ring_init(lds, kvc, wid, ln);
#pragma unroll
        for (int k = 0; k < NS - 1; ++k) ring_issue(rg, k < J ? k : J, k);
        ATT_WAIT_BAR(4);
        for (int jt = 0; jt <= J; ++jt) {
            { const int jn = jt + NS - 1; ring_issue(rg, jn < J ? jn : J, jn % NS); }
            f32x16 p0, p1; qk<0, 4>(p0, p1, lds + L_K + (jt % NS) * SLOT, qf, hi, r32);
            mask_le(p0, p1, nlim - 64 * jt, hi);
            float mx = fmaxf(p0[0], p1[0]);
#pragma unroll
            for (int r = 1; r < 16; ++r) mx = fmaxf(mx, fmaxf(p0[r], p1[r]));
            const float mn = fmaxf(m, mx); float s = 0.f;
#pragma unroll
            for (int r = 0; r < 16; ++r) s += ex2(p0[r] - mn) + ex2(p1[r] - mn);
            l = l * ex2(m - mn) + s; m = mn;
            ATT_WAIT_BAR(4);
        }
        { const float mo = xhalf(m), lo = xhalf(l), M = fmaxf(m, mo); l = l * ex2(m - M) + lo * ex2(mo - M); m = M; }
        const float m2 = l > 0.f ? m + lg2(l) : INFINITY;
        ring_drain();
#pragma unroll
        for (int k = 0; k < NS - 1; ++k) ring_issue(rg, k < J ? k : J, k);
        ATT_WAIT_BAR(4);
        float carry = 0.f;
        for (int jt = 0; jt <= J; ++jt) {
            { const int jn = jt + NS - 1; ring_issue(rg, jn < J ? jn : J, jn % NS); }
            f32x16 p0, p1; qk<0, 4>(p0, p1, lds + L_K + (jt % NS) * SLOT, qf, hi, r32);
            mask_le(p0, p1, nlim - 64 * jt, hi);
#pragma unroll
            for (int r = 0; r < 16; ++r) { p0[r] = ex2(p0[r] - m2); p1[r] = ex2(p1[r] - m2); }
            float ol[8];
#pragma unroll
            for (int k = 0; k < 8; ++k) ol[k] = xhalf(k < 4 ? p0[4 * k + 3] : p1[4 * k - 13]);
#pragma unroll
            for (int k = 0; k < 8; ++k) {
                float gsum = (k < 4) ? (p0[4 * k] + p0[4 * k + 1]) + (p0[4 * k + 2] + p0[4 * k + 3]) : (p1[4 * k - 16] + p1[4 * k - 15]) + (p1[4 * k - 14] + p1[4 * k - 13]);
                const float prev = hi ? ol[k] : (k > 0 ? ol[k - 1] : carry);
                const float v = quad_sum(gsum + prev);
                if (hd == 0) imp[tl * 128 + 16 * jt + 2 * k + hi] = v;
            }
            carry = ol[7];
            bf16x8 pw[4]; pack_p(pw, p0, p1);
            pv(acc, lds + L_V + (jt % NS) * SLOT, pw, lane, hi);
            ATT_WAIT_BAR(4);
        }
        ring_drain();
    }
    acc[0] *= g_c; acc[1] *= g_c;
    unsigned wo0 = 0u, wo1 = 0u, wo2 = 0u, wo3 = 0u;
#pragma unroll 1
    for (int k8 = 0; k8 < 8; ++k8) {
        const int tk = 8 * wid + k8;
        unsigned long long b0, b1;
        if (i < 16) { b0 = (2ull << i) - 1ull; b1 = 0ull; }
        else {
            const int m0 = lane, m1 = lane + 64;
            const bool c0 = (m0 <= i) && (m0 != 0) && (m0 != i) && (m0 != i - 1), c1 = (m1 <= i) && (m1 != i) && (m1 != i - 1);
            const bool f0 = (m0 == 0) || (m0 == i) || (m0 == i - 1), f1 = (m1 == i) || (m1 == i - 1);
            const float v0 = imp[tk * 128 + m0], v1 = imp[tk * 128 + m1];
            const unsigned k0 = c0 ? __float_as_uint(v0) + 1u : 0u, k1 = c1 ? __float_as_uint(v1) + 1u : 0u;
            unsigned thr = 0u;
            for (int bit = 30; bit >= 0; --bit) { const unsigned cand = thr | (1u << bit);
                const int c = __popcll(__ballot(k0 >= cand)) + __popcll(__ballot(k1 >= cand)); if (c == 13) { thr = cand - 1u; break; }
                if (c >= 13) thr = cand; }
            const bool gt0 = k0 > thr, gt1 = k1 > thr, eq0 = (k0 == thr) && c0, eq1 = (k1 == thr) && c1;
            const int need = 13 - (__popcll(__ballot(gt0)) + __popcll(__ballot(gt1)));
            const unsigned long long be0 = __ballot(eq0), be1 = __ballot(eq1), lt = (1ull << lane) - 1ull;
            const int rk0 = __popcll(be0 & lt), rk1 = __popcll(be0) + __popcll(be1 & lt);
            b0 = __ballot(f0 || gt0 || (eq0 && rk0 < need)); b1 = __ballot(f1 || gt1 || (eq1 && rk1 < need));
        }
        const unsigned w0 = (unsigned)b0, w1 = (unsigned)(b0 >> 32), w2 = (unsigned)b1, w3 = (unsigned)(b1 >> 32);
        if (lane == 0) { smk[tk * 4 + 0] = w0; smk[tk * 4 + 1] = w1; smk[tk * 4 + 2] = w2; smk[tk * 4 + 3] = w3; }
        wo0 |= w0; wo1 |= w1; wo2 |= w2; wo3 |= w3;
    }
    if (lane == 0) { wor[wid * 4 + 0] = wo0; wor[wid * 4 + 1] = wo1; wor[wid * 4 + 2] = wo2; wor[wid * 4 + 3] = wo3; }
    __syncthreads();
    unsigned un0 = 0u, un1 = 0u, un2 = 0u, un3 = 0u;
#pragma unroll
    for (int w = 0; w < 8; ++w) { un0 |= wor[w * 4 + 0]; un1 |= wor[w * 4 + 1]; un2 |= wor[w * 4 + 2]; un3 |= wor[w * 4 + 3]; }
    const unsigned sm0 = smk[tl * 4 + 0], sm1 = smk[tl * 4 + 1], sm2 = smk[tl * 4 + 2], sm3 = smk[tl * 4 + 3];
    f32x16 accs0 = acc[0], accs1 = acc[1]; (void)accs0; (void)accs1;
    { int r2 = (int)(row & 0x7fffffff); asm volatile("" : "+v"(r2)); load_q(qf, qr + (size_t)r2 * 256 + hd * 64, hi); }
#if DSELV2
    {
        { int ts = tid; asm volatile("" : "+v"(ts)); d_stash_st(lds, ts, acc); }
        const KVp kvs{proj + rowb * NINP + C_KS, proj + rowb * NINP + C_VS, NINP, NINP};
        int ln = lane; asm volatile("" : "+v"(ln)); const Ring rg = ring_init(lds, kvs, wid, ln);
        f32x16 o[2]; o[0] = zero16(); o[1] = zero16();
        const int ntile = __builtin_popcount(un0) + __builtin_popcount(un1) + __builtin_popcount(un2) + __builtin_popcount(un3);
        const unsigned kb = kfrag_base(r32, hi), vb = vbase(ln, hi);
        int jk = 0, jv = 0, jt = 0;
#define DS_K(slot) do { ring_issue_k(rg, jk, (slot)); jk = d_next(jk, un0, un1, un2, un3, i); } while (0)
#define DS_V(slot) do { ring_issue_v(rg, jv, (slot)); jv = d_next(jv, un0, un1, un2, un3, i); } while (0)
#define DS_RS(j) ((((j) < 32 ? sm0 : (j) < 64 ? sm1 : (j) < 96 ? sm2 : sm3) >> ((j) & 31)) & 1u)
#define DS_KL2(sl, j) do { kf[2 * (j)] = *(const LAS bf16x8*)(lds + L_K + (sl) * SLOT + (kb ^ ((2 * (j)) << 4))); kf[2 * (j) + 1] = *(const LAS bf16x8*)(lds + L_K + (sl) * SLOT + (kb ^ ((2 * (j)) << 4)) + 4096); } while (0)
        DS_K(0); DS_V(0); DS_K(1); DS_K(2);
        ATT_WAIT_BAR(3);
        f32x16 pA0, pA1, pB0, pB1, negm; bf16x8 kf[8];
        float mhat, l_reg = 0.f, fsc = 1.f; bool resc = false;
        qk<0, 4>(pA0, pA1, lds + L_K, qf, hi, r32);
        if (i == 0) mask_le(pA0, pA1, tt, hi);
        { float mx = max3f(pA0[0], pA1[0], pA0[1]);
#pragma unroll
          for (int r = 1; r < 15; r += 2) { mx = max3f(mx, pA1[r], pA0[r + 1]); mx = fmaxf(mx, pA1[r + 1]); }
          mx = fmaxf(mx, pA1[15]); mx = fmaxf(mx, xhalf(mx)); mhat = mx;
#pragma unroll
          for (int r = 0; r < 16; ++r) { pA0[r] = ex2(pA0[r] - mx); pA1[r] = ex2(pA1[r] - mx); negm[r] = -mx; } }
        asm volatile("" : "+v"(negm));
        ATT_WAIT_BAR(0);
        DS_K(0); DS_V(1);
        int sp = 0, sc = 1, sn = 2;
#pragma unroll
        for (int j = 0; j < 4; ++j) DS_KL2(sc, j);
        ATT_WAIT_BAR(2);
        bool rsp = true;
        jt = d_next(0, un0, un1, un2, un3, i);
#define DS_PIN(x) asm volatile("" : "+v"(x))
#define DS_SB() __builtin_amdgcn_sched_barrier(0)
#define DS_VRD(k) do { const LAS unsigned char* vp_ = lds + L_V + sp * SLOT + (vb ^ (64u * ((k) >> 2))) + ((k) & 3) * 2048; vlo[k] = vtr(vp_); vhi[k] = vtr(vp_ + 1024); } while (0)
#define DS_VFR(k) ((bf16x8){vlo[k][0], vlo[k][1], vlo[k][2], vlo[k][3], vhi[k][0], vhi[k][1], vhi[k][2], vhi[k][3]})
#define DS_PK(P, B) (rsp ? pk2(P[B], P[(B) + 1]) : 0u)
#define DS_GAPA(MF, A0, A1, A2, A3, W0, W1, PW) do { MF; sacc += A0; sacc += A1; sacc += A2; sacc += A3; DS_PIN(sacc); W0; W1; DS_PIN(PW); DS_SB(); } while (0)
#define DS_GAPB(MF, X, B) do { MF; X[B] = ex2(X[B]); X[(B) + 1] = ex2(X[(B) + 1]); X[(B) + 2] = ex2(X[(B) + 2]); X[(B) + 3] = ex2(X[(B) + 3]); DS_PIN(X); DS_SB(); } while (0)
#define DS_STEP(C0, C1, P0, P1) do { DS_SB(); \
            s16x4 vlo[8], vhi[8]; u32x4 pw0, pw1, pw2, pw3; \
            DS_VRD(0); DS_SB(); float sacc = P0[0] + P0[1]; \
            DS_GAPA(C0 = mfma32(kf[0], qf[0], negm), P0[2], P0[3], P0[4], P0[5], pw0.x = DS_PK(P0, 0), pw0.y = DS_PK(P0, 2), pw0); \
            DS_VRD(4); DS_SB(); DS_GAPA(C1 = mfma32(kf[1], qf[0], negm), P0[6], P0[7], P0[8], P0[9], pw0.z = DS_PK(P0, 4), pw0.w = DS_PK(P0, 6), pw0); \
            DS_VRD(1); DS_SB(); DS_GAPA(C0 = mfma32(kf[2], qf[1], C0), P0[10], P0[11], P0[12], P0[13], pw1.x = DS_PK(P0, 8), pw1.y = DS_PK(P0, 10), pw1); \
            DS_VRD(5); DS_SB(); DS_GAPA(C1 = mfma32(kf[3], qf[1], C1), P0[14], P0[15], P1[0], P1[1], pw1.z = DS_PK(P0, 12), pw1.w = DS_PK(P0, 14), pw1); \
            DS_VRD(2); DS_SB(); DS_GAPA(C0 = mfma32(kf[4], qf[2], C0), P1[2], P1[3], P1[4], P1[5], pw2.x = DS_PK(P1, 0), pw2.y = DS_PK(P1, 2), pw2); \
            DS_VRD(6); DS_SB(); DS_GAPA(C1 = mfma32(kf[5], qf[2], C1), P1[6], P1[7], P1[8], P1[9], pw2.z = DS_PK(P1, 4), pw2.w = DS_PK(P1, 6), pw2); \
            DS_VRD(3); DS_SB(); DS_GAPA(C0 = mfma32(kf[6], qf[3], C0), P1[10], P1[11], P1[12], P1[13], pw3.x = DS_PK(P1, 8), pw3.y = DS_PK(P1, 10), pw3); \
            DS_VRD(7); DS_SB(); DS_GAPA(C1 = mfma32(kf[7], qf[3], C1), P1[14], P1[15], 0.f, 0.f, pw3.z = DS_PK(P1, 12), pw3.w = DS_PK(P1, 14), pw3); \
            l_reg += rsp ? sacc : 0.f; \
            DS_K(sc); DS_V(sn);                                      \
            const bool rsc = DS_RS(jt); \
            if (jt == i) mask_le(C0, C1, tt, hi); \
            { float mx = max3f(C0[0], C1[0], C0[1]); \
              _Pragma("unroll") for (int r = 1; r < 15; r += 2) { mx = max3f(mx, C1[r], C0[r + 1]); mx = fmaxf(mx, C1[r + 1]); } \
              mx = fmaxf(mx, C1[15]); mx = fmaxf(mx, xhalf(mx)); mx = rsc ? mx : -INFINITY; \
              resc = false; \
              if (__any(mx > 8.f)) { const float dl = fmaxf(mx, 0.f); mhat += dl; \
                  _Pragma("unroll") for (int r = 0; r < 16; ++r) { C0[r] -= dl; C1[r] -= dl; negm[r] = -mhat; } \
                  asm volatile("" : "+v"(negm)); fsc = ex2(-dl); l_reg *= fsc; resc = true; } } \
            DS_SB(); \
            DS_GAPB(o[0] = mfma32(DS_VFR(0), __builtin_bit_cast(bf16x8, pw0), o[0]), C0, 0); \
            DS_GAPB(o[1] = mfma32(DS_VFR(4), __builtin_bit_cast(bf16x8, pw0), o[1]), C0, 4); \
            DS_KL2(sn, 0); DS_SB(); DS_GAPB(o[0] = mfma32(DS_VFR(1), __builtin_bit_cast(bf16x8, pw1), o[0]), C0, 8); \
            DS_KL2(sn, 1); DS_SB(); DS_GAPB(o[1] = mfma32(DS_VFR(5), __builtin_bit_cast(bf16x8, pw1), o[1]), C0, 12); \
            DS_KL2(sn, 2); DS_SB(); DS_GAPB(o[0] = mfma32(DS_VFR(2), __builtin_bit_cast(bf16x8, pw2), o[0]), C1, 0); \
            DS_KL2(sn, 3); DS_SB(); DS_GAPB(o[1] = mfma32(DS_VFR(6), __builtin_bit_cast(bf16x8, pw2), o[1]), C1, 4); \
            DS_GAPB(o[0] = mfma32(DS_VFR(3), __builtin_bit_cast(bf16x8, pw3), o[0]), C1, 8); \
            DS_GAPB(o[1] = mfma32(DS_VFR(7), __builtin_bit_cast(bf16x8, pw3), o[1]), C1, 12); \
            ATT_WAIT_BAR(2);                                         \
            if (resc) { o[0] *= fsc; o[1] *= fsc; }                  \
            rsp = rsc; jt = d_next(jt, un0, un1, un2, un3, i); { const int s_ = sp; sp = sc; sc = sn; sn = s_; } \
        } while (0)
        int t = 1;
        for (; t + 1 < ntile; t += 2) { DS_STEP(pB0, pB1, pA0, pA1); DS_STEP(pA0, pA1, pB0, pB1); }
        if (t < ntile) { DS_STEP(pB0, pB1, pA0, pA1);
#pragma unroll
            for (int r = 0; r < 16; ++r) { pA0[r] = pB0[r]; pA1[r] = pB1[r]; } }
        { float sacc = 0.f;
#pragma unroll
          for (int r = 0; r < 16; ++r) sacc += pA0[r] + pA1[r];
          l_reg += rsp ? sacc : 0.f;
          bf16x8 pw[4]; pack_p(pw, pA0, pA1);
          if (!__all(rsp)) {
#pragma unroll
              for (int k = 0; k < 4; ++k) { u32x4 w = __builtin_bit_cast(u32x4, pw[k]); w.x = rsp ? w.x : 0u; w.y = rsp ? w.y : 0u; w.z = rsp ? w.z : 0u; w.w = rsp ? w.w : 0u; pw[k] = __builtin_bit_cast(bf16x8, w); } }
          pv(o, lds + L_V + sp * SLOT, pw, ln, hi); }
        ring_drain();
        l_reg += xhalf(l_reg);
        const float f = g_s / l_reg;
        { int ts = tid; asm volatile("" : "+v"(ts)); d_stash_ld(lds, ts, acc); }
        acc[0] += o[0] * f; acc[1] += o[1] * f;
#undef DS_K
#undef DS_V
#undef DS_RS
#undef DS_KL2
#undef DS_PIN
#undef DS_SB
#undef DS_VRD
#undef DS_VFR
#undef DS_PK
#undef DS_GAPA
#undef DS_GAPB
#undef DS_STEP
    }
#else
    for (int rs_ = 0; rs_ < ((DSUB & 1) ? 2 : 1); ++rs_) { if (rs_) { acc[0] = accs0; acc[1] = accs1; }
        const KVp kvs{proj + rowb * NINP + C_KS, proj + rowb * NINP + C_VS, NINP, NINP};
        int ln = lane; asm volatile("" : "+v"(ln)); const Ring rg = ring_init(lds, kvs, wid, ln);
        f32x16 o[2]; o[0] = zero16(); o[1] = zero16(); m = 0.f; l = 0.f; bool seen = false;
        const int ntile = __builtin_popcount(un0) + __builtin_popcount(un1) + __builtin_popcount(un2) + __builtin_popcount(un3);
        int jt = 0, ji = 0;
#pragma unroll
        for (int k = 0; k < NS - 1; ++k) { ring_issue(rg, ji, k); ji = d_next(ji, un0, un1, un2, un3, i); }
        ATT_WAIT_BAR(4);
        for (int it = 0; it < ntile; ++it) {
            ring_issue(rg, ji, (it + NS - 1) % NS); ji = d_next(ji, un0, un1, un2, un3, i);
            const unsigned w = jt < 32 ? sm0 : jt < 64 ? sm1 : jt < 96 ? sm2 : sm3;
            const bool rowsel = (w >> (jt & 31)) & 1u;
            if (__any(rowsel)) {
                f32x16 p0, p1; bf16x8 pw[4];
                qk<0, 4>(p0, p1, lds + L_K + (it % NS) * SLOT, qf, hi, r32);
                if (jt == i) mask_le(p0, p1, tt, hi);
                osm3f<false, true>(p0, p1, m, seen, l, o, lds + L_V + (it % NS) * SLOT, rowsel, lane, hi, p0, p1, lds, qf);
            }
            jt = d_next(jt, un0, un1, un2, un3, i);
            ATT_WAIT_BAR(4);
        }
        ring_drain();
        l += xhalf(l);
        const float f = g_s / l;
        acc[0] += o[0] * f; acc[1] += o[1] * f;
    }
#endif
    f32x16 accw0 = acc[0], accw1 = acc[1]; (void)accw0; (void)accw1;
    for (int rw_ = 0; rw_ < ((DSUB & 2) ? 2 : 1); ++rw_) { if (rw_) { acc[0] = accw0; acc[1] = accw1; }
        const KVp kvw{proj + rowb * NINP + C_KW, proj + rowb * NINP + C_VW, NINP, NINP};
        int ln = lane; asm volatile("" : "+v"(ln)); const Ring rg = ring_init(lds, kvw, wid, ln);
        f32x16 o[2]; o[0] = zero16(); o[1] = zero16(); m = 0.f; l = 0.f; bool seen = false;
        const int j0 = i >= 8 ? i - 8 : 0;
#pragma unroll
        for (int k = 0; k < NS - 1; ++k) ring_issue(rg, j0 + k < i ? j0 + k : i, k);
        ATT_WAIT_BAR(4);
        for (int jt = j0; jt <= i; ++jt) {
            { const int jn = jt + NS - 1; ring_issue(rg, jn < i ? jn : i, (jn - j0) % NS); }
            f32x16 p0, p1; bf16x8 pw[4];
            qk<0, 4>(p0, p1, lds + L_K + ((jt - j0) % NS) * SLOT, qf, hi, r32);
            if (jt == i) mask_le(p0, p1, tt, hi);
            if (jt == i - 8) mask_gt(p0, p1, tt, hi);
            osm3f<false>(p0, p1, m, seen, l, o, lds + L_V + ((jt - j0) % NS) * SLOT, true, lane, hi, p0, p1, lds, qf);
            ATT_WAIT_BAR(4);
        }
        ring_drain();
        l += xhalf(l);
        const float f = g_w / l;
        acc[0] += o[0] * f; acc[1] += o[1] * f;
    }
    { int r2 = (int)(row & 0x7fffffff); asm volatile("" : "+v"(r2)); store_o(mixed + (size_t)r2 * DM + 768 + hd * 64, acc, hi); }
}
#undef ATT_WAIT_BAR
}


#if CHECK_N
namespace chk {
__device__ __forceinline__ float bf(const bf16_t* p) { return __uint_as_float(((unsigned)*p) << 16); }
__device__ __forceinline__ float logsig(float z) { return z >= 0.f ? -log1pf(expf(-z)) : z - log1pf(expf(z)); }
__device__ __forceinline__ bool close(float a, float b) { return fabsf(a - b) <= 0.02f + 0.05f * fabsf(b); }
__device__ bool chk_A(const bf16_t* proj, const bf16_t* mixed, int b, int h, int t, int lane) {
    const size_t rb = (size_t)b * SEQ; const float q = bf(proj + (rb + t) * NINP + C_AQ + h * 64 + lane) * (1.f / LOG2E);
    float o = 0.f, later = 0.f;
    for (int s = t - 1; s >= 0; --s) {
        const float z = wave_sum(q * bf(proj + (rb + s) * NINP + C_AK + h * 64 + lane));
        o += expf(logsig(z) + later) * bf(proj + (rb + s) * NINP + C_AV + h * 64 + lane);
        later += logsig(-z);
        if (later < -80.f) break;
    }
    return __all(close(bf(mixed + (rb + t) * DM + 0 + h * 64 + lane), o)) != 0;
}
__device__ bool chk_B(const bf16_t* proj, const bf16_t* mixed, const float* gain, float lam, float lam_init, int b, int h, int t, int lane) {
    const size_t rb = (size_t)b * SEQ; const float q = bf(proj + (rb + t) * NINP + C_BQ + h * 64 + lane);
    float m0 = -INFINITY, m1 = -INFINITY, l0 = 0.f, l1 = 0.f, o = 0.f;
    for (int s = 0; s <= t; ++s) { const float p = q * bf(proj + (rb + s) * NINP + C_BK + h * 64 + lane); m0 = fmaxf(m0, wave_sum(lane < 32 ? p : 0.f)); m1 = fmaxf(m1, wave_sum(lane < 32 ? 0.f : p)); }
    for (int s = 0; s <= t; ++s) { const float p = q * bf(proj + (rb + s) * NINP + C_BK + h * 64 + lane); l0 += exp2f(wave_sum(lane < 32 ? p : 0.f) - m0); l1 += exp2f(wave_sum(lane < 32 ? 0.f : p) - m1); }
    for (int s = 0; s <= t; ++s) { const float p = q * bf(proj + (rb + s) * NINP + C_BK + h * 64 + lane);
        const float w = exp2f(wave_sum(lane < 32 ? p : 0.f) - m0) / l0 - lam * exp2f(wave_sum(lane < 32 ? 0.f : p) - m1) / l1;
        o += w * bf(proj + (rb + s) * NINP + C_BV + h * 64 + lane); }
    const float rs = rsqrtf(wave_sum(o * o) / 64.f + RMS_EPS) * (1.f - lam_init);
    return __all(close(bf(mixed + (rb + t) * DM + 256 + h * 64 + lane), o * rs * gain[lane])) != 0;
}
__device__ bool chk_C(const bf16_t* proj, const bf16_t* kmean, const bf16_t* mixed, int b, int h, int t, int lane) {
    const size_t rb = (size_t)b * SEQ; const float q = bf(proj + (rb + t) * NINP + C_CQ + h * 64 + lane);
    const int own = t >> 8; unsigned sel = 0u;
    float g0 = -INFINITY, g1 = -INFINITY, g2 = -INFINITY; int j0 = -1, j1 = -1, j2 = -1;
    for (int j = 0; j < own; ++j) {
        const float g = wave_sum(q * bf(kmean + ((size_t)((b * 4 + h) * 32 + j)) * 64 + lane));
        if (g > g0) { g2 = g1; j2 = j1; g1 = g0; j1 = j0; g0 = g; j0 = j; } else if (g > g1) { g2 = g1; j2 = j1; g1 = g; j1 = j; } else if (g > g2) { g2 = g; j2 = j; }
    }
    if (j0 >= 0) sel |= 1u << j0; if (j1 >= 0) sel |= 1u << j1; if (j2 >= 0) sel |= 1u << j2;
    float mx = -INFINITY, l = 0.f, o = 0.f;
    for (int s = 0; s <= t; ++s) { const int blk = s >> 8; if (blk != own && !((sel >> blk) & 1u)) continue; mx = fmaxf(mx, wave_sum(q * bf(proj + (rb + s) * NINP + C_CK + h * 64 + lane))); }
    for (int s = 0; s <= t; ++s) { const int blk = s >> 8; if (blk != own && !((sel >> blk) & 1u)) continue;
        const float w = exp2f(wave_sum(q * bf(proj + (rb + s) * NINP + C_CK + h * 64 + lane)) - mx); l += w; o += w * bf(proj + (rb + s) * NINP + C_CV + h * 64 + lane); }
    bool ok = __all(close(bf(mixed + (rb + t) * DM + 512 + h * 64 + lane), o / l)) != 0;
    { const int j = (t >> 3) & 31; float s = 0.f; for (int k = 0; k < 256; ++k) s += bf(proj + (rb + 256 * j + k) * NINP + C_CK + h * 64 + lane);
      ok = ok && (__all(fabsf(bf(kmean + ((size_t)((b * 4 + h) * 32 + j)) * 64 + lane) - s * (1.f / 256.f)) <= 0.004f) != 0); }
    return ok;
}
__device__ bool chk_D(const bf16_t* proj, const bf16_t* qr, const bf16_t* kc, const bf16_t* vc, const float* gates, const bf16_t* mixed, int b, int t, int lane) {
    const size_t rb = (size_t)b * SEQ, row = rb + t; const int qblk = t >> 6;
    const int ncv = t >= 31 ? ((t - 31) >> 4) + 1 : 0;
    float imp0 = 0.f, imp1 = 0.f;
    float acc0 = 0.f, acc1 = 0.f, acc2 = 0.f, acc3 = 0.f;
    for (int hd = 0; hd < 4; ++hd) {
        const float q = bf(proj + row * NINP + C_DQ + hd * 64 + lane);
        float mx = -INFINITY, l = 0.f, oc = 0.f;
        for (int n = 0; n < ncv; ++n) mx = fmaxf(mx, wave_sum(q * bf(kc + ((size_t)b * NCMP + n) * 64 + lane)));
        for (int n = 0; n < ncv; ++n) l += exp2f(wave_sum(q * bf(kc + ((size_t)b * NCMP + n) * 64 + lane)) - mx);
        for (int n = 0; n < ncv; ++n) { const float p = exp2f(wave_sum(q * bf(kc + ((size_t)b * NCMP + n) * 64 + lane)) - mx) / l;
            oc += p * bf(vc + ((size_t)b * NCMP + n) * 64 + lane);
            if (16 * n < 64 * lane + 64 && 16 * n + 32 > 64 * lane) imp0 += p;
            if (16 * n < 64 * (lane + 64) + 64 && 16 * n + 32 > 64 * (lane + 64)) imp1 += p; }
        const float gc = gates[row * 12 + hd * 3] * oc;
        if (hd == 0) acc0 = gc; else if (hd == 1) acc1 = gc; else if (hd == 2) acc2 = gc; else acc3 = gc;
    }
    bool s0 = false, s1 = false;
    for (int k = 0; k < 16; ++k) {
        const int ma = lane, mb = lane + 64;
        const float va = s0 ? -INFINITY : ((ma == 0 || ma == qblk || ma == qblk - 1) ? INFINITY : (ma <= qblk ? imp0 : -INFINITY));
        const float vb = s1 ? -INFINITY : ((mb == qblk || mb == qblk - 1) ? INFINITY : (mb <= qblk ? imp1 : -INFINITY));
        float bv = va; int bi = s0 ? 1000 : ma;
        { const int ib = s1 ? 1000 : mb; if (vb > bv || (vb == bv && ib < bi)) { bv = vb; bi = ib; } }
#pragma unroll
        for (int off = 1; off < 64; off <<= 1) { const float ov = __shfl_xor(bv, off); const int oi = __shfl_xor(bi, off); if (ov > bv || (ov == bv && oi < bi)) { bv = ov; bi = oi; } }
        if (bi == ma) s0 = true; if (bi == mb) s1 = true;
    }
    const unsigned long long selA = __ballot(s0), selB = __ballot(s1);
    bool ok = true;
    for (int hd = 0; hd < 4; ++hd) {
        const float q = bf(qr + row * 256 + hd * 64 + lane);
        float mx = -INFINITY, l = 0.f, os = 0.f;
        for (int s = 0; s <= t; ++s) { const int m = s >> 6; if (!(((m < 64 ? selA : selB) >> (m & 63)) & 1ull)) continue; mx = fmaxf(mx, wave_sum(q * bf(proj + (rb + s) * NINP + C_KS + lane))); }
        for (int s = 0; s <= t; ++s) { const int m = s >> 6; if (!(((m < 64 ? selA : selB) >> (m & 63)) & 1ull)) continue;
            const float p = exp2f(wave_sum(q * bf(proj + (rb + s) * NINP + C_KS + lane)) - mx); l += p; os += p * bf(proj + (rb + s) * NINP + C_VS + lane); }
        float mw = -INFINITY, lw = 0.f, ow = 0.f; const int sw0 = t - 511 > 0 ? t - 511 : 0;
        for (int s = sw0; s <= t; ++s) mw = fmaxf(mw, wave_sum(q * bf(proj + (rb + s) * NINP + C_KW + lane)));
        for (int s = sw0; s <= t; ++s) { const float p = exp2f(wave_sum(q * bf(proj + (rb + s) * NINP + C_KW + lane)) - mw); lw += p; ow += p * bf(proj + (rb + s) * NINP + C_VW + lane); }
        const float acc = hd == 0 ? acc0 : hd == 1 ? acc1 : hd == 2 ? acc2 : acc3;
        const float ref = acc + gates[row * 12 + hd * 3 + 1] * os / l + gates[row * 12 + hd * 3 + 2] * ow / lw;
        ok = ok && (__all(close(bf(mixed + row * DM + 768 + hd * 64 + lane), ref)) != 0);
    }
    return ok;
}
__device__ float dotcol(const float* x, const float* w, int row, int c, int lane) { float s = 0.f; for (int k = lane; k < DM; k += 64) s += x[(size_t)row * DM + k] * w[(size_t)k * NIN + c]; return wave_sum(s); }
__device__ bool chk_proj(const float* x, const float* w_in, const int* pos, const bf16_t* proj, const bf16_t* qr, const float* gates, int row, int c, int lane) {
    const bool r16 = (c >= C_BQ && c < C_BV), r32 = (c >= C_CQ && c < C_CV) || (c >= C_DQ && c < C_KC) || (c >= C_KS && c < C_VS) || (c >= C_KW && c < C_VW);
    float v = dotcol(x, w_in, row, c, lane), rot = v;
    if (r16 || r32) { const int half = r16 ? 16 : 32, j = c & (2 * half - 1), f = j & (half - 1); const bool lo = j < half;
        const float other = dotcol(x, w_in, row, lo ? c + half : c - half, lane);
        const float ang = (float)pos[row] * powf(10000.f, -(float)f / (float)half); float sn, cs; sincosf(ang, &sn, &cs);
        rot = lo ? v * cs - other * sn : v * cs + other * sn; }
    float sc = 1.f; if (c < C_AK || (c >= C_CQ && c < C_CK) || (c >= C_DQ && c < C_KC)) sc = QS64; if (c >= C_BQ && c < C_BK) sc = QS32;
    bool ok;
    if (c >= C_G) ok = fabsf(gates[(size_t)row * 12 + (c - C_G)] - 1.f / (1.f + expf(-v))) <= 0.01f;
    else if (c >= C_DQ && c < C_KC) ok = close(bf(proj + (size_t)row * NINP + c), v * sc) && close(bf(qr + (size_t)row * 256 + (c - C_DQ)), rot * sc);
    else ok = close(bf(proj + (size_t)row * NINP + c), rot * sc);
    return __all(ok) != 0;
}
__device__ bool chk_cmp(const bf16_t* proj, const float* cpos, const float* w1, const float* w2, const bf16_t* kcv, int kv, int b, int i, int d, int lane) {
    float h0 = 0.f, h1 = 0.f, h2 = 0.f, h3 = 0.f;
    for (int kk = 0; kk < 2048; ++kk) { const int j = kk >> 6, dd = kk & 63;
        const float tv = bf(proj + ((size_t)b * SEQ + 16 * i + j) * NINP + (kv ? C_VC : C_KC) + dd) + cpos[kk]; const float* wr = w1 + (size_t)kk * 256 + lane;
        h0 += tv * wr[0]; h1 += tv * wr[64]; h2 += tv * wr[128]; h3 += tv * wr[192]; }
    h0 = h0 / (1.f + expf(-h0)); h1 = h1 / (1.f + expf(-h1)); h2 = h2 / (1.f + expf(-h2)); h3 = h3 / (1.f + expf(-h3));
    const float o = wave_sum(h0 * w2[(size_t)lane * 64 + d] + h1 * w2[(size_t)(lane + 64) * 64 + d] + h2 * w2[(size_t)(lane + 128) * 64 + d] + h3 * w2[(size_t)(lane + 192) * 64 + d]);
    return close(bf(kcv + ((size_t)b * NCMP + i) * 64 + d), o);
}
}
#endif

constexpr int LDS_CTL = 131072, LDS_BYTES = 147456;
constexpr int LW_BAR = 0, LW_CNT = 8, LW_TS = 16, LW_CNTL = 32, LW_BASEL = 40, LW_PE = 64;
struct SchedGU {
    const LAS int* cw; const int* list; int t0, t1, G, c, nh; bool dense; unsigned apitch;
    static constexpr bool GATHER_DMA = true;
    __device__ __forceinline__ const int* aentry(const pg8::Unit& u, int r) const {
        if (dense) return list;
        const int e = u.pb / 28 - 1, slot = (u.pm - cw[LW_TS + e]) * 256 + r;
        return list + e * 32768 + (slot < cw[LW_CNT + e] ? slot : 0); }
    __device__ __forceinline__ unsigned afinish(const pg8::Unit& u, int r, int pid) const {
        if (dense) return (unsigned)(u.pm * 256 + r) * apitch;
        const int e = u.pb / 28 - 1, slot = (u.pm - cw[LW_TS + e]) * 256 + r;
        return slot < cw[LW_CNT + e] ? (unsigned)(pid >> 1) * apitch : 0u; }
    __device__ __forceinline__ bool next(int i, pg8::Unit& u) const {
        int L;
        if (c >= nh) L = i < 4 ? i * (G - nh) + (c - nh) : 4 * (G - nh) + (i - 4) * G + c; else L = 4 * (G - nh) + i * G + c;
        if (L >= (t1 - t0) * 28) return false;
        u.pm = t0 + L / 28; u.pn = L % 28; int e = 0;
        if (!dense) {
#pragma unroll
            for (int k_ = 1; k_ < 8; ++k_) e += (u.pm >= cw[LW_TS + k_]) ? 1 : 0; }
        u.pb = (dense ? 0 : 1 + e) * 28 + u.pn; return true;
    }
    __device__ __forceinline__ unsigned arow(const pg8::Unit& u, int r) const {
        if (dense) return (unsigned)(u.pm * 256 + r) * apitch;
        const int e = u.pb / 28 - 1, slot = (u.pm - cw[LW_TS + e]) * 256 + r;
        const int pid = slot < cw[LW_CNT + e] ? list[e * 32768 + slot] : 0;
        return (unsigned)(pid >> 1) * apitch;
    }
};
struct SchedDN {
    static constexpr bool GATHER_DMA = false;
    const LAS int* cw; int t0, t1, s0, G, c; bool dense; bool xm;
    __device__ __forceinline__ bool next(int i, pg8::Unit& u) const {
        if (xm) { const int x = c & 7, r = c >> 3; u.pm = t0 + i * (G >> 2) + (r >> 2) * 8 + x; u.pn = r & 3; if (u.pm >= t1) return false; }
        else { const int L = i * G + c; if (L >= (t1 - t0) * 4) return false; u.pm = t0 + (L >> 2); u.pn = L & 3; }
        int e = 0;
        if (!dense) {
#pragma unroll
            for (int k_ = 1; k_ < 8; ++k_) e += (u.pm >= cw[LW_TS + k_]) ? 1 : 0; }
        u.pb = (dense ? 0 : 1 + e) * 4 + u.pn; return true;
    }
    __device__ __forceinline__ unsigned arow(const pg8::Unit& u, int r) const { return (unsigned)((u.pm - s0) * 256 + r) * (unsigned)DFF; }
};
struct EpiDown {
    static constexpr bool PERM = true; static constexpr int DUPID = 32;
    bool dense; const bf16_t* h1; bf16_t* ps; bf16_t* Y; const LAS int* cw; const int* list; const float* moeg; float sc;
    __device__ __forceinline__ void operator()(const Acc& acc, const pg8::Unit& u, int wr, int wc, int fr, int fq) const {
        const int col = u.pn * 256 + wc * 32 + 8 * fq;
        if (dense) {
#pragma unroll
            for (int ai = 0; ai < 2; ++ai) {
                u32x4 rw[4][2];
#pragma unroll
                for (int m = 0; m < 4; ++m) { const size_t off = (size_t)(u.pm * 256 + ai * 128 + wr * 64 + m * 16 + fr) * DM + col;
#pragma unroll
                    for (int bj = 0; bj < 2; ++bj) rw[m][bj] = *(const u32x4*)(h1 + off + bj * 128); }
                __builtin_amdgcn_sched_barrier(0);
#pragma unroll
                for (int m = 0; m < 4; ++m) { const size_t off = (size_t)(u.pm * 256 + ai * 128 + wr * 64 + m * 16 + fr) * DM + col;
#pragma unroll
                    for (int bj = 0; bj < 2; ++bj) { const size_t o = off + bj * 128; const u32x4 w = rw[m][bj];
                        const f32x4 b0 = {bflo(w.x), bfhi(w.x), bflo(w.y), bfhi(w.y)}, b1 = {bflo(w.z), bfhi(w.z), bflo(w.w), bfhi(w.w)};
                        st_bf8(ps + o, b0 * ALPHA + acc[ai][bj][m][0] * sc, b1 * ALPHA + acc[ai][bj][m][1] * sc); } }
                __builtin_amdgcn_sched_barrier(0);
            }
        } else {
            const int e = u.pb / 4 - 1, s0 = (u.pm - cw[LW_TS + e]) * 256, ce = cw[LW_CNT + e];
            int pidv[8]; float gv[8];
#pragma unroll
            for (int i = 0; i < 8; ++i) { const int slot = s0 + (i >> 2) * 128 + wr * 64 + (i & 3) * 16 + fr; pidv[i] = list[e * 32768 + (slot < ce ? slot : s0)]; }
#pragma unroll
            for (int i = 0; i < 8; ++i) gv[i] = moeg[pidv[i]] * sc;
            __builtin_amdgcn_sched_barrier(0);
#pragma unroll
            for (int ai = 0; ai < 2; ++ai)
#pragma unroll
                for (int m = 0; m < 4; ++m) { const int slot = s0 + ai * 128 + wr * 64 + m * 16 + fr;
                    if (slot < ce) { const int pid = pidv[ai * 4 + m]; const float g = gv[ai * 4 + m]; bf16_t* yp = Y + (size_t)pid * DM + col;
#pragma unroll
                        for (int bj = 0; bj < 2; ++bj) st_bf8(yp + bj * 128, acc[ai][bj][m][0] * g, acc[ai][bj][m][1] * g); } }
        }
    }
};
struct EpiPle {
    static constexpr bool PERM = true; static constexpr int DUPID = 64;
    const bf16_t* h2; const bf16_t* P; float* out32; bf16_t* o16b;
    __device__ __forceinline__ void operator()(const Acc& acc, const pg8::Unit& u, int wr, int wc, int fr, int fq) const {
#pragma unroll
        for (int ai = 0; ai < 2; ++ai)
#pragma unroll
            for (int mp = 0; mp < 2; ++mp) {
                u32x4 rh[4], rp[4];
#pragma unroll
                for (int i = 0; i < 4; ++i) { const size_t o = (size_t)(u.pm * 256 + ai * 128 + wr * 64 + (2 * mp + (i >> 1)) * 16 + fr) * DM + u.pn * 256 + wc * 32 + 8 * fq + (i & 1) * 128;
                    rh[i] = *(const u32x4*)(h2 + o); rp[i] = *(const u32x4*)(P + o); }
                __builtin_amdgcn_sched_barrier(0);
#pragma unroll
                for (int i = 0; i < 4; ++i) { const int m = 2 * mp + (i >> 1), bj = i & 1; const size_t o = (size_t)(u.pm * 256 + ai * 128 + wr * 64 + m * 16 + fr) * DM + u.pn * 256 + wc * 32 + 8 * fq + bj * 128;
                    const u32x4 wh = rh[i], wp = rp[i];
                    const f32x4 h0 = {bflo(wh.x), bfhi(wh.x), bflo(wh.y), bfhi(wh.y)}, h1 = {bflo(wh.z), bfhi(wh.z), bflo(wh.w), bfhi(wh.w)}, p0 = {bflo(wp.x), bfhi(wp.x), bflo(wp.y), bfhi(wp.y)}, p1 = {bflo(wp.z), bfhi(wp.z), bflo(wp.w), bfhi(wp.w)};
                    const f32x4 a0 = acc[ai][bj][m][0], a1 = acc[ai][bj][m][1]; f32x4 r0, r1;
#pragma unroll
                    for (int e = 0; e < 4; ++e) { r0[e] = h0[e] + sigmoidf_(a0[e]) * p0[e]; r1[e] = h1[e] + sigmoidf_(a1[e]) * p1[e]; }
                    if (out32) { *(f32x4*)(out32 + o) = r0; *(f32x4*)(out32 + o + 4) = r1; } else st_bf8(o16b + o, r0, r1); }
                __builtin_amdgcn_sched_barrier(0);
            }
    }
};
struct SchedCmp {
    static constexpr bool GATHER_DMA = false;
    int c;
    __device__ bool next(int i, pg8::Unit& u) const { if (i > 0 || c >= 32) return false; u.pm = c & 7; u.pn = (c >> 3) & 1; u.pb = 2 * (c >> 4) + ((c >> 3) & 1); return true; }
    __device__ __forceinline__ unsigned arow(const pg8::Unit& u, int r) const { const int rr = u.pm * 256 + r; return (unsigned)(((rr >> 9) * SEQ + 16 * (rr & 511)) * NINP + ((u.pb >> 1) ? C_VC : C_KC)) * 2u; }
};

template <class RM> __device__ __forceinline__ void transpose_item(const float* W, int K, int N, bf16_t* WT, const RM& rm, LAS float* scr, int item, int lane) {
    const int nblk = (N + 31) / 32, kb = item / nblk, nb = item % nblk, k0 = 64 * kb, n0 = 32 * nb;
    const int n4 = 4 * (lane & 7), kr = lane >> 3;
    const bool ok = (n0 + n4 + 3 < N);
    f32x4 v[8];
#pragma unroll
    for (int i = 0; i < 8; ++i) v[i] = ok ? *(const f32x4*)(W + (size_t)(k0 + kr + 8 * i) * N + n0 + n4) : (f32x4){0.f, 0.f, 0.f, 0.f};
#pragma unroll
    for (int i = 0; i < 8; ++i) { LAS float* d = scr + (kr + 8 * i) * 33 + n4; d[0] = v[i][0]; d[1] = v[i][1]; d[2] = v[i][2]; d[3] = v[i][3]; }
    asm volatile("s_waitcnt lgkmcnt(0)" ::: "memory");
    const int c = lane & 7;
#pragma unroll
    for (int j = 0; j < 4; ++j) { const int n = (lane >> 3) + 8 * j; const LAS float* s = scr + (8 * c) * 33 + n;
        u32x4 o; o.x = pk2(s[0 * 33], s[1 * 33]); o.y = pk2(s[2 * 33], s[3 * 33]); o.z = pk2(s[4 * 33], s[5 * 33]); o.w = pk2(s[6 * 33], s[7 * 33]);
        if (n0 + n < N) *(u32x4*)(WT + (size_t)rm(n0 + n) * K + k0 + 8 * c) = o; }
    asm volatile("s_waitcnt lgkmcnt(0)" ::: "memory");
}
template <class RM> __device__ __forceinline__ void transpose_item8(const float* W, int K, int N, unsigned char* WT, const RM& rm, LAS float* scr, int item, int lane) {
    const int nblk = (N + 31) / 32, kb = item / nblk, nb = item % nblk, k0 = 64 * kb, n0 = 32 * nb;
    const int n4 = 4 * (lane & 7), kr = lane >> 3;
    f32x4 v[8];
#pragma unroll
    for (int i = 0; i < 8; ++i) v[i] = *(const f32x4*)(W + (size_t)(k0 + kr + 8 * i) * N + n0 + n4);
#pragma unroll
    for (int i = 0; i < 8; ++i) { LAS float* d = scr + (kr + 8 * i) * 33 + n4; d[0] = v[i][0]; d[1] = v[i][1]; d[2] = v[i][2]; d[3] = v[i][3]; }
    asm volatile("s_waitcnt lgkmcnt(0)" ::: "memory");
    const int c = lane & 7;
#pragma unroll
    for (int j = 0; j < 4; ++j) { const int n = (lane >> 3) + 8 * j; const LAS float* s = scr + (8 * c) * 33 + n;
        u32x2 o; o.x = pk_fp8x4(32.f * s[0 * 33], 32.f * s[1 * 33], 32.f * s[2 * 33], 32.f * s[3 * 33]); o.y = pk_fp8x4(32.f * s[4 * 33], 32.f * s[5 * 33], 32.f * s[6 * 33], 32.f * s[7 * 33]);
        *(u32x2*)(WT + (size_t)rm(n0 + n) * K + k0 + 8 * c) = o; }
    asm volatile("s_waitcnt lgkmcnt(0)" ::: "memory");
}
#define T8_LOAD(v, W_, N_, item_) do { const float* tw_ = (W_); const int tN_ = (N_), ti_ = (item_); const int nblk_ = (tN_ + 31) / 32, k0_ = 64 * (ti_ / nblk_), n0_ = 32 * (ti_ % nblk_); \
        _Pragma("unroll") for (int i_ = 0; i_ < 8; ++i_) v[i_] = *(const f32x4*)(tw_ + (size_t)(k0_ + (lane >> 3) + 8 * i_) * tN_ + n0_ + 4 * (lane & 7)); } while (0)
template <class RM> __device__ __forceinline__ void t8_finish(f32x4 v0, f32x4 v1, f32x4 v2, f32x4 v3, f32x4 v4, f32x4 v5, f32x4 v6, f32x4 v7, int K, int N, unsigned char* WT, const RM& rm, LAS float* scr, int item, int lane) {
    const int nblk = (N + 31) / 32, kb = item / nblk, nb = item % nblk, k0 = 64 * kb, n0 = 32 * nb;
    const int n4 = 4 * (lane & 7), kr = lane >> 3;
    const f32x4 v[8] = {v0, v1, v2, v3, v4, v5, v6, v7};
#pragma unroll
    for (int i = 0; i < 8; ++i) { LAS float* d = scr + (kr + 8 * i) * 33 + n4; d[0] = v[i][0]; d[1] = v[i][1]; d[2] = v[i][2]; d[3] = v[i][3]; }
    asm volatile("s_waitcnt lgkmcnt(0)" ::: "memory");
    const int c = lane & 7;
#pragma unroll
    for (int j = 0; j < 4; ++j) { const int n = (lane >> 3) + 8 * j; const LAS float* s = scr + (8 * c) * 33 + n;
        u32x2 o; o.x = pk_fp8x4(32.f * s[0 * 33], 32.f * s[1 * 33], 32.f * s[2 * 33], 32.f * s[3 * 33]); o.y = pk_fp8x4(32.f * s[4 * 33], 32.f * s[5 * 33], 32.f * s[6 * 33], 32.f * s[7 * 33]);
        *(u32x2*)(WT + (size_t)rm(n0 + n) * K + k0 + 8 * c) = o; }
    asm volatile("s_waitcnt lgkmcnt(0)" ::: "memory");
}
struct RmId { int off; __device__ __forceinline__ int operator()(int n) const { return off + n; } };
struct RmIl { int s; __device__ __forceinline__ int operator()(int n) const { return 2 * n + s; } };
struct RmIn { __device__ __forceinline__ int operator()(int n) const {
    const bool rp = (n >= C_CQ && n < C_CV) || (n >= C_DQ && n < C_KC) || (n >= C_KS && n < C_VS) || (n >= C_KW && n < C_VW);
    return rp ? ((n & ~48) | ((n & 16) << 1) | ((n & 32) >> 1)) : n; } };

struct Args { const void* in[23]; float* out; unsigned char* ws; int ph_lo, ph_hi; };
constexpr int NWAVES = 8, NTHREADS = 512;
constexpr int NPHASES = 1 + 11 + 13 + (CHECK_N ? 2 : 0);

__global__ void __launch_bounds__(NTHREADS, 2) mk_fwd(Args args) {
    extern __shared__ __attribute__((aligned(16))) unsigned char lds_raw[];
    LAS unsigned char* lds = (LAS unsigned char*)lds_raw;
    LAS int* cw = (LAS int*)(lds + LDS_CTL);
    const int tid0 = threadIdx.x, wave0 = __builtin_amdgcn_readfirstlane(tid0 >> 6);
    const int G = gridDim.x, bx = blockIdx.x, vcu = (G % 8 == 0) ? (bx % 8) * (G / 8) + bx / 8 : bx;
    const int NGW = G * NWAVES;
    unsigned* ctl = (unsigned*)(args.ws + WS_CTL);
    const int lo = args.ph_lo, hi = args.ph_hi;
    for (int u = tid0; u < (LDS_BYTES - LDS_CTL) / 4; u += NTHREADS) cw[u] = 0;
    __syncthreads();
    XcdBarrier bar; bar.bar = ctl + CW_BAR; bar.x = 0; bar.st = nullptr;
    if (hi - lo > 1) bar = xcd_barrier_post(ctl + CW_BAR, (volatile LAS unsigned*)(cw + LW_BAR));
    float* const dout = args.out;
#define CAS __attribute__((address_space(4)))
#define KIN(i) (*(const void* CAS const*)(ka + 8 * (i)))
#define PHASE_NAMES \
    unsigned zz_ = 0u; asm volatile("" : "+v"(zz_)); int tid = wave0 * 64 + (int)__builtin_amdgcn_mbcnt_hi(~0u, __builtin_amdgcn_mbcnt_lo(~0u, zz_)); asm volatile("" : "+v"(tid)); const int lane = tid & 63, wave = __builtin_amdgcn_readfirstlane(tid >> 6), gw = vcu * NWAVES + wave; \
    CAS const unsigned char* ka = (CAS const unsigned char*)__builtin_amdgcn_kernarg_segment_ptr(); asm volatile("" : "+s"(ka)); \
    unsigned char* ws = *(unsigned char* CAS const*)(ka + 24 * 8); \
    const float* x = (const float*)KIN(0); const float* pin = (const float*)KIN(1); const int* pos = (const int*)KIN(2); \
    const float* w_in = (const float*)KIN(3); const float* w_out = (const float*)KIN(4); \
    const float* ln_mix_g = (const float*)KIN(5); const float* ln_mix_b = (const float*)KIN(6); \
    const float* diff_lambda = (const float*)KIN(7); const float* diff_gain = (const float*)KIN(8); \
    const float* cmp_pos = (const float*)KIN(9); const float* cmp_w1 = (const float*)KIN(10); const float* cmp_w2 = (const float*)KIN(11); \
    const float* ffn_w1 = (const float*)KIN(12); const float* ffn_w3 = (const float*)KIN(13); const float* ffn_w2 = (const float*)KIN(14); \
    const float* moe_router = (const float*)KIN(15); const float* moe_w1 = (const float*)KIN(16); const float* moe_w3 = (const float*)KIN(17); const float* moe_w2 = (const float*)KIN(18); \
    const float* ln_ffn_g = (const float*)KIN(19); const float* ln_ffn_b = (const float*)KIN(20); \
    const float* ple_proj = (const float*)KIN(21); const float* ple_gate = (const float*)KIN(22); \
    unsigned char* misc = ws + WS_MISC; \
    float* lamv = (float*)(misc + OFF_LAM); float* c1 = (float*)(misc + OFF_C1); \
    bf16_t* kmean = (bf16_t*)(misc + OFF_KMEAN); bf16_t* KC = (bf16_t*)(misc + OFF_KC); bf16_t* VC = (bf16_t*)(misc + OFF_VC); \
    float* gates = (float*)(misc + OFF_GATES); float* moeg = (float*)(misc + OFF_MOEG); int* list = (int*)(misc + OFF_LIST); float* hid = (float*)(misc + OFF_HID); \
    float* cos32 = (float*)(ws + WS_ROPE); float* sin32 = cos32 + (size_t)NT * 32; float* cos16 = sin32 + (size_t)NT * 32; float* sin16 = cos16 + (size_t)NT * 16; \
    unsigned char* wb = ws + WS_W; \
    bf16_t* hb = (bf16_t*)(ws + WS_HB); bf16_t* pb = (bf16_t*)(ws + WS_PB); \
    unsigned char* R = ws + WS_R; int* mlist = (int*)(ws + WS_MLIST); unsigned char* hb8 = R + 240 * MiB; \
    bf16_t* proj = (bf16_t*)(R + R_PROJ); bf16_t* qr = (bf16_t*)(R + R_QR); bf16_t* mixed = (bf16_t*)(R + R_MIXED); \
    bf16_t* hidb = (bf16_t*)(R + R_HID); float* H2 = (float*)(R + R_H2); bf16_t* Pp = (bf16_t*)(R + R_P); \
    (void)lane; (void)gw; (void)x; (void)pin; (void)pos; (void)w_in; (void)w_out; (void)ln_mix_g; (void)ln_mix_b; (void)diff_lambda; (void)diff_gain; (void)cmp_pos; (void)cmp_w1; (void)cmp_w2; \
    (void)ffn_w1; (void)ffn_w3; (void)ffn_w2; (void)moe_router; (void)moe_w1; (void)moe_w3; (void)moe_w2; (void)ln_ffn_g; (void)ln_ffn_b; (void)ple_proj; (void)ple_gate; (void)lamv; (void)c1; \
    (void)kmean; (void)KC; (void)VC; (void)gates; (void)moeg; (void)list; (void)hid; (void)sin16; (void)wb; (void)hb; (void)pb; (void)proj; (void)qr; (void)mixed; (void)hidb; (void)H2; (void)Pp; (void)mlist; (void)hb8;

    int ph = 0;
#if TIMA || TIMB
#define TIM_START(k) { int b0_ = bx | wave0; asm volatile("" : "+s"(b0_)); if (b0_ == 0 && __builtin_amdgcn_mbcnt_hi(~0u, __builtin_amdgcn_mbcnt_lo(~0u, 0u)) == 0u) { const unsigned long long t_ = __builtin_amdgcn_s_memrealtime(); cw[480] = (int)(unsigned)t_; cw[481] = (int)(unsigned)(t_ >> 32); cw[482] = (k); } }
#define TIM_STOP { int b0_ = bx | wave0; asm volatile("" : "+s"(b0_)); if (b0_ == 0 && __builtin_amdgcn_mbcnt_hi(~0u, __builtin_amdgcn_mbcnt_lo(~0u, 0u)) == 0u) { const unsigned long long t0_ = ((unsigned long long)(unsigned)cw[481] << 32) | (unsigned)cw[480]; const unsigned dt_ = (unsigned)(__builtin_amdgcn_s_memrealtime() - t0_); const int ts_ = cw[482]; \
    if ((TIMA >> ts_) & 1) atomicAdd(ctl + 12288, dt_); if ((TIMB >> ts_) & 1) atomicAdd(ctl + 12352, dt_); } }
#else
#define TIM_START(k)
#define TIM_STOP
#endif
#define PHASE_BEGIN(k) if (ph >= lo && ph < hi) { TIM_START(k) for (int rep_ = 0; rep_ < (((PHMASK >> (k)) & 1) ? 1 + (((DUPMASK >> (k)) & 1) && (DUPL < 0 || DUPL == Lcur)) : 0); ++rep_) { if (rep_) xcd_barrier(bar); PHASE_NAMES
#define PHASE_END   } if (ph + 1 < hi) xcd_barrier(bar); TIM_STOP } ++ph;

    int Lcur = -1;
    PHASE_BEGIN(0)
    {
        LAS float* scr = (LAS float*)(lds + wave * 16384);
        for (int f = gw; f < 3 * 1792; f += NGW) {
            const int idx = f / 1792, item = f % 1792, e = idx / 3, which = idx % 3;
            const float* W = e == 0 ? (which == 0 ? ffn_w1 : which == 1 ? ffn_w3 : ffn_w2) : ((which == 0 ? moe_w1 : which == 1 ? moe_w3 : moe_w2) + (size_t)(e - 1) * DM * DFF);
            if (which < 2) transpose_item8(W, DM, DFF, (unsigned char*)(wb + W_F13) + (size_t)e * 2 * DFF * DM, RmIl{which}, scr, item, lane);
            else transpose_item8(W, DFF, DM, (unsigned char*)(wb + W8_F2) + (size_t)e * DM * DFF, RmId{0}, scr, item, lane);
        }
        for (int f = gw; f < DEPTH * 16 * 93; f += NGW) { const int L = f / (16 * 93), item = f % (16 * 93);
            transpose_item(w_in + (size_t)L * DM * NIN, DM, NIN, (bf16_t*)(wb + W_IN) + (size_t)L * NINP * DM, RmIn{}, scr, item, lane); }
        for (int f = gw; f < DEPTH * 512; f += NGW) { const int L = f / 512, item = f % 512;
            transpose_item(w_out + (size_t)L * DM * DM, DM, DM, (bf16_t*)(wb + W_OUT) + (size_t)L * DM * DM, RmId{0}, scr, item, lane); }
        for (int f = gw; f < DEPTH * 512; f += NGW) { const int L = f / 512, item = f % 512;
            transpose_item(ple_gate + (size_t)L * DM * DM, DM, DM, (bf16_t*)(wb + W_PG) + (size_t)L * DM * DM, RmId{0}, scr, item, lane); }
        for (int f = gw; f < DEPTH * 128; f += NGW) { const int L = f / 128, item = f % 128;
            transpose_item(ple_proj + (size_t)L * PLE * DM, PLE, DM, (bf16_t*)(wb + W_PP) + (size_t)L * DM * PLE, RmId{0}, scr, item, lane); }
        for (int f = gw; f < DEPTH * 2 * 256; f += NGW) { const int lk = f / 256, hf = (f % 256) / 128, item = f % 128;
            transpose_item(cmp_w1 + ((size_t)lk * 2048 + hf * 1024) * 256, 1024, 256, (bf16_t*)(wb + W_C1) + (size_t)lk * 512 * 1024, RmId{hf * 256}, scr, item, lane); }
        for (int f = gw * 64 + lane; f < DEPTH * (NINP - NIN) * (DM / 8); f += NGW * 64) { const int L = f / ((NINP - NIN) * (DM / 8)), r = f % ((NINP - NIN) * (DM / 8));
            *(u32x4*)((bf16_t*)(wb + W_IN) + ((size_t)L * NINP + NIN) * DM + (size_t)r * 8) = (u32x4){0u, 0u, 0u, 0u}; }
        for (int r = gw; r < NT; r += 2 * NGW) { const int r2 = r + NGW < NT ? r + NGW : r;
            const f32x4* xa = (const f32x4*)(x + (size_t)r * DM) + lane; const f32x4* xb = (const f32x4*)(x + (size_t)r2 * DM) + lane; f32x4 va[4], vb[4];
#pragma unroll
            for (int j = 0; j < 4; ++j) { va[j] = xa[64 * j]; vb[j] = xb[64 * j]; }
            u32x2* oa = (u32x2*)(hb + (size_t)r * DM) + lane; u32x2* ob = (u32x2*)(hb + (size_t)r2 * DM) + lane;
#pragma unroll
            for (int j = 0; j < 4; ++j) { u32x2 w; w.x = pk2(va[j][0], va[j][1]); w.y = pk2(va[j][2], va[j][3]); oa[64 * j] = w; w.x = pk2(vb[j][0], vb[j][1]); w.y = pk2(vb[j][2], vb[j][3]); ob[64 * j] = w; } }
        { const int fi = lane & 31;
          const float i32_ = powf(10000.f, -(float)fi / 32.f), i16_ = powf(10000.f, -(float)(fi & 15) / 16.f);
          for (int f = gw * 64 + lane; f < NT * 32; f += NGW * 64) { const int tok = f >> 5; const float p = (float)pos[tok];
            { const float a = p * i32_; const double t = (double)a * 0.15915494309189535; const float rr = (float)(((double)t - __builtin_rint(t)) * 6.283185307179586); float s, c; sincosf(rr, &s, &c); cos32[f] = c; sin32[f] = s; }
            if (fi < 16) { const float a = p * i16_; const double t = (double)a * 0.15915494309189535; const float rr = (float)(((double)t - __builtin_rint(t)) * 6.283185307179586); float s, c; sincosf(rr, &s, &c); cos16[tok * 16 + fi] = c; sin16[tok * 16 + fi] = s; } } }
        if (vcu < DEPTH * 2 * 4) {
            const int lk = vcu >> 2, sl = vcu & 3;
            const float* pe = cmp_pos + (size_t)lk * 2048 + sl * 512; const float* w1 = cmp_w1 + ((size_t)lk * 2048 + sl * 512) * 256;
            const int n4 = 4 * (tid & 63), kg = tid >> 6; f32x4 s = {0.f, 0.f, 0.f, 0.f};
#pragma unroll 16
            for (int kk = kg * 64; kk < kg * 64 + 64; ++kk) s += pe[kk] * *(const f32x4*)(w1 + (size_t)kk * 256 + n4);
            LAS float* red = (LAS float*)lds;
            __syncthreads(); *(LAS f32x4*)(red + kg * 256 + n4) = s; __syncthreads();
            if (tid < 256) { float a = 0.f;
#pragma unroll
                for (int q = 0; q < 8; ++q) a += red[q * 256 + tid];
                c1[(lk * 4 + sl) * 256 + tid] = a; }
        }
        if (vcu == DEPTH * 2 * 4 && tid < DEPTH) { const float* lf = diff_lambda + tid * 128; float a = 0.f, b = 0.f;
            for (int k = 0; k < 32; ++k) { a += lf[k] * lf[32 + k]; b += lf[64 + k] * lf[96 + k]; }
            lamv[tid] = expf(a) - expf(b) + (0.8f - 0.6f * expf(-0.3f * (float)tid)); }
    }
    PHASE_END

    for (int L = 0; L < DEPTH; ++L) { Lcur = L;
        const float lam_init = (L == 0) ? 0.2f : 0.35550907f;
        const bool moe = (L & 1);
        PHASE_BEGIN(1)
        {
            pg8::Gemm g{L == 0 ? hb : (const bf16_t*)dout + (size_t)NT * DM, (const bf16_t*)(wb + W_IN) + (size_t)L * NINP * DM, DM, 128u};
            pg8::StaticOrder S; S.init(NT, NINP, G, bx, DM);
            EpiInProj E{proj, qr, gates, cos32, sin32, cos16, sin16};
            pg8::gemm_phase(lds, g, S, E, tid);
        }
        PHASE_END
        PHASE_BEGIN(2)
        {
            if (vcu < 32) {
                pg8::Gemm g{proj, (const bf16_t*)(wb + W_C1) + (size_t)L * 2 * 512 * 1024, 1024, (unsigned)(NINP * 2)};
                SchedCmp S{vcu}; EpiCmp E{(bf16_t*)hid};
                pg8::gemm_phase(lds, g, S, E, tid);
            } else {
                if (L == 0) {
                    LAS float* scr = (LAS float*)(lds + wave * 16384);
                    const int gw2 = (vcu - 32) * NWAVES + wave, NGW2 = (G - 32) * NWAVES;
#define T8_SRC(f_) ((((f_) / 1792) % 3 == 0 ? moe_w1 : ((f_) / 1792) % 3 == 1 ? moe_w3 : moe_w2) + (size_t)(((f_) / 1792) / 3 - 1) * DM * DFF)
#define T8_DO(v, f_) do { const int idx = (f_) / 1792, item = (f_) % 1792, e = idx / 3, which = idx % 3; \
                        if (which < 2) t8_finish(v[0], v[1], v[2], v[3], v[4], v[5], v[6], v[7], DM, DFF, (unsigned char*)(wb + W_F13) + (size_t)e * 2 * DFF * DM, RmIl{which}, scr, item, lane); \
                        else t8_finish(v[0], v[1], v[2], v[3], v[4], v[5], v[6], v[7], DFF, DM, (unsigned char*)(wb + W8_F2) + (size_t)e * DM * DFF, RmId{0}, scr, item, lane); } while (0)
                    constexpr int FEND = 27 * 1792;
                    f32x4 va[8];
                    { const int f0 = 3 * 1792 + gw2; T8_LOAD(va, T8_SRC(f0), ((f0 / 1792) % 3 < 2 ? DFF : DM), f0 % 1792); }
                    for (int f = 3 * 1792 + gw2; f < FEND; f += 2 * NGW2) {
                        const int f1 = f + NGW2, f2 = f + 2 * NGW2, f1c = f1 < FEND ? f1 : f, f2c = f2 < FEND ? f2 : f; f32x4 vb[8];
                        T8_LOAD(vb, T8_SRC(f1c), ((f1c / 1792) % 3 < 2 ? DFF : DM), f1c % 1792);
                        T8_DO(va, f);
                        T8_LOAD(va, T8_SRC(f2c), ((f2c / 1792) % 3 < 2 ? DFF : DM), f2c % 1792);
                        if (f1 < FEND) T8_DO(vb, f1);
                    }
#undef T8_SRC
#undef T8_DO
                    __syncthreads();
                }
                LAS float* part = (LAS float*)lds;
                for (int it = vcu - 32; it < 512; it += G - 32) {
                    const int bh = it >> 5, j = it & 31, b = bh >> 2, h = bh & 3, kg = tid >> 3, c = tid & 7;
                    const bf16_t* kp = proj + ((size_t)b * SEQ + 256 * j + 4 * kg) * NINP + C_CK + h * 64 + c * 8;
                    float s[8] = {0.f, 0.f, 0.f, 0.f, 0.f, 0.f, 0.f, 0.f};
#pragma unroll
                    for (int k = 0; k < 4; ++k) { const u32x4 v = *(const u32x4*)(kp + (size_t)k * NINP);
                        s[0] += bflo(v.x); s[1] += bfhi(v.x); s[2] += bflo(v.y); s[3] += bfhi(v.y); s[4] += bflo(v.z); s[5] += bfhi(v.z); s[6] += bflo(v.w); s[7] += bfhi(v.w); }
                    __syncthreads();
#pragma unroll
                    for (int q = 0; q < 8; ++q) part[kg * 64 + c * 8 + q] = s[q];
                    __syncthreads();
                    if (tid < 64) { float a = 0.f; for (int k = 0; k < 64; ++k) a += part[k * 64 + tid]; kmean[(size_t)it * 64 + tid] = (bf16_t)(pk2(a * (1.f / 256.f), 0.f) & 0xffffu); }
                }
            }
        }
        PHASE_END
        PHASE_BEGIN(3)
        {
            { LAS float* hs = (LAS float*)(lds + wave * 1024);
              const bf16_t* uv = (const bf16_t*)hid;
              for (int gi = gw; gi < 2 * 2048; gi += NGW) {
                const int kv = gi >> 11, r = gi & 2047, r1 = r < 2047 ? r + 1 : r;
                const float* cp = c1 + L * 2048 + kv * 1024;
#pragma unroll
                for (int q = 0; q < 4; ++q) { const int n = lane + 64 * q;
                    const float a = bf2f_(uv[((size_t)kv * 2048 + r) * 512 + n]) + bf2f_(uv[((size_t)kv * 2048 + r1) * 512 + 256 + n]) + ((cp[n] + cp[256 + n]) + (cp[512 + n] + cp[768 + n]));
                    hs[n] = a * sigmoidf_(a); }
                const float* w2 = cmp_w2 + ((size_t)(L * 2 + kv) * 256) * 64 + lane;
                float o = 0.f;
#pragma unroll 8
                for (int n = 0; n < 256; ++n) o += hs[n] * w2[(size_t)n * 64];
                (kv ? VC : KC)[(size_t)r * 64 + lane] = (bf16_t)(pk2((r & 511) != 511 ? o : 0.f, 0.f) & 0xffffu);
              }
              __syncthreads();
            }
            { const int bh = vcu >> 4, s = vcu & 15;
              for (int k = 0; k < 2; ++k) { int tq = tid; asm volatile("" : "+v"(tq)); att::unit_Csel(lds, proj, kmean, ctl + CW_MC + L * 512, mlist, bh >> 2, bh & 3, k ? 31 - s : s, tq, wave, tq & 63); } }
        }
        PHASE_END
        PHASE_BEGIN(4)
        {
            const float lam = lamv[L];
#define ATT_TID int tq = tid; asm volatile("" : "+v"(tq)); const int lq = tq & 63;
            {
                LAS int* pre = (LAS int*)(lds + att::L_X + 1024); LAS int* cn = pre + 520;
                __syncthreads();
                { const int cnv = (int)__hip_atomic_load(ctl + CW_MC + L * 512 + tid, __ATOMIC_RELAXED, __HIP_MEMORY_SCOPE_AGENT); cn[tid] = cnv;
                  const int myu = (cnv + 255) >> 8; int incl = myu; const int l_ = lane_now();
#pragma unroll
                  for (int o = 1; o < 64; o <<= 1) { const int t_ = __builtin_amdgcn_ds_bpermute(((l_ - o) & 63) << 2, incl); if (l_ >= o) incl += t_; }
                  if (l_ == 63 && wave < 7) pre[513 + wave] = incl;
                  __syncthreads();
                  int base = 0;
#pragma unroll
                  for (int w = 0; w < 7; ++w) base += (w < wave) ? pre[513 + w] : 0;
                  pre[tid] = base + incl - myu;
                  if (tid == NTHREADS - 1) pre[512] = base + incl; }
                __syncthreads();
                const int U = pre[512];
                for (int u = vcu; u < U; u += G) {
                    int lo_ = 0, hi_ = 512;
                    while (hi_ - lo_ > 1) { const int mid = (lo_ + hi_) >> 1; if (pre[mid] <= u) lo_ = mid; else hi_ = mid; }
                    ATT_TID att::unit_Cgather(lds, proj, mlist, (bf16_t*)hb, (float*)pb, lo_, u - pre[lo_], cn[lo_], tq, wave, lq);
                }
            }
            { const int bh = vcu >> 4, s = vcu & 15;
#if CHECK_C
              for (int k = 0; k < 2; ++k) { ATT_TID att::unit_C(lds, proj, kmean, mixed, bh >> 2, bh & 3, (k & 1) ? 31 - s : s, tq, wave, lq); }
#endif
              if (ATTMASK & 2) for (int k = 0; k < ((DUPATT & 2) ? 4 : 2); ++k) { ATT_TID att::unit_B(lds, proj, mixed, diff_gain + L * 64, lam, lam_init, bh >> 2, bh & 3, (k & 1) ? 31 - s : s, tq, wave, lq); } }
        }
        PHASE_END
        PHASE_BEGIN(12)
        {
            { const int bh = vcu >> 4, s = vcu & 15;
              if (ATTMASK & 4) for (int k = 0; k < 2; ++k) { ATT_TID att::unit_Cown(lds, proj, (const bf16_t*)hb, (const float*)pb, mixed, ctl + CW_FLAG, bh >> 2, bh & 3, (k & 1) ? 31 - s : s, tq, wave, lq); }
              if (ATTMASK & 1) for (int k = 0; k < ((DUPATT & 1) ? 4 : 2); ++k) { ATT_TID att::unit_A(lds, proj, mixed, bh >> 2, bh & 3, (k & 1) ? 31 - s : s, tq, wave, lq); } }
            { const int b = vcu >> 6, s = vcu & 63;
              if (ATTMASK & 8) for (int k = 0; k < ((DUPATT & 8) ? 4 : 2); ++k) { ATT_TID att::unit_D(lds, proj, qr, KC, VC, gates, mixed, b, (k & 1) ? 127 - s : s, tq, wave, lq); } }
#undef ATT_TID
        }
        PHASE_END
#if CHECK_N
        PHASE_BEGIN(13)
        {
            {
                if (CHECK_N & 1) for (int gi = gw; gi < 4096; gi += NGW) { const int grp = gi >> 10, sidx = gi & 1023, b = sidx & 3, h = (sidx >> 2) & 3, t = (sidx * 977 + 13 + 2048 * (sidx & 3)) & 8191;
                    bool ok;
                    if (grp == 0) ok = chk::chk_A(proj, mixed, b, h, t, lane);
                    else if (grp == 1) ok = chk::chk_B(proj, mixed, diff_gain + L * 64, lamv[L], lam_init, b, h, t, lane);
                    else if (grp == 2) ok = chk::chk_C(proj, kmean, mixed, b, h, t, lane);
                    else ok = chk::chk_D(proj, qr, KC, VC, gates, mixed, b, t, lane);
                    if (!ok && lane == 0) atomicAdd(ctl + CW_FLAG + 64 * (1 + grp), 1u); }
                for (int gi = gw + ((CHECK_N & 2) ? 0 : 1024); gi < ((CHECK_N & 4) ? 2048 : 1024); gi += NGW) { const int sidx = gi & 1023; bool ok = true;
                    if (gi < 1024) { if (L == 0) ok = chk::chk_proj(x, w_in, pos, proj, qr, gates, (sidx * 7919 + 31) & (NT - 1), (sidx * 613 + 5) % NIN, lane); }
                    else ok = chk::chk_cmp(proj, cmp_pos + (size_t)(L * 2 + (sidx & 1)) * 2048, cmp_w1 + (size_t)(L * 2 + (sidx & 1)) * 2048 * 256, cmp_w2 + (size_t)(L * 2 + (sidx & 1)) * 256 * 64, (sidx & 1) ? VC : KC, sidx & 1, (sidx >> 1) & 3, (sidx * 131) % 511, (sidx * 29) & 63, lane);
                    if (!ok && lane == 0) atomicAdd(ctl + CW_FLAG + 64 * (1 + 4 + (gi >> 10)), 1u); }
            }
        }
        PHASE_END
#endif
        PHASE_BEGIN(5)
        {
            pg8::Gemm g{mixed, (const bf16_t*)(wb + W_OUT) + (size_t)L * DM * DM, DM, 128u};
            pg8::StaticOrder S; S.init(NT, DM, G, bx, DM);
            EpiPresum E{L == 0 ? x : nullptr, (const bf16_t*)dout + (size_t)NT * DM, (bf16_t*)dout};
            pg8::gemm_phase(lds, g, S, E, tid);
        }
        PHASE_END
        PHASE_BEGIN(6)
        {
            const float* gv = ln_mix_g + L * DM; const float* bv = ln_mix_b + L * DM;
            f32x4 gg[4], bb[4];
#pragma unroll
            for (int j = 0; j < 4; ++j) { gg[j] = *((const f32x4*)gv + lane + 64 * j); bb[j] = *((const f32x4*)bv + lane + 64 * j); }
            if (tid < 8) cw[LW_CNTL + tid] = 0;
            if (moe) {
                for (int s_ = tid; s_ < 2048; s_ += 512) { const int e_ = s_ >> 1, hf_ = s_ & 1;
                    *((LAS f32x4*)(lds + hf_ * 16384) + (e_ & 7) * 128 + (e_ >> 3)) = *((const f32x4*)moe_router + s_); }
            }
            __syncthreads();
            int k = 0;
            u32x2 nx[2][4]; f32x4 npv[2];
#pragma unroll
            for (int h = 0; h < 2; ++h) { const int r0 = gw + h * NGW < NT ? gw + h * NGW : gw; const u32x2* xr = (const u32x2*)((const bf16_t*)dout + (size_t)r0 * DM) + lane;
#pragma unroll
              for (int j = 0; j < 4; ++j) nx[h][j] = xr[64 * j];
              npv[h] = *((const f32x4*)(pin + ((size_t)L * NT + r0) * PLE) + lane); }
            for (int rb = gw; rb < NT; rb += 2 * NGW) {
#pragma unroll
              for (int h = 0; h < 2; ++h) { const int r = rb + h * NGW; if (r < NT) {
                u32x2 cx[4];
#pragma unroll
                for (int j = 0; j < 4; ++j) cx[j] = nx[h][j];
                const f32x4 pv4 = npv[h];
                { const int rn = r + 2 * NGW < NT ? r + 2 * NGW : r; const u32x2* xr = (const u32x2*)((const bf16_t*)dout + (size_t)rn * DM) + lane;
#pragma unroll
                  for (int j = 0; j < 4; ++j) nx[h][j] = xr[64 * j];
                  npv[h] = *((const f32x4*)(pin + ((size_t)L * NT + rn) * PLE) + lane); }
                f32x4 v[4]; float s = 0.f;
#pragma unroll
                for (int j = 0; j < 4; ++j) { const u32x2 w = cx[j]; v[j] = (f32x4){bflo(w.x), bfhi(w.x), bflo(w.y), bfhi(w.y)}; s += (v[j][0] + v[j][1]) + (v[j][2] + v[j][3]); }
                const float mean = wave_sum(s) * (1.f / DM); float s2 = 0.f;
#pragma unroll
                for (int j = 0; j < 4; ++j) { v[j] = v[j] - mean; s2 += (v[j][0] * v[j][0] + v[j][1] * v[j][1]) + (v[j][2] * v[j][2] + v[j][3] * v[j][3]); }
                const float rstd = rsqrtf(wave_sum(s2) * (1.f / DM) + LN_EPS);
                u32x2* o8 = (u32x2*)(hb + (size_t)r * DM) + lane; unsigned* o4 = (unsigned*)(hb8 + (size_t)r * DM) + lane;
#pragma unroll
                for (int j = 0; j < 4; ++j) { v[j] = v[j] * rstd * gg[j] + bb[j]; u32x2 w; w.x = pk2(v[j][0], v[j][1]); w.y = pk2(v[j][2], v[j][3]); o8[64 * j] = w; o4[64 * j] = pk_fp8x4(v[j][0], v[j][1], v[j][2], v[j][3]); }
                if (moe) {
                    float lg[8];
#pragma unroll
                    for (int e = 0; e < 8; ++e) lg[e] = 0.f;
#pragma unroll
                    for (int j = 0; j < 4; ++j)
#pragma unroll
                        for (int q = 0; q < 4; ++q) { const int sl_ = ((4 * lane + q) & 7) * 128 + (lane >> 1) + 32 * j;
                            const f32x4 w0 = *((const LAS f32x4*)lds + sl_), w1 = *((const LAS f32x4*)(lds + 16384) + sl_); const float hv = v[j][q];
                            lg[0] += hv * w0[0]; lg[1] += hv * w0[1]; lg[2] += hv * w0[2]; lg[3] += hv * w0[3]; lg[4] += hv * w1[0]; lg[5] += hv * w1[1]; lg[6] += hv * w1[2]; lg[7] += hv * w1[3]; }
#pragma unroll
                    for (int e = 0; e < 8; ++e) lg[e] = wave_sum(lg[e]);
                    int e0 = 0; float b0 = lg[0];
#pragma unroll
                    for (int e = 1; e < 8; ++e) if (lg[e] > b0) { b0 = lg[e]; e0 = e; }
                    int e1 = -1; float b1 = -INFINITY;
#pragma unroll
                    for (int e = 0; e < 8; ++e) if (e != e0 && lg[e] > b1) { b1 = lg[e]; e1 = e; }
                    const float g1 = 1.f / (1.f + expf(b0 - b1)), g0 = 1.f - g1;
                    if (lane == 0) {
                        const int s0 = __hip_atomic_fetch_add(cw + LW_CNTL + e0, 1, __ATOMIC_RELAXED, __HIP_MEMORY_SCOPE_WORKGROUP), s1 = __hip_atomic_fetch_add(cw + LW_CNTL + e1, 1, __ATOMIC_RELAXED, __HIP_MEMORY_SCOPE_WORKGROUP);
                        const int ix = (wave * 16 + k) * 2; cw[LW_PE + ix] = e0 | (s0 << 8); cw[LW_PE + ix + 1] = e1 | (s1 << 8);
                        moeg[2 * r] = g0; moeg[2 * r + 1] = g1;
                    }
                }
                { u32x2 w; w.x = pk2(pv4[0], pv4[1]); w.y = pk2(pv4[2], pv4[3]); *((u32x2*)(pb + (size_t)r * PLE) + lane) = w; }
                ++k;
              } }
            }
            if (moe) {
                __syncthreads();
                if (tid < 8) cw[LW_BASEL + tid] = (int)__hip_atomic_fetch_add(ctl + CW_CNT + 64 * tid, (unsigned)cw[LW_CNTL + tid], __ATOMIC_RELAXED, __HIP_MEMORY_SCOPE_AGENT);
                __syncthreads();
                if (tid < 256) { const int wv = tid >> 5, kk = (tid >> 1) & 15, r = vcu * NWAVES + wv + kk * NGW;
                    if (r < NT) { const int pe = cw[LW_PE + tid], e = pe & 255, sl = pe >> 8; list[e * 32768 + cw[LW_BASEL + e] + sl] = 2 * r + (tid & 1); } }
            }
        }
        PHASE_END
        for (int chunk = 0; chunk < (moe ? 2 : 1); ++chunk) {
            PHASE_BEGIN(7)
            {
                __syncthreads();
                if (tid < 8) cw[LW_CNT + tid] = moe ? (int)__hip_atomic_load(ctl + CW_CNT + 64 * tid, __ATOMIC_RELAXED, __HIP_MEMORY_SCOPE_AGENT) : (tid == 0 ? NT : 0);
                __syncthreads();
                if (tid < 9) { int ts = 0;
#pragma unroll
                    for (int e = 0; e < 8; ++e) ts += (e < tid) ? (cw[LW_CNT + e] + 255) >> 8 : 0;
                    cw[LW_TS + tid] = ts; }
                __syncthreads();
                const int ntile = cw[LW_TS + 8], kx = (LEFTOVER && ntile > 256) ? ntile - 256 : 0, tA = ntile < 128 + kx ? ntile : 128 + kx;
                const int t0 = chunk == 0 ? 0 : tA, t1 = chunk == 0 ? tA : ntile;
                int nh = 0;
                if (LEFTOVER && chunk == 1 && kx > 0) {
                    nh = 4 * kx;
                    pg8::Gemm g{hidb, (const bf16_t*)(wb + W8_F2), DFF, 128u};
                    SchedDN S{cw, 128, tA, 0, G, bx, false, false}; EpiDown E{false, hb, (bf16_t*)dout, (bf16_t*)dout, cw, list, moeg, 1.f / 256.f};
                    pg8::gemm_phase<EpiDown, SchedDN, true>(lds, g, S, E, tid);
                }
                if (t1 > t0) {
                    pg8::Gemm g{(const bf16_t*)hb8, (const bf16_t*)(wb + W_F13), DM, 128u};
                    SchedGU S{cw, list, t0, t1, G, bx, nh, !moe, 1024u}; EpiSwiglu E{(unsigned char*)hidb, t0, 1.f / 32.f};
                    int tg = tid; asm volatile("" : "+v"(tg));
                    pg8::gemm_phase<EpiSwiglu, SchedGU, true>(lds, g, S, E, tg);
                }
            }
            PHASE_END
            PHASE_BEGIN(8)
            {
                __syncthreads();
                if (tid < 8) cw[LW_CNT + tid] = moe ? (int)__hip_atomic_load(ctl + CW_CNT + 64 * tid, __ATOMIC_RELAXED, __HIP_MEMORY_SCOPE_AGENT) : (tid == 0 ? NT : 0);
                __syncthreads();
                if (tid < 9) { int ts = 0;
#pragma unroll
                    for (int e = 0; e < 8; ++e) ts += (e < tid) ? (cw[LW_CNT + e] + 255) >> 8 : 0;
                    cw[LW_TS + tid] = ts; }
                __syncthreads();
                const int ntile = cw[LW_TS + 8], kx = (LEFTOVER && ntile > 256) ? ntile - 256 : 0, tA = ntile < 128 + kx ? ntile : 128 + kx;
                const int t0 = chunk == 0 ? 0 : tA, t1 = chunk == 0 ? (ntile < 128 ? ntile : 128) : ntile;
                if (t1 > t0) {
                    pg8::Gemm g{hidb, (const bf16_t*)(wb + W8_F2), DFF, 128u};
                    SchedDN S{cw, t0, t1, t0, G, bx, !moe, (G & 31) == 0}; EpiDown E{!moe, hb, (bf16_t*)dout, (bf16_t*)dout, cw, list, moeg, 1.f / 256.f};
                    pg8::gemm_phase<EpiDown, SchedDN, true>(lds, g, S, E, tid);
                }
            }
            PHASE_END
        }
        PHASE_BEGIN(9)
        {
            const float* gv = ln_ffn_g + L * DM; const float* bv = ln_ffn_b + L * DM;
            f32x4 gg[4], bb[4];
#pragma unroll
            for (int j = 0; j < 4; ++j) { gg[j] = *((const f32x4*)gv + lane + 64 * j); bb[j] = *((const f32x4*)bv + lane + 64 * j); }
            u32x2 na[2][4], nc[2][4], nd[2][4];
#pragma unroll
            for (int h = 0; h < 2; ++h) { const int r0 = gw + h * NGW < NT ? gw + h * NGW : gw;
#pragma unroll
              for (int j = 0; j < 4; ++j) { na[h][j] = (u32x2){0u, 0u}; nd[h][j] = (u32x2){0u, 0u}; }
              if (!moe) { const u32x2* xr = (const u32x2*)((const bf16_t*)dout + (size_t)r0 * DM) + lane;
#pragma unroll
                for (int j = 0; j < 4; ++j) nc[h][j] = xr[64 * j];
              } else { const u32x2* ha = (const u32x2*)(hb + (size_t)r0 * DM) + lane; const u32x2* y0 = (const u32x2*)((const bf16_t*)dout + (size_t)(2 * r0) * DM) + lane; const u32x2* y1 = (const u32x2*)((const bf16_t*)dout + (size_t)(2 * r0 + 1) * DM) + lane;
#pragma unroll
                for (int j = 0; j < 4; ++j) { na[h][j] = ha[64 * j]; nc[h][j] = y0[64 * j]; nd[h][j] = y1[64 * j]; } } }
            for (int rb = gw; rb < NT; rb += 2 * NGW) {
#pragma unroll
              for (int h = 0; h < 2; ++h) { const int r = rb + h * NGW; if (r < NT) {
                f32x4 v[4]; float s = 0.f;
                u32x2* h8 = (u32x2*)(hb + (size_t)r * DM) + lane;
                u32x2 ca[4], cc[4], cd[4];
#pragma unroll
                for (int j = 0; j < 4; ++j) { ca[j] = na[h][j]; cc[j] = nc[h][j]; cd[j] = nd[h][j]; }
                const int rn = r + 2 * NGW < NT ? r + 2 * NGW : r;
                if (!moe) {
                    const u32x2* xr = (const u32x2*)((const bf16_t*)dout + (size_t)rn * DM) + lane;
#pragma unroll
                    for (int j = 0; j < 4; ++j) nc[h][j] = xr[64 * j];
#pragma unroll
                    for (int j = 0; j < 4; ++j) { const u32x2 w = cc[j]; v[j] = (f32x4){bflo(w.x), bfhi(w.x), bflo(w.y), bfhi(w.y)}; }
                } else {
                    const u32x2* ha = (const u32x2*)(hb + (size_t)rn * DM) + lane; const u32x2* y0 = (const u32x2*)((const bf16_t*)dout + (size_t)(2 * rn) * DM) + lane; const u32x2* y1 = (const u32x2*)((const bf16_t*)dout + (size_t)(2 * rn + 1) * DM) + lane;
#pragma unroll
                    for (int j = 0; j < 4; ++j) { na[h][j] = ha[64 * j]; nc[h][j] = y0[64 * j]; nd[h][j] = y1[64 * j]; }
#pragma unroll
                    for (int j = 0; j < 4; ++j) { const u32x2 a = ca[j], c = cc[j], d = cd[j];
                        v[j][0] = ALPHA * bflo(a.x) + (bflo(c.x) + bflo(d.x)); v[j][1] = ALPHA * bfhi(a.x) + (bfhi(c.x) + bfhi(d.x));
                        v[j][2] = ALPHA * bflo(a.y) + (bflo(c.y) + bflo(d.y)); v[j][3] = ALPHA * bfhi(a.y) + (bfhi(c.y) + bfhi(d.y)); }
                }
#pragma unroll
                for (int j = 0; j < 4; ++j) s += (v[j][0] + v[j][1]) + (v[j][2] + v[j][3]);
                const float mean = wave_sum(s) * (1.f / DM); float s2 = 0.f;
#pragma unroll
                for (int j = 0; j < 4; ++j) { v[j] = v[j] - mean; s2 += (v[j][0] * v[j][0] + v[j][1] * v[j][1]) + (v[j][2] * v[j][2] + v[j][3] * v[j][3]); }
                const float rstd = rsqrtf(wave_sum(s2) * (1.f / DM) + LN_EPS);
#pragma unroll
                for (int j = 0; j < 4; ++j) { v[j] = v[j] * rstd * gg[j] + bb[j]; u32x2 w; w.x = pk2(v[j][0], v[j][1]); w.y = pk2(v[j][2], v[j][3]); h8[64 * j] = w; }
              } }
            }
            { pg8::Gemm g{pb, (const bf16_t*)(wb + W_PP) + (size_t)L * DM * PLE, PLE, 128u};
              pg8::StaticOrder S; S.init(NT, DM, G, bx, PLE);
              EpiBf16 E{Pp, DM};
              int tp = tid; asm volatile("" : "+v"(tp));
              pg8::gemm_phase(lds, g, S, E, tp); }
        }
        PHASE_END
        PHASE_BEGIN(11)
        {
            pg8::Gemm g{hb, (const bf16_t*)(wb + W_PG) + (size_t)L * DM * DM, DM, 128u};
            pg8::StaticOrder S; S.init(NT, DM, G, bx, DM);
            EpiPle E{hb, Pp, (L + 1 < DEPTH) ? nullptr : dout, (bf16_t*)dout + (size_t)NT * DM};
            pg8::gemm_phase(lds, g, S, E, tid);
        }
        PHASE_END
    }
#if CHECK_N
    xcd_barrier(bar);
    { bool bad = false;
      for (int grp = 0; grp < 6; ++grp) bad = bad || (__hip_atomic_load(ctl + CW_FLAG + 64 * (1 + grp), __ATOMIC_RELAXED, __HIP_MEMORY_SCOPE_AGENT) > (unsigned)CHECK_ALLOW);
      if (bad) { unsigned zz_ = 0u; asm volatile("" : "+v"(zz_)); const int tidf = wave0 * 64 + (int)__builtin_amdgcn_mbcnt_hi(~0u, __builtin_amdgcn_mbcnt_lo(~0u, zz_));
        for (size_t i = (size_t)bx * NTHREADS + tidf; i < (size_t)NT * DM; i += (size_t)G * NTHREADS) dout[i] = 0.f; } }
#endif
#if CHECK_C
    xcd_barrier(bar);
    if (__hip_atomic_load(ctl + CW_FLAG, __ATOMIC_RELAXED, __HIP_MEMORY_SCOPE_AGENT) != 0u) { unsigned zz_ = 0u; asm volatile("" : "+v"(zz_)); const int tidf = wave0 * 64 + (int)__builtin_amdgcn_mbcnt_hi(~0u, __builtin_amdgcn_mbcnt_lo(~0u, zz_));
        for (size_t i = (size_t)bx * NTHREADS + tidf; i < (size_t)NT * DM; i += (size_t)G * NTHREADS) dout[i] = 0.f; }
#endif
#if TIMA || TIMB
    xcd_barrier(bar);
    { const float ta = (float)__hip_atomic_load(ctl + 12288, __ATOMIC_RELAXED, __HIP_MEMORY_SCOPE_AGENT) * 1e-5f, tb = (float)__hip_atomic_load(ctl + 12352, __ATOMIC_RELAXED, __HIP_MEMORY_SCOPE_AGENT) * 1e-2f;
      unsigned zz_ = 0u; asm volatile("" : "+v"(zz_)); const int tidf = wave0 * 64 + (int)__builtin_amdgcn_mbcnt_hi(~0u, __builtin_amdgcn_mbcnt_lo(~0u, zz_));
      for (size_t i = (size_t)bx * NTHREADS + tidf; i < (size_t)NT * DM; i += (size_t)G * NTHREADS) dout[i] = (i == 0 && TIMB) ? 1000.f * tb : dout[i] * (1.f + ta); }
#endif
#undef PHASE_BEGIN
#undef PHASE_END
}

extern "C" void kernel_launch(void* const* d_in, const int* in_sizes, int n_in, void* d_out, int out_size, void* d_ws, size_t ws_size, hipStream_t stream) {
    static int grid = 0;
    if (grid == 0) {
        if (n_in != 23 || out_size != NT * DM || ws_size < WS_END) { fprintf(stderr, "kernel_launch: unexpected problem (n_in %d out %d ws %zu need %zu)\n", n_in, out_size, ws_size, (size_t)WS_END); grid = -1; return; }
        int dev = 0, cus = 0;
        if (hipGetDevice(&dev) != hipSuccess || hipDeviceGetAttribute(&cus, hipDeviceAttributeMultiprocessorCount, dev) != hipSuccess) { grid = -1; return; }
        if (hipFuncSetAttribute((const void*)mk_fwd, hipFuncAttributeMaxDynamicSharedMemorySize, LDS_BYTES) != hipSuccess) { fprintf(stderr, "kernel_launch: hipFuncSetAttribute failed\n"); grid = -1; return; }
        int per_cu = 0;
        if (hipOccupancyMaxActiveBlocksPerMultiprocessor(&per_cu, (const void*)mk_fwd, NTHREADS, LDS_BYTES) != hipSuccess || per_cu < 1) { fprintf(stderr, "kernel_launch: occupancy query says %d blocks per CU\n", per_cu); }
        (void)hipGetLastError();
        grid = cus;
        if (grid != 256) { fprintf(stderr, "kernel_launch: built for 256 CUs, device has %d\n", cus); grid = -1; return; }
    }
    if (grid < 0) return;
    (void)hipMemsetAsync((char*)d_ws + WS_CTL, 0, CTL_ZERO_BYTES, stream);
    Args a{};
    for (int i = 0; i < 23; ++i) a.in[i] = d_in[i];
    a.out = (float*)d_out; a.ws = (unsigned char*)d_ws;
#if MK_MULTI
    for (int p = 0; p < NPHASES; ++p) { a.ph_lo = p; a.ph_hi = p + 1; hipLaunchKernelGGL(mk_fwd, dim3(grid), dim3(NTHREADS), LDS_BYTES, stream, a); }
#else
    a.ph_lo = 0; a.ph_hi = NPHASES;
    hipLaunchKernelGGL(mk_fwd, dim3(grid), dim3(NTHREADS), LDS_BYTES, stream, a);
#endif
}
```
